# Optimizing an MI355X kernel written in HIP

```python
import math
import jax, jax.numpy as jnp
from jax import lax
import numpy as np

D_MODEL = 1024
BATCH = 16
SEQ = 2048
DEPTH = 1

HEAD_DIM = 64
A_Q_HEADS = 8
A_KV_HEADS = 2
B_DILATION_GROUPS = ((128, 1), (512, 4), (2048, 16))
B_HEADS_PER_GROUP = 4
B_HEADS = B_HEADS_PER_GROUP * len(B_DILATION_GROUPS)
GRID_W = 64
A_ROPE_THETA = 10000.0
PARTIAL_ROPE_THETA = 500000.0
PARTIAL_ROPE_DIMS = HEAD_DIM // 4
N_EXPERTS = 16
EC_CAPACITY_FACTOR = 2
D_FF_EXPERT = 2 * D_MODEL
Q_BLOCK = 128
LN_EPS = 1e-5
QK_NORM_EPS = 1e-6
MASK_VALUE = -1e30
DEEPNORM_ALPHA = (2.0 * DEPTH) ** 0.25
DEEPNORM_BETA = (8.0 * DEPTH) ** -0.25

A_Q_W = A_Q_HEADS * HEAD_DIM
A_KV_W = A_KV_HEADS * HEAD_DIM
B_W = B_HEADS * HEAD_DIM
B_OUT_W = B_HEADS_PER_GROUP * HEAD_DIM
IN_WIDTHS = (A_Q_W, A_KV_W, A_KV_W, B_W, B_W, B_W, D_MODEL, D_MODEL)
IN_TOTAL = sum(IN_WIDTHS)

kernel_name = "hybrid_gqa_dilated_ec_moe_encoder"


def layer_norm(x, g, b):
    xf = x.astype(jnp.float32)
    mu = jnp.mean(xf, axis=-1, keepdims=True)
    var = jnp.mean(jnp.square(xf - mu), axis=-1, keepdims=True)
    return ((xf - mu) * lax.rsqrt(var + LN_EPS) * g.astype(jnp.float32) + b.astype(jnp.float32)).astype(x.dtype)


def rms_norm(x, g):
    xf = x.astype(jnp.float32)
    y = xf * lax.rsqrt(jnp.mean(xf * xf, axis=-1, keepdims=True) + QK_NORM_EPS)
    return (y * g.astype(jnp.float32)).astype(x.dtype)


def rope_angles(pos, dim, theta):
    inv_freq = theta ** (-jnp.arange(0, dim, 2, dtype=jnp.float32) / dim)
    return pos.astype(jnp.float32)[:, None] * inv_freq[None, :]


def apply_rotary(x, ang):
    half = x.shape[-1] // 2
    cos = jnp.cos(ang)[None, :, None, :]
    sin = jnp.sin(ang)[None, :, None, :]
    x1 = x[..., :half].astype(jnp.float32)
    x2 = x[..., half:].astype(jnp.float32)
    return jnp.concatenate([x1 * cos - x2 * sin, x2 * cos + x1 * sin], axis=-1).astype(x.dtype)


def gqa_blocked(q, k, v):
    B, S, Hq, dh = q.shape
    Hkv = k.shape[2]
    G = Hq // Hkv
    nblk = S // Q_BLOCK
    scale = dh ** -0.5
    qb = q.reshape(B, nblk, Q_BLOCK, Hkv, G, dh).transpose(1, 0, 2, 3, 4, 5)

    def one_block(qblk):
        s = jnp.einsum('bqkgd,bskd->bkgqs', qblk, k, preferred_element_type=jnp.float32) * scale
        p = jax.nn.softmax(s, axis=-1).astype(v.dtype)
        return jnp.einsum('bkgqs,bskd->bqkgd', p, v)

    o = lax.map(one_block, qb)
    return o.transpose(1, 0, 2, 3, 4, 5).reshape(B, S, Hq * dh)


def dilated_band_attention(q, k, v, window, dilation):
    B, S, H, dh = q.shape
    half = window // (2 * dilation)
    n = S // dilation
    Qb = half
    nb = -(-n // Qb)
    pad_end = nb * Qb - n
    scale = dh ** -0.5

    def split(t):
        return t.reshape(B, n, dilation, H, dh).transpose(0, 2, 1, 3, 4)

    qs = jnp.pad(split(q), ((0, 0), (0, 0), (0, pad_end), (0, 0), (0, 0)))
    qs = qs.reshape(B, dilation, nb, Qb, H, dh)

    def key_blocks(t):
        tp = jnp.pad(split(t), ((0, 0), (0, 0), (Qb, pad_end + Qb), (0, 0), (0, 0)))
        tp = tp.reshape(B, dilation, nb + 2, Qb, H, dh)
        return jnp.concatenate([tp[:, :, :-2], tp[:, :, 1:-1], tp[:, :, 2:]], axis=3)

    ks = key_blocks(k)
    vs = key_blocks(v)
    a = jnp.arange(Qb)
    c = jnp.arange(3 * Qb)
    blk = jnp.arange(nb)
    rel = c[None, :] - Qb - a[:, None]
    key_idx = blk[:, None] * Qb + c[None, :] - Qb
    valid = (key_idx >= 0) & (key_idx < n)
    mask = (jnp.abs(rel) <= half)[None, :, :] & valid[:, None, :]

    s = jnp.einsum('brnqhd,brnkhd->brnhqk', qs, ks, preferred_element_type=jnp.float32) * scale
    s = jnp.where(mask[None, None, :, None, :, :], s, MASK_VALUE)
    lse = jax.nn.logsumexp(s, axis=-1)
    p = jnp.exp(s - lse[..., None]).astype(v.dtype)
    o = jnp.einsum('brnhqk,brnkhd->brnqhd', p, vs)
    o = o.reshape(B, dilation, nb * Qb, H, dh)[:, :, :n]
    o = o.transpose(0, 2, 1, 3, 4).reshape(B, S, H, dh)
    lse = lse.transpose(0, 1, 2, 4, 3).reshape(B, dilation, nb * Qb, H)[:, :, :n]
    lse = lse.transpose(0, 2, 1, 3).reshape(B, S, H)
    return o, lse


def hybrid_mixer(h, w_in, b_gate, qn_g, kn_g, w_branch_a, w_branch_b, w_out, ang_row, ang_col, ang_t):
    B, S, _ = h.shape
    proj = jnp.einsum('bsd,de->bse', h, w_in)
    offsets = []
    acc = 0
    for w in IN_WIDTHS[:-1]:
        acc += w
        offsets.append(acc)
    qa, ka, va, qb, kb, vb, ga, gb = jnp.split(proj, offsets, axis=-1)

    half_rot = HEAD_DIM // 2
    qa = rms_norm(qa.reshape(B, S, A_Q_HEADS, HEAD_DIM), qn_g)
    ka = rms_norm(ka.reshape(B, S, A_KV_HEADS, HEAD_DIM), kn_g)
    qa = jnp.concatenate([apply_rotary(qa[..., :half_rot], ang_row), apply_rotary(qa[..., half_rot:], ang_col)], axis=-1)
    ka = jnp.concatenate([apply_rotary(ka[..., :half_rot], ang_row), apply_rotary(ka[..., half_rot:], ang_col)], axis=-1)
    va = va.reshape(B, S, A_KV_HEADS, HEAD_DIM)
    ya = jnp.einsum('bse,ed->bsd', gqa_blocked(qa, ka, va), w_branch_a)

    def partial_rope(t):
        t = t.reshape(B, S, B_HEADS, HEAD_DIM)
        return jnp.concatenate([apply_rotary(t[..., :PARTIAL_ROPE_DIMS], ang_t), t[..., PARTIAL_ROPE_DIMS:]], axis=-1)
    qb = partial_rope(qb)
    kb = partial_rope(kb)
    vb = vb.reshape(B, S, B_HEADS, HEAD_DIM)
    outs = []
    lses = []
    for gi, (window, dilation) in enumerate(B_DILATION_GROUPS):
        sl = slice(gi * B_HEADS_PER_GROUP, (gi + 1) * B_HEADS_PER_GROUP)
        o, lse = dilated_band_attention(qb[:, :, sl], kb[:, :, sl], vb[:, :, sl], window, dilation)
        outs.append(o)
        lses.append(lse)
    wts = jax.nn.softmax(jnp.stack(lses, axis=0), axis=0)
    ob = jnp.einsum('gbsh,gbshd->bshd', wts.astype(vb.dtype), jnp.stack(outs, axis=0))
    yb = jnp.einsum('bse,ed->bsd', ob.reshape(B, S, B_OUT_W), w_branch_b)

    gates = jax.nn.sigmoid(jnp.concatenate([ga, gb], axis=-1).astype(jnp.float32) + b_gate.astype(jnp.float32))
    gates = gates.astype(ya.dtype)
    merged = gates[..., :D_MODEL] * ya + gates[..., D_MODEL:] * yb
    return jnp.einsum('bsd,de->bse', merged, w_out)


def expert_choice_ffn(h, w_router, w_gate, w_up, w_down):
    B, S, D = h.shape
    cap = EC_CAPACITY_FACTOR * S // N_EXPERTS
    logits = jnp.einsum('bsd,de->bse', h, w_router, preferred_element_type=jnp.float32)
    aff = jax.nn.softmax(logits, axis=-1)
    gate_vals, tok_idx = lax.top_k(aff.transpose(0, 2, 1), cap)
    xe = jax.vmap(lambda hb, ib: hb[ib])(h, tok_idx)
    g = jnp.einsum('becd,edf->becf', xe, w_gate)
    u = jnp.einsum('becd,edf->becf', xe, w_up)
    ye = jnp.einsum('becf,efd->becd', jax.nn.silu(g) * u, w_down)
    ye = ye * gate_vals[..., None].astype(ye.dtype)

    def combine(ib, yb):
        return jnp.zeros((S, D), yb.dtype).at[ib.reshape(-1)].add(yb.reshape(-1, D))

    return jax.vmap(combine)(tok_idx, ye)


def setup_inputs(seed: int = 0) -> dict:
    key = jax.random.key(seed)
    ks = jax.random.split(key, 20)
    L, D, E, F = DEPTH, D_MODEL, N_EXPERTS, D_FF_EXPERT
    nrm = lambda k, shape: jax.random.normal(k, shape, jnp.float32)
    col_scale = jnp.concatenate([
        jnp.full((w,), DEEPNORM_BETA if idx in (2, 5) else 1.0, jnp.float32)
        for idx, w in enumerate(IN_WIDTHS)])
    return {
        "x": nrm(ks[0], (BATCH, SEQ, D)),
        "ln0_g": 1.0 + 0.02 * nrm(ks[1], (D,)),
        "ln0_b": 0.02 * nrm(ks[2], (D,)),
        "w_in": nrm(ks[3], (L, D, IN_TOTAL)) * (D ** -0.5) * col_scale,
        "b_gate": 0.1 * nrm(ks[4], (L, 2 * D)),
        "qn_g": 1.0 + 0.02 * nrm(ks[5], (L, HEAD_DIM)),
        "kn_g": 1.0 + 0.02 * nrm(ks[6], (L, HEAD_DIM)),
        "w_branch_a": nrm(ks[7], (L, A_Q_W, D)) * (A_Q_W ** -0.5),
        "w_branch_b": nrm(ks[8], (L, B_OUT_W, D)) * (B_OUT_W ** -0.5),
        "w_out": nrm(ks[9], (L, D, D)) * (D ** -0.5) * DEEPNORM_BETA,
        "ln1_g": 1.0 + 0.02 * nrm(ks[10], (L, D)),
        "ln1_b": 0.02 * nrm(ks[11], (L, D)),
        "w_router": nrm(ks[12], (L, D, E)) * (D ** -0.5),
        "w_gate_e": nrm(ks[13], (L, E, D, F)) * (D ** -0.5),
        "w_up_e": nrm(ks[14], (L, E, D, F)) * (D ** -0.5),
        "w_down_e": nrm(ks[15], (L, E, F, D)) * (F ** -0.5) * DEEPNORM_BETA,
        "ln2_g": 1.0 + 0.02 * nrm(ks[16], (L, D)),
        "ln2_b": 0.02 * nrm(ks[17], (L, D)),
    }


def reference(x, ln0_g, ln0_b, w_in, b_gate, qn_g, kn_g, w_branch_a, w_branch_b, w_out,
              ln1_g, ln1_b, w_router, w_gate_e, w_up_e, w_down_e, ln2_g, ln2_b):
    S = x.shape[1]
    rows = S // GRID_W
    t = jnp.arange(S)
    row_idx = jnp.repeat(jnp.arange(rows), GRID_W)
    col_idx = jnp.tile(jnp.arange(GRID_W), rows)
    ang_row = rope_angles(row_idx, HEAD_DIM // 2, A_ROPE_THETA)
    ang_col = rope_angles(col_idx, HEAD_DIM // 2, A_ROPE_THETA)
    ang_t = rope_angles(t, PARTIAL_ROPE_DIMS, PARTIAL_ROPE_THETA)

    h = layer_norm(x, ln0_g, ln0_b)
    for l in range(DEPTH):
        mix = hybrid_mixer(h, w_in[l], b_gate[l], qn_g[l], kn_g[l], w_branch_a[l], w_branch_b[l],
                           w_out[l], ang_row, ang_col, ang_t)
        h = layer_norm(DEEPNORM_ALPHA * h + mix, ln1_g[l], ln1_b[l])
        ffn = expert_choice_ffn(h, w_router[l], w_gate_e[l], w_up_e[l], w_down_e[l])
        h = layer_norm(DEEPNORM_ALPHA * h + ffn, ln2_g[l], ln2_b[l])
    return h
```

```cpp
#include <hip/hip_runtime.h>
#include <cstdio>
#include <cstdint>
namespace pg8 {
#define PG8_LAS __attribute__((address_space(3)))
typedef unsigned short bf16_t;
typedef short bf16x8 __attribute__((ext_vector_type(8)));
typedef float f32x4 __attribute__((ext_vector_type(4)));
typedef unsigned u32x4 __attribute__((ext_vector_type(4)));
constexpr int BM = 256, BK = 64, HALF = 128, HTB = HALF * BK * 2  , STAGE_BYTES = 8 * HTB, NXCD = 8, WGM = 8;

__host__ __device__ __forceinline__ int lds_byte(int r, int c) { const int st = (r >> 4) * 2 + (c >> 5), rr = r & 15, cc = c & 31, ob = rr * 64 + cc * 2; return st * 1024 + (ob ^ (((ob >> 9) & 1) << 5)); }
__host__ __device__ __forceinline__ void stage_rc(int b, int& R, int& C) { const int st = b / 1024, sb = b % 1024, swz = sb ^ (((sb >> 9) & 1) << 5); R = (st >> 1) * 16 + swz / 64; C = (st & 1) * 32 + (swz % 64) / 2; }
__host__ __device__ __forceinline__ int perm32(int rho) { const int n = rho >> 4, i = rho & 15; return 8 * (i >> 2) + 4 * n + (i & 3); }

struct Unit { int pm, pn, am, bt; };
struct Gemm { const bf16_t* A; const bf16_t* Bt; int M, N, K; };

struct StaticOrder {
    int nM, nN, nwg, G, c;
    __host__ __device__ void init(int M, int N, int G_, int c_) { nM = M / BM; nN = N / BM; nwg = nM * nN; G = G_; c = c_; }
    __host__ __device__ bool next(int i, Unit& u) const {
        const long L = (long)i * G + c; if (L >= nwg) return false;
        int wgid = (int)L; { const int q = nwg / NXCD, r = nwg % NXCD, xcd = wgid % NXCD, off = wgid / NXCD; wgid = (xcd < r ? xcd * (q + 1) : r * (q + 1) + (xcd - r) * q) + off; }
        const int nig = WGM * nN, gid = wgid / nig, fm = gid * WGM, gsz = (nM - fm) < WGM ? (nM - fm) : WGM;
        u.pm = fm + ((wgid % nig) % gsz); u.pn = (wgid % nig) / gsz; u.am = u.pm; u.bt = u.pn; return true;
    }
    __device__ __forceinline__ void a_ready(const Unit&) const {}
    __device__ __forceinline__ void done(const Unit&) const {}
};

__device__ __forceinline__ unsigned cvt_pk_bf16(float lo, float hi) { unsigned r; asm volatile("v_cvt_pk_bf16_f32 %0, %1, %2" : "=v"(r) : "v"(lo), "v"(hi)); return r; }
__device__ __forceinline__ float bf_lo(unsigned w) { return __uint_as_float(w << 16); }
__device__ __forceinline__ float bf_hi(unsigned w) { return __uint_as_float(w & 0xffff0000u); }
__device__ __forceinline__ float sigmoidf_(float x) { return 1.0f / (1.0f + __expf(-x)); }
__device__ __forceinline__ u32x4 pack8(const f32x4 v0, const f32x4 v1) { u32x4 w; w.x = cvt_pk_bf16(v0[0], v0[1]); w.y = cvt_pk_bf16(v0[2], v0[3]); w.z = cvt_pk_bf16(v1[0], v1[1]); w.w = cvt_pk_bf16(v1[2], v1[3]); return w; }

struct EpiProj {
    static constexpr bool PERM = true, AFTER_DRAIN = false;
    bf16_t* qkv; bf16_t* gates; const float* b_gate;
    __device__ __forceinline__ void operator()(const f32x4 (&acc)[2][2][4][2], const Unit& u, int wr, int wc, int fr, int fq) const {
        const int row0 = u.pm * BM + wr * 64 + fr;
        const bool isg = u.pn >= 12;
        bf16_t* base = isg ? gates : qkv; const int ldc = isg ? 2048 : 3072; const int colt = isg ? (u.pn - 12) * BM : u.pn * BM;
        const int col0 = colt + wc * 32 + 8 * fq;
        f32x4 bv[2][2];
#pragma unroll
        for (int bj = 0; bj < 2; ++bj)
#pragma unroll
            for (int n = 0; n < 2; ++n) bv[bj][n] = isg ? *(const f32x4*)(b_gate + col0 + bj * HALF + 4 * n) : (f32x4){0.f, 0.f, 0.f, 0.f};
#pragma unroll
        for (int ai = 0; ai < 2; ++ai)
#pragma unroll
            for (int m = 0; m < 4; ++m) { bf16_t* rowp = base + (size_t)(row0 + ai * HALF + m * 16) * ldc + col0;
#pragma unroll
                for (int bj = 0; bj < 2; ++bj) { f32x4 v0 = acc[ai][bj][m][0] + bv[bj][0], v1 = acc[ai][bj][m][1] + bv[bj][1];
                    if (isg) {
#pragma unroll
                        for (int i = 0; i < 4; ++i) { v0[i] = sigmoidf_(v0[i]); v1[i] = sigmoidf_(v1[i]); } }
                    *(u32x4*)(rowp + bj * HALF) = pack8(v0, v1); } }
    }
};
struct EpiPlain {
    static constexpr bool PERM = true, AFTER_DRAIN = false;
    bf16_t* O; int ldc;
    __device__ __forceinline__ void operator()(const f32x4 (&acc)[2][2][4][2], const Unit& u, int wr, int wc, int fr, int fq) const {
        const int row0 = u.pm * BM + wr * 64 + fr; const int col0 = u.pn * BM + wc * 32 + 8 * fq;
#pragma unroll
        for (int ai = 0; ai < 2; ++ai)
#pragma unroll
            for (int m = 0; m < 4; ++m) { bf16_t* rowp = O + (size_t)(row0 + ai * HALF + m * 16) * ldc + col0;
#pragma unroll
                for (int bj = 0; bj < 2; ++bj) *(u32x4*)(rowp + bj * HALF) = pack8(acc[ai][bj][m][0], acc[ai][bj][m][1]); }
    }
};
template <bool ACCUM> struct EpiGate {
    static constexpr bool PERM = true, AFTER_DRAIN = false;
    bf16_t* merged; const bf16_t* gates; int goff;
    __device__ __forceinline__ void operator()(const f32x4 (&acc)[2][2][4][2], const Unit& u, int wr, int wc, int fr, int fq) const {
        const int row0 = u.pm * BM + wr * 64 + fr; const int col0 = u.pn * BM + wc * 32 + 8 * fq;
#pragma unroll
        for (int ai = 0; ai < 2; ++ai)
#pragma unroll
            for (int m = 0; m < 4; ++m) { const size_t r = (size_t)(row0 + ai * HALF + m * 16);
#pragma unroll
                for (int bj = 0; bj < 2; ++bj) {
                    const u32x4 g = *(const u32x4*)(gates + r * 2048 + goff + col0 + bj * HALF);
                    f32x4 v0 = acc[ai][bj][m][0], v1 = acc[ai][bj][m][1];
                    v0[0] *= bf_lo(g.x); v0[1] *= bf_hi(g.x); v0[2] *= bf_lo(g.y); v0[3] *= bf_hi(g.y);
                    v1[0] *= bf_lo(g.z); v1[1] *= bf_hi(g.z); v1[2] *= bf_lo(g.w); v1[3] *= bf_hi(g.w);
                    bf16_t* p = merged + r * 1024 + col0 + bj * HALF;
                    if (ACCUM) { const u32x4 o = *(const u32x4*)p;
                        v0[0] += bf_lo(o.x); v0[1] += bf_hi(o.x); v0[2] += bf_lo(o.y); v0[3] += bf_hi(o.y);
                        v1[0] += bf_lo(o.z); v1[1] += bf_hi(o.z); v1[2] += bf_lo(o.w); v1[3] += bf_hi(o.w); }
                    *(u32x4*)p = pack8(v0, v1); } }
    }
};
struct EpiSwiglu {
    static constexpr bool PERM = true, AFTER_DRAIN = false;
    bf16_t* act;
    __device__ __forceinline__ void operator()(const f32x4 (&acc)[2][2][4][2], const Unit& u, int wr, int wc, int fr, int fq) const {
        const int row0 = u.pm * BM + wr * 64 + fr; const int col0 = u.pn * HALF + wc * 32 + 8 * fq;
#pragma unroll
        for (int ai = 0; ai < 2; ++ai)
#pragma unroll
            for (int m = 0; m < 4; ++m) {
                f32x4 v0, v1;
#pragma unroll
                for (int i = 0; i < 4; ++i) { const float g0 = acc[ai][0][m][0][i], g1 = acc[ai][0][m][1][i];
                    v0[i] = g0 * sigmoidf_(g0) * acc[ai][1][m][0][i]; v1[i] = g1 * sigmoidf_(g1) * acc[ai][1][m][1][i]; }
                *(u32x4*)(act + (size_t)(row0 + ai * HALF + m * 16) * 2048 + col0) = pack8(v0, v1); }
    }
};
template <class Epi, class Sched, bool ALIGN_EPI = false, bool SP2 = false>
__device__ __forceinline__ void gemm_phase(PG8_LAS unsigned char* lds, const Gemm g, const Sched& S, const Epi& E) {
    const int tid = threadIdx.x, wid = __builtin_amdgcn_readfirstlane(tid >> 6), lane = tid & 63, wr = wid >> 2, wc = wid & 3, fr = lane & 15, fq = lane >> 4;
    const int K = g.K, nt = K / BK;
    unsigned voffA[2], voffB[2];
#pragma unroll
    for (int i = 0; i < 2; ++i) { int R, C; stage_rc(tid * 16 + i * 8192, R, C); const int Rb = Epi::PERM ? ((R & ~31) + perm32(R & 31)) : R;
        voffA[i] = (unsigned)(R * K + C) * 2u; voffB[i] = (unsigned)(Rb * K + C) * 2u; }
    const size_t kstep = (size_t)(BK * 2);
    const size_t hstep = (size_t)HALF * K * 2;
    const size_t tstep = 2 * hstep;
    const unsigned ldsw = (unsigned)wid * 1024u;
    const int aoff = lds_byte(wr * 64 + fr, fq * 8), boff = lds_byte(wc * 32 + fr, fq * 8);
#define PG8_SA(b, h) (((b) * 2 + (h)) * HTB)
#define PG8_SB(b, h) ((4 + (b) * 2 + (h)) * HTB)
#define PG8_STAGE(bufoff, gbase, voff) do { _Pragma("unroll") for (int _i = 0; _i < 2; ++_i) \
        __builtin_amdgcn_global_load_lds((const unsigned*)((const char*)(gbase) + (voff)[_i]), (PG8_LAS unsigned*)(lds + (bufoff) + ldsw + _i * 8192), 16, 0, 0); } while (0)
#define PG8_LDA(dst, b, h) do { _Pragma("unroll") for (int m = 0; m < 4; ++m) _Pragma("unroll") for (int k = 0; k < 2; ++k) dst[m][k] = *(const PG8_LAS bf16x8*)(lds + PG8_SA(b, h) + aoff + m * 2048 + k * 1024); } while (0)
#define PG8_LDB(dst, b, h) do { _Pragma("unroll") for (int n = 0; n < 2; ++n) _Pragma("unroll") for (int k = 0; k < 2; ++k) dst[n][k] = *(const PG8_LAS bf16x8*)(lds + PG8_SB(b, h) + boff + n * 2048 + k * 1024); } while (0)
#define PG8_MMA(ai, bj, At, Bt) do { __builtin_amdgcn_s_setprio(1); _Pragma("unroll") for (int m = 0; m < 4; ++m) _Pragma("unroll") for (int n = 0; n < 2; ++n) _Pragma("unroll") for (int k = 0; k < 2; ++k) \
        acc[ai][bj][m][n] = __builtin_amdgcn_mfma_f32_16x16x32_bf16(Bt[n][k], At[m][k], acc[ai][bj][m][n], 0, 0, 0); __builtin_amdgcn_s_setprio(0); } while (0)
#define PG8_WAIT_V(n) asm volatile("s_waitcnt vmcnt(" #n ")" ::: "memory")
#define PG8_WAIT_L(n) asm volatile("s_waitcnt lgkmcnt(" #n ")" ::: "memory")
#define PG8_BAR __builtin_amdgcn_s_barrier()
#define PG8_SCHED __builtin_amdgcn_sched_barrier(0)
    Unit cur, nxt; int ui = 0;
    if (!S.next(0, cur)) return;
    f32x4 acc[2][2][4][2];
#pragma unroll
    for (int a = 0; a < 2; ++a)
#pragma unroll
        for (int b = 0; b < 2; ++b)
#pragma unroll
            for (int m = 0; m < 4; ++m)
#pragma unroll
                for (int n = 0; n < 2; ++n) acc[a][b][m][n] = (f32x4){0.f, 0.f, 0.f, 0.f};
    bf16x8 At[4][2], B0[2][2], B1[2][2];
    const char* cA = (const char*)g.A + (size_t)cur.am * tstep; const char* cB = (const char*)g.Bt + (size_t)cur.bt * tstep;
    S.a_ready(cur);
    if constexpr (SP2) {
        PG8_STAGE(PG8_SB(0, 0), cB, voffB); PG8_STAGE(PG8_SB(0, 1), cB + hstep, voffB); PG8_STAGE(PG8_SA(0, 0), cA, voffA); PG8_STAGE(PG8_SA(0, 1), cA + hstep, voffA);
        if (wr == 1) PG8_BAR;
        PG8_WAIT_V(2); PG8_BAR;
        PG8_STAGE(PG8_SB(1, 0), cB + kstep, voffB); PG8_STAGE(PG8_SA(1, 0), cA + kstep, voffA); PG8_STAGE(PG8_SB(1, 1), cB + hstep + kstep, voffB);
        PG8_WAIT_V(6); PG8_BAR;
    } else {
        PG8_STAGE(PG8_SB(0, 0), cB, voffB); PG8_STAGE(PG8_SA(0, 0), cA, voffA); PG8_STAGE(PG8_SB(0, 1), cB + hstep, voffB); PG8_STAGE(PG8_SA(0, 1), cA + hstep, voffA);
        if (wr == 1) PG8_BAR;
        PG8_WAIT_V(4); PG8_BAR;
        PG8_STAGE(PG8_SB(1, 0), cB + kstep, voffB); PG8_STAGE(PG8_SA(1, 0), cA + kstep, voffA); PG8_STAGE(PG8_SB(1, 1), cB + hstep + kstep, voffB);
        PG8_WAIT_V(6); PG8_BAR;
    }
    for (;;) {
        const bool has_next = S.next(ui + 1, nxt);
        const char* nA = has_next ? (const char*)g.A + (size_t)nxt.am * tstep : cA; const char* nB = has_next ? (const char*)g.Bt + (size_t)nxt.bt * tstep : cB;
        for (int t = 0; t < nt; t += 2) {
            const bool last = (t == nt - 2);
            const char* a1 = cA + (size_t)(t + 1) * kstep;
            const char* a2 = last ? nA : cA + (size_t)(t + 2) * kstep; const char* b2 = last ? nB : cB + (size_t)(t + 2) * kstep;
            const char* a3 = a2 + kstep; const char* b3 = b2 + kstep;
            if (last && has_next) S.a_ready(nxt);
            if constexpr (SP2) {
            PG8_LDB(B0, 0, 0); PG8_LDB(B1, 0, 1); PG8_SCHED; PG8_LDA(At, 0, 0); PG8_STAGE(PG8_SA(1, 1), a1 + hstep, voffA);
            PG8_WAIT_V(8); PG8_WAIT_L(0); PG8_BAR; PG8_MMA(0, 0, At, B0); PG8_MMA(0, 1, At, B1); PG8_BAR; PG8_SCHED;
            PG8_LDA(At, 0, 1); PG8_STAGE(PG8_SB(0, 0), b2, voffB); PG8_STAGE(PG8_SB(0, 1), b2 + hstep, voffB); PG8_STAGE(PG8_SA(0, 0), a2, voffA);
            PG8_WAIT_V(8); PG8_WAIT_L(0); PG8_BAR; PG8_MMA(1, 0, At, B0); PG8_MMA(1, 1, At, B1); PG8_BAR; PG8_SCHED;
            PG8_LDB(B0, 1, 0); PG8_LDB(B1, 1, 1); PG8_SCHED; PG8_LDA(At, 1, 0); PG8_STAGE(PG8_SA(0, 1), a2 + hstep, voffA);
            PG8_WAIT_V(8); PG8_WAIT_L(0); PG8_BAR; PG8_MMA(0, 0, At, B0); PG8_MMA(0, 1, At, B1); PG8_BAR; PG8_SCHED;
            PG8_LDA(At, 1, 1); PG8_STAGE(PG8_SB(1, 0), b3, voffB); PG8_STAGE(PG8_SB(1, 1), b3 + hstep, voffB); PG8_STAGE(PG8_SA(1, 0), a3, voffA);
            PG8_WAIT_V(8); PG8_WAIT_L(0); PG8_BAR; PG8_MMA(1, 0, At, B0); PG8_MMA(1, 1, At, B1); PG8_BAR; PG8_SCHED;
            } else {
            PG8_LDB(B0, 0, 0); PG8_SCHED; PG8_LDA(At, 0, 0); PG8_STAGE(PG8_SA(1, 1), a1 + hstep, voffA);
            PG8_WAIT_L(8); PG8_BAR; PG8_WAIT_L(0); PG8_MMA(0, 0, At, B0); PG8_BAR; PG8_SCHED;
            PG8_LDB(B1, 0, 1); PG8_STAGE(PG8_SB(0, 0), b2, voffB);
            PG8_BAR; PG8_WAIT_L(0); PG8_MMA(0, 1, At, B1); PG8_BAR;
            PG8_LDA(At, 0, 1); PG8_STAGE(PG8_SA(0, 0), a2, voffA);
            PG8_BAR; PG8_WAIT_L(0); PG8_MMA(1, 0, At, B0); PG8_BAR; PG8_SCHED;
            PG8_STAGE(PG8_SB(0, 1), b2 + hstep, voffB);
            PG8_WAIT_V(6); PG8_BAR; PG8_MMA(1, 1, At, B1); PG8_BAR;
            PG8_LDB(B0, 1, 0); PG8_SCHED; PG8_LDA(At, 1, 0); PG8_STAGE(PG8_SA(0, 1), a2 + hstep, voffA);
            PG8_WAIT_L(8); PG8_BAR; PG8_WAIT_L(0); PG8_MMA(0, 0, At, B0); PG8_BAR; PG8_SCHED;
            PG8_LDB(B1, 1, 1); PG8_STAGE(PG8_SB(1, 0), b3, voffB);
            PG8_BAR; PG8_WAIT_L(0); PG8_MMA(0, 1, At, B1); PG8_BAR;
            PG8_LDA(At, 1, 1); PG8_STAGE(PG8_SA(1, 0), a3, voffA);
            PG8_BAR; PG8_WAIT_L(0); PG8_MMA(1, 0, At, B0); PG8_BAR; PG8_SCHED;
            PG8_STAGE(PG8_SB(1, 1), b3 + hstep, voffB);
            PG8_WAIT_V(6); PG8_BAR; PG8_MMA(1, 1, At, B1); PG8_BAR;
            }
        }
        if constexpr (ALIGN_EPI) { if (wr == 0) PG8_BAR; }
        if constexpr (!Epi::AFTER_DRAIN) { E(acc, cur, wr, wc, fr, fq); S.done(cur); }
        if (!has_next) break;
#pragma unroll
        for (int a = 0; a < 2; ++a)
#pragma unroll
            for (int b = 0; b < 2; ++b)
#pragma unroll
                for (int m = 0; m < 4; ++m)
#pragma unroll
                    for (int n = 0; n < 2; ++n) acc[a][b][m][n] = (f32x4){0.f, 0.f, 0.f, 0.f};
        cur = nxt; cA = nA; cB = nB; ++ui;
        if constexpr (ALIGN_EPI) { if (wr == 1) PG8_BAR; }
    }
    PG8_WAIT_V(0);
    if constexpr (!ALIGN_EPI) { if (wr == 0) PG8_BAR; }
    PG8_BAR;
    if constexpr (Epi::AFTER_DRAIN) { E.fused(acc, cur, wr, wc, fr, fq, lds, wid, lane); S.done(cur); }
#undef PG8_SA
#undef PG8_SB
#undef PG8_STAGE
#undef PG8_LDA
#undef PG8_LDB
#undef PG8_MMA
#undef PG8_WAIT_V
#undef PG8_WAIT_L
#undef PG8_BAR
#undef PG8_SCHED
}
}
#define GAS __attribute__((address_space(1)))
#define LAS __attribute__((address_space(3)))
typedef unsigned short bf16;
typedef unsigned v4u __attribute__((ext_vector_type(4)));
typedef float f32x4 __attribute__((ext_vector_type(4)));
typedef short bf16x8 __attribute__((ext_vector_type(8)));
typedef GAS unsigned gu32;
typedef GAS unsigned long long gu64;
#define RLX_AGENT __ATOMIC_RELAXED, __HIP_MEMORY_SCOPE_AGENT
#define LDS_WAIT() asm volatile("s_waitcnt lgkmcnt(0)" ::: "memory")
#define VM_WAIT() asm volatile("s_waitcnt vmcnt(0)" ::: "memory")
__device__ __forceinline__ unsigned long long rt() { return __builtin_amdgcn_s_memrealtime(); }
__device__ __forceinline__ unsigned f2bf(float f) { unsigned u = __builtin_bit_cast(unsigned, f); return (u + 0x7fffu + ((u >> 16) & 1u)) >> 16; }
__device__ __forceinline__ unsigned pk2(float lo, float hi) { return f2bf(lo) | (f2bf(hi) << 16); }

#define XB_TMO      128
#define XB_XCNT(j)  (256  + 64 * (j))
#define XB_XSUB(j)  (1280 + 64 * (j))
#define XB_XGEN(j)  (2304 + 64 * (j))
#define XB_TOP      3328
#define XB_TOPGEN   3392
#define XCD_BAR_WORDS 3456
#define XB_SPIN_CAP (1u << 24)

__device__ __forceinline__ unsigned xb_ld(unsigned* p)              { return __hip_atomic_load(p, __ATOMIC_RELAXED, __HIP_MEMORY_SCOPE_AGENT); }
__device__ __forceinline__ unsigned xb_add(unsigned* p, unsigned v) { return __hip_atomic_fetch_add(p, v, __ATOMIC_RELAXED, __HIP_MEMORY_SCOPE_AGENT); }
__device__ __forceinline__ unsigned xb_xcc_id() { return (unsigned)__builtin_amdgcn_s_getreg((3 << 11) | 20) & 0xFu; }
#define XB_SPIN(cond, bar) do { unsigned _sp = 0; while (cond) { __builtin_amdgcn_s_sleep(1); \
    if ((++_sp & 255u) == 0u) { if (xb_ld(&(bar)[XB_TMO])) break; if (_sp > XB_SPIN_CAP) { atomicAdd(&(bar)[XB_TMO], 1u); break; } } } } while (0)

struct XcdBarrier {
    unsigned* bar; unsigned x;
    volatile LAS unsigned* st;
};

__device__ __forceinline__ XcdBarrier xcd_barrier_post(unsigned* bar, volatile LAS unsigned* st) {
    XcdBarrier b; b.bar = bar; b.x = xb_xcc_id(); b.st = st;
    if (threadIdx.x == 0) (void)xb_add(&bar[XB_XCNT(b.x)], 1u);
    return b;
}
__device__ __forceinline__ void xcd_barrier_complete(unsigned* bar, unsigned x, unsigned& nloc, unsigned& nx) {
    const unsigned G = gridDim.x * gridDim.y * gridDim.z;
    unsigned sum, cnt, mine, sp = 0u;
    for (;;) {
        sum = 0u; cnt = 0u; mine = 0u;
#pragma unroll
        for (unsigned j = 0; j < 16; ++j) { const unsigned c = xb_ld(&bar[XB_XCNT(j)]); sum += c; cnt += (c > 0u) ? 1u : 0u; mine = (j == x) ? c : mine; }
        if (sum == G) break;
        __builtin_amdgcn_s_sleep(1);
        if ((++sp & 255u) == 0u) { if (xb_ld(&bar[XB_TMO])) break; if (sp > XB_SPIN_CAP) { atomicAdd(&bar[XB_TMO], 1u); break; } }
    }
    nloc = mine > 0u ? mine : 1u; nx = cnt > 0u ? cnt : 1u;
}

__device__ __forceinline__ void xcd_barrier(const XcdBarrier& b) {
    asm volatile("s_waitcnt vmcnt(0)" ::: "memory");
    __syncthreads();
    if (threadIdx.x == 0) {
        unsigned* bar = b.bar;
        __builtin_amdgcn_s_waitcnt(0);
        unsigned nloc = b.st[0], nx = b.st[1];
        if (nloc == 0u) { xcd_barrier_complete(bar, b.x, nloc, nx); b.st[0] = nloc; b.st[1] = nx; }
        const unsigned old = xb_add(&bar[XB_XSUB(b.x)], 1u);
        const unsigned gen = old / nloc;
        if (old + 1u == (gen + 1u) * nloc) {
            __builtin_amdgcn_fence(__ATOMIC_RELEASE, "agent");
            asm volatile("s_waitcnt vmcnt(0)" ::: "memory");
            const unsigned og = xb_add(&bar[XB_TOP], 1u);
            const unsigned tg = og / nx;
            if (og + 1u == (tg + 1u) * nx) xb_add(&bar[XB_TOPGEN], 1u);
            else XB_SPIN(xb_ld(&bar[XB_TOPGEN]) == tg, bar);
            __builtin_amdgcn_fence(__ATOMIC_ACQUIRE, "agent");
            xb_add(&bar[XB_XGEN(b.x)], 1u);
            asm volatile("s_waitcnt vmcnt(0)" ::: "memory");
        } else {
            XB_SPIN(xb_ld(&bar[XB_XGEN(b.x)]) == gen, bar);
            __builtin_amdgcn_fence(__ATOMIC_ACQUIRE, "agent");
            asm volatile("s_waitcnt vmcnt(0)" ::: "memory");
        }
    }
    __syncthreads();
}


constexpr int NWAVES = 8;
constexpr int BATCH = 16, SEQ = 2048, DM = 1024, MTOK = BATCH * SEQ;
constexpr int NEXP = 16, CAP = 256, DFF = 2048, NSLOT = BATCH * NEXP * CAP;
constexpr int QKVW = 3072, GATEW = 2048;
constexpr int OFF_QA = 0, OFF_KA = 512, OFF_VA = 640, OFF_QB = 768, OFF_KB = 1536, OFF_VB = 2304;
constexpr float LN_EPS = 1e-5f, QK_EPS = 1e-6f;
constexpr float ALPHA = 1.189207115002721f;
constexpr float C2 = 0.125f * 1.4426950408889634f;

constexpr size_t MiB = 1u << 20;
constexpr size_t WS_CTL = 0, CTL_ZERO_BYTES = 1 * MiB;
constexpr size_t WS_STAT0 = 1 * MiB;
constexpr size_t WS_AFF = 2 * MiB;
constexpr size_t WS_INV = 4 * MiB;
constexpr size_t WS_TOK = 5 * MiB;
constexpr size_t WS_WIN = 8 * MiB;
constexpr size_t WS_WA = 18 * MiB;
constexpr size_t WS_WB = 19 * MiB;
constexpr size_t WS_WO = 20 * MiB;
constexpr size_t ARENA = 32 * MiB;
constexpr size_t A_H0B = ARENA + 0 * MiB;
constexpr size_t A_QKV = ARENA + 64 * MiB;
constexpr size_t A_GATES = ARENA + 256 * MiB;
constexpr size_t A_ATTNA = ARENA + 0 * MiB;
constexpr size_t A_OB = ARENA + 32 * MiB;
constexpr size_t A_MERGED = ARENA + 64 * MiB;
constexpr size_t A_MIX = ARENA + 128 * MiB;
constexpr size_t A_H1B = ARENA + 0 * MiB;
constexpr size_t A_WGU = ARENA + 256 * MiB;
constexpr size_t A_WD = ARENA + 384 * MiB;
constexpr size_t A_XE = ARENA + 128 * MiB;
constexpr size_t A_ACT = ARENA + 0 * MiB;
constexpr size_t A_YE = ARENA + 128 * MiB;
constexpr size_t WS_END = ARENA + 448 * MiB;
constexpr int CW_TMO = 0, CW_BAR = 4096;

constexpr int RING_OFF = 0, RING_BYTES = 131072;
constexpr int LDSCTL_OFF = RING_BYTES, MISC_OFF = LDSCTL_OFF + 320;
constexpr int LDS_BYTES = 147456;

typedef short s16x4v __attribute__((ext_vector_type(4)));
typedef unsigned u32x2 __attribute__((ext_vector_type(2)));

struct Frame {
    LAS unsigned char* lds;
    volatile LAS unsigned* MISC;
    gu32* ctl;
    int tid, lane, wave;
    int vcu, G;
};

__device__ __forceinline__ float wave_sum(float v) {
#pragma unroll
    for (int o = 1; o < 64; o <<= 1) v += __shfl_xor(v, o);
    return v;
}
__device__ __forceinline__ float bf2f(bf16 h) { return __uint_as_float(((unsigned)h) << 16); }

__device__ __forceinline__ void transpose_item(const float* W, int ldw, int k0, int n0, bf16* WT, int ldt, size_t dst_row, LAS float* scr, int lane) {
#pragma unroll 8
    for (int i = 0; i < 32; ++i) { const int kk = 2 * i + (lane >> 5); scr[kk * 33 + (lane & 31)] = W[(size_t)(k0 + kk) * ldw + n0 + (lane & 31)]; }
    LDS_WAIT(); asm volatile("" ::: "memory");
    const int c = lane & 7;
#pragma unroll
    for (int j = 0; j < 4; ++j) { const int n = (lane >> 3) + 8 * j; const LAS float* s = scr + (8 * c) * 33 + n;
        v4u o; o.x = pk2(s[0 * 33], s[1 * 33]); o.y = pk2(s[2 * 33], s[3 * 33]); o.z = pk2(s[4 * 33], s[5 * 33]); o.w = pk2(s[6 * 33], s[7 * 33]);
        *(GAS v4u*)(WT + (dst_row + n) * (size_t)ldt + k0 + 8 * c) = o; }
    LDS_WAIT(); asm volatile("" ::: "memory");
}

struct Ptrs {
    const float *x, *ln0_g, *ln0_b, *w_in, *b_gate, *qn_g, *kn_g, *w_a, *w_b, *w_out, *ln1_g, *ln1_b, *w_router, *w_gate_e, *w_up_e, *w_down_e, *ln2_g, *ln2_b;
    float* out; unsigned char* ws;
};

__device__ __forceinline__ void p0_prologue(Frame& F, const Ptrs& P) {
    LAS float* scr = (LAS float*)(F.lds + RING_OFF + F.wave * 16384);
    const int gw = F.vcu * NWAVES + F.wave, NGW = F.G * NWAVES;
    bf16* win_t = (bf16*)(P.ws + WS_WIN); bf16* wa_t = (bf16*)(P.ws + WS_WA); bf16* wb_t = (bf16*)(P.ws + WS_WB); bf16* wo_t = (bf16*)(P.ws + WS_WO);
    constexpr int I_IN = (1024 / 64) * (5120 / 32), I_A = (512 / 64) * (1024 / 32), I_B = (256 / 64) * (1024 / 32), I_O = (1024 / 64) * (1024 / 32);
    for (int it = gw; it < I_IN + I_A + I_B + I_O; it += NGW) {
        int r = it;
        if (r < I_IN) { const int nb = r % 160, kb = r / 160; transpose_item(P.w_in, 5120, kb * 64, nb * 32, win_t, 1024, (size_t)nb * 32, scr, F.lane); continue; } r -= I_IN;
        if (r < I_A) { const int nb = r % 32, kb = r / 32; transpose_item(P.w_a, 1024, kb * 64, nb * 32, wa_t, 512, (size_t)nb * 32, scr, F.lane); continue; } r -= I_A;
        if (r < I_B) { const int nb = r % 32, kb = r / 32; transpose_item(P.w_b, 1024, kb * 64, nb * 32, wb_t, 256, (size_t)nb * 32, scr, F.lane); continue; } r -= I_B;
        { const int nb = r % 32, kb = r / 32; transpose_item(P.w_out, 1024, kb * 64, nb * 32, wo_t, 1024, (size_t)nb * 32, scr, F.lane); }
    }
    bf16* h0b = (bf16*)(P.ws + A_H0B); float* st0 = (float*)(P.ws + WS_STAT0);
    f32x4 g[4], bb[4];
#pragma unroll
    for (int j = 0; j < 4; ++j) { g[j] = ((const f32x4*)P.ln0_g)[F.lane + 64 * j]; bb[j] = ((const f32x4*)P.ln0_b)[F.lane + 64 * j]; }
    for (int m = gw; m < MTOK; m += NGW) {
        const GAS f32x4* xr = (const GAS f32x4*)(P.x + (size_t)m * DM) + F.lane;
        f32x4 v[4]; float s = 0.f;
#pragma unroll
        for (int j = 0; j < 4; ++j) { v[j] = xr[64 * j]; s += (v[j].x + v[j].y) + (v[j].z + v[j].w); }
        const float mean = wave_sum(s) * (1.f / DM); float s2 = 0.f;
#pragma unroll
        for (int j = 0; j < 4; ++j) { v[j] = v[j] - mean; s2 += (v[j].x * v[j].x + v[j].y * v[j].y) + (v[j].z * v[j].z + v[j].w * v[j].w); }
        const float rstd = 1.f / sqrtf(wave_sum(s2) * (1.f / DM) + LN_EPS);
        GAS unsigned long long* o8 = (GAS unsigned long long*)(h0b + (size_t)m * DM) + F.lane;
#pragma unroll
        for (int j = 0; j < 4; ++j) { const f32x4 y = v[j] * rstd * g[j] + bb[j]; o8[64 * j] = (unsigned long long)pk2(y.x, y.y) | ((unsigned long long)pk2(y.z, y.w) << 32); }
        if (F.lane == 0) { st0[2 * m] = mean; st0[2 * m + 1] = rstd; }
    }
}

__device__ __forceinline__ void sincos_rev(float angle, float& sn, float& cs) {
    const double rev = (double)angle * 0.15915494309189533577; const double fr = rev - __builtin_rint(rev);
    sn = __builtin_amdgcn_sinf((float)fr); cs = __builtin_amdgcn_cosf((float)fr);
}
__device__ __forceinline__ void p1b_prep(Frame& F, const Ptrs& P) {
    const int gw = F.vcu * NWAVES + F.wave, NGW = F.G * NWAVES, d = F.lane;
    bf16* qkv = (bf16*)(P.ws + A_QKV);
    const float qg = P.qn_g[d], kg = P.kn_g[d];
    const float invfA = exp2f(-(float)(d & 15) * (13.287712379549449f / 16.f));
    const float invfB = exp2f(-(float)(d & 7) * (18.931568569324174f / 8.f));
    for (int m = gw; m < MTOK; m += NGW) {
        const int t = m & (SEQ - 1);
        const float posA = (d < 32) ? (float)(t >> 6) : (float)(t & 63);
        float snA, csA, snB, csB; sincos_rev(posA * invfA, snA, csA); sincos_rev((float)t * invfB, snB, csB);
        bf16* row = qkv + (size_t)m * QKVW;
#pragma unroll 2
        for (int hh = 0; hh < 10; ++hh) {
            bf16* p = row + (hh < 8 ? OFF_QA + hh * 64 : OFF_KA + (hh - 8) * 64) + d;
            const float x = bf2f(*p); const float ss = wave_sum(x * x);
            const float y = x * (1.0f / sqrtf(ss * (1.f / 64.f) + QK_EPS)) * (hh < 8 ? qg : kg);
            const float yp = __shfl_xor(y, 16);
            float o = (d & 16) ? (y * csA + yp * snA) : (y * csA - yp * snA);
            if (hh < 8) o *= C2;
            *p = (bf16)f2bf(o);
        }
#pragma unroll 2
        for (int hh = 0; hh < 24; ++hh) {
            const bool isq = hh < 12;
            bf16* p = row + (isq ? OFF_QB + hh * 64 : OFF_KB + (hh - 12) * 64) + d;
            const float y = bf2f(*p); const float yp = __shfl_xor(y, 8);
            float o = y;
            if (d < 16) o = (d & 8) ? (y * csB + yp * snB) : (y * csB - yp * snB);
            if (isq) o *= C2;
            if (isq || d < 16) *p = (bf16)f2bf(o);
        }
    }
}

__device__ __forceinline__ void attnA_naive_unit(Frame& F, const Ptrs& P, int unit) {
    const int b = unit >> 5, h = (unit >> 2) & 7, qc = unit & 3, kvh = h >> 2;
    const bf16* qkv = (const bf16*)(P.ws + A_QKV); bf16* attna = (bf16*)(P.ws + A_ATTNA);
    const size_t rowq = (size_t)b * SEQ + qc * 512 + F.tid;
    LAS float* Ks = (LAS float*)(F.lds + RING_OFF); LAS float* Vs = Ks + 64 * 64;
    float q[64], o[64];
    { const v4u* qp = (const v4u*)(qkv + rowq * QKVW + OFF_QA + h * 64);
#pragma unroll
      for (int c = 0; c < 8; ++c) { const v4u w = qp[c]; q[8 * c + 0] = pg8::bf_lo(w.x); q[8 * c + 1] = pg8::bf_hi(w.x); q[8 * c + 2] = pg8::bf_lo(w.y); q[8 * c + 3] = pg8::bf_hi(w.y);
          q[8 * c + 4] = pg8::bf_lo(w.z); q[8 * c + 5] = pg8::bf_hi(w.z); q[8 * c + 6] = pg8::bf_lo(w.w); q[8 * c + 7] = pg8::bf_hi(w.w); } }
#pragma unroll
    for (int dd = 0; dd < 64; ++dd) o[dd] = 0.f;
    float mrun = -1e30f, l = 0.f;
    for (int kt = 0; kt < SEQ / 64; ++kt) {
        __syncthreads();
        { const int kr = F.tid >> 3, ch = F.tid & 7; const size_t rk = ((size_t)b * SEQ + kt * 64 + kr) * QKVW;
          const v4u wk = *(const v4u*)(qkv + rk + OFF_KA + kvh * 64 + ch * 8), wv = *(const v4u*)(qkv + rk + OFF_VA + kvh * 64 + ch * 8);
          LAS f32x4* kd = (LAS f32x4*)(Ks + kr * 64 + ch * 8); LAS f32x4* vd = (LAS f32x4*)(Vs + kr * 64 + ch * 8);
          kd[0] = (f32x4){pg8::bf_lo(wk.x), pg8::bf_hi(wk.x), pg8::bf_lo(wk.y), pg8::bf_hi(wk.y)}; kd[1] = (f32x4){pg8::bf_lo(wk.z), pg8::bf_hi(wk.z), pg8::bf_lo(wk.w), pg8::bf_hi(wk.w)};
          vd[0] = (f32x4){pg8::bf_lo(wv.x), pg8::bf_hi(wv.x), pg8::bf_lo(wv.y), pg8::bf_hi(wv.y)}; vd[1] = (f32x4){pg8::bf_lo(wv.z), pg8::bf_hi(wv.z), pg8::bf_lo(wv.w), pg8::bf_hi(wv.w)}; }
        __syncthreads();
        for (int key = 0; key < 64; ++key) {
            const LAS f32x4* kp = (const LAS f32x4*)(Ks + key * 64); const LAS f32x4* vp = (const LAS f32x4*)(Vs + key * 64);
            float s0 = 0.f, s1 = 0.f;
#pragma unroll
            for (int c = 0; c < 16; c += 2) { const f32x4 k0 = kp[c], k1 = kp[c + 1];
                s0 += q[4 * c] * k0.x + q[4 * c + 1] * k0.y + q[4 * c + 2] * k0.z + q[4 * c + 3] * k0.w;
                s1 += q[4 * c + 4] * k1.x + q[4 * c + 5] * k1.y + q[4 * c + 6] * k1.z + q[4 * c + 7] * k1.w; }
            const float s = s0 + s1;
            const float mn = fmaxf(mrun, s); const float a = exp2f(mrun - mn), pw = exp2f(s - mn);
            l = l * a + pw; mrun = mn;
#pragma unroll
            for (int c = 0; c < 16; ++c) { const f32x4 vv = vp[c];
                o[4 * c] = o[4 * c] * a + pw * vv.x; o[4 * c + 1] = o[4 * c + 1] * a + pw * vv.y; o[4 * c + 2] = o[4 * c + 2] * a + pw * vv.z; o[4 * c + 3] = o[4 * c + 3] * a + pw * vv.w; }
        }
    }
    const float rl = 1.0f / l;
    v4u* op = (v4u*)(attna + rowq * 512 + h * 64);
#pragma unroll
    for (int c = 0; c < 8; ++c) { v4u w; w.x = pk2(o[8 * c] * rl, o[8 * c + 1] * rl); w.y = pk2(o[8 * c + 2] * rl, o[8 * c + 3] * rl); w.z = pk2(o[8 * c + 4] * rl, o[8 * c + 5] * rl); w.w = pk2(o[8 * c + 6] * rl, o[8 * c + 7] * rl); op[c] = w; }
}

__device__ __forceinline__ void attnB_naive_unit(Frame& F, const Ptrs& P, int unit) {
    const int b = unit >> 4, j = (unit >> 2) & 3, qc = unit & 3;
    const bf16* qkv = (const bf16*)(P.ws + A_QKV); bf16* ob = (bf16*)(P.ws + A_OB);
    const int t = qc * 512 + F.tid; const size_t rowq = (size_t)b * SEQ + t;
    float q[64], o[64];
#pragma unroll
    for (int dd = 0; dd < 64; ++dd) o[dd] = 0.f;
    float mrun = -1e30f, l = 0.f;
    for (int g = 0; g < 3; ++g) {
        const int head = 4 * g + j, dil = (g == 0) ? 1 : (g == 1) ? 4 : 16;
        { const v4u* qp = (const v4u*)(qkv + rowq * QKVW + OFF_QB + head * 64);
#pragma unroll
          for (int c = 0; c < 8; ++c) { const v4u w = qp[c]; q[8 * c + 0] = pg8::bf_lo(w.x); q[8 * c + 1] = pg8::bf_hi(w.x); q[8 * c + 2] = pg8::bf_lo(w.y); q[8 * c + 3] = pg8::bf_hi(w.y);
              q[8 * c + 4] = pg8::bf_lo(w.z); q[8 * c + 5] = pg8::bf_hi(w.z); q[8 * c + 6] = pg8::bf_lo(w.w); q[8 * c + 7] = pg8::bf_hi(w.w); } }
        for (int jj = -64; jj <= 64; ++jj) {
            const int tk = t + jj * dil;
            if (tk < 0 || tk >= SEQ) continue;
            const size_t rk = ((size_t)b * SEQ + tk) * QKVW;
            const v4u* kp = (const v4u*)(qkv + rk + OFF_KB + head * 64); const v4u* vp = (const v4u*)(qkv + rk + OFF_VB + head * 64);
            float s = 0.f;
#pragma unroll
            for (int c = 0; c < 8; ++c) { const v4u w = kp[c];
                s += q[8 * c] * pg8::bf_lo(w.x) + q[8 * c + 1] * pg8::bf_hi(w.x) + q[8 * c + 2] * pg8::bf_lo(w.y) + q[8 * c + 3] * pg8::bf_hi(w.y)
                   + q[8 * c + 4] * pg8::bf_lo(w.z) + q[8 * c + 5] * pg8::bf_hi(w.z) + q[8 * c + 6] * pg8::bf_lo(w.w) + q[8 * c + 7] * pg8::bf_hi(w.w); }
            const float mn = fmaxf(mrun, s); const float a = exp2f(mrun - mn), pw = exp2f(s - mn);
            l = l * a + pw; mrun = mn;
#pragma unroll
            for (int c = 0; c < 8; ++c) { const v4u w = vp[c];
                o[8 * c] = o[8 * c] * a + pw * pg8::bf_lo(w.x); o[8 * c + 1] = o[8 * c + 1] * a + pw * pg8::bf_hi(w.x); o[8 * c + 2] = o[8 * c + 2] * a + pw * pg8::bf_lo(w.y); o[8 * c + 3] = o[8 * c + 3] * a + pw * pg8::bf_hi(w.y);
                o[8 * c + 4] = o[8 * c + 4] * a + pw * pg8::bf_lo(w.z); o[8 * c + 5] = o[8 * c + 5] * a + pw * pg8::bf_hi(w.z); o[8 * c + 6] = o[8 * c + 6] * a + pw * pg8::bf_lo(w.w); o[8 * c + 7] = o[8 * c + 7] * a + pw * pg8::bf_hi(w.w); }
        }
    }
    const float rl = 1.0f / l;
    v4u* op = (v4u*)(ob + rowq * 256 + j * 64);
#pragma unroll
    for (int c = 0; c < 8; ++c) { v4u w; w.x = pk2(o[8 * c] * rl, o[8 * c + 1] * rl); w.y = pk2(o[8 * c + 2] * rl, o[8 * c + 3] * rl); w.z = pk2(o[8 * c + 4] * rl, o[8 * c + 5] * rl); w.w = pk2(o[8 * c + 6] * rl, o[8 * c + 7] * rl); op[c] = w; }
}

__device__ __forceinline__ void p5_ln1_router_convert(Frame& F, const Ptrs& P) {
    const int gw = F.vcu * NWAVES + F.wave, NGW = F.G * NWAVES;
    { LAS float* scr = (LAS float*)(F.lds + RING_OFF + F.wave * 16384);
      bf16* wgu = (bf16*)(P.ws + A_WGU); bf16* wd = (bf16*)(P.ws + A_WD);
      constexpr int I_G = 16 * 64, I_D = 32 * 32, PER_E = 2 * I_G + I_D;
      for (int it = gw; it < NEXP * PER_E; it += NGW) {
          const int e = it / PER_E; int r = it % PER_E;
          if (r < I_G) { const int nb = r % 64, kb = r / 64, n0 = nb * 32; transpose_item(P.w_gate_e + (size_t)e * DM * DFF, DFF, kb * 64, n0, wgu, 1024, (size_t)e * 4096 + (n0 >> 7) * 256 + (n0 & 127), scr, F.lane); continue; } r -= I_G;
          if (r < I_G) { const int nb = r % 64, kb = r / 64, n0 = nb * 32; transpose_item(P.w_up_e + (size_t)e * DM * DFF, DFF, kb * 64, n0, wgu, 1024, (size_t)e * 4096 + (n0 >> 7) * 256 + 128 + (n0 & 127), scr, F.lane); continue; } r -= I_G;
          { const int nb = r % 32, kb = r / 32, n0 = nb * 32; transpose_item(P.w_down_e + (size_t)e * DFF * DM, DM, kb * 64, n0, wd, 2048, (size_t)e * 1024 + n0, scr, F.lane); }
      } }
    const bf16* mix = (const bf16*)(P.ws + A_MIX); bf16* h1b = (bf16*)(P.ws + A_H1B); const float* st0 = (const float*)(P.ws + WS_STAT0); float* aff = (float*)(P.ws + WS_AFF);
    for (int m = gw; m < MTOK; m += NGW) {
        const float mean0 = st0[2 * m], rstd0 = st0[2 * m + 1];
        const GAS f32x4* xr = (const GAS f32x4*)(P.x + (size_t)m * DM) + F.lane;
        const GAS u32x2* mr = (const GAS u32x2*)(mix + (size_t)m * DM) + F.lane;
        f32x4 v[4]; float s = 0.f;
#pragma unroll
        for (int j = 0; j < 4; ++j) { const f32x4 xv = xr[64 * j]; const u32x2 mw = mr[64 * j];
            const f32x4 g0 = ((const f32x4*)P.ln0_g)[F.lane + 64 * j], b0 = ((const f32x4*)P.ln0_b)[F.lane + 64 * j];
            const f32x4 h0 = (xv - mean0) * rstd0 * g0 + b0;
            v[j] = h0 * ALPHA + (f32x4){pg8::bf_lo(mw.x), pg8::bf_hi(mw.x), pg8::bf_lo(mw.y), pg8::bf_hi(mw.y)};
            s += (v[j].x + v[j].y) + (v[j].z + v[j].w); }
        const float mean = wave_sum(s) * (1.f / DM); float s2 = 0.f;
#pragma unroll
        for (int j = 0; j < 4; ++j) { v[j] = v[j] - mean; s2 += (v[j].x * v[j].x + v[j].y * v[j].y) + (v[j].z * v[j].z + v[j].w * v[j].w); }
        const float rstd = 1.f / sqrtf(wave_sum(s2) * (1.f / DM) + LN_EPS);
        GAS f32x4* o4 = (GAS f32x4*)(P.out + (size_t)m * DM) + F.lane;
        GAS unsigned long long* o8 = (GAS unsigned long long*)(h1b + (size_t)m * DM) + F.lane;
        float lg[16];
#pragma unroll
        for (int e = 0; e < 16; ++e) lg[e] = 0.f;
#pragma unroll
        for (int j = 0; j < 4; ++j) { const f32x4 g1 = ((const f32x4*)P.ln1_g)[F.lane + 64 * j], b1 = ((const f32x4*)P.ln1_b)[F.lane + 64 * j];
            const f32x4 y = v[j] * rstd * g1 + b1; v[j] = y;
            o4[64 * j] = y; o8[64 * j] = (unsigned long long)pk2(y.x, y.y) | ((unsigned long long)pk2(y.z, y.w) << 32);
            const f32x4* wr = (const f32x4*)(P.w_router + (size_t)(4 * F.lane + 256 * j) * 16);
#pragma unroll
            for (int i = 0; i < 4; ++i) { const float yv = y[i];
#pragma unroll
                for (int c = 0; c < 4; ++c) { const f32x4 w = wr[i * 4 + c]; lg[4 * c] += yv * w.x; lg[4 * c + 1] += yv * w.y; lg[4 * c + 2] += yv * w.z; lg[4 * c + 3] += yv * w.w; } } }
#pragma unroll
        for (int e = 0; e < 16; ++e) lg[e] = wave_sum(lg[e]);
        float mx = lg[0];
#pragma unroll
        for (int e = 1; e < 16; ++e) mx = fmaxf(mx, lg[e]);
        float se = 0.f;
#pragma unroll
        for (int e = 0; e < 16; ++e) { lg[e] = expf(lg[e] - mx); se += lg[e]; }
        float mine = 0.f;
#pragma unroll
        for (int e = 0; e < 16; ++e) if (F.lane == e) mine = lg[e] / se;
        if (F.lane < 16) aff[(size_t)m * 16 + F.lane] = mine;
    }
}

__device__ __forceinline__ void p6_topk_unit(Frame& F, const Ptrs& P, int unit) {
    const int e = unit >> 4, b = unit & 15;
    const float* aff = (const float*)(P.ws + WS_AFF); short* inv = (short*)(P.ws + WS_INV); int* tok = (int*)(P.ws + WS_TOK);
    const bf16* h1b = (const bf16*)(P.ws + A_H1B); bf16* xe = (bf16*)(P.ws + A_XE);
    LAS unsigned* cnt = (LAS unsigned*)(F.lds + RING_OFF);
    LAS int* ltok = (LAS int*)(F.lds + RING_OFF + 256);
    unsigned key[4];
#pragma unroll
    for (int i = 0; i < 4; ++i) key[i] = __float_as_uint(aff[((size_t)b * SEQ + 4 * F.tid + i) * 16 + e]);
    __syncthreads();
    unsigned thr = 0u;
    for (int bit = 31; bit >= 0; --bit) {
        const unsigned cand = thr | (1u << bit);
        unsigned c = 0;
#pragma unroll
        for (int i = 0; i < 4; ++i) c += (unsigned)__popcll(__ballot(key[i] >= cand));
        LAS unsigned* cb = cnt + ((bit & 1) ? 8 : 0);
        if (F.lane == 0) cb[F.wave] = c;
        __syncthreads();
        unsigned tot = 0;
#pragma unroll
        for (int w = 0; w < 8; ++w) tot += cb[w];
        if (tot >= (unsigned)CAP) thr = cand;
    }
    __syncthreads();
    unsigned cg = 0, ce = 0;
#pragma unroll
    for (int i = 0; i < 4; ++i) { cg += key[i] > thr; ce += key[i] == thr; }
    unsigned pk = cg | (ce << 16), inc = pk;
#pragma unroll
    for (int o = 1; o < 64; o <<= 1) { const unsigned up = __shfl_up(inc, o); if (F.lane >= o) inc += up; }
    if (F.lane == 63) cnt[16 + F.wave] = inc;
    __syncthreads();
    unsigned base = 0, total = 0;
#pragma unroll
    for (int w = 0; w < 8; ++w) { const unsigned tw = cnt[16 + w]; if (w < F.wave) base += tw; total += tw; }
    const unsigned excl = base + inc - pk;
    unsigned pg = excl & 0xffffu, pe = excl >> 16; const unsigned ngt = total & 0xffffu; const unsigned need = (unsigned)CAP - ngt;
#pragma unroll
    for (int i = 0; i < 4; ++i) {
        const int t = 4 * F.tid + i; int slot = -1;
        if (key[i] > thr) { slot = (int)(pg + (pe < need ? pe : need)); ++pg; }
        else if (key[i] == thr) { if (pe < need) slot = (int)(pg + pe); ++pe; }
        inv[((size_t)b * SEQ + t) * 16 + e] = (short)slot;
        if (slot >= 0) { ltok[slot] = t; tok[unit * CAP + slot] = t; }
    }
    __syncthreads();
    for (int c = F.wave; c < CAP; c += NWAVES) {
        const v4u* src = (const v4u*)(h1b + ((size_t)b * SEQ + ltok[c]) * DM); v4u* dst = (v4u*)(xe + ((size_t)unit * CAP + c) * DM);
        const v4u a0 = src[F.lane], a1 = src[F.lane + 64]; dst[F.lane] = a0; dst[F.lane + 64] = a1;
    }
    __syncthreads();
}

__device__ __forceinline__ void p9_final(Frame& F, const Ptrs& P) {
    const int gw = F.vcu * NWAVES + F.wave, NGW = F.G * NWAVES;
    const float* aff = (const float*)(P.ws + WS_AFF); const short* inv = (const short*)(P.ws + WS_INV); const bf16* ye = (const bf16*)(P.ws + A_YE);
    for (int m = gw; m < MTOK; m += NGW) {
        const int b = m >> 11;
        GAS f32x4* o4 = (GAS f32x4*)(P.out + (size_t)m * DM) + F.lane;
        f32x4 v[4];
#pragma unroll
        for (int j = 0; j < 4; ++j) v[j] = o4[64 * j] * ALPHA;
        for (int e = 0; e < NEXP; ++e) {
            const int p = __builtin_amdgcn_readfirstlane((int)inv[(size_t)m * 16 + e]);
            if (p < 0) continue;
            const float gt = aff[(size_t)m * 16 + e];
            const GAS u32x2* yr = (const GAS u32x2*)(ye + ((size_t)(e * 16 + b) * CAP + p) * DM) + F.lane;
#pragma unroll
            for (int j = 0; j < 4; ++j) { const u32x2 w = yr[64 * j]; v[j] += (f32x4){pg8::bf_lo(w.x), pg8::bf_hi(w.x), pg8::bf_lo(w.y), pg8::bf_hi(w.y)} * gt; }
        }
        float s = 0.f;
#pragma unroll
        for (int j = 0; j < 4; ++j) s += (v[j].x + v[j].y) + (v[j].z + v[j].w);
        const float mean = wave_sum(s) * (1.f / DM); float s2 = 0.f;
#pragma unroll
        for (int j = 0; j < 4; ++j) { v[j] = v[j] - mean; s2 += (v[j].x * v[j].x + v[j].y * v[j].y) + (v[j].z * v[j].z + v[j].w * v[j].w); }
        const float rstd = 1.f / sqrtf(wave_sum(s2) * (1.f / DM) + LN_EPS);
#pragma unroll
        for (int j = 0; j < 4; ++j) { const f32x4 g2 = ((const f32x4*)P.ln2_g)[F.lane + 64 * j], b2 = ((const f32x4*)P.ln2_b)[F.lane + 64 * j]; o4[64 * j] = v[j] * rstd * g2 + b2; }
    }
}

struct OrderUp {
    int hf, vcu;
    __device__ __forceinline__ bool next(int i, pg8::Unit& u) const {
        if (i >= 8) return false;
        const int e = hf * 8 + i, x = vcu >> 5, l = vcu & 31, b = (x >> 1) * 4 + (l & 3), j = (x & 1) * 8 + (l >> 2);
        u.pm = i * 16 + b; u.pn = j; u.am = e * 16 + b; u.bt = e * 16 + j; return true;
    }
    __device__ __forceinline__ void a_ready(const pg8::Unit&) const {}
    __device__ __forceinline__ void done(const pg8::Unit&) const {}
};
struct OrderDown {
    int hf, vcu;
    __device__ __forceinline__ bool next(int i, pg8::Unit& u) const {
        if (i >= 2) return false;
        const int x = vcu >> 5, l = vcu & 31, pml = i * 64 + x * 8 + (l & 7), pn = l >> 3, pmg = hf * 128 + pml;
        u.pm = pmg; u.pn = pn; u.am = pml; u.bt = (pmg >> 4) * 4 + pn; return true;
    }
    __device__ __forceinline__ void a_ready(const pg8::Unit&) const {}
    __device__ __forceinline__ void done(const pg8::Unit&) const {}
};

#ifndef MK_N_LAUNCHES
#define MK_N_LAUNCHES 1
#endif
constexpr int N_PHASES = 13;
struct Args { Ptrs p; int ph_lo, ph_hi, li, pad; };
__global__ void __launch_bounds__(NWAVES * 64, 2) fwd_kernel(Args args) {
    extern __shared__ __attribute__((aligned(16))) unsigned char lds[];
    Frame F;
    F.lds = (LAS unsigned char*)lds;
    F.MISC = (volatile LAS unsigned*)(F.lds + MISC_OFF);
    F.tid = threadIdx.x; F.lane = F.tid & 63; F.wave = __builtin_amdgcn_readfirstlane(F.tid >> 6);
    F.G = gridDim.x; { const int bx = blockIdx.x; F.vcu = (bx % 8) * (F.G / 8) + bx / 8; }
    const Ptrs& P = args.p;
    unsigned char* ws = P.ws;
    F.ctl = (gu32*)(ws + WS_CTL);
    for (int u = F.tid; u < (LDS_BYTES - LDSCTL_OFF) / 4; u += NWAVES * 64) ((LAS unsigned*)(F.lds + LDSCTL_OFF))[u] = 0u;
    __syncthreads();
    XcdBarrier bar = xcd_barrier_post((unsigned*)(F.ctl + CW_BAR) + args.li * XCD_BAR_WORDS, F.MISC + 8);
    const int lo = args.ph_lo, hi = args.ph_hi;
#define IN(k) (lo <= (k) && (k) < hi)
#define SEAM(k) do { if (IN(k) && IN((k) + 1)) xcd_barrier(bar); } while (0)

    bf16* const h0b = (bf16*)(ws + A_H0B); bf16* const qkv = (bf16*)(ws + A_QKV); bf16* const gates = (bf16*)(ws + A_GATES);
    bf16* const attna = (bf16*)(ws + A_ATTNA); bf16* const ob = (bf16*)(ws + A_OB); bf16* const merged = (bf16*)(ws + A_MERGED); bf16* const mix = (bf16*)(ws + A_MIX);
    bf16* const xe = (bf16*)(ws + A_XE); bf16* const act = (bf16*)(ws + A_ACT); bf16* const ye = (bf16*)(ws + A_YE);

    if (IN(0)) { p0_prologue(F, P); } SEAM(0);
    if (IN(1)) {
        pg8::Gemm g{h0b, (const bf16*)(ws + WS_WIN), MTOK, 5120, 1024}; pg8::StaticOrder S; S.init(MTOK, 5120, F.G, (int)blockIdx.x);
        pg8::EpiProj E{qkv, gates, P.b_gate};
        pg8::gemm_phase<pg8::EpiProj, pg8::StaticOrder, true, true>(F.lds + RING_OFF, g, S, E);
    } SEAM(1);
    if (IN(2)) { p1b_prep(F, P); } SEAM(2);
    if (IN(3)) {
        for (int u = F.vcu; u < 512; u += F.G) attnA_naive_unit(F, P, u);
        for (int u = F.vcu; u < 256; u += F.G) attnB_naive_unit(F, P, u);
    } SEAM(3);
    if (IN(4)) {
        { pg8::Gemm g{attna, (const bf16*)(ws + WS_WA), MTOK, 1024, 512}; pg8::StaticOrder S; S.init(MTOK, 1024, F.G, (int)blockIdx.x);
          pg8::EpiGate<false> E{merged, gates, 0};
          pg8::gemm_phase<pg8::EpiGate<false>, pg8::StaticOrder, true, true>(F.lds + RING_OFF, g, S, E); }
        asm volatile("s_waitcnt vmcnt(0)" ::: "memory"); __syncthreads();
        { pg8::Gemm g{ob, (const bf16*)(ws + WS_WB), MTOK, 1024, 256}; pg8::StaticOrder S; S.init(MTOK, 1024, F.G, (int)blockIdx.x);
          pg8::EpiGate<true> E{merged, gates, 1024};
          pg8::gemm_phase<pg8::EpiGate<true>, pg8::StaticOrder, true, true>(F.lds + RING_OFF, g, S, E); }
    } SEAM(4);
    if (IN(5)) {
        pg8::Gemm g{merged, (const bf16*)(ws + WS_WO), MTOK, 1024, 1024}; pg8::StaticOrder S; S.init(MTOK, 1024, F.G, (int)blockIdx.x);
        pg8::EpiPlain E{mix, 1024};
        pg8::gemm_phase<pg8::EpiPlain, pg8::StaticOrder, true, true>(F.lds + RING_OFF, g, S, E);
    } SEAM(5);
    if (IN(6)) { p5_ln1_router_convert(F, P); } SEAM(6);
    if (IN(7)) { for (int u = F.vcu; u < 256; u += F.G) p6_topk_unit(F, P, u); } SEAM(7);
#pragma unroll 1
    for (int hf = 0; hf < 2; ++hf) {
        if (IN(8 + 2 * hf)) {
            pg8::Gemm g{xe, (const bf16*)(ws + A_WGU), 0, 0, 1024}; OrderUp S{hf, F.vcu};
            pg8::EpiSwiglu E{act};
            pg8::gemm_phase<pg8::EpiSwiglu, OrderUp, true, true>(F.lds + RING_OFF, g, S, E);
        } SEAM(8 + 2 * hf);
        if (IN(9 + 2 * hf)) {
            pg8::Gemm g{act, (const bf16*)(ws + A_WD), 0, 0, 2048}; OrderDown S{hf, F.vcu};
            pg8::EpiPlain E{ye, 1024};
            pg8::gemm_phase<pg8::EpiPlain, OrderDown, true, true>(F.lds + RING_OFF, g, S, E);
        } SEAM(9 + 2 * hf);
    }
    if (IN(12)) { p9_final(F, P); }
#undef IN
#undef SEAM
}

extern "C" void kernel_launch(void* const* d_in, const int* in_sizes, int n_in, void* d_out, int out_size, void* d_ws, size_t ws_size, hipStream_t stream) {
    static int grid = 0;
    if (grid == 0) {
        if (n_in != 18 || in_sizes[0] != MTOK * DM || out_size != MTOK * DM || ws_size < WS_END) { fprintf(stderr, "kernel_launch: unexpected shapes / workspace (n_in %d, ws %zu, need %zu)\n", n_in, ws_size, (size_t)WS_END); grid = -1; return; }
        if (hipFuncSetAttribute((const void*)fwd_kernel, hipFuncAttributeMaxDynamicSharedMemorySize, LDS_BYTES) != hipSuccess) { fprintf(stderr, "kernel_launch: hipFuncSetAttribute failed\n"); grid = -1; return; }
        (void)hipGetLastError();
        grid = 256;
    }
    if (grid < 0) return;
    if (hipMemsetAsync((char*)d_ws + WS_CTL, 0, CTL_ZERO_BYTES, stream) != hipSuccess) return;
    Args a{};
    const float** pp = (const float**)&a.p;
    for (int i = 0; i < 18; ++i) pp[i] = (const float*)d_in[i];
    a.p.out = (float*)d_out; a.p.ws = (unsigned char*)d_ws;
    constexpr int NL = MK_N_LAUNCHES;
    for (int li = 0; li < NL; ++li) {
        a.ph_lo = (NL == 1) ? 0 : li; a.ph_hi = (NL == 1) ? N_PHASES : li + 1; a.li = (NL == 1) ? 0 : 0;
        hipLaunchKernelGGL(fwd_kernel, dim3(grid), dim3(NWAVES * 64), LDS_BYTES, stream, a);
    }
}
```

```cpp
#include <hip/hip_runtime.h>
#include <cstdio>
#include <cstdint>
namespace pg8 {
#define PG8_LAS __attribute__((address_space(3)))
typedef unsigned short bf16_t;
typedef short bf16x8 __attribute__((ext_vector_type(8)));
typedef float f32x4 __attribute__((ext_vector_type(4)));
typedef unsigned u32x4 __attribute__((ext_vector_type(4)));
constexpr int BM = 256, BK = 64, HALF = 128, HTB = HALF * BK * 2  , STAGE_BYTES = 8 * HTB, NXCD = 8, WGM = 8;

__host__ __device__ __forceinline__ int lds_byte(int r, int c) { const int st = (r >> 4) * 2 + (c >> 5), rr = r & 15, cc = c & 31, ob = rr * 64 + cc * 2; return st * 1024 + (ob ^ (((ob >> 9) & 1) << 5)); }
__host__ __device__ __forceinline__ void stage_rc(int b, int& R, int& C) { const int st = b / 1024, sb = b % 1024, swz = sb ^ (((sb >> 9) & 1) << 5); R = (st >> 1) * 16 + swz / 64; C = (st & 1) * 32 + (swz % 64) / 2; }
__host__ __device__ __forceinline__ int perm32(int rho) { const int n = rho >> 4, i = rho & 15; return 8 * (i >> 2) + 4 * n + (i & 3); }

struct Unit { int pm, pn, am, bt; };
struct Gemm { const bf16_t* A; const bf16_t* Bt; int M, N, K; };

struct StaticOrder {
    int nM, nN, nwg, G, c;
    __host__ __device__ void init(int M, int N, int G_, int c_) { nM = M / BM; nN = N / BM; nwg = nM * nN; G = G_; c = c_; }
    __host__ __device__ bool next(int i, Unit& u) const {
        const long L = (long)i * G + c; if (L >= nwg) return false;
        int wgid = (int)L; { const int q = nwg / NXCD, r = nwg % NXCD, xcd = wgid % NXCD, off = wgid / NXCD; wgid = (xcd < r ? xcd * (q + 1) : r * (q + 1) + (xcd - r) * q) + off; }
        const int nig = WGM * nN, gid = wgid / nig, fm = gid * WGM, gsz = (nM - fm) < WGM ? (nM - fm) : WGM;
        u.pm = fm + ((wgid % nig) % gsz); u.pn = (wgid % nig) / gsz; u.am = u.pm; u.bt = u.pn; return true;
    }
    __device__ __forceinline__ void a_ready(const Unit&) const {}
    __device__ __forceinline__ void done(const Unit&) const {}
};

__device__ __forceinline__ unsigned cvt_pk_bf16(float lo, float hi) { unsigned r; asm volatile("v_cvt_pk_bf16_f32 %0, %1, %2" : "=v"(r) : "v"(lo), "v"(hi)); return r; }
__device__ __forceinline__ float bf_lo(unsigned w) { return __uint_as_float(w << 16); }
__device__ __forceinline__ float bf_hi(unsigned w) { return __uint_as_float(w & 0xffff0000u); }
__device__ __forceinline__ float sigmoidf_(float x) { return 1.0f / (1.0f + __expf(-x)); }
__device__ __forceinline__ u32x4 pack8(const f32x4 v0, const f32x4 v1) { u32x4 w; w.x = cvt_pk_bf16(v0[0], v0[1]); w.y = cvt_pk_bf16(v0[2], v0[3]); w.z = cvt_pk_bf16(v1[0], v1[1]); w.w = cvt_pk_bf16(v1[2], v1[3]); return w; }

struct EpiProj {
    static constexpr bool PERM = true, AFTER_DRAIN = false;
    bf16_t* qkv; bf16_t* gates; const float* b_gate;
    __device__ __forceinline__ void operator()(const f32x4 (&acc)[2][2][4][2], const Unit& u, int wr, int wc, int fr, int fq) const {
        const int row0 = u.pm * BM + wr * 64 + fr;
        const bool isg = u.pn >= 12;
        bf16_t* base = isg ? gates : qkv; const int ldc = isg ? 2048 : 3072; const int colt = isg ? (u.pn - 12) * BM : u.pn * BM;
        const int col0 = colt + wc * 32 + 8 * fq;
        f32x4 bv[2][2];
#pragma unroll
        for (int bj = 0; bj < 2; ++bj)
#pragma unroll
            for (int n = 0; n < 2; ++n) bv[bj][n] = isg ? *(const f32x4*)(b_gate + col0 + bj * HALF + 4 * n) : (f32x4){0.f, 0.f, 0.f, 0.f};
#pragma unroll
        for (int ai = 0; ai < 2; ++ai)
#pragma unroll
            for (int m = 0; m < 4; ++m) { bf16_t* rowp = base + (size_t)(row0 + ai * HALF + m * 16) * ldc + col0;
#pragma unroll
                for (int bj = 0; bj < 2; ++bj) { f32x4 v0 = acc[ai][bj][m][0] + bv[bj][0], v1 = acc[ai][bj][m][1] + bv[bj][1];
                    if (isg) {
#pragma unroll
                        for (int i = 0; i < 4; ++i) { v0[i] = sigmoidf_(v0[i]); v1[i] = sigmoidf_(v1[i]); } }
                    *(u32x4*)(rowp + bj * HALF) = pack8(v0, v1); } }
    }
};
struct EpiPlain {
    static constexpr bool PERM = true, AFTER_DRAIN = false;
    bf16_t* O; int ldc;
    __device__ __forceinline__ void operator()(const f32x4 (&acc)[2][2][4][2], const Unit& u, int wr, int wc, int fr, int fq) const {
        const int row0 = u.pm * BM + wr * 64 + fr; const int col0 = u.pn * BM + wc * 32 + 8 * fq;
#pragma unroll
        for (int ai = 0; ai < 2; ++ai)
#pragma unroll
            for (int m = 0; m < 4; ++m) { bf16_t* rowp = O + (size_t)(row0 + ai * HALF + m * 16) * ldc + col0;
#pragma unroll
                for (int bj = 0; bj < 2; ++bj) *(u32x4*)(rowp + bj * HALF) = pack8(acc[ai][bj][m][0], acc[ai][bj][m][1]); }
    }
};
template <bool ACCUM> struct EpiGate {
    static constexpr bool PERM = true, AFTER_DRAIN = false;
    bf16_t* merged; const bf16_t* gates; int goff;
    __device__ __forceinline__ void operator()(const f32x4 (&acc)[2][2][4][2], const Unit& u, int wr, int wc, int fr, int fq) const {
        const int row0 = u.pm * BM + wr * 64 + fr; const int col0 = u.pn * BM + wc * 32 + 8 * fq;
#pragma unroll
        for (int ai = 0; ai < 2; ++ai)
#pragma unroll
            for (int m = 0; m < 4; ++m) { const size_t r = (size_t)(row0 + ai * HALF + m * 16);
#pragma unroll
                for (int bj = 0; bj < 2; ++bj) {
                    const u32x4 g = *(const u32x4*)(gates + r * 2048 + goff + col0 + bj * HALF);
                    f32x4 v0 = acc[ai][bj][m][0], v1 = acc[ai][bj][m][1];
                    v0[0] *= bf_lo(g.x); v0[1] *= bf_hi(g.x); v0[2] *= bf_lo(g.y); v0[3] *= bf_hi(g.y);
                    v1[0] *= bf_lo(g.z); v1[1] *= bf_hi(g.z); v1[2] *= bf_lo(g.w); v1[3] *= bf_hi(g.w);
                    bf16_t* p = merged + r * 1024 + col0 + bj * HALF;
                    if (ACCUM) { const u32x4 o = *(const u32x4*)p;
                        v0[0] += bf_lo(o.x); v0[1] += bf_hi(o.x); v0[2] += bf_lo(o.y); v0[3] += bf_hi(o.y);
                        v1[0] += bf_lo(o.z); v1[1] += bf_hi(o.z); v1[2] += bf_lo(o.w); v1[3] += bf_hi(o.w); }
                    *(u32x4*)p = pack8(v0, v1); } }
    }
};
struct EpiSwiglu {
    static constexpr bool PERM = true, AFTER_DRAIN = false;
    bf16_t* act;
    __device__ __forceinline__ void operator()(const f32x4 (&acc)[2][2][4][2], const Unit& u, int wr, int wc, int fr, int fq) const {
        const int row0 = u.pm * BM + wr * 64 + fr; const int col0 = u.pn * HALF + wc * 32 + 8 * fq;
#pragma unroll
        for (int ai = 0; ai < 2; ++ai)
#pragma unroll
            for (int m = 0; m < 4; ++m) {
                f32x4 v0, v1;
#pragma unroll
                for (int i = 0; i < 4; ++i) { const float g0 = acc[ai][0][m][0][i], g1 = acc[ai][0][m][1][i];
                    v0[i] = g0 * sigmoidf_(g0) * acc[ai][1][m][0][i]; v1[i] = g1 * sigmoidf_(g1) * acc[ai][1][m][1][i]; }
                *(u32x4*)(act + (size_t)(row0 + ai * HALF + m * 16) * 2048 + col0) = pack8(v0, v1); }
    }
};
template <class Epi, class Sched, bool ALIGN_EPI = false, bool SP2 = false>
__device__ __forceinline__ void gemm_phase(PG8_LAS unsigned char* lds, const Gemm g, const Sched& S, const Epi& E) {
    int tid_ = threadIdx.x; asm volatile("" : "+v"(tid_));
    const int tid = tid_, wid = __builtin_amdgcn_readfirstlane(tid >> 6), lane = tid & 63, wr = wid >> 2, wc = wid & 3, fr = lane & 15, fq = lane >> 4;
    const int K = g.K, nt = K / BK;
    unsigned voffA[2], voffB[2];
#pragma unroll
    for (int i = 0; i < 2; ++i) { int R, C; stage_rc(tid * 16 + i * 8192, R, C); const int Rb = Epi::PERM ? ((R & ~31) + perm32(R & 31)) : R;
        voffA[i] = (unsigned)(R * K + C) * 2u; voffB[i] = (unsigned)(Rb * K + C) * 2u; }
    const size_t kstep = (size_t)(BK * 2);
    const size_t hstep = (size_t)HALF * K * 2;
    const size_t tstep = 2 * hstep;
    const unsigned ldsw = (unsigned)wid * 1024u;
    const int aoff = lds_byte(wr * 64 + fr, fq * 8), boff = lds_byte(wc * 32 + fr, fq * 8);
#define PG8_SA(b, h) (((b) * 2 + (h)) * HTB)
#define PG8_SB(b, h) ((4 + (b) * 2 + (h)) * HTB)
#define PG8_STAGE(bufoff, gbase, voff) do { _Pragma("unroll") for (int _i = 0; _i < 2; ++_i) \
        __builtin_amdgcn_global_load_lds((const unsigned*)((const char*)(gbase) + (voff)[_i]), (PG8_LAS unsigned*)(lds + (bufoff) + ldsw + _i * 8192), 16, 0, 0); } while (0)
#define PG8_LDA(dst, b, h) do { _Pragma("unroll") for (int m = 0; m < 4; ++m) _Pragma("unroll") for (int k = 0; k < 2; ++k) dst[m][k] = *(const PG8_LAS bf16x8*)(lds + PG8_SA(b, h) + aoff + m * 2048 + k * 1024); } while (0)
#define PG8_LDB(dst, b, h) do { _Pragma("unroll") for (int n = 0; n < 2; ++n) _Pragma("unroll") for (int k = 0; k < 2; ++k) dst[n][k] = *(const PG8_LAS bf16x8*)(lds + PG8_SB(b, h) + boff + n * 2048 + k * 1024); } while (0)
#define PG8_MMA(ai, bj, At, Bt) do { __builtin_amdgcn_s_setprio(1); _Pragma("unroll") for (int m = 0; m < 4; ++m) _Pragma("unroll") for (int n = 0; n < 2; ++n) _Pragma("unroll") for (int k = 0; k < 2; ++k) \
        acc[ai][bj][m][n] = __builtin_amdgcn_mfma_f32_16x16x32_bf16(Bt[n][k], At[m][k], acc[ai][bj][m][n], 0, 0, 0); __builtin_amdgcn_s_setprio(0); } while (0)
#define PG8_WAIT_V(n) asm volatile("s_waitcnt vmcnt(" #n ")" ::: "memory")
#define PG8_WAIT_L(n) asm volatile("s_waitcnt lgkmcnt(" #n ")" ::: "memory")
#define PG8_BAR __builtin_amdgcn_s_barrier()
#define PG8_SCHED __builtin_amdgcn_sched_barrier(0)
    Unit cur, nxt; int ui = 0;
    if (!S.next(0, cur)) return;
    f32x4 acc[2][2][4][2];
#pragma unroll
    for (int a = 0; a < 2; ++a)
#pragma unroll
        for (int b = 0; b < 2; ++b)
#pragma unroll
            for (int m = 0; m < 4; ++m)
#pragma unroll
                for (int n = 0; n < 2; ++n) acc[a][b][m][n] = (f32x4){0.f, 0.f, 0.f, 0.f};
    bf16x8 At[4][2], B0[2][2], B1[2][2];
    const char* cA = (const char*)g.A + (size_t)cur.am * tstep; const char* cB = (const char*)g.Bt + (size_t)cur.bt * tstep;
    S.a_ready(cur);
    if constexpr (SP2) {
        PG8_STAGE(PG8_SB(0, 0), cB, voffB); PG8_STAGE(PG8_SB(0, 1), cB + hstep, voffB); PG8_STAGE(PG8_SA(0, 0), cA, voffA); PG8_STAGE(PG8_SA(0, 1), cA + hstep, voffA);
        if (wr == 1) PG8_BAR;
        PG8_WAIT_V(2); PG8_BAR;
        PG8_STAGE(PG8_SB(1, 0), cB + kstep, voffB); PG8_STAGE(PG8_SA(1, 0), cA + kstep, voffA); PG8_STAGE(PG8_SB(1, 1), cB + hstep + kstep, voffB);
        PG8_WAIT_V(6); PG8_BAR;
    } else {
        PG8_STAGE(PG8_SB(0, 0), cB, voffB); PG8_STAGE(PG8_SA(0, 0), cA, voffA); PG8_STAGE(PG8_SB(0, 1), cB + hstep, voffB); PG8_STAGE(PG8_SA(0, 1), cA + hstep, voffA);
        if (wr == 1) PG8_BAR;
        PG8_WAIT_V(4); PG8_BAR;
        PG8_STAGE(PG8_SB(1, 0), cB + kstep, voffB); PG8_STAGE(PG8_SA(1, 0), cA + kstep, voffA); PG8_STAGE(PG8_SB(1, 1), cB + hstep + kstep, voffB);
        PG8_WAIT_V(6); PG8_BAR;
    }
    for (;;) {
        const bool has_next = S.next(ui + 1, nxt);
        const char* nA = has_next ? (const char*)g.A + (size_t)nxt.am * tstep : cA; const char* nB = has_next ? (const char*)g.Bt + (size_t)nxt.bt * tstep : cB;
        for (int t = 0; t < nt; t += 2) {
            const bool last = (t == nt - 2);
            const char* a1 = cA + (size_t)(t + 1) * kstep;
            const char* a2 = last ? nA : cA + (size_t)(t + 2) * kstep; const char* b2 = last ? nB : cB + (size_t)(t + 2) * kstep;
            const char* a3 = a2 + kstep; const char* b3 = b2 + kstep;
            if (last && has_next) S.a_ready(nxt);
            if constexpr (SP2) {
            PG8_LDB(B0, 0, 0); PG8_LDB(B1, 0, 1); PG8_SCHED; PG8_LDA(At, 0, 0); PG8_STAGE(PG8_SA(1, 1), a1 + hstep, voffA);
            PG8_WAIT_V(8); PG8_WAIT_L(0); PG8_BAR; PG8_MMA(0, 0, At, B0); PG8_MMA(0, 1, At, B1); PG8_BAR; PG8_SCHED;
            PG8_LDA(At, 0, 1); PG8_STAGE(PG8_SB(0, 0), b2, voffB); PG8_STAGE(PG8_SB(0, 1), b2 + hstep, voffB); PG8_STAGE(PG8_SA(0, 0), a2, voffA);
            PG8_WAIT_V(8); PG8_WAIT_L(0); PG8_BAR; PG8_MMA(1, 0, At, B0); PG8_MMA(1, 1, At, B1); PG8_BAR; PG8_SCHED;
            PG8_LDB(B0, 1, 0); PG8_LDB(B1, 1, 1); PG8_SCHED; PG8_LDA(At, 1, 0); PG8_STAGE(PG8_SA(0, 1), a2 + hstep, voffA);
            PG8_WAIT_V(8); PG8_WAIT_L(0); PG8_BAR; PG8_MMA(0, 0, At, B0); PG8_MMA(0, 1, At, B1); PG8_BAR; PG8_SCHED;
            PG8_LDA(At, 1, 1); PG8_STAGE(PG8_SB(1, 0), b3, voffB); PG8_STAGE(PG8_SB(1, 1), b3 + hstep, voffB); PG8_STAGE(PG8_SA(1, 0), a3, voffA);
            PG8_WAIT_V(8); PG8_WAIT_L(0); PG8_BAR; PG8_MMA(1, 0, At, B0); PG8_MMA(1, 1, At, B1); PG8_BAR; PG8_SCHED;
            } else {
            PG8_LDB(B0, 0, 0); PG8_SCHED; PG8_LDA(At, 0, 0); PG8_STAGE(PG8_SA(1, 1), a1 + hstep, voffA);
            PG8_WAIT_L(8); PG8_BAR; PG8_WAIT_L(0); PG8_MMA(0, 0, At, B0); PG8_BAR; PG8_SCHED;
            PG8_LDB(B1, 0, 1); PG8_STAGE(PG8_SB(0, 0), b2, voffB);
            PG8_BAR; PG8_WAIT_L(0); PG8_MMA(0, 1, At, B1); PG8_BAR;
            PG8_LDA(At, 0, 1); PG8_STAGE(PG8_SA(0, 0), a2, voffA);
            PG8_BAR; PG8_WAIT_L(0); PG8_MMA(1, 0, At, B0); PG8_BAR; PG8_SCHED;
            PG8_STAGE(PG8_SB(0, 1), b2 + hstep, voffB);
            PG8_WAIT_V(6); PG8_BAR; PG8_MMA(1, 1, At, B1); PG8_BAR;
            PG8_LDB(B0, 1, 0); PG8_SCHED; PG8_LDA(At, 1, 0); PG8_STAGE(PG8_SA(0, 1), a2 + hstep, voffA);
            PG8_WAIT_L(8); PG8_BAR; PG8_WAIT_L(0); PG8_MMA(0, 0, At, B0); PG8_BAR; PG8_SCHED;
            PG8_LDB(B1, 1, 1); PG8_STAGE(PG8_SB(1, 0), b3, voffB);
            PG8_BAR; PG8_WAIT_L(0); PG8_MMA(0, 1, At, B1); PG8_BAR;
            PG8_LDA(At, 1, 1); PG8_STAGE(PG8_SA(1, 0), a3, voffA);
            PG8_BAR; PG8_WAIT_L(0); PG8_MMA(1, 0, At, B0); PG8_BAR; PG8_SCHED;
            PG8_STAGE(PG8_SB(1, 1), b3 + hstep, voffB);
            PG8_WAIT_V(6); PG8_BAR; PG8_MMA(1, 1, At, B1); PG8_BAR;
            }
        }
        if constexpr (ALIGN_EPI) { if (wr == 0) PG8_BAR; }
        if constexpr (!Epi::AFTER_DRAIN) { E(acc, cur, wr, wc, fr, fq); S.done(cur); }
        if (!has_next) break;
#pragma unroll
        for (int a = 0; a < 2; ++a)
#pragma unroll
            for (int b = 0; b < 2; ++b)
#pragma unroll
                for (int m = 0; m < 4; ++m)
#pragma unroll
                    for (int n = 0; n < 2; ++n) acc[a][b][m][n] = (f32x4){0.f, 0.f, 0.f, 0.f};
        cur = nxt; cA = nA; cB = nB; ++ui;
        if constexpr (ALIGN_EPI) { if (wr == 1) PG8_BAR; }
    }
    PG8_WAIT_V(0);
    if constexpr (!ALIGN_EPI) { if (wr == 0) PG8_BAR; }
    PG8_BAR;
    if constexpr (Epi::AFTER_DRAIN) { E.fused(acc, cur, wr, wc, fr, fq, lds, wid, lane); S.done(cur); }
#undef PG8_SA
#undef PG8_SB
#undef PG8_STAGE
#undef PG8_LDA
#undef PG8_LDB
#undef PG8_MMA
#undef PG8_WAIT_V
#undef PG8_WAIT_L
#undef PG8_BAR
#undef PG8_SCHED
}
}
#include <hip/hip_bf16.h>
#include <cmath>
namespace attn_body {
using bf16=__hip_bfloat16;
using bf16x8=__attribute__((ext_vector_type(8)))short;
using s16x4=__attribute__((ext_vector_type(4)))short;
using f32x16=__attribute__((ext_vector_type(16)))float;
using u32x4=__attribute__((ext_vector_type(4)))unsigned;
constexpr int BATCH=16,NHEAD=8,SEQ=2048,D=64,PQ=3072,PO=512;
constexpr int NW=8,QBLK=32,QB=QBLK*NW,KVBLK=64,NQB=SEQ/QB;
constexpr int ATTN_UNIT_ROWS=QB;
__device__ __forceinline__ int crow(int r,int hi){return (r&3)+8*(r>>2)+4*hi;}
#define SBAR() __builtin_amdgcn_sched_barrier(0)
__device__ __forceinline__ void cmask(f32x16&p0,f32x16&p1,int jb,int qrel,int hi){
  const float NEG=-INFINITY; int kb=64*jb+4*hi;
  #pragma unroll
  for(int r=0;r<16;++r){int kv=kb+(r&3)+8*(r>>2); if(kv>qrel)p0[r]=NEG; if(kv+32>qrel)p1[r]=NEG;}
}

constexpr int NSLOT=3, SLOTB=8192;
constexpr int LDS_K=0, LDS_V=NSLOT*SLOTB, LDS_WS=2*NSLOT*SLOTB, LDS_OST=LDS_WS+NW*64*4, LDS_BYTES=LDS_OST+NW*4096;
constexpr float C2=0.125f*1.4426950408889634f;
__device__ __forceinline__ void glds16(const void*gsrc,unsigned lds_dst){unsigned keep;
  asm volatile("s_mov_b32 %0, m0\n\ts_mov_b32 m0, %2\n\ts_nop 0\n\tglobal_load_lds_dwordx4 %1, off\n\ts_mov_b32 m0, %0":"=&s"(keep):"v"(gsrc),"s"(lds_dst):"memory");}
__device__ __forceinline__ float max3f(float a,float b,float c){float r;asm("v_max3_f32 %0, %1, %2, %3":"=v"(r):"v"(a),"v"(b),"v"(c));return r;}
__device__ __forceinline__ float max2f(float a,float b){float r;asm("v_max_f32_e32 %0, %1, %2":"=v"(r):"v"(a),"v"(b));return r;}
__device__ __forceinline__ float fadd_s(float a,float b){float r;asm("v_add_f32_e32 %0, %1, %2":"=v"(r):"v"(a),"v"(b));return r;}
__device__ __forceinline__ float fsub_s(float a,float b){float r;asm("v_sub_f32_e32 %0, %1, %2":"=v"(r):"v"(a),"v"(b));return r;}
typedef float f32x2_t __attribute__((ext_vector_type(2))); typedef __bf16 bf16x2_t __attribute__((ext_vector_type(2)));
__device__ __forceinline__ unsigned cvtpk_s(float lo,float hi){f32x2_t v={lo,hi};bf16x2_t b=__builtin_convertvector(v,bf16x2_t);return __builtin_bit_cast(unsigned,b);}
#define WAIT_BAR(N) asm volatile("s_waitcnt vmcnt(" #N ") lgkmcnt(0)\n\ts_barrier":::"memory")

__device__ __forceinline__ void qkt(f32x16&p0,f32x16&p1,const char*Kslot,const bf16x8*qr,const f32x16&negm,int r32,int hi){
  const char*kb=Kslot+hi*1024+r32*16;
  #pragma unroll
  for(int d0=0;d0<4;++d0){
    const bf16x8 b0=*reinterpret_cast<const bf16x8*>(kb+d0*2048);
    const bf16x8 b1=*reinterpret_cast<const bf16x8*>(kb+d0*2048+512);
    if(d0==0){p0=__builtin_amdgcn_mfma_f32_32x32x16_bf16(b0,qr[0],negm,0,0,0);p1=__builtin_amdgcn_mfma_f32_32x32x16_bf16(b1,qr[0],negm,0,0,0);}
    else{p0=__builtin_amdgcn_mfma_f32_32x32x16_bf16(b0,qr[d0],p0,0,0,0);p1=__builtin_amdgcn_mfma_f32_32x32x16_bf16(b1,qr[d0],p1,0,0,0);}}
}
typedef __attribute__((address_space(3))) const char* lds_cptr;
typedef short v4i16_t __attribute__((ext_vector_type(4)));
__device__ __forceinline__ void kload8(bf16x8*kf,lds_cptr kp){
  kf[0]=*(const __attribute__((address_space(3))) bf16x8*)(kp);      kf[1]=*(const __attribute__((address_space(3))) bf16x8*)(kp+512);
  kf[2]=*(const __attribute__((address_space(3))) bf16x8*)(kp+2048); kf[3]=*(const __attribute__((address_space(3))) bf16x8*)(kp+2560);
  kf[4]=*(const __attribute__((address_space(3))) bf16x8*)(kp+4096); kf[5]=*(const __attribute__((address_space(3))) bf16x8*)(kp+4608);
  kf[6]=*(const __attribute__((address_space(3))) bf16x8*)(kp+6144); kf[7]=*(const __attribute__((address_space(3))) bf16x8*)(kp+6656);
}
__device__ __forceinline__ void kload2(bf16x8*kf,lds_cptr kp,int j){ kf[2*j]=*(const __attribute__((address_space(3))) bf16x8*)(kp+j*2048); kf[2*j+1]=*(const __attribute__((address_space(3))) bf16x8*)(kp+j*2048+512); }
__device__ __forceinline__ s16x4 vtr(lds_cptr p){ return __builtin_bit_cast(s16x4,__builtin_amdgcn_ds_read_tr16_b64_v4i16((__attribute__((address_space(3))) v4i16_t*)p)); }
__device__ __forceinline__ float rowmax(const f32x16&p0,const f32x16&p1){
  float a=max3f(p0[0],p0[1],p1[0]),b=max3f(p0[2],p0[3],p1[1]);a=max3f(a,p1[2],p1[3]);
  #pragma unroll
  for(int r=4;r<16;r+=4){a=max3f(a,p0[r],p0[r+1]);b=max3f(b,p0[r+2],p0[r+3]);a=max3f(a,p1[r],p1[r+1]);b=max3f(b,p1[r+2],p1[r+3]);}
  const float m=max2f(a,b);
  auto rr=__builtin_amdgcn_permlane32_swap(__float_as_uint(m),__float_as_uint(m),false,false);
  return max2f(__uint_as_float(rr[0]),__uint_as_float(rr[1]));
}
__device__ __forceinline__ void pv(f32x16*o,int vb,bf16x8 pa0,bf16x8 pa1,bf16x8 pa2,bf16x8 pa3){
  #pragma unroll
  for(int d0=0;d0<2;++d0){s16x4 lo[4],hi[4];
    #pragma unroll
    for(int ks=0;ks<4;++ks){
      asm volatile("ds_read_b64_tr_b16 %0,%1 offset:%c2":"=&v"(lo[ks]):"v"(vb),"i"(d0*4096+ks*1024):"memory");
      asm volatile("ds_read_b64_tr_b16 %0,%1 offset:%c2":"=&v"(hi[ks]):"v"(vb),"i"(d0*4096+ks*1024+512):"memory");}
    asm volatile("s_waitcnt lgkmcnt(0)":::"memory");SBAR();
    #define PK(k) (bf16x8){lo[k][0],lo[k][1],lo[k][2],lo[k][3],hi[k][0],hi[k][1],hi[k][2],hi[k][3]}
    o[d0]=__builtin_amdgcn_mfma_f32_32x32x16_bf16(pa0,PK(0),o[d0],0,0,0);
    o[d0]=__builtin_amdgcn_mfma_f32_32x32x16_bf16(pa1,PK(1),o[d0],0,0,0);
    o[d0]=__builtin_amdgcn_mfma_f32_32x32x16_bf16(pa2,PK(2),o[d0],0,0,0);
    o[d0]=__builtin_amdgcn_mfma_f32_32x32x16_bf16(pa3,PK(3),o[d0],0,0,0);
    #undef PK
  }
}

#ifndef ATTN_STORE16
#define ATTN_STORE16(p,v) (*(u32x4*)(p)=(v))
#endif
template<int THRL> __device__ __forceinline__ void attn_unit(int b,int h,int kvh,int qb,const bf16*Q,const bf16*__restrict__ K,const bf16*__restrict__ V,bf16*O,char*shm){
  int tid_=threadIdx.x; asm volatile("":"+v"(tid_)); const int tid=tid_,lane=tid&63,r32=lane&31,hi=lane>>5; const int wid=__builtin_amdgcn_readfirstlane(tid>>6);
  const long rowbase=(long)b*SEQ; const int q0=qb*QB;
  const bf16*Qw=Q+(rowbase+q0+wid*QBLK)*PQ+h*D;
  const bf16*Kh=K+rowbase*PQ+kvh*D,*Vh=V+rowbase*PQ+kvh*D;
  const unsigned lds0=(unsigned)(uintptr_t)shm;
  float*wsf=(float*)(shm+LDS_WS)+wid*64;
  const bf16*ksrc=Kh+(long)lane*PQ+wid*8;
  const bf16*vsrc=Vh+(long)(16*(wid&3)+(lane>>2))*PQ+(wid>>2)*32+(lane&3)*8;
  const unsigned kdst=lds0+LDS_K+wid*1024, vdst=lds0+LDS_V+wid*1024;
  #define DMA_K(t,slot) glds16(ksrc+(long)(t)*KVBLK*PQ,(unsigned)__builtin_amdgcn_readfirstlane(kdst+(slot)))
  #define DMA_V(t,slot) glds16(vsrc+(long)(t)*KVBLK*PQ,(unsigned)__builtin_amdgcn_readfirstlane(vdst+(slot)))
  const int vb0=(int)(lds0+LDS_V)+((lane>>4)&1)*32+(lane&3)*8+(4*hi+((lane&15)>>2))*64;
  const char*Kbase=shm+LDS_K; bf16x8 kf[8];
  const lds_cptr shm3=(lds_cptr)shm; const lds_cptr kp0=shm3+LDS_K+hi*1024+r32*16; const lds_cptr vp0=shm3+LDS_V+((lane>>4)&1)*32+(lane&3)*8+(4*hi+((lane&15)>>2))*64;
  constexpr int NT=SEQ/KVBLK;
  DMA_K(0,0);DMA_V(0,0);DMA_K(1,SLOTB);
  bf16x8 qr[4];
  #pragma unroll
  for(int d0=0;d0<4;++d0)qr[d0]=*reinterpret_cast<const bf16x8*>(&Qw[(long)r32*PQ+d0*16+hi*8]);
  float mhat=0.f,l_reg=0.f;f32x16 o[2];o[0]=f32x16{};o[1]=f32x16{};f32x16 negm=f32x16{};asm volatile("":"+v"(negm));

  #define CMASK(P0,P1,t) do{}while(0)
  bool resc=false;
  #define START(P0,P1) do{ const float rm=rowmax(P0,P1); resc=false; \
    { const float dl=rm; mhat=fadd_s(mhat,dl); \
      _Pragma("unroll") for(int r=0;r<16;++r){P0[r]=fsub_s(P0[r],dl);P1[r]=fsub_s(P1[r],dl);} \
      _Pragma("unroll") for(int r=0;r<16;++r)negm[r]=-mhat; asm volatile("":"+v"(negm)); } \
    _Pragma("unroll") for(int r=0;r<16;++r)P0[r]=__builtin_amdgcn_exp2f(P0[r]); }while(0)
  #define RESC() do{ if(resc){ asm volatile("s_waitcnt lgkmcnt(0)":::"memory"); \
      _Pragma("unroll") for(int d_=0;d_<2;++d_) _Pragma("unroll") for(int r=0;r<16;++r)o[d_][r]*=wsf[crow(r,hi)]; } }while(0)
  f32x16 pA0,pA1,pB0,pB1;
  int sl_prev=0,sl_cur=0,sl_next=SLOTB;
  #define ROT() do{sl_prev=sl_cur;sl_cur=sl_next;sl_next=(sl_next==(NSLOT-1)*SLOTB)?0:sl_next+SLOTB;}while(0)
  DMA_K(2,2*SLOTB);
  WAIT_BAR(3);
  qkt(pA0,pA1,Kbase,qr,negm,r32,hi);asm volatile("s_nop 15\n\ts_nop 7":"+v"(pA0),"+v"(pA1));CMASK(pA0,pA1,0);
  START(pA0,pA1);
  _Pragma("unroll") for(int r=0;r<16;++r)pA1[r]=__builtin_amdgcn_exp2f(pA1[r]);
  WAIT_BAR(0);
  DMA_K(3,0);DMA_V(1,SLOTB);
  ROT();
  kload8(kf,kp0+sl_cur);
  WAIT_BAR(2);
  s16x4 vlo[8],vhi[8]; u32x4 pw0,pw1,pw2,pw3;
  #define PKW(P,B) cvtpk_s(P[B],P[B+1])
  #define PAF(k) __builtin_bit_cast(bf16x8,pw##k)
  #define VFR(i) (bf16x8){vlo[i][0],vlo[i][1],vlo[i][2],vlo[i][3],vhi[i][0],vhi[i][1],vhi[i][2],vhi[i][3]}
  #define PIN(x) asm volatile("":"+v"(x))
  #define MX3(a,b,c) __builtin_fmaxf(__builtin_fmaxf((a),(b)),(c))
  #define GAPA(MF,A0,A1,A2,A3,W0,W1,PW) do{ MF; sacc+=A0; sacc+=A1; sacc+=A2; sacc+=A3; PIN(sacc); W0; W1; PIN(PW); SBAR(); }while(0)
  #define EX(v) __builtin_amdgcn_exp2f(v)
  #define GAPB(MF,X,B) do{ MF; X[B]=EX(X[B]); X[B+1]=EX(X[B+1]); X[B+2]=EX(X[B+2]); X[B+3]=EX(X[B+3]); PIN(X); SBAR(); }while(0)
  #define VRD(i) do{ vlo[i]=vtr(vp_+(((i)>>2)*4096+((i)&3)*1024)); vhi[i]=vtr(vp_+(((i)>>2)*4096+((i)&3)*1024+512)); }while(0)
  #define KRD(G,j) do{ if(G){ kload2(kf,kp0+sl_next,j); SBAR(); } }while(0)
  #define STEP(C0,C1,P0,P1,t,GK,GV,GL) do{ SBAR(); \
    const lds_cptr vp_=vp0+sl_prev; \
    VRD(0); SBAR(); float sacc=(P0[0]+P0[1]); \
    GAPA(C0=__builtin_amdgcn_mfma_f32_32x32x16_bf16(kf[0],qr[0],negm,0,0,0), P0[2],P0[3],P0[4],P0[5],     pw0[0]=PKW(P0,0), pw0[1]=PKW(P0,2), pw0); \
    VRD(4); SBAR(); GAPA(C1=__builtin_amdgcn_mfma_f32_32x32x16_bf16(kf[1],qr[0],negm,0,0,0), P0[6],P0[7],P0[8],P0[9],     pw0[2]=PKW(P0,4), pw0[3]=PKW(P0,6), pw0); \
    VRD(1); SBAR(); GAPA(C0=__builtin_amdgcn_mfma_f32_32x32x16_bf16(kf[2],qr[1],C0,0,0,0),   P0[10],P0[11],P0[12],P0[13], pw1[0]=PKW(P0,8), pw1[1]=PKW(P0,10), pw1); \
    VRD(5); SBAR(); GAPA(C1=__builtin_amdgcn_mfma_f32_32x32x16_bf16(kf[3],qr[1],C1,0,0,0),   P0[14],P0[15],P1[0],P1[1],   pw1[2]=PKW(P0,12),pw1[3]=PKW(P0,14), pw1); \
    VRD(2); SBAR(); GAPA(C0=__builtin_amdgcn_mfma_f32_32x32x16_bf16(kf[4],qr[2],C0,0,0,0),   P1[2],P1[3],P1[4],P1[5],     pw2[0]=PKW(P1,0), pw2[1]=PKW(P1,2), pw2); \
    VRD(6); SBAR(); GAPA(C1=__builtin_amdgcn_mfma_f32_32x32x16_bf16(kf[5],qr[2],C1,0,0,0),   P1[6],P1[7],P1[8],P1[9],     pw2[2]=PKW(P1,4), pw2[3]=PKW(P1,6), pw2); \
    VRD(3); SBAR(); GAPA(C0=__builtin_amdgcn_mfma_f32_32x32x16_bf16(kf[6],qr[3],C0,0,0,0),   P1[10],P1[11],P1[12],P1[13], pw3[0]=PKW(P1,8), pw3[1]=PKW(P1,10), pw3); \
    VRD(7); SBAR(); GAPA(C1=__builtin_amdgcn_mfma_f32_32x32x16_bf16(kf[7],qr[3],C1,0,0,0),   P1[14],P1[15],0.f,0.f,       pw3[2]=PKW(P1,12),pw3[3]=PKW(P1,14), pw3); \
    l_reg+=sacc; \
    if(GK){DMA_K((t)+3,sl_cur);} if(GV){DMA_V((t)+1,sl_next);} \
    CMASK(C0,C1,t); \
    { float a=MX3(C0[0],C0[1],C1[0]),b=MX3(C0[2],C0[3],C1[1]); a=MX3(a,C1[2],C1[3]); \
      _Pragma("unroll") for(int r=4;r<16;r+=4){a=MX3(a,C0[r],C0[r+1]);b=MX3(b,C0[r+2],C0[r+3]);a=MX3(a,C1[r],C1[r+1]);b=MX3(b,C1[r+2],C1[r+3]);} \
      float rm=__builtin_fmaxf(a,b); { auto rr=__builtin_amdgcn_permlane32_swap(__float_as_uint(rm),__float_as_uint(rm),false,false); rm=__builtin_fmaxf(__uint_as_float(rr[0]),__uint_as_float(rr[1])); } \
      resc=false; \
      if(__builtin_expect(__any(rm>(float)THRL),0)){ const float dl=__builtin_fmaxf(rm,0.f); mhat+=dl; \
        _Pragma("unroll") for(int r=0;r<16;++r){C0[r]-=dl;C1[r]-=dl;} \
        _Pragma("unroll") for(int r=0;r<16;++r)negm[r]=-mhat; asm volatile("":"+v"(negm)); \
        const float f=__builtin_amdgcn_exp2f(-dl); l_reg*=f; if(hi==0)wsf[r32]=f; resc=true; } } \
    SBAR(); \
    GAPB(o[0]=__builtin_amdgcn_mfma_f32_32x32x16_bf16(PAF(0),VFR(0),o[0],0,0,0), C0,0); \
    GAPB(o[1]=__builtin_amdgcn_mfma_f32_32x32x16_bf16(PAF(0),VFR(4),o[1],0,0,0), C0,4); \
    KRD(GL,0); GAPB(o[0]=__builtin_amdgcn_mfma_f32_32x32x16_bf16(PAF(1),VFR(1),o[0],0,0,0), C0,8); \
    KRD(GL,1); GAPB(o[1]=__builtin_amdgcn_mfma_f32_32x32x16_bf16(PAF(1),VFR(5),o[1],0,0,0), C0,12); \
    KRD(GL,2); GAPB(o[0]=__builtin_amdgcn_mfma_f32_32x32x16_bf16(PAF(2),VFR(2),o[0],0,0,0), C1,0); \
    KRD(GL,3); GAPB(o[1]=__builtin_amdgcn_mfma_f32_32x32x16_bf16(PAF(2),VFR(6),o[1],0,0,0), C1,4); \
    GAPB(o[0]=__builtin_amdgcn_mfma_f32_32x32x16_bf16(PAF(3),VFR(3),o[0],0,0,0), C1,8); \
    GAPB(o[1]=__builtin_amdgcn_mfma_f32_32x32x16_bf16(PAF(3),VFR(7),o[1],0,0,0), C1,12); \
    }while(0)
  int t=1;
  #undef CMASK
  #define CMASK(P0,P1,t) do{}while(0)
  for(;t+5<NT;t+=2){
    STEP(pB0,pB1,pA0,pA1,t,true,true,true);     WAIT_BAR(2); RESC(); ROT();
    STEP(pA0,pA1,pB0,pB1,t+1,true,true,true);   WAIT_BAR(2); RESC(); ROT();
  }
  #undef CMASK
  #define CMASK(P0,P1,t) do{}while(0)
  #define ENDW(tt) do{ if((tt)+3<NT){WAIT_BAR(2);} else if((tt)+2<NT){WAIT_BAR(1);} else {WAIT_BAR(0);} }while(0)
  for(;t+1<NT;t+=2){
    STEP(pB0,pB1,pA0,pA1,t,(t+3<NT),(t+1<NT),(t+1<NT));       ENDW(t);   RESC(); ROT();
    STEP(pA0,pA1,pB0,pB1,t+1,(t+4<NT),(t+2<NT),(t+2<NT));     ENDW(t+1); RESC(); ROT();
  }
  STEP(pB0,pB1,pA0,pA1,NT-1,false,false,false); RESC();
  { float sacc=pB0[0]+pB0[1]; _Pragma("unroll") for(int r=2;r<16;++r)sacc+=pB0[r]; _Pragma("unroll") for(int r=0;r<16;++r)sacc+=pB1[r]; l_reg+=sacc;
    pw0=(u32x4){PKW(pB0,0),PKW(pB0,2),PKW(pB0,4),PKW(pB0,6)};pw1=(u32x4){PKW(pB0,8),PKW(pB0,10),PKW(pB0,12),PKW(pB0,14)};pw2=(u32x4){PKW(pB1,0),PKW(pB1,2),PKW(pB1,4),PKW(pB1,6)};pw3=(u32x4){PKW(pB1,8),PKW(pB1,10),PKW(pB1,12),PKW(pB1,14)};
    SBAR(); pv(o,vb0+sl_cur,PAF(0),PAF(1),PAF(2),PAF(3)); }
  #undef PKW
  #undef PAF
  #undef VFR
  #undef PIN
  #undef MX3
  #undef GAPA
  #undef GAPB
  #undef EX
  #undef VRD
  #undef KRD
  #undef STEP
  #undef ENDW
  {auto rr=__builtin_amdgcn_permlane32_swap(__float_as_uint(l_reg),__float_as_uint(l_reg),false,false);l_reg=__uint_as_float(rr[0])+__uint_as_float(rr[1]);}
  if(hi==0)wsf[32+r32]=l_reg;asm volatile("s_waitcnt lgkmcnt(0)":::"memory");
  float rli[16];
  #pragma unroll
  for(int r=0;r<16;++r)rli[r]=__builtin_amdgcn_rcpf(wsf[32+crow(r,hi)]);
  bf16*Ow=O+(rowbase+q0+wid*QBLK)*PO+h*D;
  { bf16*stg=(bf16*)(shm+LDS_OST)+wid*2048;
    #pragma unroll
    for(int r=0;r<16;++r){const int orow=crow(r,hi);
      #pragma unroll
      for(int d0=0;d0<2;++d0)stg[orow*64+d0*32+r32]=__float2bfloat16(o[d0][r]*rli[r]);}
    asm volatile("s_waitcnt lgkmcnt(0)":::"memory");
    #pragma unroll
    for(int i=0;i<4;++i){const int row=i*8+(lane>>3),ch=lane&7; const u32x4 v=*(const u32x4*)(stg+row*64+ch*8); ATTN_STORE16(Ow+(long)row*PO+ch*8,v);} }
  asm volatile("s_waitcnt lgkmcnt(0)\n\ts_barrier":::"memory");
  #undef DMA_K
  #undef DMA_V
  #undef CMASK
  #undef START
  #undef RESC
  #undef ROT
}
constexpr int ATTN_LDS_BYTES=LDS_BYTES;
struct AttnTensors { const bf16* Q; const bf16* K; const bf16* V; bf16* O; };
#undef SBAR
#undef WAIT_BAR
}
#define GAS __attribute__((address_space(1)))
#define LAS __attribute__((address_space(3)))
typedef unsigned short bf16;
typedef unsigned v4u __attribute__((ext_vector_type(4)));
typedef float f32x4 __attribute__((ext_vector_type(4)));
typedef short bf16x8 __attribute__((ext_vector_type(8)));
typedef GAS unsigned gu32;
typedef GAS unsigned long long gu64;
#define RLX_AGENT __ATOMIC_RELAXED, __HIP_MEMORY_SCOPE_AGENT
#define LDS_WAIT() asm volatile("s_waitcnt lgkmcnt(0)" ::: "memory")
#define VM_WAIT() asm volatile("s_waitcnt vmcnt(0)" ::: "memory")
__device__ __forceinline__ unsigned long long rt() { return __builtin_amdgcn_s_memrealtime(); }
__device__ __forceinline__ unsigned f2bf(float f) { unsigned u = __builtin_bit_cast(unsigned, f); return (u + 0x7fffu + ((u >> 16) & 1u)) >> 16; }
__device__ __forceinline__ unsigned pk2(float lo, float hi) { return f2bf(lo) | (f2bf(hi) << 16); }

#define XB_TMO      128
#define XB_XCNT(j)  (256  + 64 * (j))
#define XB_XSUB(j)  (1280 + 64 * (j))
#define XB_XGEN(j)  (2304 + 64 * (j))
#define XB_TOP      3328
#define XB_TOPGEN   3392
#define XCD_BAR_WORDS 3456
#define XB_SPIN_CAP (1u << 24)

__device__ __forceinline__ unsigned xb_ld(unsigned* p)              { return __hip_atomic_load(p, __ATOMIC_RELAXED, __HIP_MEMORY_SCOPE_AGENT); }
__device__ __forceinline__ unsigned xb_add(unsigned* p, unsigned v) { return __hip_atomic_fetch_add(p, v, __ATOMIC_RELAXED, __HIP_MEMORY_SCOPE_AGENT); }
__device__ __forceinline__ unsigned xb_xcc_id() { return (unsigned)__builtin_amdgcn_s_getreg((3 << 11) | 20) & 0xFu; }
#define XB_SPIN(cond, bar) do { unsigned _sp = 0; while (cond) { __builtin_amdgcn_s_sleep(1); \
    if ((++_sp & 255u) == 0u) { if (xb_ld(&(bar)[XB_TMO])) break; if (_sp > XB_SPIN_CAP) { atomicAdd(&(bar)[XB_TMO], 1u); break; } } } } while (0)

struct XcdBarrier {
    unsigned* bar; unsigned x;
    volatile LAS unsigned* st;
};

__device__ __forceinline__ XcdBarrier xcd_barrier_post(unsigned* bar, volatile LAS unsigned* st) {
    XcdBarrier b; b.bar = bar; b.x = xb_xcc_id(); b.st = st;
    if (threadIdx.x == 0) (void)xb_add(&bar[XB_XCNT(b.x)], 1u);
    return b;
}
__device__ __forceinline__ void xcd_barrier_complete(unsigned* bar, unsigned x, unsigned& nloc, unsigned& nx) {
    const unsigned G = gridDim.x * gridDim.y * gridDim.z;
    unsigned sum, cnt, mine, sp = 0u;
    for (;;) {
        sum = 0u; cnt = 0u; mine = 0u;
#pragma unroll
        for (unsigned j = 0; j < 16; ++j) { const unsigned c = xb_ld(&bar[XB_XCNT(j)]); sum += c; cnt += (c > 0u) ? 1u : 0u; mine = (j == x) ? c : mine; }
        if (sum == G) break;
        __builtin_amdgcn_s_sleep(1);
        if ((++sp & 255u) == 0u) { if (xb_ld(&bar[XB_TMO])) break; if (sp > XB_SPIN_CAP) { atomicAdd(&bar[XB_TMO], 1u); break; } }
    }
    nloc = mine > 0u ? mine : 1u; nx = cnt > 0u ? cnt : 1u;
}

__device__ __forceinline__ void xcd_barrier(const XcdBarrier& b) {
    asm volatile("s_waitcnt vmcnt(0)" ::: "memory");
    __syncthreads();
    if (threadIdx.x == 0) {
        unsigned* bar = b.bar;
        __builtin_amdgcn_s_waitcnt(0);
        unsigned nloc = b.st[0], nx = b.st[1];
        if (nloc == 0u) { xcd_barrier_complete(bar, b.x, nloc, nx); b.st[0] = nloc; b.st[1] = nx; }
        const unsigned old = xb_add(&bar[XB_XSUB(b.x)], 1u);
        const unsigned gen = old / nloc;
        if (old + 1u == (gen + 1u) * nloc) {
            __builtin_amdgcn_fence(__ATOMIC_RELEASE, "agent");
            asm volatile("s_waitcnt vmcnt(0)" ::: "memory");
            const unsigned og = xb_add(&bar[XB_TOP], 1u);
            const unsigned tg = og / nx;
            if (og + 1u == (tg + 1u) * nx) xb_add(&bar[XB_TOPGEN], 1u);
            else XB_SPIN(xb_ld(&bar[XB_TOPGEN]) == tg, bar);
            __builtin_amdgcn_fence(__ATOMIC_ACQUIRE, "agent");
            xb_add(&bar[XB_XGEN(b.x)], 1u);
            asm volatile("s_waitcnt vmcnt(0)" ::: "memory");
        } else {
            XB_SPIN(xb_ld(&bar[XB_XGEN(b.x)]) == gen, bar);
            __builtin_amdgcn_fence(__ATOMIC_ACQUIRE, "agent");
            asm volatile("s_waitcnt vmcnt(0)" ::: "memory");
        }
    }
    __syncthreads();
}


constexpr int NWAVES = 8;
constexpr int BATCH = 16, SEQ = 2048, DM = 1024, MTOK = BATCH * SEQ;
constexpr int NEXP = 16, CAP = 256, DFF = 2048, NSLOT = BATCH * NEXP * CAP;
constexpr int QKVW = 3072, GATEW = 2048;
constexpr int OFF_QA = 0, OFF_KA = 512, OFF_VA = 640, OFF_QB = 768, OFF_KB = 1536, OFF_VB = 2304;
constexpr float LN_EPS = 1e-5f, QK_EPS = 1e-6f;
constexpr float ALPHA = 1.189207115002721f;
constexpr float C2 = 0.125f * 1.4426950408889634f;

constexpr size_t MiB = 1u << 20;
constexpr size_t WS_CTL = 0, CTL_ZERO_BYTES = 1 * MiB;
constexpr size_t WS_STAT0 = 1 * MiB;
constexpr size_t WS_AFF = 2 * MiB;
constexpr size_t WS_INV = 4 * MiB;
constexpr size_t WS_TOK = 5 * MiB;
constexpr size_t WS_WIN = 8 * MiB;
constexpr size_t WS_WA = 18 * MiB;
constexpr size_t WS_WB = 19 * MiB;
constexpr size_t WS_WO = 20 * MiB;
constexpr size_t ARENA = 32 * MiB;
constexpr size_t A_H0B = ARENA + 0 * MiB;
constexpr size_t A_QKV = ARENA + 64 * MiB;
constexpr size_t A_GATES = ARENA + 256 * MiB;
constexpr size_t A_ATTNA = ARENA + 0 * MiB;
constexpr size_t A_OB = ARENA + 32 * MiB;
constexpr size_t A_MERGED = ARENA + 64 * MiB;
constexpr size_t A_MIX = ARENA + 128 * MiB;
constexpr size_t A_H1B = ARENA + 0 * MiB;
constexpr size_t A_WGU = ARENA + 256 * MiB;
constexpr size_t A_WD = ARENA + 384 * MiB;
constexpr size_t A_XE = ARENA + 128 * MiB;
constexpr size_t A_ACT = ARENA + 0 * MiB;
constexpr size_t A_YE = ARENA + 128 * MiB;
constexpr size_t WS_END = ARENA + 448 * MiB;
constexpr int CW_TMO = 0, CW_BAR = 4096;

constexpr int RING_OFF = 0, RING_BYTES = 131072;
constexpr int LDSCTL_OFF = RING_BYTES, MISC_OFF = LDSCTL_OFF + 320;
constexpr int LDS_BYTES = 147456;

typedef short s16x4v __attribute__((ext_vector_type(4)));
typedef unsigned u32x2 __attribute__((ext_vector_type(2)));

struct Frame {
    LAS unsigned char* lds;
    volatile LAS unsigned* MISC;
    gu32* ctl;
    int tid, lane, wave;
    int vcu, G;
};

__device__ __forceinline__ float wave_sum(float v) {
#pragma unroll
    for (int o = 1; o < 64; o <<= 1) v += __shfl_xor(v, o);
    return v;
}
__device__ __forceinline__ float bf2f(bf16 h) { return __uint_as_float(((unsigned)h) << 16); }

__device__ __forceinline__ void transpose_item(const float* W, int ldw, int k0, int n0, bf16* WT, int ldt, size_t dst_row, LAS float* scr, int lane) {
#pragma unroll 8
    for (int i = 0; i < 32; ++i) { const int kk = 2 * i + (lane >> 5); scr[kk * 33 + (lane & 31)] = W[(size_t)(k0 + kk) * ldw + n0 + (lane & 31)]; }
    LDS_WAIT(); asm volatile("" ::: "memory");
    const int c = lane & 7;
#pragma unroll
    for (int j = 0; j < 4; ++j) { const int n = (lane >> 3) + 8 * j; const LAS float* s = scr + (8 * c) * 33 + n;
        v4u o; o.x = pk2(s[0 * 33], s[1 * 33]); o.y = pk2(s[2 * 33], s[3 * 33]); o.z = pk2(s[4 * 33], s[5 * 33]); o.w = pk2(s[6 * 33], s[7 * 33]);
        *(GAS v4u*)(WT + (dst_row + n) * (size_t)ldt + k0 + 8 * c) = o; }
    LDS_WAIT(); asm volatile("" ::: "memory");
}

struct Ptrs {
    const float *x, *ln0_g, *ln0_b, *w_in, *b_gate, *qn_g, *kn_g, *w_a, *w_b, *w_out, *ln1_g, *ln1_b, *w_router, *w_gate_e, *w_up_e, *w_down_e, *ln2_g, *ln2_b;
    float* out; unsigned char* ws;
};
struct Args { Ptrs p; int ph_lo, ph_hi, li, pad; };
typedef const __attribute__((address_space(4))) Args* KArgsP;
__device__ __forceinline__ KArgsP kargs() { KArgsP k = (KArgsP)__builtin_amdgcn_kernarg_segment_ptr(); asm volatile("" : "+s"(k)); return k; }

__device__ __forceinline__ void p0_prologue(Frame& F, KArgsP K) {
    LAS float* scr = (LAS float*)(F.lds + RING_OFF + F.wave * 16384);
    const int gw = F.vcu * NWAVES + F.wave, NGW = F.G * NWAVES;
    bf16* win_t = (bf16*)(K->p.ws + WS_WIN); bf16* wa_t = (bf16*)(K->p.ws + WS_WA); bf16* wb_t = (bf16*)(K->p.ws + WS_WB); bf16* wo_t = (bf16*)(K->p.ws + WS_WO);
    constexpr int I_IN = (1024 / 64) * (5120 / 32), I_A = (512 / 64) * (1024 / 32), I_B = (256 / 64) * (1024 / 32), I_O = (1024 / 64) * (1024 / 32);
    for (int it = gw; it < I_IN + I_A + I_B + I_O; it += NGW) {
        int r = it;
        if (r < I_IN) { const int nb = r % 160, kb = r / 160; transpose_item(K->p.w_in, 5120, kb * 64, nb * 32, win_t, 1024, (size_t)nb * 32, scr, F.lane); continue; } r -= I_IN;
        if (r < I_A) { const int nb = r % 32, kb = r / 32; transpose_item(K->p.w_a, 1024, kb * 64, nb * 32, wa_t, 512, (size_t)nb * 32, scr, F.lane); continue; } r -= I_A;
        if (r < I_B) { const int nb = r % 32, kb = r / 32; transpose_item(K->p.w_b, 1024, kb * 64, nb * 32, wb_t, 256, (size_t)nb * 32, scr, F.lane); continue; } r -= I_B;
        { const int nb = r % 32, kb = r / 32; transpose_item(K->p.w_out, 1024, kb * 64, nb * 32, wo_t, 1024, (size_t)nb * 32, scr, F.lane); }
    }
    bf16* h0b = (bf16*)(K->p.ws + A_H0B); float* st0 = (float*)(K->p.ws + WS_STAT0);
    f32x4 g[4], bb[4];
#pragma unroll
    for (int j = 0; j < 4; ++j) { g[j] = ((const f32x4*)K->p.ln0_g)[F.lane + 64 * j]; bb[j] = ((const f32x4*)K->p.ln0_b)[F.lane + 64 * j]; }
    for (int m = gw; m < MTOK; m += NGW) {
        const GAS f32x4* xr = (const GAS f32x4*)(K->p.x + (size_t)m * DM) + F.lane;
        f32x4 v[4]; float s = 0.f;
#pragma unroll
        for (int j = 0; j < 4; ++j) { v[j] = xr[64 * j]; s += (v[j].x + v[j].y) + (v[j].z + v[j].w); }
        const float mean = wave_sum(s) * (1.f / DM); float s2 = 0.f;
#pragma unroll
        for (int j = 0; j < 4; ++j) { v[j] = v[j] - mean; s2 += (v[j].x * v[j].x + v[j].y * v[j].y) + (v[j].z * v[j].z + v[j].w * v[j].w); }
        const float rstd = 1.f / sqrtf(wave_sum(s2) * (1.f / DM) + LN_EPS);
        GAS unsigned long long* o8 = (GAS unsigned long long*)(h0b + (size_t)m * DM) + F.lane;
#pragma unroll
        for (int j = 0; j < 4; ++j) { const f32x4 y = v[j] * rstd * g[j] + bb[j]; o8[64 * j] = (unsigned long long)pk2(y.x, y.y) | ((unsigned long long)pk2(y.z, y.w) << 32); }
        if (F.lane == 0) { st0[2 * m] = mean; st0[2 * m + 1] = rstd; }
    }
}

__device__ __forceinline__ void sincos_rev(float angle, float& sn, float& cs) {
    const double rev = (double)angle * 0.15915494309189533577; const double fr = rev - __builtin_rint(rev);
    sn = __builtin_amdgcn_sinf((float)fr); cs = __builtin_amdgcn_cosf((float)fr);
}
__device__ __forceinline__ void p1b_prep(Frame& F, KArgsP K) {
    const int gw = F.vcu * NWAVES + F.wave, NGW = F.G * NWAVES, d = F.lane;
    bf16* qkv = (bf16*)(K->p.ws + A_QKV);
    const float qg = K->p.qn_g[d], kg = K->p.kn_g[d];
    const float invfA = exp2f(-(float)(d & 15) * (13.287712379549449f / 16.f));
    const float invfB = exp2f(-(float)(d & 7) * (18.931568569324174f / 8.f));
    for (int m = gw; m < MTOK; m += NGW) {
        const int t = m & (SEQ - 1);
        const float posA = (d < 32) ? (float)(t >> 6) : (float)(t & 63);
        float snA, csA, snB, csB; sincos_rev(posA * invfA, snA, csA); sincos_rev((float)t * invfB, snB, csB);
        bf16* row = qkv + (size_t)m * QKVW;
#pragma unroll 2
        for (int hh = 0; hh < 10; ++hh) {
            bf16* p = row + (hh < 8 ? OFF_QA + hh * 64 : OFF_KA + (hh - 8) * 64) + d;
            const float x = bf2f(*p); const float ss = wave_sum(x * x);
            const float y = x * (1.0f / sqrtf(ss * (1.f / 64.f) + QK_EPS)) * (hh < 8 ? qg : kg);
            const float yp = __shfl_xor(y, 16);
            float o = (d & 16) ? (y * csA + yp * snA) : (y * csA - yp * snA);
            if (hh < 8) o *= C2;
            *p = (bf16)f2bf(o);
        }
#pragma unroll 2
        for (int hh = 0; hh < 24; ++hh) {
            const bool isq = hh < 12;
            bf16* p = row + (isq ? OFF_QB + hh * 64 : OFF_KB + (hh - 12) * 64) + d;
            const float y = bf2f(*p); const float yp = __shfl_xor(y, 8);
            float o = y;
            if (d < 16) o = (d & 8) ? (y * csB + yp * snB) : (y * csB - yp * snB);
            if (isq) o *= C2;
            if (isq || d < 16) *p = (bf16)f2bf(o);
        }
    }
}

__device__ __forceinline__ void attnA_naive_unit(Frame& F, KArgsP K, int unit) {
    const int b = unit >> 5, h = (unit >> 2) & 7, qc = unit & 3, kvh = h >> 2;
    const bf16* qkv = (const bf16*)(K->p.ws + A_QKV); bf16* attna = (bf16*)(K->p.ws + A_ATTNA);
    const size_t rowq = (size_t)b * SEQ + qc * 512 + F.tid;
    LAS float* Ks = (LAS float*)(F.lds + RING_OFF); LAS float* Vs = Ks + 64 * 64;
    float q[64], o[64];
    { const v4u* qp = (const v4u*)(qkv + rowq * QKVW + OFF_QA + h * 64);
#pragma unroll
      for (int c = 0; c < 8; ++c) { const v4u w = qp[c]; q[8 * c + 0] = pg8::bf_lo(w.x); q[8 * c + 1] = pg8::bf_hi(w.x); q[8 * c + 2] = pg8::bf_lo(w.y); q[8 * c + 3] = pg8::bf_hi(w.y);
          q[8 * c + 4] = pg8::bf_lo(w.z); q[8 * c + 5] = pg8::bf_hi(w.z); q[8 * c + 6] = pg8::bf_lo(w.w); q[8 * c + 7] = pg8::bf_hi(w.w); } }
#pragma unroll
    for (int dd = 0; dd < 64; ++dd) o[dd] = 0.f;
    float mrun = -1e30f, l = 0.f;
    for (int kt = 0; kt < SEQ / 64; ++kt) {
        __syncthreads();
        { const int kr = F.tid >> 3, ch = F.tid & 7; const size_t rk = ((size_t)b * SEQ + kt * 64 + kr) * QKVW;
          const v4u wk = *(const v4u*)(qkv + rk + OFF_KA + kvh * 64 + ch * 8), wv = *(const v4u*)(qkv + rk + OFF_VA + kvh * 64 + ch * 8);
          LAS f32x4* kd = (LAS f32x4*)(Ks + kr * 64 + ch * 8); LAS f32x4* vd = (LAS f32x4*)(Vs + kr * 64 + ch * 8);
          kd[0] = (f32x4){pg8::bf_lo(wk.x), pg8::bf_hi(wk.x), pg8::bf_lo(wk.y), pg8::bf_hi(wk.y)}; kd[1] = (f32x4){pg8::bf_lo(wk.z), pg8::bf_hi(wk.z), pg8::bf_lo(wk.w), pg8::bf_hi(wk.w)};
          vd[0] = (f32x4){pg8::bf_lo(wv.x), pg8::bf_hi(wv.x), pg8::bf_lo(wv.y), pg8::bf_hi(wv.y)}; vd[1] = (f32x4){pg8::bf_lo(wv.z), pg8::bf_hi(wv.z), pg8::bf_lo(wv.w), pg8::bf_hi(wv.w)}; }
        __syncthreads();
        for (int key = 0; key < 64; ++key) {
            const LAS f32x4* kp = (const LAS f32x4*)(Ks + key * 64); const LAS f32x4* vp = (const LAS f32x4*)(Vs + key * 64);
            float s0 = 0.f, s1 = 0.f;
#pragma unroll
            for (int c = 0; c < 16; c += 2) { const f32x4 k0 = kp[c], k1 = kp[c + 1];
                s0 += q[4 * c] * k0.x + q[4 * c + 1] * k0.y + q[4 * c + 2] * k0.z + q[4 * c + 3] * k0.w;
                s1 += q[4 * c + 4] * k1.x + q[4 * c + 5] * k1.y + q[4 * c + 6] * k1.z + q[4 * c + 7] * k1.w; }
            const float s = s0 + s1;
            const float mn = fmaxf(mrun, s); const float a = exp2f(mrun - mn), pw = exp2f(s - mn);
            l = l * a + pw; mrun = mn;
#pragma unroll
            for (int c = 0; c < 16; ++c) { const f32x4 vv = vp[c];
                o[4 * c] = o[4 * c] * a + pw * vv.x; o[4 * c + 1] = o[4 * c + 1] * a + pw * vv.y; o[4 * c + 2] = o[4 * c + 2] * a + pw * vv.z; o[4 * c + 3] = o[4 * c + 3] * a + pw * vv.w; }
        }
    }
    const float rl = 1.0f / l;
    v4u* op = (v4u*)(attna + rowq * 512 + h * 64);
#pragma unroll
    for (int c = 0; c < 8; ++c) { v4u w; w.x = pk2(o[8 * c] * rl, o[8 * c + 1] * rl); w.y = pk2(o[8 * c + 2] * rl, o[8 * c + 3] * rl); w.z = pk2(o[8 * c + 4] * rl, o[8 * c + 5] * rl); w.w = pk2(o[8 * c + 6] * rl, o[8 * c + 7] * rl); op[c] = w; }
}

__device__ __forceinline__ void attnB_naive_unit(Frame& F, KArgsP K, int unit) {
    const int b = unit >> 4, j = (unit >> 2) & 3, qc = unit & 3;
    const bf16* qkv = (const bf16*)(K->p.ws + A_QKV); bf16* ob = (bf16*)(K->p.ws + A_OB);
    const int t = qc * 512 + F.tid; const size_t rowq = (size_t)b * SEQ + t;
    float q[64], o[64];
#pragma unroll
    for (int dd = 0; dd < 64; ++dd) o[dd] = 0.f;
    float mrun = -1e30f, l = 0.f;
    for (int g = 0; g < 3; ++g) {
        const int head = 4 * g + j, dil = (g == 0) ? 1 : (g == 1) ? 4 : 16;
        { const v4u* qp = (const v4u*)(qkv + rowq * QKVW + OFF_QB + head * 64);
#pragma unroll
          for (int c = 0; c < 8; ++c) { const v4u w = qp[c]; q[8 * c + 0] = pg8::bf_lo(w.x); q[8 * c + 1] = pg8::bf_hi(w.x); q[8 * c + 2] = pg8::bf_lo(w.y); q[8 * c + 3] = pg8::bf_hi(w.y);
              q[8 * c + 4] = pg8::bf_lo(w.z); q[8 * c + 5] = pg8::bf_hi(w.z); q[8 * c + 6] = pg8::bf_lo(w.w); q[8 * c + 7] = pg8::bf_hi(w.w); } }
        for (int jj = -64; jj <= 64; ++jj) {
            const int tk = t + jj * dil;
            if (tk < 0 || tk >= SEQ) continue;
            const size_t rk = ((size_t)b * SEQ + tk) * QKVW;
            const v4u* kp = (const v4u*)(qkv + rk + OFF_KB + head * 64); const v4u* vp = (const v4u*)(qkv + rk + OFF_VB + head * 64);
            float s = 0.f;
#pragma unroll
            for (int c = 0; c < 8; ++c) { const v4u w = kp[c];
                s += q[8 * c] * pg8::bf_lo(w.x) + q[8 * c + 1] * pg8::bf_hi(w.x) + q[8 * c + 2] * pg8::bf_lo(w.y) + q[8 * c + 3] * pg8::bf_hi(w.y)
                   + q[8 * c + 4] * pg8::bf_lo(w.z) + q[8 * c + 5] * pg8::bf_hi(w.z) + q[8 * c + 6] * pg8::bf_lo(w.w) + q[8 * c + 7] * pg8::bf_hi(w.w); }
            const float mn = fmaxf(mrun, s); const float a = exp2f(mrun - mn), pw = exp2f(s - mn);
            l = l * a + pw; mrun = mn;
#pragma unroll
            for (int c = 0; c < 8; ++c) { const v4u w = vp[c];
                o[8 * c] = o[8 * c] * a + pw * pg8::bf_lo(w.x); o[8 * c + 1] = o[8 * c + 1] * a + pw * pg8::bf_hi(w.x); o[8 * c + 2] = o[8 * c + 2] * a + pw * pg8::bf_lo(w.y); o[8 * c + 3] = o[8 * c + 3] * a + pw * pg8::bf_hi(w.y);
                o[8 * c + 4] = o[8 * c + 4] * a + pw * pg8::bf_lo(w.z); o[8 * c + 5] = o[8 * c + 5] * a + pw * pg8::bf_hi(w.z); o[8 * c + 6] = o[8 * c + 6] * a + pw * pg8::bf_lo(w.w); o[8 * c + 7] = o[8 * c + 7] * a + pw * pg8::bf_hi(w.w); }
        }
    }
    const float rl = 1.0f / l;
    v4u* op = (v4u*)(ob + rowq * 256 + j * 64);
#pragma unroll
    for (int c = 0; c < 8; ++c) { v4u w; w.x = pk2(o[8 * c] * rl, o[8 * c + 1] * rl); w.y = pk2(o[8 * c + 2] * rl, o[8 * c + 3] * rl); w.z = pk2(o[8 * c + 4] * rl, o[8 * c + 5] * rl); w.w = pk2(o[8 * c + 6] * rl, o[8 * c + 7] * rl); op[c] = w; }
}

__device__ __forceinline__ void p5_ln1_router_convert(Frame& F, KArgsP K) {
    const int gw = F.vcu * NWAVES + F.wave, NGW = F.G * NWAVES;
    { LAS float* scr = (LAS float*)(F.lds + RING_OFF + F.wave * 16384);
      bf16* wgu = (bf16*)(K->p.ws + A_WGU); bf16* wd = (bf16*)(K->p.ws + A_WD);
      constexpr int I_G = 16 * 64, I_D = 32 * 32, PER_E = 2 * I_G + I_D;
      for (int it = gw; it < NEXP * PER_E; it += NGW) {
          const int e = it / PER_E; int r = it % PER_E;
          if (r < I_G) { const int nb = r % 64, kb = r / 64, n0 = nb * 32; transpose_item(K->p.w_gate_e + (size_t)e * DM * DFF, DFF, kb * 64, n0, wgu, 1024, (size_t)e * 4096 + (n0 >> 7) * 256 + (n0 & 127), scr, F.lane); continue; } r -= I_G;
          if (r < I_G) { const int nb = r % 64, kb = r / 64, n0 = nb * 32; transpose_item(K->p.w_up_e + (size_t)e * DM * DFF, DFF, kb * 64, n0, wgu, 1024, (size_t)e * 4096 + (n0 >> 7) * 256 + 128 + (n0 & 127), scr, F.lane); continue; } r -= I_G;
          { const int nb = r % 32, kb = r / 32, n0 = nb * 32; transpose_item(K->p.w_down_e + (size_t)e * DFF * DM, DM, kb * 64, n0, wd, 2048, (size_t)e * 1024 + n0, scr, F.lane); }
      } }
    const bf16* mix = (const bf16*)(K->p.ws + A_MIX); bf16* h1b = (bf16*)(K->p.ws + A_H1B); const float* st0 = (const float*)(K->p.ws + WS_STAT0); float* aff = (float*)(K->p.ws + WS_AFF);
    for (int m = gw; m < MTOK; m += NGW) {
        const float mean0 = st0[2 * m], rstd0 = st0[2 * m + 1];
        const GAS f32x4* xr = (const GAS f32x4*)(K->p.x + (size_t)m * DM) + F.lane;
        const GAS u32x2* mr = (const GAS u32x2*)(mix + (size_t)m * DM) + F.lane;
        f32x4 v[4]; float s = 0.f;
#pragma unroll
        for (int j = 0; j < 4; ++j) { const f32x4 xv = xr[64 * j]; const u32x2 mw = mr[64 * j];
            const f32x4 g0 = ((const f32x4*)K->p.ln0_g)[F.lane + 64 * j], b0 = ((const f32x4*)K->p.ln0_b)[F.lane + 64 * j];
            const f32x4 h0 = (xv - mean0) * rstd0 * g0 + b0;
            v[j] = h0 * ALPHA + (f32x4){pg8::bf_lo(mw.x), pg8::bf_hi(mw.x), pg8::bf_lo(mw.y), pg8::bf_hi(mw.y)};
            s += (v[j].x + v[j].y) + (v[j].z + v[j].w); }
        const float mean = wave_sum(s) * (1.f / DM); float s2 = 0.f;
#pragma unroll
        for (int j = 0; j < 4; ++j) { v[j] = v[j] - mean; s2 += (v[j].x * v[j].x + v[j].y * v[j].y) + (v[j].z * v[j].z + v[j].w * v[j].w); }
        const float rstd = 1.f / sqrtf(wave_sum(s2) * (1.f / DM) + LN_EPS);
        GAS f32x4* o4 = (GAS f32x4*)(K->p.out + (size_t)m * DM) + F.lane;
        GAS unsigned long long* o8 = (GAS unsigned long long*)(h1b + (size_t)m * DM) + F.lane;
        float lg[16];
#pragma unroll
        for (int e = 0; e < 16; ++e) lg[e] = 0.f;
#pragma unroll
        for (int j = 0; j < 4; ++j) { const f32x4 g1 = ((const f32x4*)K->p.ln1_g)[F.lane + 64 * j], b1 = ((const f32x4*)K->p.ln1_b)[F.lane + 64 * j];
            const f32x4 y = v[j] * rstd * g1 + b1; v[j] = y;
            o4[64 * j] = y; o8[64 * j] = (unsigned long long)pk2(y.x, y.y) | ((unsigned long long)pk2(y.z, y.w) << 32);
            const f32x4* wr = (const f32x4*)(K->p.w_router + (size_t)(4 * F.lane + 256 * j) * 16);
#pragma unroll
            for (int i = 0; i < 4; ++i) { const float yv = y[i];
#pragma unroll
                for (int c = 0; c < 4; ++c) { const f32x4 w = wr[i * 4 + c]; lg[4 * c] += yv * w.x; lg[4 * c + 1] += yv * w.y; lg[4 * c + 2] += yv * w.z; lg[4 * c + 3] += yv * w.w; } } }
#pragma unroll
        for (int e = 0; e < 16; ++e) lg[e] = wave_sum(lg[e]);
        float mx = lg[0];
#pragma unroll
        for (int e = 1; e < 16; ++e) mx = fmaxf(mx, lg[e]);
        float se = 0.f;
#pragma unroll
        for (int e = 0; e < 16; ++e) { lg[e] = expf(lg[e] - mx); se += lg[e]; }
        float mine = 0.f;
#pragma unroll
        for (int e = 0; e < 16; ++e) if (F.lane == e) mine = lg[e] / se;
        if (F.lane < 16) aff[(size_t)m * 16 + F.lane] = mine;
    }
}

__device__ __forceinline__ void p6_topk_unit(Frame& F, KArgsP K, int unit) {
    const int e = unit >> 4, b = unit & 15;
    const float* aff = (const float*)(K->p.ws + WS_AFF); short* inv = (short*)(K->p.ws + WS_INV); int* tok = (int*)(K->p.ws + WS_TOK);
    const bf16* h1b = (const bf16*)(K->p.ws + A_H1B); bf16* xe = (bf16*)(K->p.ws + A_XE);
    LAS unsigned* cnt = (LAS unsigned*)(F.lds + RING_OFF);
    LAS int* ltok = (LAS int*)(F.lds + RING_OFF + 256);
    unsigned key[4];
#pragma unroll
    for (int i = 0; i < 4; ++i) key[i] = __float_as_uint(aff[((size_t)b * SEQ + 4 * F.tid + i) * 16 + e]);
    __syncthreads();
    unsigned thr = 0u;
    for (int bit = 31; bit >= 0; --bit) {
        const unsigned cand = thr | (1u << bit);
        unsigned c = 0;
#pragma unroll
        for (int i = 0; i < 4; ++i) c += (unsigned)__popcll(__ballot(key[i] >= cand));
        LAS unsigned* cb = cnt + ((bit & 1) ? 8 : 0);
        if (F.lane == 0) cb[F.wave] = c;
        __syncthreads();
        unsigned tot = 0;
#pragma unroll
        for (int w = 0; w < 8; ++w) tot += cb[w];
        if (tot >= (unsigned)CAP) thr = cand;
    }
    __syncthreads();
    unsigned cg = 0, ce = 0;
#pragma unroll
    for (int i = 0; i < 4; ++i) { cg += key[i] > thr; ce += key[i] == thr; }
    unsigned pk = cg | (ce << 16), inc = pk;
#pragma unroll
    for (int o = 1; o < 64; o <<= 1) { const unsigned up = __shfl_up(inc, o); if (F.lane >= o) inc += up; }
    if (F.lane == 63) cnt[16 + F.wave] = inc;
    __syncthreads();
    unsigned base = 0, total = 0;
#pragma unroll
    for (int w = 0; w < 8; ++w) { const unsigned tw = cnt[16 + w]; if (w < F.wave) base += tw; total += tw; }
    const unsigned excl = base + inc - pk;
    unsigned pg = excl & 0xffffu, pe = excl >> 16; const unsigned ngt = total & 0xffffu; const unsigned need = (unsigned)CAP - ngt;
#pragma unroll
    for (int i = 0; i < 4; ++i) {
        const int t = 4 * F.tid + i; int slot = -1;
        if (key[i] > thr) { slot = (int)(pg + (pe < need ? pe : need)); ++pg; }
        else if (key[i] == thr) { if (pe < need) slot = (int)(pg + pe); ++pe; }
        inv[((size_t)b * SEQ + t) * 16 + e] = (short)slot;
        if (slot >= 0) { ltok[slot] = t; tok[unit * CAP + slot] = t; }
    }
    __syncthreads();
    for (int c = F.wave; c < CAP; c += NWAVES) {
        const v4u* src = (const v4u*)(h1b + ((size_t)b * SEQ + ltok[c]) * DM); v4u* dst = (v4u*)(xe + ((size_t)unit * CAP + c) * DM);
        const v4u a0 = src[F.lane], a1 = src[F.lane + 64]; dst[F.lane] = a0; dst[F.lane + 64] = a1;
    }
    __syncthreads();
}

__device__ __forceinline__ void p9_final(Frame& F, KArgsP K) {
    const int gw = F.vcu * NWAVES + F.wave, NGW = F.G * NWAVES;
    const float* aff = (const float*)(K->p.ws + WS_AFF); const short* inv = (const short*)(K->p.ws + WS_INV); const bf16* ye = (const bf16*)(K->p.ws + A_YE);
    for (int m = gw; m < MTOK; m += NGW) {
        const int b = m >> 11;
        GAS f32x4* o4 = (GAS f32x4*)(K->p.out + (size_t)m * DM) + F.lane;
        f32x4 v[4];
#pragma unroll
        for (int j = 0; j < 4; ++j) v[j] = o4[64 * j] * ALPHA;
        for (int e = 0; e < NEXP; ++e) {
            const int p = __builtin_amdgcn_readfirstlane((int)inv[(size_t)m * 16 + e]);
            if (p < 0) continue;
            const float gt = aff[(size_t)m * 16 + e];
            const GAS u32x2* yr = (const GAS u32x2*)(ye + ((size_t)(e * 16 + b) * CAP + p) * DM) + F.lane;
#pragma unroll
            for (int j = 0; j < 4; ++j) { const u32x2 w = yr[64 * j]; v[j] += (f32x4){pg8::bf_lo(w.x), pg8::bf_hi(w.x), pg8::bf_lo(w.y), pg8::bf_hi(w.y)} * gt; }
        }
        float s = 0.f;
#pragma unroll
        for (int j = 0; j < 4; ++j) s += (v[j].x + v[j].y) + (v[j].z + v[j].w);
        const float mean = wave_sum(s) * (1.f / DM); float s2 = 0.f;
#pragma unroll
        for (int j = 0; j < 4; ++j) { v[j] = v[j] - mean; s2 += (v[j].x * v[j].x + v[j].y * v[j].y) + (v[j].z * v[j].z + v[j].w * v[j].w); }
        const float rstd = 1.f / sqrtf(wave_sum(s2) * (1.f / DM) + LN_EPS);
#pragma unroll
        for (int j = 0; j < 4; ++j) { const f32x4 g2 = ((const f32x4*)K->p.ln2_g)[F.lane + 64 * j], b2 = ((const f32x4*)K->p.ln2_b)[F.lane + 64 * j]; o4[64 * j] = v[j] * rstd * g2 + b2; }
    }
}

struct OrderUp {
    int hf, vcu;
    __device__ __forceinline__ bool next(int i, pg8::Unit& u) const {
        if (i >= 8) return false;
        const int e = hf * 8 + i, x = vcu >> 5, l = vcu & 31, b = (x >> 1) * 4 + (l & 3), j = (x & 1) * 8 + (l >> 2);
        u.pm = i * 16 + b; u.pn = j; u.am = e * 16 + b; u.bt = e * 16 + j; return true;
    }
    __device__ __forceinline__ void a_ready(const pg8::Unit&) const {}
    __device__ __forceinline__ void done(const pg8::Unit&) const {}
};
struct OrderDown {
    int hf, vcu;
    __device__ __forceinline__ bool next(int i, pg8::Unit& u) const {
        if (i >= 2) return false;
        const int x = vcu >> 5, l = vcu & 31, pml = i * 64 + x * 8 + (l & 7), pn = l >> 3, pmg = hf * 128 + pml;
        u.pm = pmg; u.pn = pn; u.am = pml; u.bt = (pmg >> 4) * 4 + pn; return true;
    }
    __device__ __forceinline__ void a_ready(const pg8::Unit&) const {}
    __device__ __forceinline__ void done(const pg8::Unit&) const {}
};

#ifndef MK_N_LAUNCHES
#define MK_N_LAUNCHES 1
#endif
constexpr int N_PHASES = 13;
__global__ void __launch_bounds__(NWAVES * 64, 2) fwd_kernel(Args args) {
    extern __shared__ __attribute__((aligned(16))) unsigned char lds[];
#define MKFRAME(F) Frame F; { int t_ = threadIdx.x; asm volatile("" : "+v"(t_)); F.lds = (LAS unsigned char*)lds; F.MISC = (volatile LAS unsigned*)(F.lds + MISC_OFF); F.ctl = nullptr; \
        F.tid = t_; F.lane = t_ & 63; F.wave = __builtin_amdgcn_readfirstlane(t_ >> 6); F.G = 256; const int bx_ = blockIdx.x; F.vcu = (bx_ & 7) * 32 + (bx_ >> 3); }
#define BP(off) ((bf16*)(kargs()->p.ws + (off)))
#define SEAM() do { XcdBarrier b_; b_.bar = (unsigned*)(kargs()->p.ws + WS_CTL) + CW_BAR; b_.x = xb_xcc_id(); b_.st = (volatile LAS unsigned*)((LAS unsigned char*)lds + MISC_OFF) + 8; xcd_barrier(b_); } while (0)
    { const int t_ = threadIdx.x;
      for (int u = t_; u < (LDS_BYTES - LDSCTL_OFF) / 4; u += NWAVES * 64) ((LAS unsigned*)((LAS unsigned char*)lds + LDSCTL_OFF))[u] = 0u;
      __syncthreads();
      (void)xcd_barrier_post((unsigned*)(kargs()->p.ws + WS_CTL) + CW_BAR, (volatile LAS unsigned*)((LAS unsigned char*)lds + MISC_OFF) + 8); }

    { MKFRAME(F); p0_prologue(F, kargs()); } SEAM();
    { MKFRAME(F);
      pg8::Gemm g{BP(A_H0B), (const bf16*)(kargs()->p.ws + WS_WIN), MTOK, 5120, 1024}; pg8::StaticOrder S; S.init(MTOK, 5120, 256, (int)blockIdx.x);
      pg8::EpiProj E{BP(A_QKV), BP(A_GATES), kargs()->p.b_gate};
      pg8::gemm_phase<pg8::EpiProj, pg8::StaticOrder, true, true>(F.lds + RING_OFF, g, S, E); } SEAM();
    { MKFRAME(F); p1b_prep(F, kargs()); } SEAM();
    { MKFRAME(F);
#if defined(NAIVE_ATTN_A)
      attnA_naive_unit(F, kargs(), F.vcu); attnA_naive_unit(F, kargs(), F.vcu + 256);
#else
      { const attn_body::bf16* q_ = (const attn_body::bf16*)BP(A_QKV); attn_body::bf16* o_ = (attn_body::bf16*)BP(A_ATTNA);
        const int g = F.vcu >> 3, s = F.vcu & 7, ab = g >> 1, akvh = g & 1;
#pragma unroll 1
        for (int i = 0; i < 4; ++i) attn_body::attn_unit<8>(ab, akvh * 4 + i, akvh, s, q_ + OFF_QA, q_ + OFF_KA, q_ + OFF_VA, o_, (char*)lds + RING_OFF); }
      __syncthreads();
#endif
    }
    { MKFRAME(F); attnB_naive_unit(F, kargs(), F.vcu); } SEAM();
    { MKFRAME(F);
      { pg8::Gemm g{BP(A_ATTNA), (const bf16*)(kargs()->p.ws + WS_WA), MTOK, 1024, 512}; pg8::StaticOrder S; S.init(MTOK, 1024, 256, (int)blockIdx.x);
        pg8::EpiGate<false> E{BP(A_MERGED), BP(A_GATES), 0};
        pg8::gemm_phase<pg8::EpiGate<false>, pg8::StaticOrder, true, true>(F.lds + RING_OFF, g, S, E); }
      asm volatile("s_waitcnt vmcnt(0)" ::: "memory"); __syncthreads(); }
    { MKFRAME(F);
      { pg8::Gemm g{BP(A_OB), (const bf16*)(kargs()->p.ws + WS_WB), MTOK, 1024, 256}; pg8::StaticOrder S; S.init(MTOK, 1024, 256, (int)blockIdx.x);
        pg8::EpiGate<true> E{BP(A_MERGED), BP(A_GATES), 1024};
        pg8::gemm_phase<pg8::EpiGate<true>, pg8::StaticOrder, true, true>(F.lds + RING_OFF, g, S, E); } } SEAM();
    { MKFRAME(F);
      pg8::Gemm g{BP(A_MERGED), (const bf16*)(kargs()->p.ws + WS_WO), MTOK, 1024, 1024}; pg8::StaticOrder S; S.init(MTOK, 1024, 256, (int)blockIdx.x);
      pg8::EpiPlain E{BP(A_MIX), 1024};
      pg8::gemm_phase<pg8::EpiPlain, pg8::StaticOrder, true, true>(F.lds + RING_OFF, g, S, E); } SEAM();
    { MKFRAME(F); p5_ln1_router_convert(F, kargs()); } SEAM();
    { MKFRAME(F); p6_topk_unit(F, kargs(), F.vcu); } SEAM();
    { MKFRAME(F); pg8::Gemm g{BP(A_XE), (const bf16*)(kargs()->p.ws + A_WGU), 0, 0, 1024}; OrderUp S{0, F.vcu}; pg8::EpiSwiglu E{BP(A_ACT)};
      pg8::gemm_phase<pg8::EpiSwiglu, OrderUp, true, true>(F.lds + RING_OFF, g, S, E); } SEAM();
    { MKFRAME(F); pg8::Gemm g{BP(A_ACT), (const bf16*)(kargs()->p.ws + A_WD), 0, 0, 2048}; OrderDown S{0, F.vcu}; pg8::EpiPlain E{BP(A_YE), 1024};
      pg8::gemm_phase<pg8::EpiPlain, OrderDown, true, true>(F.lds + RING_OFF, g, S, E); } SEAM();
    { MKFRAME(F); pg8::Gemm g{BP(A_XE), (const bf16*)(kargs()->p.ws + A_WGU), 0, 0, 1024}; OrderUp S{1, F.vcu}; pg8::EpiSwiglu E{BP(A_ACT)};
      pg8::gemm_phase<pg8::EpiSwiglu, OrderUp, true, true>(F.lds + RING_OFF, g, S, E); } SEAM();
    { MKFRAME(F); pg8::Gemm g{BP(A_ACT), (const bf16*)(kargs()->p.ws + A_WD), 0, 0, 2048}; OrderDown S{1, F.vcu}; pg8::EpiPlain E{BP(A_YE), 1024};
      pg8::gemm_phase<pg8::EpiPlain, OrderDown, true, true>(F.lds + RING_OFF, g, S, E); } SEAM();
    { MKFRAME(F); p9_final(F, kargs()); }
#undef MKFRAME
#undef BP
#undef SEAM
}

extern "C" void kernel_launch(void* const* d_in, const int* in_sizes, int n_in, void* d_out, int out_size, void* d_ws, size_t ws_size, hipStream_t stream) {
    static int grid = 0;
    if (grid == 0) {
        if (n_in != 18 || in_sizes[0] != MTOK * DM || out_size != MTOK * DM || ws_size < WS_END) { fprintf(stderr, "kernel_launch: unexpected shapes / workspace (n_in %d, ws %zu, need %zu)\n", n_in, ws_size, (size_t)WS_END); grid = -1; return; }
        if (hipFuncSetAttribute((const void*)fwd_kernel, hipFuncAttributeMaxDynamicSharedMemorySize, LDS_BYTES) != hipSuccess) { fprintf(stderr, "kernel_launch: hipFuncSetAttribute failed\n"); grid = -1; return; }
        (void)hipGetLastError();
        grid = 256;
    }
    if (grid < 0) return;
    if (hipMemsetAsync((char*)d_ws + WS_CTL, 0, CTL_ZERO_BYTES, stream) != hipSuccess) return;
    Args a{};
    const float** pp = (const float**)&a.p;
    for (int i = 0; i < 18; ++i) pp[i] = (const float*)d_in[i];
    a.p.out = (float*)d_out; a.p.ws = (unsigned char*)d_ws;
    a.ph_lo = 0; a.ph_hi = N_PHASES; a.li = 0;
    hipLaunchKernelGGL(fwd_kernel, dim3(grid), dim3(NWAVES * 64), LDS_BYTES, stream, a);
}
```

```cpp
#include <hip/hip_runtime.h>
#include <cstdio>
#include <cstdint>
namespace pg8 {
#define PG8_LAS __attribute__((address_space(3)))
typedef unsigned short bf16_t;
typedef short bf16x8 __attribute__((ext_vector_type(8)));
typedef float f32x4 __attribute__((ext_vector_type(4)));
typedef unsigned u32x4 __attribute__((ext_vector_type(4)));
constexpr int BM = 256, BK = 64, HALF = 128, HTB = HALF * BK * 2  , STAGE_BYTES = 8 * HTB, NXCD = 8, WGM = 8;

__host__ __device__ __forceinline__ int lds_byte(int r, int c) { const int st = (r >> 4) * 2 + (c >> 5), rr = r & 15, cc = c & 31, ob = rr * 64 + cc * 2; return st * 1024 + (ob ^ (((ob >> 9) & 1) << 5)); }
__host__ __device__ __forceinline__ void stage_rc(int b, int& R, int& C) { const int st = b / 1024, sb = b % 1024, swz = sb ^ (((sb >> 9) & 1) << 5); R = (st >> 1) * 16 + swz / 64; C = (st & 1) * 32 + (swz % 64) / 2; }
__host__ __device__ __forceinline__ int perm32(int rho) { const int n = rho >> 4, i = rho & 15; return 8 * (i >> 2) + 4 * n + (i & 3); }

struct Unit { int pm, pn, am, bt; };
struct Gemm { const bf16_t* A; const bf16_t* Bt; int M, N, K; };

struct StaticOrder {
    int nM, nN, nwg, G, c;
    __host__ __device__ void init(int M, int N, int G_, int c_) { nM = M / BM; nN = N / BM; nwg = nM * nN; G = G_; c = c_; }
    __host__ __device__ bool next(int i, Unit& u) const {
        const long L = (long)i * G + c; if (L >= nwg) return false;
        int wgid = (int)L; { const int q = nwg / NXCD, r = nwg % NXCD, xcd = wgid % NXCD, off = wgid / NXCD; wgid = (xcd < r ? xcd * (q + 1) : r * (q + 1) + (xcd - r) * q) + off; }
        const int nig = WGM * nN, gid = wgid / nig, fm = gid * WGM, gsz = (nM - fm) < WGM ? (nM - fm) : WGM;
        u.pm = fm + ((wgid % nig) % gsz); u.pn = (wgid % nig) / gsz; u.am = u.pm; u.bt = u.pn; return true;
    }
    __device__ __forceinline__ void a_ready(const Unit&) const {}
    __device__ __forceinline__ void done(const Unit&) const {}
};

__device__ __forceinline__ unsigned cvt_pk_bf16(float lo, float hi) { unsigned r; asm volatile("v_cvt_pk_bf16_f32 %0, %1, %2" : "=v"(r) : "v"(lo), "v"(hi)); return r; }
__device__ __forceinline__ float bf_lo(unsigned w) { return __uint_as_float(w << 16); }
__device__ __forceinline__ float bf_hi(unsigned w) { return __uint_as_float(w & 0xffff0000u); }
__device__ __forceinline__ float sigmoidf_(float x) { return 1.0f / (1.0f + __expf(-x)); }
__device__ __forceinline__ u32x4 pack8(const f32x4 v0, const f32x4 v1) { u32x4 w; w.x = cvt_pk_bf16(v0[0], v0[1]); w.y = cvt_pk_bf16(v0[2], v0[3]); w.z = cvt_pk_bf16(v1[0], v1[1]); w.w = cvt_pk_bf16(v1[2], v1[3]); return w; }

struct EpiProj {
    static constexpr bool PERM = true, AFTER_DRAIN = false;
    bf16_t* qkv; bf16_t* gates; const float* b_gate;
    __device__ __forceinline__ void operator()(const f32x4 (&acc)[2][2][4][2], const Unit& u, int wr, int wc, int fr, int fq) const {
        const int row0 = u.pm * BM + wr * 64 + fr;
        const bool isg = u.pn >= 12;
        bf16_t* base = isg ? gates : qkv; const int ldc = isg ? 2048 : 3072; const int colt = isg ? (u.pn - 12) * BM : u.pn * BM;
        const int col0 = colt + wc * 32 + 8 * fq;
        f32x4 bv[2][2];
#pragma unroll
        for (int bj = 0; bj < 2; ++bj)
#pragma unroll
            for (int n = 0; n < 2; ++n) bv[bj][n] = isg ? *(const f32x4*)(b_gate + col0 + bj * HALF + 4 * n) : (f32x4){0.f, 0.f, 0.f, 0.f};
#pragma unroll
        for (int ai = 0; ai < 2; ++ai)
#pragma unroll
            for (int m = 0; m < 4; ++m) { bf16_t* rowp = base + (size_t)(row0 + ai * HALF + m * 16) * ldc + col0;
#pragma unroll
                for (int bj = 0; bj < 2; ++bj) { f32x4 v0 = acc[ai][bj][m][0] + bv[bj][0], v1 = acc[ai][bj][m][1] + bv[bj][1];
                    if (isg) {
#pragma unroll
                        for (int i = 0; i < 4; ++i) { v0[i] = sigmoidf_(v0[i]); v1[i] = sigmoidf_(v1[i]); } }
                    *(u32x4*)(rowp + bj * HALF) = pack8(v0, v1); } }
    }
};
struct EpiPlain {
    static constexpr bool PERM = true, AFTER_DRAIN = false;
    bf16_t* O; int ldc;
    __device__ __forceinline__ void operator()(const f32x4 (&acc)[2][2][4][2], const Unit& u, int wr, int wc, int fr, int fq) const {
        const int row0 = u.pm * BM + wr * 64 + fr; const int col0 = u.pn * BM + wc * 32 + 8 * fq;
#pragma unroll
        for (int ai = 0; ai < 2; ++ai)
#pragma unroll
            for (int m = 0; m < 4; ++m) { bf16_t* rowp = O + (size_t)(row0 + ai * HALF + m * 16) * ldc + col0;
#pragma unroll
                for (int bj = 0; bj < 2; ++bj) *(u32x4*)(rowp + bj * HALF) = pack8(acc[ai][bj][m][0], acc[ai][bj][m][1]); }
    }
};
template <bool ACCUM> struct EpiGate {
    static constexpr bool PERM = true, AFTER_DRAIN = false;
    bf16_t* merged; const bf16_t* gates; int goff;
    __device__ __forceinline__ void operator()(const f32x4 (&acc)[2][2][4][2], const Unit& u, int wr, int wc, int fr, int fq) const {
        const int row0 = u.pm * BM + wr * 64 + fr; const int col0 = u.pn * BM + wc * 32 + 8 * fq;
#pragma unroll
        for (int ai = 0; ai < 2; ++ai)
#pragma unroll
            for (int m = 0; m < 4; ++m) { const size_t r = (size_t)(row0 + ai * HALF + m * 16);
#pragma unroll
                for (int bj = 0; bj < 2; ++bj) {
                    const u32x4 g = *(const u32x4*)(gates + r * 2048 + goff + col0 + bj * HALF);
                    f32x4 v0 = acc[ai][bj][m][0], v1 = acc[ai][bj][m][1];
                    v0[0] *= bf_lo(g.x); v0[1] *= bf_hi(g.x); v0[2] *= bf_lo(g.y); v0[3] *= bf_hi(g.y);
                    v1[0] *= bf_lo(g.z); v1[1] *= bf_hi(g.z); v1[2] *= bf_lo(g.w); v1[3] *= bf_hi(g.w);
                    bf16_t* p = merged + r * 1024 + col0 + bj * HALF;
                    if (ACCUM) { const u32x4 o = *(const u32x4*)p;
                        v0[0] += bf_lo(o.x); v0[1] += bf_hi(o.x); v0[2] += bf_lo(o.y); v0[3] += bf_hi(o.y);
                        v1[0] += bf_lo(o.z); v1[1] += bf_hi(o.z); v1[2] += bf_lo(o.w); v1[3] += bf_hi(o.w); }
                    *(u32x4*)p = pack8(v0, v1); } }
    }
};
struct EpiSwiglu {
    static constexpr bool PERM = true, AFTER_DRAIN = false;
    bf16_t* act;
    __device__ __forceinline__ void operator()(const f32x4 (&acc)[2][2][4][2], const Unit& u, int wr, int wc, int fr, int fq) const {
        const int row0 = u.pm * BM + wr * 64 + fr; const int col0 = u.pn * HALF + wc * 32 + 8 * fq;
#pragma unroll
        for (int ai = 0; ai < 2; ++ai)
#pragma unroll
            for (int m = 0; m < 4; ++m) {
                f32x4 v0, v1;
#pragma unroll
                for (int i = 0; i < 4; ++i) { const float g0 = acc[ai][0][m][0][i], g1 = acc[ai][0][m][1][i];
                    v0[i] = g0 * sigmoidf_(g0) * acc[ai][1][m][0][i]; v1[i] = g1 * sigmoidf_(g1) * acc[ai][1][m][1][i]; }
                *(u32x4*)(act + (size_t)(row0 + ai * HALF + m * 16) * 2048 + col0) = pack8(v0, v1); }
    }
};
template <class Epi, class Sched, bool ALIGN_EPI = false, bool SP2 = false>
__device__ __forceinline__ void gemm_phase(PG8_LAS unsigned char* lds, const Gemm g, const Sched& S, const Epi& E) {
    int tid_ = threadIdx.x; asm volatile("" : "+v"(tid_));
    const int tid = tid_, wid = __builtin_amdgcn_readfirstlane(tid >> 6), lane = tid & 63, wr = wid >> 2, wc = wid & 3, fr = lane & 15, fq = lane >> 4;
    const int K = g.K, nt = K / BK;
    unsigned voffA[2], voffB[2];
#pragma unroll
    for (int i = 0; i < 2; ++i) { int R, C; stage_rc(tid * 16 + i * 8192, R, C); const int Rb = Epi::PERM ? ((R & ~31) + perm32(R & 31)) : R;
        voffA[i] = (unsigned)(R * K + C) * 2u; voffB[i] = (unsigned)(Rb * K + C) * 2u; }
    const size_t kstep = (size_t)(BK * 2);
    const size_t hstep = (size_t)HALF * K * 2;
    const size_t tstep = 2 * hstep;
    const unsigned ldsw = (unsigned)wid * 1024u;
    const int aoff = lds_byte(wr * 64 + fr, fq * 8), boff = lds_byte(wc * 32 + fr, fq * 8);
#define PG8_SA(b, h) (((b) * 2 + (h)) * HTB)
#define PG8_SB(b, h) ((4 + (b) * 2 + (h)) * HTB)
#define PG8_STAGE(bufoff, gbase, voff) do { _Pragma("unroll") for (int _i = 0; _i < 2; ++_i) \
        __builtin_amdgcn_global_load_lds((const unsigned*)((const char*)(gbase) + (voff)[_i]), (PG8_LAS unsigned*)(lds + (bufoff) + ldsw + _i * 8192), 16, 0, 0); } while (0)
#define PG8_LDA(dst, b, h) do { _Pragma("unroll") for (int m = 0; m < 4; ++m) _Pragma("unroll") for (int k = 0; k < 2; ++k) dst[m][k] = *(const PG8_LAS bf16x8*)(lds + PG8_SA(b, h) + aoff + m * 2048 + k * 1024); } while (0)
#define PG8_LDB(dst, b, h) do { _Pragma("unroll") for (int n = 0; n < 2; ++n) _Pragma("unroll") for (int k = 0; k < 2; ++k) dst[n][k] = *(const PG8_LAS bf16x8*)(lds + PG8_SB(b, h) + boff + n * 2048 + k * 1024); } while (0)
#define PG8_MMA(ai, bj, At, Bt) do { __builtin_amdgcn_s_setprio(1); _Pragma("unroll") for (int m = 0; m < 4; ++m) _Pragma("unroll") for (int n = 0; n < 2; ++n) _Pragma("unroll") for (int k = 0; k < 2; ++k) \
        acc[ai][bj][m][n] = __builtin_amdgcn_mfma_f32_16x16x32_bf16(Bt[n][k], At[m][k], acc[ai][bj][m][n], 0, 0, 0); __builtin_amdgcn_s_setprio(0); } while (0)
#define PG8_WAIT_V(n) asm volatile("s_waitcnt vmcnt(" #n ")" ::: "memory")
#define PG8_WAIT_L(n) asm volatile("s_waitcnt lgkmcnt(" #n ")" ::: "memory")
#define PG8_BAR __builtin_amdgcn_s_barrier()
#define PG8_SCHED __builtin_amdgcn_sched_barrier(0)
    Unit cur, nxt; int ui = 0;
    if (!S.next(0, cur)) return;
    f32x4 acc[2][2][4][2];
#pragma unroll
    for (int a = 0; a < 2; ++a)
#pragma unroll
        for (int b = 0; b < 2; ++b)
#pragma unroll
            for (int m = 0; m < 4; ++m)
#pragma unroll
                for (int n = 0; n < 2; ++n) acc[a][b][m][n] = (f32x4){0.f, 0.f, 0.f, 0.f};
    bf16x8 At[4][2], B0[2][2], B1[2][2];
    const char* cA = (const char*)g.A + (size_t)cur.am * tstep; const char* cB = (const char*)g.Bt + (size_t)cur.bt * tstep;
    S.a_ready(cur);
    if constexpr (SP2) {
        PG8_STAGE(PG8_SB(0, 0), cB, voffB); PG8_STAGE(PG8_SB(0, 1), cB + hstep, voffB); PG8_STAGE(PG8_SA(0, 0), cA, voffA); PG8_STAGE(PG8_SA(0, 1), cA + hstep, voffA);
        if (wr == 1) PG8_BAR;
        PG8_WAIT_V(2); PG8_BAR;
        PG8_STAGE(PG8_SB(1, 0), cB + kstep, voffB); PG8_STAGE(PG8_SA(1, 0), cA + kstep, voffA); PG8_STAGE(PG8_SB(1, 1), cB + hstep + kstep, voffB);
        PG8_WAIT_V(6); PG8_BAR;
    } else {
        PG8_STAGE(PG8_SB(0, 0), cB, voffB); PG8_STAGE(PG8_SA(0, 0), cA, voffA); PG8_STAGE(PG8_SB(0, 1), cB + hstep, voffB); PG8_STAGE(PG8_SA(0, 1), cA + hstep, voffA);
        if (wr == 1) PG8_BAR;
        PG8_WAIT_V(4); PG8_BAR;
        PG8_STAGE(PG8_SB(1, 0), cB + kstep, voffB); PG8_STAGE(PG8_SA(1, 0), cA + kstep, voffA); PG8_STAGE(PG8_SB(1, 1), cB + hstep + kstep, voffB);
        PG8_WAIT_V(6); PG8_BAR;
    }
    for (;;) {
        const bool has_next = S.next(ui + 1, nxt);
        const char* nA = has_next ? (const char*)g.A + (size_t)nxt.am * tstep : cA; const char* nB = has_next ? (const char*)g.Bt + (size_t)nxt.bt * tstep : cB;
        for (int t = 0; t < nt; t += 2) {
            const bool last = (t == nt - 2);
            const char* a1 = cA + (size_t)(t + 1) * kstep;
            const char* a2 = last ? nA : cA + (size_t)(t + 2) * kstep; const char* b2 = last ? nB : cB + (size_t)(t + 2) * kstep;
            const char* a3 = a2 + kstep; const char* b3 = b2 + kstep;
            if (last && has_next) S.a_ready(nxt);
            if constexpr (SP2) {
            PG8_LDB(B0, 0, 0); PG8_LDB(B1, 0, 1); PG8_SCHED; PG8_LDA(At, 0, 0); PG8_STAGE(PG8_SA(1, 1), a1 + hstep, voffA);
            PG8_WAIT_V(8); PG8_WAIT_L(0); PG8_BAR; PG8_MMA(0, 0, At, B0); PG8_MMA(0, 1, At, B1); PG8_BAR; PG8_SCHED;
            PG8_LDA(At, 0, 1); PG8_STAGE(PG8_SB(0, 0), b2, voffB); PG8_STAGE(PG8_SB(0, 1), b2 + hstep, voffB); PG8_STAGE(PG8_SA(0, 0), a2, voffA);
            PG8_WAIT_V(8); PG8_WAIT_L(0); PG8_BAR; PG8_MMA(1, 0, At, B0); PG8_MMA(1, 1, At, B1); PG8_BAR; PG8_SCHED;
            PG8_LDB(B0, 1, 0); PG8_LDB(B1, 1, 1); PG8_SCHED; PG8_LDA(At, 1, 0); PG8_STAGE(PG8_SA(0, 1), a2 + hstep, voffA);
            PG8_WAIT_V(8); PG8_WAIT_L(0); PG8_BAR; PG8_MMA(0, 0, At, B0); PG8_MMA(0, 1, At, B1); PG8_BAR; PG8_SCHED;
            PG8_LDA(At, 1, 1); PG8_STAGE(PG8_SB(1, 0), b3, voffB); PG8_STAGE(PG8_SB(1, 1), b3 + hstep, voffB); PG8_STAGE(PG8_SA(1, 0), a3, voffA);
            PG8_WAIT_V(8); PG8_WAIT_L(0); PG8_BAR; PG8_MMA(1, 0, At, B0); PG8_MMA(1, 1, At, B1); PG8_BAR; PG8_SCHED;
            } else {
            PG8_LDB(B0, 0, 0); PG8_SCHED; PG8_LDA(At, 0, 0); PG8_STAGE(PG8_SA(1, 1), a1 + hstep, voffA);
            PG8_WAIT_L(8); PG8_BAR; PG8_WAIT_L(0); PG8_MMA(0, 0, At, B0); PG8_BAR; PG8_SCHED;
            PG8_LDB(B1, 0, 1); PG8_STAGE(PG8_SB(0, 0), b2, voffB);
            PG8_BAR; PG8_WAIT_L(0); PG8_MMA(0, 1, At, B1); PG8_BAR;
            PG8_LDA(At, 0, 1); PG8_STAGE(PG8_SA(0, 0), a2, voffA);
            PG8_BAR; PG8_WAIT_L(0); PG8_MMA(1, 0, At, B0); PG8_BAR; PG8_SCHED;
            PG8_STAGE(PG8_SB(0, 1), b2 + hstep, voffB);
            PG8_WAIT_V(6); PG8_BAR; PG8_MMA(1, 1, At, B1); PG8_BAR;
            PG8_LDB(B0, 1, 0); PG8_SCHED; PG8_LDA(At, 1, 0); PG8_STAGE(PG8_SA(0, 1), a2 + hstep, voffA);
            PG8_WAIT_L(8); PG8_BAR; PG8_WAIT_L(0); PG8_MMA(0, 0, At, B0); PG8_BAR; PG8_SCHED;
            PG8_LDB(B1, 1, 1); PG8_STAGE(PG8_SB(1, 0), b3, voffB);
            PG8_BAR; PG8_WAIT_L(0); PG8_MMA(0, 1, At, B1); PG8_BAR;
            PG8_LDA(At, 1, 1); PG8_STAGE(PG8_SA(1, 0), a3, voffA);
            PG8_BAR; PG8_WAIT_L(0); PG8_MMA(1, 0, At, B0); PG8_BAR; PG8_SCHED;
            PG8_STAGE(PG8_SB(1, 1), b3 + hstep, voffB);
            PG8_WAIT_V(6); PG8_BAR; PG8_MMA(1, 1, At, B1); PG8_BAR;
            }
        }
        if constexpr (ALIGN_EPI) { if (wr == 0) PG8_BAR; }
        if constexpr (!Epi::AFTER_DRAIN) { E(acc, cur, wr, wc, fr, fq); S.done(cur); }
        if (!has_next) break;
#pragma unroll
        for (int a = 0; a < 2; ++a)
#pragma unroll
            for (int b = 0; b < 2; ++b)
#pragma unroll
                for (int m = 0; m < 4; ++m)
#pragma unroll
                    for (int n = 0; n < 2; ++n) acc[a][b][m][n] = (f32x4){0.f, 0.f, 0.f, 0.f};
        cur = nxt; cA = nA; cB = nB; ++ui;
        if constexpr (ALIGN_EPI) { if (wr == 1) PG8_BAR; }
    }
    PG8_WAIT_V(0);
    if constexpr (!ALIGN_EPI) { if (wr == 0) PG8_BAR; }
    PG8_BAR;
    if constexpr (Epi::AFTER_DRAIN) { E.fused(acc, cur, wr, wc, fr, fq, lds, wid, lane); S.done(cur); }
#undef PG8_SA
#undef PG8_SB
#undef PG8_STAGE
#undef PG8_LDA
#undef PG8_LDB
#undef PG8_MMA
#undef PG8_WAIT_V
#undef PG8_WAIT_L
#undef PG8_BAR
#undef PG8_SCHED
}
}
#include <hip/hip_bf16.h>
#include <cmath>
namespace attn_body {
using bf16=__hip_bfloat16;
using bf16x8=__attribute__((ext_vector_type(8)))short;
using s16x4=__attribute__((ext_vector_type(4)))short;
using f32x16=__attribute__((ext_vector_type(16)))float;
using u32x4=__attribute__((ext_vector_type(4)))unsigned;
constexpr int BATCH=16,NHEAD=8,SEQ=2048,D=64,PQ=3072,PO=512;
constexpr int NW=8,QBLK=32,QB=QBLK*NW,KVBLK=64,NQB=SEQ/QB;
constexpr int ATTN_UNIT_ROWS=QB;
__device__ __forceinline__ int crow(int r,int hi){return (r&3)+8*(r>>2)+4*hi;}
#define SBAR() __builtin_amdgcn_sched_barrier(0)
__device__ __forceinline__ void cmask(f32x16&p0,f32x16&p1,int jb,int qrel,int hi){
  const float NEG=-INFINITY; int kb=64*jb+4*hi;
  #pragma unroll
  for(int r=0;r<16;++r){int kv=kb+(r&3)+8*(r>>2); if(kv>qrel)p0[r]=NEG; if(kv+32>qrel)p1[r]=NEG;}
}

constexpr int NSLOT=3, SLOTB=8192;
constexpr int LDS_K=0, LDS_V=NSLOT*SLOTB, LDS_WS=2*NSLOT*SLOTB, LDS_OST=LDS_WS+NW*64*4, LDS_BYTES=LDS_OST+NW*4096;
constexpr float C2=0.125f*1.4426950408889634f;
__device__ __forceinline__ void glds16(const void*gsrc,unsigned lds_dst){unsigned keep;
  asm volatile("s_mov_b32 %0, m0\n\ts_mov_b32 m0, %2\n\ts_nop 0\n\tglobal_load_lds_dwordx4 %1, off\n\ts_mov_b32 m0, %0":"=&s"(keep):"v"(gsrc),"s"(lds_dst):"memory");}
__device__ __forceinline__ float max3f(float a,float b,float c){float r;asm("v_max3_f32 %0, %1, %2, %3":"=v"(r):"v"(a),"v"(b),"v"(c));return r;}
__device__ __forceinline__ float max2f(float a,float b){float r;asm("v_max_f32_e32 %0, %1, %2":"=v"(r):"v"(a),"v"(b));return r;}
__device__ __forceinline__ float fadd_s(float a,float b){float r;asm("v_add_f32_e32 %0, %1, %2":"=v"(r):"v"(a),"v"(b));return r;}
__device__ __forceinline__ float fsub_s(float a,float b){float r;asm("v_sub_f32_e32 %0, %1, %2":"=v"(r):"v"(a),"v"(b));return r;}
typedef float f32x2_t __attribute__((ext_vector_type(2))); typedef __bf16 bf16x2_t __attribute__((ext_vector_type(2)));
__device__ __forceinline__ unsigned cvtpk_s(float lo,float hi){f32x2_t v={lo,hi};bf16x2_t b=__builtin_convertvector(v,bf16x2_t);return __builtin_bit_cast(unsigned,b);}
#define WAIT_BAR(N) asm volatile("s_waitcnt vmcnt(" #N ") lgkmcnt(0)\n\ts_barrier":::"memory")

__device__ __forceinline__ void qkt(f32x16&p0,f32x16&p1,const char*Kslot,const bf16x8*qr,const f32x16&negm,int r32,int hi){
  const char*kb=Kslot+hi*1024+r32*16;
  #pragma unroll
  for(int d0=0;d0<4;++d0){
    const bf16x8 b0=*reinterpret_cast<const bf16x8*>(kb+d0*2048);
    const bf16x8 b1=*reinterpret_cast<const bf16x8*>(kb+d0*2048+512);
    if(d0==0){p0=__builtin_amdgcn_mfma_f32_32x32x16_bf16(b0,qr[0],negm,0,0,0);p1=__builtin_amdgcn_mfma_f32_32x32x16_bf16(b1,qr[0],negm,0,0,0);}
    else{p0=__builtin_amdgcn_mfma_f32_32x32x16_bf16(b0,qr[d0],p0,0,0,0);p1=__builtin_amdgcn_mfma_f32_32x32x16_bf16(b1,qr[d0],p1,0,0,0);}}
}
typedef __attribute__((address_space(3))) const char* lds_cptr;
typedef short v4i16_t __attribute__((ext_vector_type(4)));
__device__ __forceinline__ void kload8(bf16x8*kf,lds_cptr kp){
  kf[0]=*(const __attribute__((address_space(3))) bf16x8*)(kp);      kf[1]=*(const __attribute__((address_space(3))) bf16x8*)(kp+512);
  kf[2]=*(const __attribute__((address_space(3))) bf16x8*)(kp+2048); kf[3]=*(const __attribute__((address_space(3))) bf16x8*)(kp+2560);
  kf[4]=*(const __attribute__((address_space(3))) bf16x8*)(kp+4096); kf[5]=*(const __attribute__((address_space(3))) bf16x8*)(kp+4608);
  kf[6]=*(const __attribute__((address_space(3))) bf16x8*)(kp+6144); kf[7]=*(const __attribute__((address_space(3))) bf16x8*)(kp+6656);
}
__device__ __forceinline__ void kload2(bf16x8*kf,lds_cptr kp,int j){ kf[2*j]=*(const __attribute__((address_space(3))) bf16x8*)(kp+j*2048); kf[2*j+1]=*(const __attribute__((address_space(3))) bf16x8*)(kp+j*2048+512); }
__device__ __forceinline__ s16x4 vtr(lds_cptr p){ return __builtin_bit_cast(s16x4,__builtin_amdgcn_ds_read_tr16_b64_v4i16((__attribute__((address_space(3))) v4i16_t*)p)); }
__device__ __forceinline__ float rowmax(const f32x16&p0,const f32x16&p1){
  float a=max3f(p0[0],p0[1],p1[0]),b=max3f(p0[2],p0[3],p1[1]);a=max3f(a,p1[2],p1[3]);
  #pragma unroll
  for(int r=4;r<16;r+=4){a=max3f(a,p0[r],p0[r+1]);b=max3f(b,p0[r+2],p0[r+3]);a=max3f(a,p1[r],p1[r+1]);b=max3f(b,p1[r+2],p1[r+3]);}
  const float m=max2f(a,b);
  auto rr=__builtin_amdgcn_permlane32_swap(__float_as_uint(m),__float_as_uint(m),false,false);
  return max2f(__uint_as_float(rr[0]),__uint_as_float(rr[1]));
}
__device__ __forceinline__ void pv(f32x16*o,int vb,bf16x8 pa0,bf16x8 pa1,bf16x8 pa2,bf16x8 pa3){
  #pragma unroll
  for(int d0=0;d0<2;++d0){s16x4 lo[4],hi[4];
    #pragma unroll
    for(int ks=0;ks<4;++ks){
      asm volatile("ds_read_b64_tr_b16 %0,%1 offset:%c2":"=&v"(lo[ks]):"v"(vb),"i"(d0*4096+ks*1024):"memory");
      asm volatile("ds_read_b64_tr_b16 %0,%1 offset:%c2":"=&v"(hi[ks]):"v"(vb),"i"(d0*4096+ks*1024+512):"memory");}
    asm volatile("s_waitcnt lgkmcnt(0)":::"memory");SBAR();
    #define PK(k) (bf16x8){lo[k][0],lo[k][1],lo[k][2],lo[k][3],hi[k][0],hi[k][1],hi[k][2],hi[k][3]}
    o[d0]=__builtin_amdgcn_mfma_f32_32x32x16_bf16(pa0,PK(0),o[d0],0,0,0);
    o[d0]=__builtin_amdgcn_mfma_f32_32x32x16_bf16(pa1,PK(1),o[d0],0,0,0);
    o[d0]=__builtin_amdgcn_mfma_f32_32x32x16_bf16(pa2,PK(2),o[d0],0,0,0);
    o[d0]=__builtin_amdgcn_mfma_f32_32x32x16_bf16(pa3,PK(3),o[d0],0,0,0);
    #undef PK
  }
}

#ifndef ATTN_STORE16
#define ATTN_STORE16(p,v) (*(u32x4*)(p)=(v))
#endif
template<int THRL> __device__ __forceinline__ void attn_unit(int b,int h,int kvh,int qb,const bf16*Q,const bf16*__restrict__ K,const bf16*__restrict__ V,bf16*O,char*shm){
  int tid_=threadIdx.x; asm volatile("":"+v"(tid_)); const int tid=tid_,lane=tid&63,r32=lane&31,hi=lane>>5; const int wid=__builtin_amdgcn_readfirstlane(tid>>6);
  const long rowbase=(long)b*SEQ; const int q0=qb*QB;
  const bf16*Qw=Q+(rowbase+q0+wid*QBLK)*PQ+h*D;
  const bf16*Kh=K+rowbase*PQ+kvh*D,*Vh=V+rowbase*PQ+kvh*D;
  const unsigned lds0=(unsigned)(uintptr_t)shm;
  float*wsf=(float*)(shm+LDS_WS)+wid*64;
  const bf16*ksrc=Kh+(long)lane*PQ+wid*8;
  const bf16*vsrc=Vh+(long)(16*(wid&3)+(lane>>2))*PQ+(wid>>2)*32+(lane&3)*8;
  const unsigned kdst=lds0+LDS_K+wid*1024, vdst=lds0+LDS_V+wid*1024;
  #define DMA_K(t,slot) glds16(ksrc+(long)(t)*KVBLK*PQ,(unsigned)__builtin_amdgcn_readfirstlane(kdst+(slot)))
  #define DMA_V(t,slot) glds16(vsrc+(long)(t)*KVBLK*PQ,(unsigned)__builtin_amdgcn_readfirstlane(vdst+(slot)))
  const int vb0=(int)(lds0+LDS_V)+((lane>>4)&1)*32+(lane&3)*8+(4*hi+((lane&15)>>2))*64;
  const char*Kbase=shm+LDS_K; bf16x8 kf[8];
  const lds_cptr shm3=(lds_cptr)shm; const lds_cptr kp0=shm3+LDS_K+hi*1024+r32*16; const lds_cptr vp0=shm3+LDS_V+((lane>>4)&1)*32+(lane&3)*8+(4*hi+((lane&15)>>2))*64;
  constexpr int NT=SEQ/KVBLK;
  DMA_K(0,0);DMA_V(0,0);DMA_K(1,SLOTB);
  bf16x8 qr[4];
  #pragma unroll
  for(int d0=0;d0<4;++d0)qr[d0]=*reinterpret_cast<const bf16x8*>(&Qw[(long)r32*PQ+d0*16+hi*8]);
  float mhat=0.f,l_reg=0.f;f32x16 o[2];o[0]=f32x16{};o[1]=f32x16{};f32x16 negm=f32x16{};asm volatile("":"+v"(negm));

  #define CMASK(P0,P1,t) do{}while(0)
  bool resc=false;
  #define START(P0,P1) do{ const float rm=rowmax(P0,P1); resc=false; \
    { const float dl=rm; mhat=fadd_s(mhat,dl); \
      _Pragma("unroll") for(int r=0;r<16;++r){P0[r]=fsub_s(P0[r],dl);P1[r]=fsub_s(P1[r],dl);} \
      _Pragma("unroll") for(int r=0;r<16;++r)negm[r]=-mhat; asm volatile("":"+v"(negm)); } \
    _Pragma("unroll") for(int r=0;r<16;++r)P0[r]=__builtin_amdgcn_exp2f(P0[r]); }while(0)
  #define RESC() do{ if(resc){ asm volatile("s_waitcnt lgkmcnt(0)":::"memory"); \
      _Pragma("unroll") for(int d_=0;d_<2;++d_) _Pragma("unroll") for(int r=0;r<16;++r)o[d_][r]*=wsf[crow(r,hi)]; } }while(0)
  f32x16 pA0,pA1,pB0,pB1;
  int sl_prev=0,sl_cur=0,sl_next=SLOTB;
  #define ROT() do{sl_prev=sl_cur;sl_cur=sl_next;sl_next=(sl_next==(NSLOT-1)*SLOTB)?0:sl_next+SLOTB;}while(0)
  DMA_K(2,2*SLOTB);
  WAIT_BAR(3);
  qkt(pA0,pA1,Kbase,qr,negm,r32,hi);asm volatile("s_nop 15\n\ts_nop 7":"+v"(pA0),"+v"(pA1));CMASK(pA0,pA1,0);
  START(pA0,pA1);
  _Pragma("unroll") for(int r=0;r<16;++r)pA1[r]=__builtin_amdgcn_exp2f(pA1[r]);
  WAIT_BAR(0);
  DMA_K(3,0);DMA_V(1,SLOTB);
  ROT();
  kload8(kf,kp0+sl_cur);
  WAIT_BAR(2);
  s16x4 vlo[8],vhi[8]; u32x4 pw0,pw1,pw2,pw3;
  #define PKW(P,B) cvtpk_s(P[B],P[B+1])
  #define PAF(k) __builtin_bit_cast(bf16x8,pw##k)
  #define VFR(i) (bf16x8){vlo[i][0],vlo[i][1],vlo[i][2],vlo[i][3],vhi[i][0],vhi[i][1],vhi[i][2],vhi[i][3]}
  #define PIN(x) asm volatile("":"+v"(x))
  #define MX3(a,b,c) __builtin_fmaxf(__builtin_fmaxf((a),(b)),(c))
  #define GAPA(MF,A0,A1,A2,A3,W0,W1,PW) do{ MF; sacc+=A0; sacc+=A1; sacc+=A2; sacc+=A3; PIN(sacc); W0; W1; PIN(PW); SBAR(); }while(0)
  #define EX(v) __builtin_amdgcn_exp2f(v)
  #define GAPB(MF,X,B) do{ MF; X[B]=EX(X[B]); X[B+1]=EX(X[B+1]); X[B+2]=EX(X[B+2]); X[B+3]=EX(X[B+3]); PIN(X); SBAR(); }while(0)
  #define VRD(i) do{ vlo[i]=vtr(vp_+(((i)>>2)*4096+((i)&3)*1024)); vhi[i]=vtr(vp_+(((i)>>2)*4096+((i)&3)*1024+512)); }while(0)
  #define KRD(G,j) do{ if(G){ kload2(kf,kp0+sl_next,j); SBAR(); } }while(0)
  #define STEP(C0,C1,P0,P1,t,GK,GV,GL) do{ SBAR(); \
    const lds_cptr vp_=vp0+sl_prev; \
    VRD(0); SBAR(); float sacc=(P0[0]+P0[1]); \
    GAPA(C0=__builtin_amdgcn_mfma_f32_32x32x16_bf16(kf[0],qr[0],negm,0,0,0), P0[2],P0[3],P0[4],P0[5],     pw0[0]=PKW(P0,0), pw0[1]=PKW(P0,2), pw0); \
    VRD(4); SBAR(); GAPA(C1=__builtin_amdgcn_mfma_f32_32x32x16_bf16(kf[1],qr[0],negm,0,0,0), P0[6],P0[7],P0[8],P0[9],     pw0[2]=PKW(P0,4), pw0[3]=PKW(P0,6), pw0); \
    VRD(1); SBAR(); GAPA(C0=__builtin_amdgcn_mfma_f32_32x32x16_bf16(kf[2],qr[1],C0,0,0,0),   P0[10],P0[11],P0[12],P0[13], pw1[0]=PKW(P0,8), pw1[1]=PKW(P0,10), pw1); \
    VRD(5); SBAR(); GAPA(C1=__builtin_amdgcn_mfma_f32_32x32x16_bf16(kf[3],qr[1],C1,0,0,0),   P0[14],P0[15],P1[0],P1[1],   pw1[2]=PKW(P0,12),pw1[3]=PKW(P0,14), pw1); \
    VRD(2); SBAR(); GAPA(C0=__builtin_amdgcn_mfma_f32_32x32x16_bf16(kf[4],qr[2],C0,0,0,0),   P1[2],P1[3],P1[4],P1[5],     pw2[0]=PKW(P1,0), pw2[1]=PKW(P1,2), pw2); \
    VRD(6); SBAR(); GAPA(C1=__builtin_amdgcn_mfma_f32_32x32x16_bf16(kf[5],qr[2],C1,0,0,0),   P1[6],P1[7],P1[8],P1[9],     pw2[2]=PKW(P1,4), pw2[3]=PKW(P1,6), pw2); \
    VRD(3); SBAR(); GAPA(C0=__builtin_amdgcn_mfma_f32_32x32x16_bf16(kf[6],qr[3],C0,0,0,0),   P1[10],P1[11],P1[12],P1[13], pw3[0]=PKW(P1,8), pw3[1]=PKW(P1,10), pw3); \
    VRD(7); SBAR(); GAPA(C1=__builtin_amdgcn_mfma_f32_32x32x16_bf16(kf[7],qr[3],C1,0,0,0),   P1[14],P1[15],0.f,0.f,       pw3[2]=PKW(P1,12),pw3[3]=PKW(P1,14), pw3); \
    l_reg+=sacc; \
    if(GK){DMA_K((t)+3,sl_cur);} if(GV){DMA_V((t)+1,sl_next);} \
    CMASK(C0,C1,t); \
    { float a=MX3(C0[0],C0[1],C1[0]),b=MX3(C0[2],C0[3],C1[1]); a=MX3(a,C1[2],C1[3]); \
      _Pragma("unroll") for(int r=4;r<16;r+=4){a=MX3(a,C0[r],C0[r+1]);b=MX3(b,C0[r+2],C0[r+3]);a=MX3(a,C1[r],C1[r+1]);b=MX3(b,C1[r+2],C1[r+3]);} \
      float rm=__builtin_fmaxf(a,b); { auto rr=__builtin_amdgcn_permlane32_swap(__float_as_uint(rm),__float_as_uint(rm),false,false); rm=__builtin_fmaxf(__uint_as_float(rr[0]),__uint_as_float(rr[1])); } \
      resc=false; \
      if(__builtin_expect(__any(rm>(float)THRL),0)){ const float dl=__builtin_fmaxf(rm,0.f); mhat+=dl; \
        _Pragma("unroll") for(int r=0;r<16;++r){C0[r]-=dl;C1[r]-=dl;} \
        _Pragma("unroll") for(int r=0;r<16;++r)negm[r]=-mhat; asm volatile("":"+v"(negm)); \
        const float f=__builtin_amdgcn_exp2f(-dl); l_reg*=f; if(hi==0)wsf[r32]=f; resc=true; } } \
    SBAR(); \
    GAPB(o[0]=__builtin_amdgcn_mfma_f32_32x32x16_bf16(PAF(0),VFR(0),o[0],0,0,0), C0,0); \
    GAPB(o[1]=__builtin_amdgcn_mfma_f32_32x32x16_bf16(PAF(0),VFR(4),o[1],0,0,0), C0,4); \
    KRD(GL,0); GAPB(o[0]=__builtin_amdgcn_mfma_f32_32x32x16_bf16(PAF(1),VFR(1),o[0],0,0,0), C0,8); \
    KRD(GL,1); GAPB(o[1]=__builtin_amdgcn_mfma_f32_32x32x16_bf16(PAF(1),VFR(5),o[1],0,0,0), C0,12); \
    KRD(GL,2); GAPB(o[0]=__builtin_amdgcn_mfma_f32_32x32x16_bf16(PAF(2),VFR(2),o[0],0,0,0), C1,0); \
    KRD(GL,3); GAPB(o[1]=__builtin_amdgcn_mfma_f32_32x32x16_bf16(PAF(2),VFR(6),o[1],0,0,0), C1,4); \
    GAPB(o[0]=__builtin_amdgcn_mfma_f32_32x32x16_bf16(PAF(3),VFR(3),o[0],0,0,0), C1,8); \
    GAPB(o[1]=__builtin_amdgcn_mfma_f32_32x32x16_bf16(PAF(3),VFR(7),o[1],0,0,0), C1,12); \
    }while(0)
  int t=1;
  #undef CMASK
  #define CMASK(P0,P1,t) do{}while(0)
  for(;t+5<NT;t+=2){
    STEP(pB0,pB1,pA0,pA1,t,true,true,true);     WAIT_BAR(2); RESC(); ROT();
    STEP(pA0,pA1,pB0,pB1,t+1,true,true,true);   WAIT_BAR(2); RESC(); ROT();
  }
  #undef CMASK
  #define CMASK(P0,P1,t) do{}while(0)
  #define ENDW(tt) do{ if((tt)+3<NT){WAIT_BAR(2);} else if((tt)+2<NT){WAIT_BAR(1);} else {WAIT_BAR(0);} }while(0)
  for(;t+1<NT;t+=2){
    STEP(pB0,pB1,pA0,pA1,t,(t+3<NT),(t+1<NT),(t+1<NT));       ENDW(t);   RESC(); ROT();
    STEP(pA0,pA1,pB0,pB1,t+1,(t+4<NT),(t+2<NT),(t+2<NT));     ENDW(t+1); RESC(); ROT();
  }
  STEP(pB0,pB1,pA0,pA1,NT-1,false,false,false); RESC();
  { float sacc=pB0[0]+pB0[1]; _Pragma("unroll") for(int r=2;r<16;++r)sacc+=pB0[r]; _Pragma("unroll") for(int r=0;r<16;++r)sacc+=pB1[r]; l_reg+=sacc;
    pw0=(u32x4){PKW(pB0,0),PKW(pB0,2),PKW(pB0,4),PKW(pB0,6)};pw1=(u32x4){PKW(pB0,8),PKW(pB0,10),PKW(pB0,12),PKW(pB0,14)};pw2=(u32x4){PKW(pB1,0),PKW(pB1,2),PKW(pB1,4),PKW(pB1,6)};pw3=(u32x4){PKW(pB1,8),PKW(pB1,10),PKW(pB1,12),PKW(pB1,14)};
    SBAR(); pv(o,vb0+sl_cur,PAF(0),PAF(1),PAF(2),PAF(3)); }
  #undef PKW
  #undef PAF
  #undef VFR
  #undef PIN
  #undef MX3
  #undef GAPA
  #undef GAPB
  #undef EX
  #undef VRD
  #undef KRD
  #undef STEP
  #undef ENDW
  {auto rr=__builtin_amdgcn_permlane32_swap(__float_as_uint(l_reg),__float_as_uint(l_reg),false,false);l_reg=__uint_as_float(rr[0])+__uint_as_float(rr[1]);}
  if(hi==0)wsf[32+r32]=l_reg;asm volatile("s_waitcnt lgkmcnt(0)":::"memory");
  float rli[16];
  #pragma unroll
  for(int r=0;r<16;++r)rli[r]=__builtin_amdgcn_rcpf(wsf[32+crow(r,hi)]);
  bf16*Ow=O+(rowbase+q0+wid*QBLK)*PO+h*D;
  { bf16*stg=(bf16*)(shm+LDS_OST)+wid*2048;
    #pragma unroll
    for(int r=0;r<16;++r){const int orow=crow(r,hi);
      #pragma unroll
      for(int d0=0;d0<2;++d0)stg[orow*64+d0*32+r32]=__float2bfloat16(o[d0][r]*rli[r]);}
    asm volatile("s_waitcnt lgkmcnt(0)":::"memory");
    #pragma unroll
    for(int i=0;i<4;++i){const int row=i*8+(lane>>3),ch=lane&7; const u32x4 v=*(const u32x4*)(stg+row*64+ch*8); ATTN_STORE16(Ow+(long)row*PO+ch*8,v);} }
  asm volatile("s_waitcnt lgkmcnt(0)\n\ts_barrier":::"memory");
  #undef DMA_K
  #undef DMA_V
  #undef CMASK
  #undef START
  #undef RESC
  #undef ROT
}
constexpr int ATTN_LDS_BYTES=LDS_BYTES;
struct AttnTensors { const bf16* Q; const bf16* K; const bf16* V; bf16* O; };
constexpr int BAND_HALF=40960, BAND_K=0, BAND_V=16384, BAND_WS=32768, BAND_OST=81920, BAND_LDS_BYTES=BAND_OST+NW*4096;
__device__ __forceinline__ void band_half_unit(int hu,const bf16*__restrict__ QKV,int offq,int offk,int offv,bf16*OBG,float*LSEG,char*shm){
  int tid_=threadIdx.x; asm volatile("":"+v"(tid_)); const int tid=tid_,lane=tid&63,r32=lane&31,hi=lane>>5; const int wid=__builtin_amdgcn_readfirstlane(tid>>6);
  const int half=wid>>2, wq=wid&3;
  const int uh=__builtin_amdgcn_readfirstlane(2*hu+half);
  const int b=uh/192, rem=uh-b*192, head=rem>>4, ck=rem&15, g=head>>2, j=head&3;
  const int dil=(g==0)?1:(g==1)?4:16, sh=(g==0)?4:(g==1)?2:0;
  const int rc=ck>>sh, c=ck&((1<<sh)-1), ntile=(SEQ/64)/dil;
  const long rowbase=(long)b*SEQ;
  bf16*const OG=OBG+(long)g*BATCH*SEQ*256; float*const LG=LSEG+(long)g*BATCH*SEQ*4;
  const unsigned lds0=(unsigned)(uintptr_t)shm+half*BAND_HALF;
  char*hb=shm+half*BAND_HALF;
  typedef __attribute__((address_space(3))) float* lds_fptr;
  const lds_fptr wsf=(lds_fptr)(hb+BAND_WS+wq*256);
  const int mq=128*c+32*wq+r32;
  const bf16*Qrow=QKV+(rowbase+(long)mq*dil+rc)*PQ+offq+head*D;
  bf16x8 qr[4];
  #pragma unroll
  for(int d0=0;d0<4;++d0)qr[d0]=*reinterpret_cast<const bf16x8*>(&Qrow[d0*16+hi*8]);
  const bf16*Kc=QKV+(rowbase+rc)*PQ+offk+head*D, *Vc=QKV+(rowbase+rc)*PQ+offv+head*D;
  #define BAND_DMA(T,slot) do{ const long p0_=(long)(T)*64; \
      _Pragma("unroll") for(int q_=0;q_<2;++q_){ const int cc_=2*wq+q_; \
        glds16(Kc+((p0_+lane)*dil)*PQ+cc_*8,(unsigned)__builtin_amdgcn_readfirstlane(lds0+BAND_K+(slot)*8192+cc_*1024)); \
        glds16(Vc+((p0_+16*(cc_&3)+(lane>>2))*dil)*PQ+(cc_>>2)*32+(lane&3)*8,(unsigned)__builtin_amdgcn_readfirstlane(lds0+BAND_V+(slot)*8192+cc_*1024)); } }while(0)
  const int T0=2*c-1;
  float mrun=-1e30f,l_reg=0.f; f32x16 o[2]; o[0]=f32x16{}; o[1]=f32x16{};
  const int vb0=(int)(lds0+BAND_V)+((lane>>4)&1)*32+(lane&3)*8+(4*hi+((lane&15)>>2))*64;
  { const int T=T0; if(T>=0&&T<ntile) BAND_DMA(T,0); }
  #pragma unroll 1
  for(int s=0;s<4;++s){
    const int T=T0+s, Tn=T+1; const bool vcur=(T>=0&&T<ntile), vnext=(s<3)&&(Tn>=0&&Tn<ntile);
    if(vnext){ BAND_DMA(Tn,(s+1)&1); asm volatile("s_waitcnt vmcnt(4)":::"memory"); } else { asm volatile("s_waitcnt vmcnt(0)":::"memory"); }
    asm volatile("s_barrier":::"memory");
    const bool act=vcur&&(s>=(wq>>1))&&(s<=(wq>>1)+2);
    if(act){
      f32x16 p0,p1; const f32x16 zero=f32x16{};
      qkt(p0,p1,hb+BAND_K+(s&1)*8192,qr,zero,r32,hi);
      const int kb=64*T+4*hi-mq;
      float mx=-1e30f;
      #pragma unroll
      for(int r=0;r<16;++r){ const int d0_=kb+(r&3)+8*(r>>2), d1_=d0_+32;
        p0[r]=(d0_>=-64&&d0_<=64)?p0[r]:-1e30f; p1[r]=(d1_>=-64&&d1_<=64)?p1[r]:-1e30f; mx=__builtin_fmaxf(mx,__builtin_fmaxf(p0[r],p1[r])); }
      mx=__builtin_fmaxf(mx,__shfl_xor(mx,32));
      const float mnew=__builtin_fmaxf(mrun,mx); const float f=__builtin_amdgcn_exp2f(mrun-mnew); mrun=mnew;
      float sacc=0.f;
      #pragma unroll
      for(int r=0;r<16;++r){ p0[r]=(p0[r]>-1e29f)?__builtin_amdgcn_exp2f(p0[r]-mnew):0.f; p1[r]=(p1[r]>-1e29f)?__builtin_amdgcn_exp2f(p1[r]-mnew):0.f; sacc+=p0[r]+p1[r]; }
      l_reg=l_reg*f+sacc;
      if(hi==0)wsf[r32]=f;
      #pragma unroll
      for(int r=0;r<16;++r){ const float fr=wsf[crow(r,hi)]; o[0][r]*=fr; o[1][r]*=fr; }
      u32x4 pw0,pw1,pw2,pw3;
      pw0=(u32x4){cvtpk_s(p0[0],p0[1]),cvtpk_s(p0[2],p0[3]),cvtpk_s(p0[4],p0[5]),cvtpk_s(p0[6],p0[7])}; pw1=(u32x4){cvtpk_s(p0[8],p0[9]),cvtpk_s(p0[10],p0[11]),cvtpk_s(p0[12],p0[13]),cvtpk_s(p0[14],p0[15])};
      pw2=(u32x4){cvtpk_s(p1[0],p1[1]),cvtpk_s(p1[2],p1[3]),cvtpk_s(p1[4],p1[5]),cvtpk_s(p1[6],p1[7])}; pw3=(u32x4){cvtpk_s(p1[8],p1[9]),cvtpk_s(p1[10],p1[11]),cvtpk_s(p1[12],p1[13]),cvtpk_s(p1[14],p1[15])};
      SBAR(); pv(o,vb0+(s&1)*8192,__builtin_bit_cast(bf16x8,pw0),__builtin_bit_cast(bf16x8,pw1),__builtin_bit_cast(bf16x8,pw2),__builtin_bit_cast(bf16x8,pw3));
    }
    asm volatile("s_waitcnt lgkmcnt(0)\n\ts_barrier":::"memory");
  }
  #undef BAND_DMA
  l_reg+=__shfl_xor(l_reg,32);
  if(hi==0)wsf[32+r32]=l_reg;
  float rli[16];
  #pragma unroll
  for(int r=0;r<16;++r)rli[r]=__builtin_amdgcn_rcpf(wsf[32+crow(r,hi)]);
  { bf16*stg=(bf16*)(shm+BAND_OST)+wid*2048;
    #pragma unroll
    for(int r=0;r<16;++r){const int orow=crow(r,hi);
      #pragma unroll
      for(int d0=0;d0<2;++d0)stg[orow*64+d0*32+r32]=__float2bfloat16(o[d0][r]*rli[r]);}
    asm volatile("s_waitcnt lgkmcnt(0)":::"memory");
    #pragma unroll
    for(int i=0;i<4;++i){const int row=i*8+(lane>>3),ch=lane&7; const u32x4 v=*(const u32x4*)(stg+row*64+ch*8);
      const long grow=rowbase+(long)(128*c+32*wq+row)*dil+rc;
      *(u32x4*)(OG+grow*256+j*64+ch*8)=v;} }
  if(hi==0){ const long grow=rowbase+(long)mq*dil+rc; LG[grow*4+j]=mrun+__builtin_log2f(l_reg); }
  asm volatile("s_waitcnt lgkmcnt(0)\n\ts_barrier":::"memory");
}
#undef SBAR
#undef WAIT_BAR
}
#define GAS __attribute__((address_space(1)))
#define LAS __attribute__((address_space(3)))
typedef unsigned short bf16;
typedef unsigned v4u __attribute__((ext_vector_type(4)));
typedef float f32x4 __attribute__((ext_vector_type(4)));
typedef short bf16x8 __attribute__((ext_vector_type(8)));
typedef GAS unsigned gu32;
typedef GAS unsigned long long gu64;
#define RLX_AGENT __ATOMIC_RELAXED, __HIP_MEMORY_SCOPE_AGENT
#define LDS_WAIT() asm volatile("s_waitcnt lgkmcnt(0)" ::: "memory")
#define VM_WAIT() asm volatile("s_waitcnt vmcnt(0)" ::: "memory")
__device__ __forceinline__ unsigned long long rt() { return __builtin_amdgcn_s_memrealtime(); }
__device__ __forceinline__ unsigned f2bf(float f) { unsigned u = __builtin_bit_cast(unsigned, f); return (u + 0x7fffu + ((u >> 16) & 1u)) >> 16; }
__device__ __forceinline__ unsigned pk2(float lo, float hi) { return f2bf(lo) | (f2bf(hi) << 16); }

#define XB_TMO      128
#define XB_XCNT(j)  (256  + 64 * (j))
#define XB_XSUB(j)  (1280 + 64 * (j))
#define XB_XGEN(j)  (2304 + 64 * (j))
#define XB_TOP      3328
#define XB_TOPGEN   3392
#define XCD_BAR_WORDS 3456
#define XB_SPIN_CAP (1u << 24)

__device__ __forceinline__ unsigned xb_ld(unsigned* p)              { return __hip_atomic_load(p, __ATOMIC_RELAXED, __HIP_MEMORY_SCOPE_AGENT); }
__device__ __forceinline__ unsigned xb_add(unsigned* p, unsigned v) { return __hip_atomic_fetch_add(p, v, __ATOMIC_RELAXED, __HIP_MEMORY_SCOPE_AGENT); }
__device__ __forceinline__ unsigned xb_xcc_id() { return (unsigned)__builtin_amdgcn_s_getreg((3 << 11) | 20) & 0xFu; }
#define XB_SPIN(cond, bar) do { unsigned _sp = 0; while (cond) { __builtin_amdgcn_s_sleep(1); \
    if ((++_sp & 255u) == 0u) { if (xb_ld(&(bar)[XB_TMO])) break; if (_sp > XB_SPIN_CAP) { atomicAdd(&(bar)[XB_TMO], 1u); break; } } } } while (0)

struct XcdBarrier {
    unsigned* bar; unsigned x;
    volatile LAS unsigned* st;
};

__device__ __forceinline__ XcdBarrier xcd_barrier_post(unsigned* bar, volatile LAS unsigned* st) {
    XcdBarrier b; b.bar = bar; b.x = xb_xcc_id(); b.st = st;
    if (threadIdx.x == 0) (void)xb_add(&bar[XB_XCNT(b.x)], 1u);
    return b;
}
__device__ __forceinline__ void xcd_barrier_complete(unsigned* bar, unsigned x, unsigned& nloc, unsigned& nx) {
    const unsigned G = gridDim.x * gridDim.y * gridDim.z;
    unsigned sum, cnt, mine, sp = 0u;
    for (;;) {
        sum = 0u; cnt = 0u; mine = 0u;
#pragma unroll
        for (unsigned j = 0; j < 16; ++j) { const unsigned c = xb_ld(&bar[XB_XCNT(j)]); sum += c; cnt += (c > 0u) ? 1u : 0u; mine = (j == x) ? c : mine; }
        if (sum == G) break;
        __builtin_amdgcn_s_sleep(1);
        if ((++sp & 255u) == 0u) { if (xb_ld(&bar[XB_TMO])) break; if (sp > XB_SPIN_CAP) { atomicAdd(&bar[XB_TMO], 1u); break; } }
    }
    nloc = mine > 0u ? mine : 1u; nx = cnt > 0u ? cnt : 1u;
}

__device__ __forceinline__ void xcd_barrier(const XcdBarrier& b) {
    asm volatile("s_waitcnt vmcnt(0)" ::: "memory");
    __syncthreads();
    if (threadIdx.x == 0) {
        unsigned* bar = b.bar;
        __builtin_amdgcn_s_waitcnt(0);
        unsigned nloc = b.st[0], nx = b.st[1];
        if (nloc == 0u) { xcd_barrier_complete(bar, b.x, nloc, nx); b.st[0] = nloc; b.st[1] = nx; }
        const unsigned old = xb_add(&bar[XB_XSUB(b.x)], 1u);
        const unsigned gen = old / nloc;
        if (old + 1u == (gen + 1u) * nloc) {
            __builtin_amdgcn_fence(__ATOMIC_RELEASE, "agent");
            asm volatile("s_waitcnt vmcnt(0)" ::: "memory");
            const unsigned og = xb_add(&bar[XB_TOP], 1u);
            const unsigned tg = og / nx;
            if (og + 1u == (tg + 1u) * nx) xb_add(&bar[XB_TOPGEN], 1u);
            else XB_SPIN(xb_ld(&bar[XB_TOPGEN]) == tg, bar);
            __builtin_amdgcn_fence(__ATOMIC_ACQUIRE, "agent");
            xb_add(&bar[XB_XGEN(b.x)], 1u);
            asm volatile("s_waitcnt vmcnt(0)" ::: "memory");
        } else {
            XB_SPIN(xb_ld(&bar[XB_XGEN(b.x)]) == gen, bar);
            __builtin_amdgcn_fence(__ATOMIC_ACQUIRE, "agent");
            asm volatile("s_waitcnt vmcnt(0)" ::: "memory");
        }
    }
    __syncthreads();
}


constexpr int NWAVES = 8;
constexpr int BATCH = 16, SEQ = 2048, DM = 1024, MTOK = BATCH * SEQ;
constexpr int NEXP = 16, CAP = 256, DFF = 2048, NSLOT = BATCH * NEXP * CAP;
constexpr int QKVW = 3072, GATEW = 2048;
constexpr int OFF_QA = 0, OFF_KA = 512, OFF_VA = 640, OFF_QB = 768, OFF_KB = 1536, OFF_VB = 2304;
constexpr float LN_EPS = 1e-5f, QK_EPS = 1e-6f;
constexpr float ALPHA = 1.189207115002721f;
constexpr float C2 = 0.125f * 1.4426950408889634f;

constexpr size_t MiB = 1u << 20;
constexpr size_t WS_CTL = 0, CTL_ZERO_BYTES = 1 * MiB;
constexpr size_t WS_STAT0 = 1 * MiB;
constexpr size_t WS_AFF = 2 * MiB;
constexpr size_t WS_INV = 4 * MiB;
constexpr size_t WS_TOK = 5 * MiB;
constexpr size_t WS_LSE = 6 * MiB;
constexpr size_t WS_WIN = 8 * MiB;
constexpr size_t WS_WA = 18 * MiB;
constexpr size_t WS_WB = 19 * MiB;
constexpr size_t WS_WO = 20 * MiB;
constexpr size_t ARENA = 32 * MiB;
constexpr size_t A_H0B = ARENA + 0 * MiB;
constexpr size_t A_QKV = ARENA + 64 * MiB;
constexpr size_t A_GATES = ARENA + 256 * MiB;
constexpr size_t A_ATTNA = ARENA + 0 * MiB;
constexpr size_t A_OB = ARENA + 32 * MiB;
constexpr size_t A_OBG = ARENA + 384 * MiB;
constexpr size_t A_MERGED = ARENA + 64 * MiB;
constexpr size_t A_MIX = ARENA + 128 * MiB;
constexpr size_t A_H1B = ARENA + 0 * MiB;
constexpr size_t A_WGU = ARENA + 256 * MiB;
constexpr size_t A_WD = ARENA + 384 * MiB;
constexpr size_t A_XE = ARENA + 128 * MiB;
constexpr size_t A_ACT = ARENA + 0 * MiB;
constexpr size_t A_YE = ARENA + 128 * MiB;
constexpr size_t WS_END = ARENA + 448 * MiB;
constexpr int CW_TMO = 0, CW_BAR = 4096;

constexpr int RING_OFF = 0, RING_BYTES = 131072;
constexpr int LDSCTL_OFF = RING_BYTES, MISC_OFF = LDSCTL_OFF + 320;
constexpr int LDS_BYTES = 147456;

typedef short s16x4v __attribute__((ext_vector_type(4)));
typedef unsigned u32x2 __attribute__((ext_vector_type(2)));

struct Frame {
    LAS unsigned char* lds;
    volatile LAS unsigned* MISC;
    gu32* ctl;
    int tid, lane, wave;
    int vcu, G;
};

__device__ __forceinline__ float wave_sum(float v) {
#pragma unroll
    for (int o = 1; o < 64; o <<= 1) v += __shfl_xor(v, o);
    return v;
}
__device__ __forceinline__ float bf2f(bf16 h) { return __uint_as_float(((unsigned)h) << 16); }

__device__ __forceinline__ void transpose_item(const float* W, int ldw, int k0, int n0, bf16* WT, int ldt, size_t dst_row, LAS float* scr, int lane) {
#pragma unroll 8
    for (int i = 0; i < 32; ++i) { const int kk = 2 * i + (lane >> 5); scr[kk * 33 + (lane & 31)] = W[(size_t)(k0 + kk) * ldw + n0 + (lane & 31)]; }
    LDS_WAIT(); asm volatile("" ::: "memory");
    const int c = lane & 7;
#pragma unroll
    for (int j = 0; j < 4; ++j) { const int n = (lane >> 3) + 8 * j; const LAS float* s = scr + (8 * c) * 33 + n;
        v4u o; o.x = pk2(s[0 * 33], s[1 * 33]); o.y = pk2(s[2 * 33], s[3 * 33]); o.z = pk2(s[4 * 33], s[5 * 33]); o.w = pk2(s[6 * 33], s[7 * 33]);
        *(GAS v4u*)(WT + (dst_row + n) * (size_t)ldt + k0 + 8 * c) = o; }
    LDS_WAIT(); asm volatile("" ::: "memory");
}

struct Ptrs {
    const float *x, *ln0_g, *ln0_b, *w_in, *b_gate, *qn_g, *kn_g, *w_a, *w_b, *w_out, *ln1_g, *ln1_b, *w_router, *w_gate_e, *w_up_e, *w_down_e, *ln2_g, *ln2_b;
    float* out; unsigned char* ws;
};
struct Args { Ptrs p; int ph_lo, ph_hi, li, pad; };
typedef const __attribute__((address_space(4))) Args* KArgsP;
__device__ __forceinline__ KArgsP kargs() { KArgsP k = (KArgsP)__builtin_amdgcn_kernarg_segment_ptr(); asm volatile("" : "+s"(k)); return k; }

__device__ __forceinline__ void p0_prologue(Frame& F, KArgsP K) {
    LAS float* scr = (LAS float*)(F.lds + RING_OFF + F.wave * 16384);
    const int gw = F.vcu * NWAVES + F.wave, NGW = F.G * NWAVES;
    bf16* win_t = (bf16*)(K->p.ws + WS_WIN); bf16* wa_t = (bf16*)(K->p.ws + WS_WA); bf16* wb_t = (bf16*)(K->p.ws + WS_WB); bf16* wo_t = (bf16*)(K->p.ws + WS_WO);
    constexpr int I_IN = (1024 / 64) * (5120 / 32), I_A = (512 / 64) * (1024 / 32), I_B = (256 / 64) * (1024 / 32), I_O = (1024 / 64) * (1024 / 32);
    for (int it = gw; it < I_IN + I_A + I_B + I_O; it += NGW) {
        int r = it;
        if (r < I_IN) { const int nb = r % 160, kb = r / 160; transpose_item(K->p.w_in, 5120, kb * 64, nb * 32, win_t, 1024, (size_t)nb * 32, scr, F.lane); continue; } r -= I_IN;
        if (r < I_A) { const int nb = r % 32, kb = r / 32; transpose_item(K->p.w_a, 1024, kb * 64, nb * 32, wa_t, 512, (size_t)nb * 32, scr, F.lane); continue; } r -= I_A;
        if (r < I_B) { const int nb = r % 32, kb = r / 32; transpose_item(K->p.w_b, 1024, kb * 64, nb * 32, wb_t, 256, (size_t)nb * 32, scr, F.lane); continue; } r -= I_B;
        { const int nb = r % 32, kb = r / 32; transpose_item(K->p.w_out, 1024, kb * 64, nb * 32, wo_t, 1024, (size_t)nb * 32, scr, F.lane); }
    }
    bf16* h0b = (bf16*)(K->p.ws + A_H0B); float* st0 = (float*)(K->p.ws + WS_STAT0);
    f32x4 g[4], bb[4];
#pragma unroll
    for (int j = 0; j < 4; ++j) { g[j] = ((const f32x4*)K->p.ln0_g)[F.lane + 64 * j]; bb[j] = ((const f32x4*)K->p.ln0_b)[F.lane + 64 * j]; }
    for (int m = gw; m < MTOK; m += NGW) {
        const GAS f32x4* xr = (const GAS f32x4*)(K->p.x + (size_t)m * DM) + F.lane;
        f32x4 v[4]; float s = 0.f;
#pragma unroll
        for (int j = 0; j < 4; ++j) { v[j] = xr[64 * j]; s += (v[j].x + v[j].y) + (v[j].z + v[j].w); }
        const float mean = wave_sum(s) * (1.f / DM); float s2 = 0.f;
#pragma unroll
        for (int j = 0; j < 4; ++j) { v[j] = v[j] - mean; s2 += (v[j].x * v[j].x + v[j].y * v[j].y) + (v[j].z * v[j].z + v[j].w * v[j].w); }
        const float rstd = 1.f / sqrtf(wave_sum(s2) * (1.f / DM) + LN_EPS);
        GAS unsigned long long* o8 = (GAS unsigned long long*)(h0b + (size_t)m * DM) + F.lane;
#pragma unroll
        for (int j = 0; j < 4; ++j) { const f32x4 y = v[j] * rstd * g[j] + bb[j]; o8[64 * j] = (unsigned long long)pk2(y.x, y.y) | ((unsigned long long)pk2(y.z, y.w) << 32); }
        if (F.lane == 0) { st0[2 * m] = mean; st0[2 * m + 1] = rstd; }
    }
}

__device__ __forceinline__ void sincos_rev(float angle, float& sn, float& cs) {
    const double rev = (double)angle * 0.15915494309189533577; const double fr = rev - __builtin_rint(rev);
    sn = __builtin_amdgcn_sinf((float)fr); cs = __builtin_amdgcn_cosf((float)fr);
}
__device__ __forceinline__ void p1b_prep(Frame& F, KArgsP K) {
    const int gw = F.vcu * NWAVES + F.wave, NGW = F.G * NWAVES, d = F.lane;
    bf16* qkv = (bf16*)(K->p.ws + A_QKV);
    const float qg = K->p.qn_g[d], kg = K->p.kn_g[d];
    const float invfA = exp2f(-(float)(d & 15) * (13.287712379549449f / 16.f));
    const float invfB = exp2f(-(float)(d & 7) * (18.931568569324174f / 8.f));
    for (int m = gw; m < MTOK; m += NGW) {
        const int t = m & (SEQ - 1);
        const float posA = (d < 32) ? (float)(t >> 6) : (float)(t & 63);
        float snA, csA, snB, csB; sincos_rev(posA * invfA, snA, csA); sincos_rev((float)t * invfB, snB, csB);
        bf16* row = qkv + (size_t)m * QKVW;
#pragma unroll 2
        for (int hh = 0; hh < 10; ++hh) {
            bf16* p = row + (hh < 8 ? OFF_QA + hh * 64 : OFF_KA + (hh - 8) * 64) + d;
            const float x = bf2f(*p); const float ss = wave_sum(x * x);
            const float y = x * (1.0f / sqrtf(ss * (1.f / 64.f) + QK_EPS)) * (hh < 8 ? qg : kg);
            const float yp = __shfl_xor(y, 16);
            float o = (d & 16) ? (y * csA + yp * snA) : (y * csA - yp * snA);
            if (hh < 8) o *= C2;
            *p = (bf16)f2bf(o);
        }
#pragma unroll 2
        for (int hh = 0; hh < 24; ++hh) {
            const bool isq = hh < 12;
            bf16* p = row + (isq ? OFF_QB + hh * 64 : OFF_KB + (hh - 12) * 64) + d;
            const float y = bf2f(*p); const float yp = __shfl_xor(y, 8);
            float o = y;
            if (d < 16) o = (d & 8) ? (y * csB + yp * snB) : (y * csB - yp * snB);
            if (isq) o *= C2;
            if (isq || d < 16) *p = (bf16)f2bf(o);
        }
    }
}

__device__ __forceinline__ void attnA_naive_unit(Frame& F, KArgsP K, int unit) {
    const int b = unit >> 5, h = (unit >> 2) & 7, qc = unit & 3, kvh = h >> 2;
    const bf16* qkv = (const bf16*)(K->p.ws + A_QKV); bf16* attna = (bf16*)(K->p.ws + A_ATTNA);
    const size_t rowq = (size_t)b * SEQ + qc * 512 + F.tid;
    LAS float* Ks = (LAS float*)(F.lds + RING_OFF); LAS float* Vs = Ks + 64 * 64;
    float q[64], o[64];
    { const v4u* qp = (const v4u*)(qkv + rowq * QKVW + OFF_QA + h * 64);
#pragma unroll
      for (int c = 0; c < 8; ++c) { const v4u w = qp[c]; q[8 * c + 0] = pg8::bf_lo(w.x); q[8 * c + 1] = pg8::bf_hi(w.x); q[8 * c + 2] = pg8::bf_lo(w.y); q[8 * c + 3] = pg8::bf_hi(w.y);
          q[8 * c + 4] = pg8::bf_lo(w.z); q[8 * c + 5] = pg8::bf_hi(w.z); q[8 * c + 6] = pg8::bf_lo(w.w); q[8 * c + 7] = pg8::bf_hi(w.w); } }
#pragma unroll
    for (int dd = 0; dd < 64; ++dd) o[dd] = 0.f;
    float mrun = -1e30f, l = 0.f;
    for (int kt = 0; kt < SEQ / 64; ++kt) {
        __syncthreads();
        { const int kr = F.tid >> 3, ch = F.tid & 7; const size_t rk = ((size_t)b * SEQ + kt * 64 + kr) * QKVW;
          const v4u wk = *(const v4u*)(qkv + rk + OFF_KA + kvh * 64 + ch * 8), wv = *(const v4u*)(qkv + rk + OFF_VA + kvh * 64 + ch * 8);
          LAS f32x4* kd = (LAS f32x4*)(Ks + kr * 64 + ch * 8); LAS f32x4* vd = (LAS f32x4*)(Vs + kr * 64 + ch * 8);
          kd[0] = (f32x4){pg8::bf_lo(wk.x), pg8::bf_hi(wk.x), pg8::bf_lo(wk.y), pg8::bf_hi(wk.y)}; kd[1] = (f32x4){pg8::bf_lo(wk.z), pg8::bf_hi(wk.z), pg8::bf_lo(wk.w), pg8::bf_hi(wk.w)};
          vd[0] = (f32x4){pg8::bf_lo(wv.x), pg8::bf_hi(wv.x), pg8::bf_lo(wv.y), pg8::bf_hi(wv.y)}; vd[1] = (f32x4){pg8::bf_lo(wv.z), pg8::bf_hi(wv.z), pg8::bf_lo(wv.w), pg8::bf_hi(wv.w)}; }
        __syncthreads();
        for (int key = 0; key < 64; ++key) {
            const LAS f32x4* kp = (const LAS f32x4*)(Ks + key * 64); const LAS f32x4* vp = (const LAS f32x4*)(Vs + key * 64);
            float s0 = 0.f, s1 = 0.f;
#pragma unroll
            for (int c = 0; c < 16; c += 2) { const f32x4 k0 = kp[c], k1 = kp[c + 1];
                s0 += q[4 * c] * k0.x + q[4 * c + 1] * k0.y + q[4 * c + 2] * k0.z + q[4 * c + 3] * k0.w;
                s1 += q[4 * c + 4] * k1.x + q[4 * c + 5] * k1.y + q[4 * c + 6] * k1.z + q[4 * c + 7] * k1.w; }
            const float s = s0 + s1;
            const float mn = fmaxf(mrun, s); const float a = exp2f(mrun - mn), pw = exp2f(s - mn);
            l = l * a + pw; mrun = mn;
#pragma unroll
            for (int c = 0; c < 16; ++c) { const f32x4 vv = vp[c];
                o[4 * c] = o[4 * c] * a + pw * vv.x; o[4 * c + 1] = o[4 * c + 1] * a + pw * vv.y; o[4 * c + 2] = o[4 * c + 2] * a + pw * vv.z; o[4 * c + 3] = o[4 * c + 3] * a + pw * vv.w; }
        }
    }
    const float rl = 1.0f / l;
    v4u* op = (v4u*)(attna + rowq * 512 + h * 64);
#pragma unroll
    for (int c = 0; c < 8; ++c) { v4u w; w.x = pk2(o[8 * c] * rl, o[8 * c + 1] * rl); w.y = pk2(o[8 * c + 2] * rl, o[8 * c + 3] * rl); w.z = pk2(o[8 * c + 4] * rl, o[8 * c + 5] * rl); w.w = pk2(o[8 * c + 6] * rl, o[8 * c + 7] * rl); op[c] = w; }
}

__device__ __forceinline__ void attnB_naive_unit(Frame& F, KArgsP K, int unit) {
    const int b = unit >> 4, j = (unit >> 2) & 3, qc = unit & 3;
    const bf16* qkv = (const bf16*)(K->p.ws + A_QKV); bf16* ob = (bf16*)(K->p.ws + A_OB);
    const int t = qc * 512 + F.tid; const size_t rowq = (size_t)b * SEQ + t;
    float q[64], o[64];
#pragma unroll
    for (int dd = 0; dd < 64; ++dd) o[dd] = 0.f;
    float mrun = -1e30f, l = 0.f;
    for (int g = 0; g < 3; ++g) {
        const int head = 4 * g + j, dil = (g == 0) ? 1 : (g == 1) ? 4 : 16;
        { const v4u* qp = (const v4u*)(qkv + rowq * QKVW + OFF_QB + head * 64);
#pragma unroll
          for (int c = 0; c < 8; ++c) { const v4u w = qp[c]; q[8 * c + 0] = pg8::bf_lo(w.x); q[8 * c + 1] = pg8::bf_hi(w.x); q[8 * c + 2] = pg8::bf_lo(w.y); q[8 * c + 3] = pg8::bf_hi(w.y);
              q[8 * c + 4] = pg8::bf_lo(w.z); q[8 * c + 5] = pg8::bf_hi(w.z); q[8 * c + 6] = pg8::bf_lo(w.w); q[8 * c + 7] = pg8::bf_hi(w.w); } }
        for (int jj = -64; jj <= 64; ++jj) {
            const int tk = t + jj * dil;
            if (tk < 0 || tk >= SEQ) continue;
            const size_t rk = ((size_t)b * SEQ + tk) * QKVW;
            const v4u* kp = (const v4u*)(qkv + rk + OFF_KB + head * 64); const v4u* vp = (const v4u*)(qkv + rk + OFF_VB + head * 64);
            float s = 0.f;
#pragma unroll
            for (int c = 0; c < 8; ++c) { const v4u w = kp[c];
                s += q[8 * c] * pg8::bf_lo(w.x) + q[8 * c + 1] * pg8::bf_hi(w.x) + q[8 * c + 2] * pg8::bf_lo(w.y) + q[8 * c + 3] * pg8::bf_hi(w.y)
                   + q[8 * c + 4] * pg8::bf_lo(w.z) + q[8 * c + 5] * pg8::bf_hi(w.z) + q[8 * c + 6] * pg8::bf_lo(w.w) + q[8 * c + 7] * pg8::bf_hi(w.w); }
            const float mn = fmaxf(mrun, s); const float a = exp2f(mrun - mn), pw = exp2f(s - mn);
            l = l * a + pw; mrun = mn;
#pragma unroll
            for (int c = 0; c < 8; ++c) { const v4u w = vp[c];
                o[8 * c] = o[8 * c] * a + pw * pg8::bf_lo(w.x); o[8 * c + 1] = o[8 * c + 1] * a + pw * pg8::bf_hi(w.x); o[8 * c + 2] = o[8 * c + 2] * a + pw * pg8::bf_lo(w.y); o[8 * c + 3] = o[8 * c + 3] * a + pw * pg8::bf_hi(w.y);
                o[8 * c + 4] = o[8 * c + 4] * a + pw * pg8::bf_lo(w.z); o[8 * c + 5] = o[8 * c + 5] * a + pw * pg8::bf_hi(w.z); o[8 * c + 6] = o[8 * c + 6] * a + pw * pg8::bf_lo(w.w); o[8 * c + 7] = o[8 * c + 7] * a + pw * pg8::bf_hi(w.w); }
        }
    }
    const float rl = 1.0f / l;
    v4u* op = (v4u*)(ob + rowq * 256 + j * 64);
#pragma unroll
    for (int c = 0; c < 8; ++c) { v4u w; w.x = pk2(o[8 * c] * rl, o[8 * c + 1] * rl); w.y = pk2(o[8 * c + 2] * rl, o[8 * c + 3] * rl); w.z = pk2(o[8 * c + 4] * rl, o[8 * c + 5] * rl); w.w = pk2(o[8 * c + 6] * rl, o[8 * c + 7] * rl); op[c] = w; }
}

__device__ __forceinline__ void p3b_combine(Frame& F, KArgsP K) {
    const bf16* obg = (const bf16*)(K->p.ws + A_OBG); const float* lse = (const float*)(K->p.ws + WS_LSE); bf16* ob = (bf16*)(K->p.ws + A_OB);
    for (int it = F.vcu; it < MTOK / 16; it += F.G) {
        const int m = it * 16 + (F.tid >> 5), ch = F.tid & 31, j = ch >> 3;
        const float l0 = lse[((size_t)0 * MTOK + m) * 4 + j], l1 = lse[((size_t)1 * MTOK + m) * 4 + j], l2 = lse[((size_t)2 * MTOK + m) * 4 + j];
        const float mx = fmaxf(l0, fmaxf(l1, l2)); float w0 = exp2f(l0 - mx), w1 = exp2f(l1 - mx), w2 = exp2f(l2 - mx); const float rs = 1.0f / (w0 + w1 + w2); w0 *= rs; w1 *= rs; w2 *= rs;
        const v4u a = *(const v4u*)(obg + ((size_t)0 * MTOK + m) * 256 + ch * 8), b = *(const v4u*)(obg + ((size_t)1 * MTOK + m) * 256 + ch * 8), c = *(const v4u*)(obg + ((size_t)2 * MTOK + m) * 256 + ch * 8);
        v4u o;
        o.x = pk2(w0 * pg8::bf_lo(a.x) + w1 * pg8::bf_lo(b.x) + w2 * pg8::bf_lo(c.x), w0 * pg8::bf_hi(a.x) + w1 * pg8::bf_hi(b.x) + w2 * pg8::bf_hi(c.x));
        o.y = pk2(w0 * pg8::bf_lo(a.y) + w1 * pg8::bf_lo(b.y) + w2 * pg8::bf_lo(c.y), w0 * pg8::bf_hi(a.y) + w1 * pg8::bf_hi(b.y) + w2 * pg8::bf_hi(c.y));
        o.z = pk2(w0 * pg8::bf_lo(a.z) + w1 * pg8::bf_lo(b.z) + w2 * pg8::bf_lo(c.z), w0 * pg8::bf_hi(a.z) + w1 * pg8::bf_hi(b.z) + w2 * pg8::bf_hi(c.z));
        o.w = pk2(w0 * pg8::bf_lo(a.w) + w1 * pg8::bf_lo(b.w) + w2 * pg8::bf_lo(c.w), w0 * pg8::bf_hi(a.w) + w1 * pg8::bf_hi(b.w) + w2 * pg8::bf_hi(c.w));
        *(v4u*)(ob + (size_t)m * 256 + ch * 8) = o;
    }
}

__device__ __forceinline__ void p5_ln1_router_convert(Frame& F, KArgsP K) {
    const int gw = F.vcu * NWAVES + F.wave, NGW = F.G * NWAVES;
    { LAS float* scr = (LAS float*)(F.lds + RING_OFF + F.wave * 16384);
      bf16* wgu = (bf16*)(K->p.ws + A_WGU); bf16* wd = (bf16*)(K->p.ws + A_WD);
      constexpr int I_G = 16 * 64, I_D = 32 * 32, PER_E = 2 * I_G + I_D;
      for (int it = gw; it < NEXP * PER_E; it += NGW) {
          const int e = it / PER_E; int r = it % PER_E;
          if (r < I_G) { const int nb = r % 64, kb = r / 64, n0 = nb * 32; transpose_item(K->p.w_gate_e + (size_t)e * DM * DFF, DFF, kb * 64, n0, wgu, 1024, (size_t)e * 4096 + (n0 >> 7) * 256 + (n0 & 127), scr, F.lane); continue; } r -= I_G;
          if (r < I_G) { const int nb = r % 64, kb = r / 64, n0 = nb * 32; transpose_item(K->p.w_up_e + (size_t)e * DM * DFF, DFF, kb * 64, n0, wgu, 1024, (size_t)e * 4096 + (n0 >> 7) * 256 + 128 + (n0 & 127), scr, F.lane); continue; } r -= I_G;
          { const int nb = r % 32, kb = r / 32, n0 = nb * 32; transpose_item(K->p.w_down_e + (size_t)e * DFF * DM, DM, kb * 64, n0, wd, 2048, (size_t)e * 1024 + n0, scr, F.lane); }
      } }
    const bf16* mix = (const bf16*)(K->p.ws + A_MIX); bf16* h1b = (bf16*)(K->p.ws + A_H1B); const float* st0 = (const float*)(K->p.ws + WS_STAT0); float* aff = (float*)(K->p.ws + WS_AFF);
    for (int m = gw; m < MTOK; m += NGW) {
        const float mean0 = st0[2 * m], rstd0 = st0[2 * m + 1];
        const GAS f32x4* xr = (const GAS f32x4*)(K->p.x + (size_t)m * DM) + F.lane;
        const GAS u32x2* mr = (const GAS u32x2*)(mix + (size_t)m * DM) + F.lane;
        f32x4 v[4]; float s = 0.f;
#pragma unroll
        for (int j = 0; j < 4; ++j) { const f32x4 xv = xr[64 * j]; const u32x2 mw = mr[64 * j];
            const f32x4 g0 = ((const f32x4*)K->p.ln0_g)[F.lane + 64 * j], b0 = ((const f32x4*)K->p.ln0_b)[F.lane + 64 * j];
            const f32x4 h0 = (xv - mean0) * rstd0 * g0 + b0;
            v[j] = h0 * ALPHA + (f32x4){pg8::bf_lo(mw.x), pg8::bf_hi(mw.x), pg8::bf_lo(mw.y), pg8::bf_hi(mw.y)};
            s += (v[j].x + v[j].y) + (v[j].z + v[j].w); }
        const float mean = wave_sum(s) * (1.f / DM); float s2 = 0.f;
#pragma unroll
        for (int j = 0; j < 4; ++j) { v[j] = v[j] - mean; s2 += (v[j].x * v[j].x + v[j].y * v[j].y) + (v[j].z * v[j].z + v[j].w * v[j].w); }
        const float rstd = 1.f / sqrtf(wave_sum(s2) * (1.f / DM) + LN_EPS);
        GAS f32x4* o4 = (GAS f32x4*)(K->p.out + (size_t)m * DM) + F.lane;
        GAS unsigned long long* o8 = (GAS unsigned long long*)(h1b + (size_t)m * DM) + F.lane;
        float lg[16];
#pragma unroll
        for (int e = 0; e < 16; ++e) lg[e] = 0.f;
#pragma unroll
        for (int j = 0; j < 4; ++j) { const f32x4 g1 = ((const f32x4*)K->p.ln1_g)[F.lane + 64 * j], b1 = ((const f32x4*)K->p.ln1_b)[F.lane + 64 * j];
            const f32x4 y = v[j] * rstd * g1 + b1; v[j] = y;
            o4[64 * j] = y; o8[64 * j] = (unsigned long long)pk2(y.x, y.y) | ((unsigned long long)pk2(y.z, y.w) << 32);
            const f32x4* wr = (const f32x4*)(K->p.w_router + (size_t)(4 * F.lane + 256 * j) * 16);
#pragma unroll
            for (int i = 0; i < 4; ++i) { const float yv = y[i];
#pragma unroll
                for (int c = 0; c < 4; ++c) { const f32x4 w = wr[i * 4 + c]; lg[4 * c] += yv * w.x; lg[4 * c + 1] += yv * w.y; lg[4 * c + 2] += yv * w.z; lg[4 * c + 3] += yv * w.w; } } }
#pragma unroll
        for (int e = 0; e < 16; ++e) lg[e] = wave_sum(lg[e]);
        float mx = lg[0];
#pragma unroll
        for (int e = 1; e < 16; ++e) mx = fmaxf(mx, lg[e]);
        float se = 0.f;
#pragma unroll
        for (int e = 0; e < 16; ++e) { lg[e] = expf(lg[e] - mx); se += lg[e]; }
        float mine = 0.f;
#pragma unroll
        for (int e = 0; e < 16; ++e) if (F.lane == e) mine = lg[e] / se;
        if (F.lane < 16) aff[(size_t)m * 16 + F.lane] = mine;
    }
}

__device__ __forceinline__ void p6_topk_unit(Frame& F, KArgsP K, int unit) {
    const int e = unit >> 4, b = unit & 15;
    const float* aff = (const float*)(K->p.ws + WS_AFF); short* inv = (short*)(K->p.ws + WS_INV); int* tok = (int*)(K->p.ws + WS_TOK);
    const bf16* h1b = (const bf16*)(K->p.ws + A_H1B); bf16* xe = (bf16*)(K->p.ws + A_XE);
    LAS unsigned* cnt = (LAS unsigned*)(F.lds + RING_OFF);
    LAS int* ltok = (LAS int*)(F.lds + RING_OFF + 256);
    unsigned key[4];
#pragma unroll
    for (int i = 0; i < 4; ++i) key[i] = __float_as_uint(aff[((size_t)b * SEQ + 4 * F.tid + i) * 16 + e]);
    __syncthreads();
    unsigned thr = 0u;
    for (int bit = 31; bit >= 0; --bit) {
        const unsigned cand = thr | (1u << bit);
        unsigned c = 0;
#pragma unroll
        for (int i = 0; i < 4; ++i) c += (unsigned)__popcll(__ballot(key[i] >= cand));
        LAS unsigned* cb = cnt + ((bit & 1) ? 8 : 0);
        if (F.lane == 0) cb[F.wave] = c;
        __syncthreads();
        unsigned tot = 0;
#pragma unroll
        for (int w = 0; w < 8; ++w) tot += cb[w];
        if (tot >= (unsigned)CAP) thr = cand;
    }
    __syncthreads();
    unsigned cg = 0, ce = 0;
#pragma unroll
    for (int i = 0; i < 4; ++i) { cg += key[i] > thr; ce += key[i] == thr; }
    unsigned pk = cg | (ce << 16), inc = pk;
#pragma unroll
    for (int o = 1; o < 64; o <<= 1) { const unsigned up = __shfl_up(inc, o); if (F.lane >= o) inc += up; }
    if (F.lane == 63) cnt[16 + F.wave] = inc;
    __syncthreads();
    unsigned base = 0, total = 0;
#pragma unroll
    for (int w = 0; w < 8; ++w) { const unsigned tw = cnt[16 + w]; if (w < F.wave) base += tw; total += tw; }
    const unsigned excl = base + inc - pk;
    unsigned pg = excl & 0xffffu, pe = excl >> 16; const unsigned ngt = total & 0xffffu; const unsigned need = (unsigned)CAP - ngt;
#pragma unroll
    for (int i = 0; i < 4; ++i) {
        const int t = 4 * F.tid + i; int slot = -1;
        if (key[i] > thr) { slot = (int)(pg + (pe < need ? pe : need)); ++pg; }
        else if (key[i] == thr) { if (pe < need) slot = (int)(pg + pe); ++pe; }
        inv[((size_t)b * SEQ + t) * 16 + e] = (short)slot;
        if (slot >= 0) { ltok[slot] = t; tok[unit * CAP + slot] = t; }
    }
    __syncthreads();
    for (int c = F.wave; c < CAP; c += NWAVES) {
        const v4u* src = (const v4u*)(h1b + ((size_t)b * SEQ + ltok[c]) * DM); v4u* dst = (v4u*)(xe + ((size_t)unit * CAP + c) * DM);
        const v4u a0 = src[F.lane], a1 = src[F.lane + 64]; dst[F.lane] = a0; dst[F.lane + 64] = a1;
    }
    __syncthreads();
}

__device__ __forceinline__ void p9_final(Frame& F, KArgsP K) {
    const int gw = F.vcu * NWAVES + F.wave, NGW = F.G * NWAVES;
    const float* aff = (const float*)(K->p.ws + WS_AFF); const short* inv = (const short*)(K->p.ws + WS_INV); const bf16* ye = (const bf16*)(K->p.ws + A_YE);
    for (int m = gw; m < MTOK; m += NGW) {
        const int b = m >> 11;
        GAS f32x4* o4 = (GAS f32x4*)(K->p.out + (size_t)m * DM) + F.lane;
        f32x4 v[4];
#pragma unroll
        for (int j = 0; j < 4; ++j) v[j] = o4[64 * j] * ALPHA;
        for (int e = 0; e < NEXP; ++e) {
            const int p = __builtin_amdgcn_readfirstlane((int)inv[(size_t)m * 16 + e]);
            if (p < 0) continue;
            const float gt = aff[(size_t)m * 16 + e];
            const GAS u32x2* yr = (const GAS u32x2*)(ye + ((size_t)(e * 16 + b) * CAP + p) * DM) + F.lane;
#pragma unroll
            for (int j = 0; j < 4; ++j) { const u32x2 w = yr[64 * j]; v[j] += (f32x4){pg8::bf_lo(w.x), pg8::bf_hi(w.x), pg8::bf_lo(w.y), pg8::bf_hi(w.y)} * gt; }
        }
        float s = 0.f;
#pragma unroll
        for (int j = 0; j < 4; ++j) s += (v[j].x + v[j].y) + (v[j].z + v[j].w);
        const float mean = wave_sum(s) * (1.f / DM); float s2 = 0.f;
#pragma unroll
        for (int j = 0; j < 4; ++j) { v[j] = v[j] - mean; s2 += (v[j].x * v[j].x + v[j].y * v[j].y) + (v[j].z * v[j].z + v[j].w * v[j].w); }
        const float rstd = 1.f / sqrtf(wave_sum(s2) * (1.f / DM) + LN_EPS);
#pragma unroll
        for (int j = 0; j < 4; ++j) { const f32x4 g2 = ((const f32x4*)K->p.ln2_g)[F.lane + 64 * j], b2 = ((const f32x4*)K->p.ln2_b)[F.lane + 64 * j]; o4[64 * j] = v[j] * rstd * g2 + b2; }
    }
}

struct OrderUp {
    int hf, vcu;
    __device__ __forceinline__ bool next(int i, pg8::Unit& u) const {
        if (i >= 8) return false;
        const int e = hf * 8 + i, x = vcu >> 5, l = vcu & 31, b = (x >> 1) * 4 + (l & 3), j = (x & 1) * 8 + (l >> 2);
        u.pm = i * 16 + b; u.pn = j; u.am = e * 16 + b; u.bt = e * 16 + j; return true;
    }
    __device__ __forceinline__ void a_ready(const pg8::Unit&) const {}
    __device__ __forceinline__ void done(const pg8::Unit&) const {}
};
struct OrderDown {
    int hf, vcu;
    __device__ __forceinline__ bool next(int i, pg8::Unit& u) const {
        if (i >= 2) return false;
        const int x = vcu >> 5, l = vcu & 31, pml = i * 64 + x * 8 + (l & 7), pn = l >> 3, pmg = hf * 128 + pml;
        u.pm = pmg; u.pn = pn; u.am = pml; u.bt = (pmg >> 4) * 4 + pn; return true;
    }
    __device__ __forceinline__ void a_ready(const pg8::Unit&) const {}
    __device__ __forceinline__ void done(const pg8::Unit&) const {}
};

#ifndef MK_N_LAUNCHES
#define MK_N_LAUNCHES 1
#endif
constexpr int N_PHASES = 13;
__global__ void __launch_bounds__(NWAVES * 64, 2) fwd_kernel(Args args) {
    extern __shared__ __attribute__((aligned(16))) unsigned char lds[];
#define MKFRAME(F) Frame F; { int t_ = threadIdx.x; asm volatile("" : "+v"(t_)); F.lds = (LAS unsigned char*)lds; F.MISC = (volatile LAS unsigned*)(F.lds + MISC_OFF); F.ctl = nullptr; \
        F.tid = t_; F.lane = t_ & 63; F.wave = __builtin_amdgcn_readfirstlane(t_ >> 6); F.G = 256; const int bx_ = blockIdx.x; F.vcu = (bx_ & 7) * 32 + (bx_ >> 3); }
#define BP(off) ((bf16*)(kargs()->p.ws + (off)))
#define SEAM() do { XcdBarrier b_; b_.bar = (unsigned*)(kargs()->p.ws + WS_CTL) + CW_BAR; b_.x = xb_xcc_id(); b_.st = (volatile LAS unsigned*)((LAS unsigned char*)lds + MISC_OFF) + 8; xcd_barrier(b_); } while (0)
    { const int t_ = threadIdx.x;
      for (int u = t_; u < (LDS_BYTES - LDSCTL_OFF) / 4; u += NWAVES * 64) ((LAS unsigned*)((LAS unsigned char*)lds + LDSCTL_OFF))[u] = 0u;
      __syncthreads();
      (void)xcd_barrier_post((unsigned*)(kargs()->p.ws + WS_CTL) + CW_BAR, (volatile LAS unsigned*)((LAS unsigned char*)lds + MISC_OFF) + 8); }

    { MKFRAME(F); p0_prologue(F, kargs()); } SEAM();
    { MKFRAME(F);
      pg8::Gemm g{BP(A_H0B), (const bf16*)(kargs()->p.ws + WS_WIN), MTOK, 5120, 1024}; pg8::StaticOrder S; S.init(MTOK, 5120, 256, (int)blockIdx.x);
      pg8::EpiProj E{BP(A_QKV), BP(A_GATES), kargs()->p.b_gate};
      pg8::gemm_phase<pg8::EpiProj, pg8::StaticOrder, true, true>(F.lds + RING_OFF, g, S, E); } SEAM();
    { MKFRAME(F); p1b_prep(F, kargs()); } SEAM();
    { MKFRAME(F);
#if defined(NAIVE_ATTN_A)
      attnA_naive_unit(F, kargs(), F.vcu); attnA_naive_unit(F, kargs(), F.vcu + 256);
#else
      { const attn_body::bf16* q_ = (const attn_body::bf16*)BP(A_QKV); attn_body::bf16* o_ = (attn_body::bf16*)BP(A_ATTNA);
        const int g = F.vcu >> 3, s = F.vcu & 7, ab = g >> 1, akvh = g & 1;
#pragma unroll 1
        for (int i = 0; i < 4; ++i) attn_body::attn_unit<8>(ab, akvh * 4 + i, akvh, s, q_ + OFF_QA, q_ + OFF_KA, q_ + OFF_VA, o_, (char*)lds + RING_OFF); }
      __syncthreads();
#endif
    }
#if defined(NAIVE_ATTN_B)
    { MKFRAME(F); attnB_naive_unit(F, kargs(), F.vcu); } SEAM();
#else
    { MKFRAME(F);
#pragma unroll 1
      for (int i = 0; i < 6; ++i) attn_body::band_half_unit(F.vcu + 256 * i, (const attn_body::bf16*)BP(A_QKV), OFF_QB, OFF_KB, OFF_VB, (attn_body::bf16*)BP(A_OBG), (float*)(kargs()->p.ws + WS_LSE), (char*)lds + RING_OFF);
      __syncthreads(); } SEAM();
    { MKFRAME(F); p3b_combine(F, kargs()); }
#endif
    { MKFRAME(F);
      { pg8::Gemm g{BP(A_ATTNA), (const bf16*)(kargs()->p.ws + WS_WA), MTOK, 1024, 512}; pg8::StaticOrder S; S.init(MTOK, 1024, 256, (int)blockIdx.x);
        pg8::EpiGate<false> E{BP(A_MERGED), BP(A_GATES), 0};
        pg8::gemm_phase<pg8::EpiGate<false>, pg8::StaticOrder, true, true>(F.lds + RING_OFF, g, S, E); }
      asm volatile("s_waitcnt vmcnt(0)" ::: "memory"); __syncthreads(); }
#if !defined(NAIVE_ATTN_B)
    SEAM();
#endif
    { MKFRAME(F);
      { pg8::Gemm g{BP(A_OB), (const bf16*)(kargs()->p.ws + WS_WB), MTOK, 1024, 256}; pg8::StaticOrder S; S.init(MTOK, 1024, 256, (int)blockIdx.x);
        pg8::EpiGate<true> E{BP(A_MERGED), BP(A_GATES), 1024};
        pg8::gemm_phase<pg8::EpiGate<true>, pg8::StaticOrder, true, true>(F.lds + RING_OFF, g, S, E); } } SEAM();
    { MKFRAME(F);
      pg8::Gemm g{BP(A_MERGED), (const bf16*)(kargs()->p.ws + WS_WO), MTOK, 1024, 1024}; pg8::StaticOrder S; S.init(MTOK, 1024, 256, (int)blockIdx.x);
      pg8::EpiPlain E{BP(A_MIX), 1024};
      pg8::gemm_phase<pg8::EpiPlain, pg8::StaticOrder, true, true>(F.lds + RING_OFF, g, S, E); } SEAM();
    { MKFRAME(F); p5_ln1_router_convert(F, kargs()); } SEAM();
    { MKFRAME(F); p6_topk_unit(F, kargs(), F.vcu); } SEAM();
    { MKFRAME(F); pg8::Gemm g{BP(A_XE), (const bf16*)(kargs()->p.ws + A_WGU), 0, 0, 1024}; OrderUp S{0, F.vcu}; pg8::EpiSwiglu E{BP(A_ACT)};
      pg8::gemm_phase<pg8::EpiSwiglu, OrderUp, true, true>(F.lds + RING_OFF, g, S, E); } SEAM();
    { MKFRAME(F); pg8::Gemm g{BP(A_ACT), (const bf16*)(kargs()->p.ws + A_WD), 0, 0, 2048}; OrderDown S{0, F.vcu}; pg8::EpiPlain E{BP(A_YE), 1024};
      pg8::gemm_phase<pg8::EpiPlain, OrderDown, true, true>(F.lds + RING_OFF, g, S, E); } SEAM();
    { MKFRAME(F); pg8::Gemm g{BP(A_XE), (const bf16*)(kargs()->p.ws + A_WGU), 0, 0, 1024}; OrderUp S{1, F.vcu}; pg8::EpiSwiglu E{BP(A_ACT)};
      pg8::gemm_phase<pg8::EpiSwiglu, OrderUp, true, true>(F.lds + RING_OFF, g, S, E); } SEAM();
    { MKFRAME(F); pg8::Gemm g{BP(A_ACT), (const bf16*)(kargs()->p.ws + A_WD), 0, 0, 2048}; OrderDown S{1, F.vcu}; pg8::EpiPlain E{BP(A_YE), 1024};
      pg8::gemm_phase<pg8::EpiPlain, OrderDown, true, true>(F.lds + RING_OFF, g, S, E); } SEAM();
    { MKFRAME(F); p9_final(F, kargs()); }
#undef MKFRAME
#undef BP
#undef SEAM
}

extern "C" void kernel_launch(void* const* d_in, const int* in_sizes, int n_in, void* d_out, int out_size, void* d_ws, size_t ws_size, hipStream_t stream) {
    static int grid = 0;
    if (grid == 0) {
        if (n_in != 18 || in_sizes[0] != MTOK * DM || out_size != MTOK * DM || ws_size < WS_END) { fprintf(stderr, "kernel_launch: unexpected shapes / workspace (n_in %d, ws %zu, need %zu)\n", n_in, ws_size, (size_t)WS_END); grid = -1; return; }
        if (hipFuncSetAttribute((const void*)fwd_kernel, hipFuncAttributeMaxDynamicSharedMemorySize, LDS_BYTES) != hipSuccess) { fprintf(stderr, "kernel_launch: hipFuncSetAttribute failed\n"); grid = -1; return; }
        (void)hipGetLastError();
        grid = 256;
    }
    if (grid < 0) return;
    if (hipMemsetAsync((char*)d_ws + WS_CTL, 0, CTL_ZERO_BYTES, stream) != hipSuccess) return;
    Args a{};
    const float** pp = (const float**)&a.p;
    for (int i = 0; i < 18; ++i) pp[i] = (const float*)d_in[i];
    a.p.out = (float*)d_out; a.p.ws = (unsigned char*)d_ws;
    a.ph_lo = 0; a.ph_hi = N_PHASES; a.li = 0;
    hipLaunchKernelGGL(fwd_kernel, dim3(grid), dim3(NWAVES * 64), LDS_BYTES, stream, a);
}
```

```cpp
#include <hip/hip_runtime.h>
#include <cstdio>
#include <cstdint>
constexpr int NWAVES = 8;
constexpr int BATCH = 16, SEQ = 2048, DM = 1024, MTOK = BATCH * SEQ;
constexpr int NEXP = 16, CAP = 256, DFF = 2048, NSLOT = BATCH * NEXP * CAP;
constexpr int QKVW = 3072, GATEW = 2048;
constexpr int OFF_QA = 0, OFF_KA = 512, OFF_VA = 640, OFF_QB = 768, OFF_KB = 1536, OFF_VB = 2304;
constexpr float LN_EPS = 1e-5f, QK_EPS = 1e-6f;
constexpr float ALPHA = 1.189207115002721f;
constexpr float C2 = 0.125f * 1.4426950408889634f;

namespace pg8 {
#define PG8_LAS __attribute__((address_space(3)))
typedef unsigned short bf16_t;
typedef short bf16x8 __attribute__((ext_vector_type(8)));
typedef float f32x4 __attribute__((ext_vector_type(4)));
typedef unsigned u32x4 __attribute__((ext_vector_type(4)));
constexpr int BM = 256, BK = 64, HALF = 128, HTB = HALF * BK * 2  , STAGE_BYTES = 8 * HTB, NXCD = 8, WGM = 8;

__host__ __device__ __forceinline__ int lds_byte(int r, int c) { const int st = (r >> 4) * 2 + (c >> 5), rr = r & 15, cc = c & 31, ob = rr * 64 + cc * 2; return st * 1024 + (ob ^ (((ob >> 9) & 1) << 5)); }
__host__ __device__ __forceinline__ void stage_rc(int b, int& R, int& C) { const int st = b / 1024, sb = b % 1024, swz = sb ^ (((sb >> 9) & 1) << 5); R = (st >> 1) * 16 + swz / 64; C = (st & 1) * 32 + (swz % 64) / 2; }
__host__ __device__ __forceinline__ int perm32(int rho) { const int n = rho >> 4, i = rho & 15; return 8 * (i >> 2) + 4 * n + (i & 3); }

struct Unit { int pm, pn, am, bt; };
struct Gemm { const bf16_t* A; const bf16_t* Bt; int M, N, K; };

struct StaticOrder {
    int nM, nN, nwg, G, c;
    __host__ __device__ void init(int M, int N, int G_, int c_) { nM = M / BM; nN = N / BM; nwg = nM * nN; G = G_; c = c_; }
    __host__ __device__ bool next(int i, Unit& u) const {
        const long L = (long)i * G + c; if (L >= nwg) return false;
        int wgid = (int)L; { const int q = nwg / NXCD, r = nwg % NXCD, xcd = wgid % NXCD, off = wgid / NXCD; wgid = (xcd < r ? xcd * (q + 1) : r * (q + 1) + (xcd - r) * q) + off; }
        const int nig = WGM * nN, gid = wgid / nig, fm = gid * WGM, gsz = (nM - fm) < WGM ? (nM - fm) : WGM;
        u.pm = fm + ((wgid % nig) % gsz); u.pn = (wgid % nig) / gsz; u.am = u.pm; u.bt = u.pn; return true;
    }
    __device__ __forceinline__ void a_ready(const Unit&) const {}
    __device__ __forceinline__ void done(const Unit&) const {}
};

__device__ __forceinline__ unsigned cvt_pk_bf16(float lo, float hi) { unsigned r; asm volatile("v_cvt_pk_bf16_f32 %0, %1, %2" : "=v"(r) : "v"(lo), "v"(hi)); return r; }
__device__ __forceinline__ float bf_lo(unsigned w) { return __uint_as_float(w << 16); }
__device__ __forceinline__ float bf_hi(unsigned w) { return __uint_as_float(w & 0xffff0000u); }
__device__ __forceinline__ float sigmoidf_(float x) { return 1.0f / (1.0f + __expf(-x)); }
__device__ __forceinline__ u32x4 pack8(const f32x4 v0, const f32x4 v1) { u32x4 w; w.x = cvt_pk_bf16(v0[0], v0[1]); w.y = cvt_pk_bf16(v0[2], v0[3]); w.z = cvt_pk_bf16(v1[0], v1[1]); w.w = cvt_pk_bf16(v1[2], v1[3]); return w; }

struct EpiProj {
    static constexpr bool PERM = true, AFTER_DRAIN = false;
    bf16_t* qkv; bf16_t* gates; const float* b_gate;
    __device__ __forceinline__ void operator()(const f32x4 (&acc)[2][2][4][2], const Unit& u, int wr, int wc, int fr, int fq) const {
        const int row0 = u.pm * BM + wr * 64 + fr;
        const bool isg = u.pn >= 12;
        bf16_t* base = isg ? gates : qkv; const int ldc = isg ? 2048 : 3072; const int colt = isg ? (u.pn - 12) * BM : u.pn * BM;
        const int col0 = colt + wc * 32 + 8 * fq;
        f32x4 bv[2][2];
#pragma unroll
        for (int bj = 0; bj < 2; ++bj)
#pragma unroll
            for (int n = 0; n < 2; ++n) bv[bj][n] = isg ? *(const f32x4*)(b_gate + col0 + bj * HALF + 4 * n) : (f32x4){0.f, 0.f, 0.f, 0.f};
#pragma unroll
        for (int ai = 0; ai < 2; ++ai)
#pragma unroll
            for (int m = 0; m < 4; ++m) { bf16_t* rowp = base + (size_t)(row0 + ai * HALF + m * 16) * ldc + col0;
#pragma unroll
                for (int bj = 0; bj < 2; ++bj) { f32x4 v0 = acc[ai][bj][m][0] + bv[bj][0], v1 = acc[ai][bj][m][1] + bv[bj][1];
                    if (isg) {
#pragma unroll
                        for (int i = 0; i < 4; ++i) { v0[i] = sigmoidf_(v0[i]); v1[i] = sigmoidf_(v1[i]); } }
                    *(u32x4*)(rowp + bj * HALF) = pack8(v0, v1); } }
    }
};
struct EpiPlain {
    static constexpr bool PERM = true, AFTER_DRAIN = false;
    bf16_t* O; int ldc;
    __device__ __forceinline__ void operator()(const f32x4 (&acc)[2][2][4][2], const Unit& u, int wr, int wc, int fr, int fq) const {
        const int row0 = u.pm * BM + wr * 64 + fr; const int col0 = u.pn * BM + wc * 32 + 8 * fq;
#pragma unroll
        for (int ai = 0; ai < 2; ++ai)
#pragma unroll
            for (int m = 0; m < 4; ++m) { bf16_t* rowp = O + (size_t)(row0 + ai * HALF + m * 16) * ldc + col0;
#pragma unroll
                for (int bj = 0; bj < 2; ++bj) *(u32x4*)(rowp + bj * HALF) = pack8(acc[ai][bj][m][0], acc[ai][bj][m][1]); }
    }
};
template <bool ACCUM> struct EpiGate {
    static constexpr bool PERM = true, AFTER_DRAIN = false;
    bf16_t* merged; const bf16_t* gates; int goff;
    __device__ __forceinline__ void operator()(const f32x4 (&acc)[2][2][4][2], const Unit& u, int wr, int wc, int fr, int fq) const {
        const int row0 = u.pm * BM + wr * 64 + fr; const int col0 = u.pn * BM + wc * 32 + 8 * fq;
#pragma unroll
        for (int ai = 0; ai < 2; ++ai)
#pragma unroll
            for (int m = 0; m < 4; ++m) { const size_t r = (size_t)(row0 + ai * HALF + m * 16);
#pragma unroll
                for (int bj = 0; bj < 2; ++bj) {
                    const u32x4 g = *(const u32x4*)(gates + r * 2048 + goff + col0 + bj * HALF);
                    f32x4 v0 = acc[ai][bj][m][0], v1 = acc[ai][bj][m][1];
                    v0[0] *= bf_lo(g.x); v0[1] *= bf_hi(g.x); v0[2] *= bf_lo(g.y); v0[3] *= bf_hi(g.y);
                    v1[0] *= bf_lo(g.z); v1[1] *= bf_hi(g.z); v1[2] *= bf_lo(g.w); v1[3] *= bf_hi(g.w);
                    bf16_t* p = merged + r * 1024 + col0 + bj * HALF;
                    if (ACCUM) { const u32x4 o = *(const u32x4*)p;
                        v0[0] += bf_lo(o.x); v0[1] += bf_hi(o.x); v0[2] += bf_lo(o.y); v0[3] += bf_hi(o.y);
                        v1[0] += bf_lo(o.z); v1[1] += bf_hi(o.z); v1[2] += bf_lo(o.w); v1[3] += bf_hi(o.w); }
                    *(u32x4*)p = pack8(v0, v1); } }
    }
};
struct EpiSwiglu {
    static constexpr bool PERM = true, AFTER_DRAIN = false;
    bf16_t* act;
    __device__ __forceinline__ void operator()(const f32x4 (&acc)[2][2][4][2], const Unit& u, int wr, int wc, int fr, int fq) const {
        const int row0 = u.pm * BM + wr * 64 + fr; const int col0 = u.pn * HALF + wc * 32 + 8 * fq;
#pragma unroll
        for (int ai = 0; ai < 2; ++ai)
#pragma unroll
            for (int m = 0; m < 4; ++m) {
                f32x4 v0, v1;
#pragma unroll
                for (int i = 0; i < 4; ++i) { const float g0 = acc[ai][0][m][0][i], g1 = acc[ai][0][m][1][i];
                    v0[i] = g0 * sigmoidf_(g0) * acc[ai][1][m][0][i]; v1[i] = g1 * sigmoidf_(g1) * acc[ai][1][m][1][i]; }
                *(u32x4*)(act + (size_t)(row0 + ai * HALF + m * 16) * 2048 + col0) = pack8(v0, v1); }
    }
};

struct EpiProj2 {
    static constexpr bool PERM = true, AFTER_DRAIN = false;
    bf16_t* qkv; bf16_t* gates; const float* b_gate; const float* qn_g; const float* kn_g; const float* ropeA; const float* ropeB;
    typedef unsigned u32x2_t __attribute__((ext_vector_type(2)));
    __device__ __forceinline__ void operator()(const f32x4 (&acc)[2][2][4][2], const Unit& u, int wr, int wc, int fr, int fq) const {
        const int row0 = u.pm * BM + wr * 64 + fr;
        if (u.pn >= 12) {
            const int col0 = (u.pn - 12) * BM + wc * 32 + 8 * fq;
            f32x4 bv[2][2];
#pragma unroll
            for (int bj = 0; bj < 2; ++bj)
#pragma unroll
                for (int n = 0; n < 2; ++n) bv[bj][n] = *(const f32x4*)(b_gate + col0 + bj * HALF + 4 * n);
#pragma unroll
            for (int ai = 0; ai < 2; ++ai)
#pragma unroll
                for (int m = 0; m < 4; ++m) { bf16_t* rowp = gates + (size_t)(row0 + ai * HALF + m * 16) * 2048 + col0;
#pragma unroll
                    for (int bj = 0; bj < 2; ++bj) { f32x4 v0 = acc[ai][bj][m][0] + bv[bj][0], v1 = acc[ai][bj][m][1] + bv[bj][1];
#pragma unroll
                        for (int i = 0; i < 4; ++i) { v0[i] = sigmoidf_(v0[i]); v1[i] = sigmoidf_(v1[i]); }
                        *(u32x4*)(rowp + bj * HALF) = pack8(v0, v1); } }
            return;
        }
        int kind, colbase;
        if (u.pn < 2) { kind = 0; colbase = OFF_QA + (4 * u.pn + wc) * 64; }
        else if (u.pn == 2) { if (wc < 2) { kind = 1; colbase = OFF_KA + wc * 64; } else { kind = 2; colbase = OFF_VA + (wc - 2) * 64; } }
        else if (u.pn < 6) { kind = 3; colbase = OFF_QB + (4 * (u.pn - 3) + wc) * 64; }
        else if (u.pn < 9) { kind = 4; colbase = OFF_KB + (4 * (u.pn - 6) + wc) * 64; }
        else { kind = 2; colbase = OFF_VB + (4 * (u.pn - 9) + wc) * 64; }
        if (kind <= 1) {
            const float* gn = kind == 0 ? qn_g : kn_g; const float sc = kind == 0 ? C2 : 1.0f;
            f32x4 g[2][2];
#pragma unroll
            for (int bj = 0; bj < 2; ++bj)
#pragma unroll
                for (int n = 0; n < 2; ++n) g[bj][n] = *(const f32x4*)(gn + 32 * n + 16 * bj + 4 * fq) * sc;
#pragma unroll
            for (int ai = 0; ai < 2; ++ai)
#pragma unroll
                for (int m = 0; m < 4; ++m) { const int row = row0 + ai * HALF + m * 16; const float* ta = ropeA + (size_t)(row & (SEQ - 1)) * 64 + 4 * fq;
                    float ss = 0.f;
#pragma unroll
                    for (int bj = 0; bj < 2; ++bj)
#pragma unroll
                        for (int n = 0; n < 2; ++n) { const f32x4 x = acc[ai][bj][m][n]; ss += (x[0] * x[0] + x[1] * x[1]) + (x[2] * x[2] + x[3] * x[3]); }
                    ss += __shfl_xor(ss, 16); ss += __shfl_xor(ss, 32);
                    const float rs = 1.0f / sqrtf(ss * (1.0f / 64.0f) + QK_EPS);
                    bf16_t* rowp = qkv + (size_t)row * QKVW + colbase + 4 * fq;
#pragma unroll
                    for (int n = 0; n < 2; ++n) { const f32x4 cs = *(const f32x4*)(ta + n * 32), sn = *(const f32x4*)(ta + n * 32 + 16);
                        const f32x4 x1 = acc[ai][0][m][n] * rs * g[0][n], x2 = acc[ai][1][m][n] * rs * g[1][n];
                        const f32x4 o1 = x1 * cs - x2 * sn, o2 = x2 * cs + x1 * sn;
                        u32x2_t w1, w2; w1.x = cvt_pk_bf16(o1[0], o1[1]); w1.y = cvt_pk_bf16(o1[2], o1[3]); w2.x = cvt_pk_bf16(o2[0], o2[1]); w2.y = cvt_pk_bf16(o2[2], o2[3]);
                        *(u32x2_t*)(rowp + 32 * n) = w1; *(u32x2_t*)(rowp + 32 * n + 16) = w2; } }
        } else if (kind == 2) {
#pragma unroll
            for (int ai = 0; ai < 2; ++ai)
#pragma unroll
                for (int m = 0; m < 4; ++m) { bf16_t* rowp = qkv + (size_t)(row0 + ai * HALF + m * 16) * QKVW + colbase + 8 * fq;
#pragma unroll
                    for (int bj = 0; bj < 2; ++bj) *(u32x4*)(rowp + 32 * bj) = pack8(acc[ai][bj][m][0], acc[ai][bj][m][1]); }
        } else {
            const float sc = kind == 3 ? C2 : 1.0f;
#pragma unroll
            for (int ai = 0; ai < 2; ++ai)
#pragma unroll
                for (int m = 0; m < 4; ++m) { const int row = row0 + ai * HALF + m * 16; const float* tb = ropeB + (size_t)(row & (SEQ - 1)) * 16;
                    f32x4 a0 = acc[ai][0][m][0], a1 = acc[ai][0][m][1], b0 = acc[ai][1][m][0], b1 = acc[ai][1][m][1];
                    if (fq == 0) { const f32x4 c0 = *(const f32x4*)(tb), c1 = *(const f32x4*)(tb + 4), s0 = *(const f32x4*)(tb + 8), s1 = *(const f32x4*)(tb + 12);
                        const f32x4 o0 = a0 * c0 - b0 * s0, p0 = b0 * c0 + a0 * s0, o1 = a1 * c1 - b1 * s1, p1 = b1 * c1 + a1 * s1; a0 = o0; b0 = p0; a1 = o1; b1 = p1; }
                    a0 = a0 * sc; a1 = a1 * sc; b0 = b0 * sc; b1 = b1 * sc;
                    bf16_t* rowp = qkv + (size_t)row * QKVW + colbase + 16 * fq;
                    *(u32x4*)(rowp) = pack8(a0, a1); *(u32x4*)(rowp + 8) = pack8(b0, b1); }
        }
    }
};
template <class Epi, class Sched, bool ALIGN_EPI = false, bool SP2 = false>
__device__ __forceinline__ void gemm_phase(PG8_LAS unsigned char* lds, const Gemm g, const Sched& S, const Epi& E) {
    int tid_ = threadIdx.x; asm volatile("" : "+v"(tid_));
    const int tid = tid_, wid = __builtin_amdgcn_readfirstlane(tid >> 6), lane = tid & 63, wr = wid >> 2, wc = wid & 3, fr = lane & 15, fq = lane >> 4;
    const int K = g.K, nt = K / BK;
    unsigned voffA[2], voffB[2];
#pragma unroll
    for (int i = 0; i < 2; ++i) { int R, C; stage_rc(tid * 16 + i * 8192, R, C); const int Rb = Epi::PERM ? ((R & ~31) + perm32(R & 31)) : R;
        voffA[i] = (unsigned)(R * K + C) * 2u; voffB[i] = (unsigned)(Rb * K + C) * 2u; }
    const size_t kstep = (size_t)(BK * 2);
    const size_t hstep = (size_t)HALF * K * 2;
    const size_t tstep = 2 * hstep;
    const unsigned ldsw = (unsigned)wid * 1024u;
    const int aoff = lds_byte(wr * 64 + fr, fq * 8), boff = lds_byte(wc * 32 + fr, fq * 8);
#define PG8_SA(b, h) (((b) * 2 + (h)) * HTB)
#define PG8_SB(b, h) ((4 + (b) * 2 + (h)) * HTB)
#define PG8_STAGE(bufoff, gbase, voff) do { _Pragma("unroll") for (int _i = 0; _i < 2; ++_i) \
        __builtin_amdgcn_global_load_lds((const unsigned*)((const char*)(gbase) + (voff)[_i]), (PG8_LAS unsigned*)(lds + (bufoff) + ldsw + _i * 8192), 16, 0, 0); } while (0)
#define PG8_LDA(dst, b, h) do { _Pragma("unroll") for (int m = 0; m < 4; ++m) _Pragma("unroll") for (int k = 0; k < 2; ++k) dst[m][k] = *(const PG8_LAS bf16x8*)(lds + PG8_SA(b, h) + aoff + m * 2048 + k * 1024); } while (0)
#define PG8_LDB(dst, b, h) do { _Pragma("unroll") for (int n = 0; n < 2; ++n) _Pragma("unroll") for (int k = 0; k < 2; ++k) dst[n][k] = *(const PG8_LAS bf16x8*)(lds + PG8_SB(b, h) + boff + n * 2048 + k * 1024); } while (0)
#define PG8_MMA(ai, bj, At, Bt) do { __builtin_amdgcn_s_setprio(1); _Pragma("unroll") for (int m = 0; m < 4; ++m) _Pragma("unroll") for (int n = 0; n < 2; ++n) _Pragma("unroll") for (int k = 0; k < 2; ++k) \
        acc[ai][bj][m][n] = __builtin_amdgcn_mfma_f32_16x16x32_bf16(Bt[n][k], At[m][k], acc[ai][bj][m][n], 0, 0, 0); __builtin_amdgcn_s_setprio(0); } while (0)
#define PG8_WAIT_V(n) asm volatile("s_waitcnt vmcnt(" #n ")" ::: "memory")
#define PG8_WAIT_L(n) asm volatile("s_waitcnt lgkmcnt(" #n ")" ::: "memory")
#define PG8_BAR __builtin_amdgcn_s_barrier()
#define PG8_SCHED __builtin_amdgcn_sched_barrier(0)
    Unit cur, nxt; int ui = 0;
    if (!S.next(0, cur)) return;
    f32x4 acc[2][2][4][2];
#pragma unroll
    for (int a = 0; a < 2; ++a)
#pragma unroll
        for (int b = 0; b < 2; ++b)
#pragma unroll
            for (int m = 0; m < 4; ++m)
#pragma unroll
                for (int n = 0; n < 2; ++n) acc[a][b][m][n] = (f32x4){0.f, 0.f, 0.f, 0.f};
    bf16x8 At[4][2], B0[2][2], B1[2][2];
    const char* cA = (const char*)g.A + (size_t)cur.am * tstep; const char* cB = (const char*)g.Bt + (size_t)cur.bt * tstep;
    S.a_ready(cur);
    if constexpr (SP2) {
        PG8_STAGE(PG8_SB(0, 0), cB, voffB); PG8_STAGE(PG8_SB(0, 1), cB + hstep, voffB); PG8_STAGE(PG8_SA(0, 0), cA, voffA); PG8_STAGE(PG8_SA(0, 1), cA + hstep, voffA);
        if (wr == 1) PG8_BAR;
        PG8_WAIT_V(2); PG8_BAR;
        PG8_STAGE(PG8_SB(1, 0), cB + kstep, voffB); PG8_STAGE(PG8_SA(1, 0), cA + kstep, voffA); PG8_STAGE(PG8_SB(1, 1), cB + hstep + kstep, voffB);
        PG8_WAIT_V(6); PG8_BAR;
    } else {
        PG8_STAGE(PG8_SB(0, 0), cB, voffB); PG8_STAGE(PG8_SA(0, 0), cA, voffA); PG8_STAGE(PG8_SB(0, 1), cB + hstep, voffB); PG8_STAGE(PG8_SA(0, 1), cA + hstep, voffA);
        if (wr == 1) PG8_BAR;
        PG8_WAIT_V(4); PG8_BAR;
        PG8_STAGE(PG8_SB(1, 0), cB + kstep, voffB); PG8_STAGE(PG8_SA(1, 0), cA + kstep, voffA); PG8_STAGE(PG8_SB(1, 1), cB + hstep + kstep, voffB);
        PG8_WAIT_V(6); PG8_BAR;
    }
    for (;;) {
        const bool has_next = S.next(ui + 1, nxt);
        const char* nA = has_next ? (const char*)g.A + (size_t)nxt.am * tstep : cA; const char* nB = has_next ? (const char*)g.Bt + (size_t)nxt.bt * tstep : cB;
        for (int t = 0; t < nt; t += 2) {
            const bool last = (t == nt - 2);
            const char* a1 = cA + (size_t)(t + 1) * kstep;
            const char* a2 = last ? nA : cA + (size_t)(t + 2) * kstep; const char* b2 = last ? nB : cB + (size_t)(t + 2) * kstep;
            const char* a3 = a2 + kstep; const char* b3 = b2 + kstep;
            if (last && has_next) S.a_ready(nxt);
            if constexpr (SP2) {
            PG8_LDB(B0, 0, 0); PG8_LDB(B1, 0, 1); PG8_SCHED; PG8_LDA(At, 0, 0); PG8_STAGE(PG8_SA(1, 1), a1 + hstep, voffA);
            PG8_WAIT_V(8); PG8_WAIT_L(0); PG8_BAR; PG8_MMA(0, 0, At, B0); PG8_MMA(0, 1, At, B1); PG8_BAR; PG8_SCHED;
            PG8_LDA(At, 0, 1); PG8_STAGE(PG8_SB(0, 0), b2, voffB); PG8_STAGE(PG8_SB(0, 1), b2 + hstep, voffB); PG8_STAGE(PG8_SA(0, 0), a2, voffA);
            PG8_WAIT_V(8); PG8_WAIT_L(0); PG8_BAR; PG8_MMA(1, 0, At, B0); PG8_MMA(1, 1, At, B1); PG8_BAR; PG8_SCHED;
            PG8_LDB(B0, 1, 0); PG8_LDB(B1, 1, 1); PG8_SCHED; PG8_LDA(At, 1, 0); PG8_STAGE(PG8_SA(0, 1), a2 + hstep, voffA);
            PG8_WAIT_V(8); PG8_WAIT_L(0); PG8_BAR; PG8_MMA(0, 0, At, B0); PG8_MMA(0, 1, At, B1); PG8_BAR; PG8_SCHED;
            PG8_LDA(At, 1, 1); PG8_STAGE(PG8_SB(1, 0), b3, voffB); PG8_STAGE(PG8_SB(1, 1), b3 + hstep, voffB); PG8_STAGE(PG8_SA(1, 0), a3, voffA);
            PG8_WAIT_V(8); PG8_WAIT_L(0); PG8_BAR; PG8_MMA(1, 0, At, B0); PG8_MMA(1, 1, At, B1); PG8_BAR; PG8_SCHED;
            } else {
            PG8_LDB(B0, 0, 0); PG8_SCHED; PG8_LDA(At, 0, 0); PG8_STAGE(PG8_SA(1, 1), a1 + hstep, voffA);
            PG8_WAIT_L(8); PG8_BAR; PG8_WAIT_L(0); PG8_MMA(0, 0, At, B0); PG8_BAR; PG8_SCHED;
            PG8_LDB(B1, 0, 1); PG8_STAGE(PG8_SB(0, 0), b2, voffB);
            PG8_BAR; PG8_WAIT_L(0); PG8_MMA(0, 1, At, B1); PG8_BAR;
            PG8_LDA(At, 0, 1); PG8_STAGE(PG8_SA(0, 0), a2, voffA);
            PG8_BAR; PG8_WAIT_L(0); PG8_MMA(1, 0, At, B0); PG8_BAR; PG8_SCHED;
            PG8_STAGE(PG8_SB(0, 1), b2 + hstep, voffB);
            PG8_WAIT_V(6); PG8_BAR; PG8_MMA(1, 1, At, B1); PG8_BAR;
            PG8_LDB(B0, 1, 0); PG8_SCHED; PG8_LDA(At, 1, 0); PG8_STAGE(PG8_SA(0, 1), a2 + hstep, voffA);
            PG8_WAIT_L(8); PG8_BAR; PG8_WAIT_L(0); PG8_MMA(0, 0, At, B0); PG8_BAR; PG8_SCHED;
            PG8_LDB(B1, 1, 1); PG8_STAGE(PG8_SB(1, 0), b3, voffB);
            PG8_BAR; PG8_WAIT_L(0); PG8_MMA(0, 1, At, B1); PG8_BAR;
            PG8_LDA(At, 1, 1); PG8_STAGE(PG8_SA(1, 0), a3, voffA);
            PG8_BAR; PG8_WAIT_L(0); PG8_MMA(1, 0, At, B0); PG8_BAR; PG8_SCHED;
            PG8_STAGE(PG8_SB(1, 1), b3 + hstep, voffB);
            PG8_WAIT_V(6); PG8_BAR; PG8_MMA(1, 1, At, B1); PG8_BAR;
            }
        }
        if constexpr (ALIGN_EPI) { if (wr == 0) PG8_BAR; }
        if constexpr (!Epi::AFTER_DRAIN) { E(acc, cur, wr, wc, fr, fq); S.done(cur); }
        if (!has_next) break;
#pragma unroll
        for (int a = 0; a < 2; ++a)
#pragma unroll
            for (int b = 0; b < 2; ++b)
#pragma unroll
                for (int m = 0; m < 4; ++m)
#pragma unroll
                    for (int n = 0; n < 2; ++n) acc[a][b][m][n] = (f32x4){0.f, 0.f, 0.f, 0.f};
        cur = nxt; cA = nA; cB = nB; ++ui;
        if constexpr (ALIGN_EPI) { if (wr == 1) PG8_BAR; }
    }
    PG8_WAIT_V(0);
    if constexpr (!ALIGN_EPI) { if (wr == 0) PG8_BAR; }
    PG8_BAR;
    if constexpr (Epi::AFTER_DRAIN) { E.fused(acc, cur, wr, wc, fr, fq, lds, wid, lane); S.done(cur); }
#undef PG8_SA
#undef PG8_SB
#undef PG8_STAGE
#undef PG8_LDA
#undef PG8_LDB
#undef PG8_MMA
#undef PG8_WAIT_V
#undef PG8_WAIT_L
#undef PG8_BAR
#undef PG8_SCHED
}
}
#include <hip/hip_bf16.h>
#include <cmath>
namespace attn_body {
using bf16=__hip_bfloat16;
using bf16x8=__attribute__((ext_vector_type(8)))short;
using s16x4=__attribute__((ext_vector_type(4)))short;
using f32x16=__attribute__((ext_vector_type(16)))float;
using u32x4=__attribute__((ext_vector_type(4)))unsigned;
constexpr int BATCH=16,NHEAD=8,SEQ=2048,D=64,PQ=3072,PO=512;
constexpr int NW=8,QBLK=32,QB=QBLK*NW,KVBLK=64,NQB=SEQ/QB;
constexpr int ATTN_UNIT_ROWS=QB;
__device__ __forceinline__ int crow(int r,int hi){return (r&3)+8*(r>>2)+4*hi;}
#define SBAR() __builtin_amdgcn_sched_barrier(0)
__device__ __forceinline__ void cmask(f32x16&p0,f32x16&p1,int jb,int qrel,int hi){
  const float NEG=-INFINITY; int kb=64*jb+4*hi;
  #pragma unroll
  for(int r=0;r<16;++r){int kv=kb+(r&3)+8*(r>>2); if(kv>qrel)p0[r]=NEG; if(kv+32>qrel)p1[r]=NEG;}
}

constexpr int NSLOT=3, SLOTB=8192;
constexpr int LDS_K=0, LDS_V=NSLOT*SLOTB, LDS_WS=2*NSLOT*SLOTB, LDS_OST=LDS_WS+NW*64*4, LDS_BYTES=LDS_OST+NW*4096;
constexpr float C2=0.125f*1.4426950408889634f;
__device__ __forceinline__ void glds16(const void*gsrc,unsigned lds_dst){unsigned keep;
  asm volatile("s_mov_b32 %0, m0\n\ts_mov_b32 m0, %2\n\ts_nop 0\n\tglobal_load_lds_dwordx4 %1, off\n\ts_mov_b32 m0, %0":"=&s"(keep):"v"(gsrc),"s"(lds_dst):"memory");}
__device__ __forceinline__ float max3f(float a,float b,float c){float r;asm("v_max3_f32 %0, %1, %2, %3":"=v"(r):"v"(a),"v"(b),"v"(c));return r;}
__device__ __forceinline__ float max2f(float a,float b){float r;asm("v_max_f32_e32 %0, %1, %2":"=v"(r):"v"(a),"v"(b));return r;}
__device__ __forceinline__ float fadd_s(float a,float b){float r;asm("v_add_f32_e32 %0, %1, %2":"=v"(r):"v"(a),"v"(b));return r;}
__device__ __forceinline__ float fsub_s(float a,float b){float r;asm("v_sub_f32_e32 %0, %1, %2":"=v"(r):"v"(a),"v"(b));return r;}
typedef float f32x2_t __attribute__((ext_vector_type(2))); typedef __bf16 bf16x2_t __attribute__((ext_vector_type(2)));
__device__ __forceinline__ unsigned cvtpk_s(float lo,float hi){f32x2_t v={lo,hi};bf16x2_t b=__builtin_convertvector(v,bf16x2_t);return __builtin_bit_cast(unsigned,b);}
#define WAIT_BAR(N) asm volatile("s_waitcnt vmcnt(" #N ") lgkmcnt(0)\n\ts_barrier":::"memory")

__device__ __forceinline__ void qkt(f32x16&p0,f32x16&p1,const char*Kslot,const bf16x8*qr,const f32x16&negm,int r32,int hi){
  const char*kb=Kslot+hi*1024+r32*16;
  #pragma unroll
  for(int d0=0;d0<4;++d0){
    const bf16x8 b0=*reinterpret_cast<const bf16x8*>(kb+d0*2048);
    const bf16x8 b1=*reinterpret_cast<const bf16x8*>(kb+d0*2048+512);
    if(d0==0){p0=__builtin_amdgcn_mfma_f32_32x32x16_bf16(b0,qr[0],negm,0,0,0);p1=__builtin_amdgcn_mfma_f32_32x32x16_bf16(b1,qr[0],negm,0,0,0);}
    else{p0=__builtin_amdgcn_mfma_f32_32x32x16_bf16(b0,qr[d0],p0,0,0,0);p1=__builtin_amdgcn_mfma_f32_32x32x16_bf16(b1,qr[d0],p1,0,0,0);}}
}
typedef __attribute__((address_space(3))) const char* lds_cptr;
typedef short v4i16_t __attribute__((ext_vector_type(4)));
__device__ __forceinline__ void kload8(bf16x8*kf,lds_cptr kp){
  kf[0]=*(const __attribute__((address_space(3))) bf16x8*)(kp);      kf[1]=*(const __attribute__((address_space(3))) bf16x8*)(kp+512);
  kf[2]=*(const __attribute__((address_space(3))) bf16x8*)(kp+2048); kf[3]=*(const __attribute__((address_space(3))) bf16x8*)(kp+2560);
  kf[4]=*(const __attribute__((address_space(3))) bf16x8*)(kp+4096); kf[5]=*(const __attribute__((address_space(3))) bf16x8*)(kp+4608);
  kf[6]=*(const __attribute__((address_space(3))) bf16x8*)(kp+6144); kf[7]=*(const __attribute__((address_space(3))) bf16x8*)(kp+6656);
}
__device__ __forceinline__ void kload2(bf16x8*kf,lds_cptr kp,int j){ kf[2*j]=*(const __attribute__((address_space(3))) bf16x8*)(kp+j*2048); kf[2*j+1]=*(const __attribute__((address_space(3))) bf16x8*)(kp+j*2048+512); }
__device__ __forceinline__ s16x4 vtr(lds_cptr p){ return __builtin_bit_cast(s16x4,__builtin_amdgcn_ds_read_tr16_b64_v4i16((__attribute__((address_space(3))) v4i16_t*)p)); }
__device__ __forceinline__ float rowmax(const f32x16&p0,const f32x16&p1){
  float a=max3f(p0[0],p0[1],p1[0]),b=max3f(p0[2],p0[3],p1[1]);a=max3f(a,p1[2],p1[3]);
  #pragma unroll
  for(int r=4;r<16;r+=4){a=max3f(a,p0[r],p0[r+1]);b=max3f(b,p0[r+2],p0[r+3]);a=max3f(a,p1[r],p1[r+1]);b=max3f(b,p1[r+2],p1[r+3]);}
  const float m=max2f(a,b);
  auto rr=__builtin_amdgcn_permlane32_swap(__float_as_uint(m),__float_as_uint(m),false,false);
  return max2f(__uint_as_float(rr[0]),__uint_as_float(rr[1]));
}
__device__ __forceinline__ void pv(f32x16*o,int vb,bf16x8 pa0,bf16x8 pa1,bf16x8 pa2,bf16x8 pa3){
  #pragma unroll
  for(int d0=0;d0<2;++d0){s16x4 lo[4],hi[4];
    #pragma unroll
    for(int ks=0;ks<4;++ks){
      asm volatile("ds_read_b64_tr_b16 %0,%1 offset:%c2":"=&v"(lo[ks]):"v"(vb),"i"(d0*4096+ks*1024):"memory");
      asm volatile("ds_read_b64_tr_b16 %0,%1 offset:%c2":"=&v"(hi[ks]):"v"(vb),"i"(d0*4096+ks*1024+512):"memory");}
    asm volatile("s_waitcnt lgkmcnt(0)":::"memory");SBAR();
    #define PK(k) (bf16x8){lo[k][0],lo[k][1],lo[k][2],lo[k][3],hi[k][0],hi[k][1],hi[k][2],hi[k][3]}
    o[d0]=__builtin_amdgcn_mfma_f32_32x32x16_bf16(pa0,PK(0),o[d0],0,0,0);
    o[d0]=__builtin_amdgcn_mfma_f32_32x32x16_bf16(pa1,PK(1),o[d0],0,0,0);
    o[d0]=__builtin_amdgcn_mfma_f32_32x32x16_bf16(pa2,PK(2),o[d0],0,0,0);
    o[d0]=__builtin_amdgcn_mfma_f32_32x32x16_bf16(pa3,PK(3),o[d0],0,0,0);
    #undef PK
  }
}

#ifndef ATTN_STORE16
#define ATTN_STORE16(p,v) (*(u32x4*)(p)=(v))
#endif
template<int THRL> __device__ __forceinline__ void attn_unit(int b,int h,int kvh,int qb,const bf16*Q,const bf16*__restrict__ K,const bf16*__restrict__ V,bf16*O,char*shm){
  int tid_=threadIdx.x; asm volatile("":"+v"(tid_)); const int tid=tid_,lane=tid&63,r32=lane&31,hi=lane>>5; const int wid=__builtin_amdgcn_readfirstlane(tid>>6);
  const long rowbase=(long)b*SEQ; const int q0=qb*QB;
  const bf16*Qw=Q+(rowbase+q0+wid*QBLK)*PQ+h*D;
  const bf16*Kh=K+rowbase*PQ+kvh*D,*Vh=V+rowbase*PQ+kvh*D;
  const unsigned lds0=(unsigned)(uintptr_t)shm;
  float*wsf=(float*)(shm+LDS_WS)+wid*64;
  const bf16*ksrc=Kh+(long)lane*PQ+wid*8;
  const bf16*vsrc=Vh+(long)(16*(wid&3)+(lane>>2))*PQ+(wid>>2)*32+(lane&3)*8;
  const unsigned kdst=lds0+LDS_K+wid*1024, vdst=lds0+LDS_V+wid*1024;
  #define DMA_K(t,slot) glds16(ksrc+(long)(t)*KVBLK*PQ,(unsigned)__builtin_amdgcn_readfirstlane(kdst+(slot)))
  #define DMA_V(t,slot) glds16(vsrc+(long)(t)*KVBLK*PQ,(unsigned)__builtin_amdgcn_readfirstlane(vdst+(slot)))
  const int vb0=(int)(lds0+LDS_V)+((lane>>4)&1)*32+(lane&3)*8+(4*hi+((lane&15)>>2))*64;
  const char*Kbase=shm+LDS_K; bf16x8 kf[8];
  const lds_cptr shm3=(lds_cptr)shm; const lds_cptr kp0=shm3+LDS_K+hi*1024+r32*16; const lds_cptr vp0=shm3+LDS_V+((lane>>4)&1)*32+(lane&3)*8+(4*hi+((lane&15)>>2))*64;
  constexpr int NT=SEQ/KVBLK;
  DMA_K(0,0);DMA_V(0,0);DMA_K(1,SLOTB);
  bf16x8 qr[4];
  #pragma unroll
  for(int d0=0;d0<4;++d0)qr[d0]=*reinterpret_cast<const bf16x8*>(&Qw[(long)r32*PQ+d0*16+hi*8]);
  float mhat=0.f,l_reg=0.f;f32x16 o[2];o[0]=f32x16{};o[1]=f32x16{};f32x16 negm=f32x16{};asm volatile("":"+v"(negm));

  #define CMASK(P0,P1,t) do{}while(0)
  bool resc=false;
  #define START(P0,P1) do{ const float rm=rowmax(P0,P1); resc=false; \
    { const float dl=rm; mhat=fadd_s(mhat,dl); \
      _Pragma("unroll") for(int r=0;r<16;++r){P0[r]=fsub_s(P0[r],dl);P1[r]=fsub_s(P1[r],dl);} \
      _Pragma("unroll") for(int r=0;r<16;++r)negm[r]=-mhat; asm volatile("":"+v"(negm)); } \
    _Pragma("unroll") for(int r=0;r<16;++r)P0[r]=__builtin_amdgcn_exp2f(P0[r]); }while(0)
  #define RESC() do{ if(resc){ asm volatile("s_waitcnt lgkmcnt(0)":::"memory"); \
      _Pragma("unroll") for(int d_=0;d_<2;++d_) _Pragma("unroll") for(int r=0;r<16;++r)o[d_][r]*=wsf[crow(r,hi)]; } }while(0)
  f32x16 pA0,pA1,pB0,pB1;
  int sl_prev=0,sl_cur=0,sl_next=SLOTB;
  #define ROT() do{sl_prev=sl_cur;sl_cur=sl_next;sl_next=(sl_next==(NSLOT-1)*SLOTB)?0:sl_next+SLOTB;}while(0)
  DMA_K(2,2*SLOTB);
  WAIT_BAR(3);
  qkt(pA0,pA1,Kbase,qr,negm,r32,hi);asm volatile("s_nop 15\n\ts_nop 7":"+v"(pA0),"+v"(pA1));CMASK(pA0,pA1,0);
  START(pA0,pA1);
  _Pragma("unroll") for(int r=0;r<16;++r)pA1[r]=__builtin_amdgcn_exp2f(pA1[r]);
  WAIT_BAR(0);
  DMA_K(3,0);DMA_V(1,SLOTB);
  ROT();
  kload8(kf,kp0+sl_cur);
  WAIT_BAR(2);
  s16x4 vlo[8],vhi[8]; u32x4 pw0,pw1,pw2,pw3;
  #define PKW(P,B) cvtpk_s(P[B],P[B+1])
  #define PAF(k) __builtin_bit_cast(bf16x8,pw##k)
  #define VFR(i) (bf16x8){vlo[i][0],vlo[i][1],vlo[i][2],vlo[i][3],vhi[i][0],vhi[i][1],vhi[i][2],vhi[i][3]}
  #define PIN(x) asm volatile("":"+v"(x))
  #define MX3(a,b,c) __builtin_fmaxf(__builtin_fmaxf((a),(b)),(c))
  #define GAPA(MF,A0,A1,A2,A3,W0,W1,PW) do{ MF; sacc+=A0; sacc+=A1; sacc+=A2; sacc+=A3; PIN(sacc); W0; W1; PIN(PW); SBAR(); }while(0)
  #define EX(v) __builtin_amdgcn_exp2f(v)
  #define GAPB(MF,X,B) do{ MF; X[B]=EX(X[B]); X[B+1]=EX(X[B+1]); X[B+2]=EX(X[B+2]); X[B+3]=EX(X[B+3]); PIN(X); SBAR(); }while(0)
  #define VRD(i) do{ vlo[i]=vtr(vp_+(((i)>>2)*4096+((i)&3)*1024)); vhi[i]=vtr(vp_+(((i)>>2)*4096+((i)&3)*1024+512)); }while(0)
  #define KRD(G,j) do{ if(G){ kload2(kf,kp0+sl_next,j); SBAR(); } }while(0)
  #define STEP(C0,C1,P0,P1,t,GK,GV,GL) do{ SBAR(); \
    const lds_cptr vp_=vp0+sl_prev; \
    VRD(0); SBAR(); float sacc=(P0[0]+P0[1]); \
    GAPA(C0=__builtin_amdgcn_mfma_f32_32x32x16_bf16(kf[0],qr[0],negm,0,0,0), P0[2],P0[3],P0[4],P0[5],     pw0[0]=PKW(P0,0), pw0[1]=PKW(P0,2), pw0); \
    VRD(4); SBAR(); GAPA(C1=__builtin_amdgcn_mfma_f32_32x32x16_bf16(kf[1],qr[0],negm,0,0,0), P0[6],P0[7],P0[8],P0[9],     pw0[2]=PKW(P0,4), pw0[3]=PKW(P0,6), pw0); \
    VRD(1); SBAR(); GAPA(C0=__builtin_amdgcn_mfma_f32_32x32x16_bf16(kf[2],qr[1],C0,0,0,0),   P0[10],P0[11],P0[12],P0[13], pw1[0]=PKW(P0,8), pw1[1]=PKW(P0,10), pw1); \
    VRD(5); SBAR(); GAPA(C1=__builtin_amdgcn_mfma_f32_32x32x16_bf16(kf[3],qr[1],C1,0,0,0),   P0[14],P0[15],P1[0],P1[1],   pw1[2]=PKW(P0,12),pw1[3]=PKW(P0,14), pw1); \
    VRD(2); SBAR(); GAPA(C0=__builtin_amdgcn_mfma_f32_32x32x16_bf16(kf[4],qr[2],C0,0,0,0),   P1[2],P1[3],P1[4],P1[5],     pw2[0]=PKW(P1,0), pw2[1]=PKW(P1,2), pw2); \
    VRD(6); SBAR(); GAPA(C1=__builtin_amdgcn_mfma_f32_32x32x16_bf16(kf[5],qr[2],C1,0,0,0),   P1[6],P1[7],P1[8],P1[9],     pw2[2]=PKW(P1,4), pw2[3]=PKW(P1,6), pw2); \
    VRD(3); SBAR(); GAPA(C0=__builtin_amdgcn_mfma_f32_32x32x16_bf16(kf[6],qr[3],C0,0,0,0),   P1[10],P1[11],P1[12],P1[13], pw3[0]=PKW(P1,8), pw3[1]=PKW(P1,10), pw3); \
    VRD(7); SBAR(); GAPA(C1=__builtin_amdgcn_mfma_f32_32x32x16_bf16(kf[7],qr[3],C1,0,0,0),   P1[14],P1[15],0.f,0.f,       pw3[2]=PKW(P1,12),pw3[3]=PKW(P1,14), pw3); \
    l_reg+=sacc; \
    if(GK){DMA_K((t)+3,sl_cur);} if(GV){DMA_V((t)+1,sl_next);} \
    CMASK(C0,C1,t); \
    { float a=MX3(C0[0],C0[1],C1[0]),b=MX3(C0[2],C0[3],C1[1]); a=MX3(a,C1[2],C1[3]); \
      _Pragma("unroll") for(int r=4;r<16;r+=4){a=MX3(a,C0[r],C0[r+1]);b=MX3(b,C0[r+2],C0[r+3]);a=MX3(a,C1[r],C1[r+1]);b=MX3(b,C1[r+2],C1[r+3]);} \
      float rm=__builtin_fmaxf(a,b); { auto rr=__builtin_amdgcn_permlane32_swap(__float_as_uint(rm),__float_as_uint(rm),false,false); rm=__builtin_fmaxf(__uint_as_float(rr[0]),__uint_as_float(rr[1])); } \
      resc=false; \
      if(__builtin_expect(__any(rm>(float)THRL),0)){ const float dl=__builtin_fmaxf(rm,0.f); mhat+=dl; \
        _Pragma("unroll") for(int r=0;r<16;++r){C0[r]-=dl;C1[r]-=dl;} \
        _Pragma("unroll") for(int r=0;r<16;++r)negm[r]=-mhat; asm volatile("":"+v"(negm)); \
        const float f=__builtin_amdgcn_exp2f(-dl); l_reg*=f; if(hi==0)wsf[r32]=f; resc=true; } } \
    SBAR(); \
    GAPB(o[0]=__builtin_amdgcn_mfma_f32_32x32x16_bf16(PAF(0),VFR(0),o[0],0,0,0), C0,0); \
    GAPB(o[1]=__builtin_amdgcn_mfma_f32_32x32x16_bf16(PAF(0),VFR(4),o[1],0,0,0), C0,4); \
    KRD(GL,0); GAPB(o[0]=__builtin_amdgcn_mfma_f32_32x32x16_bf16(PAF(1),VFR(1),o[0],0,0,0), C0,8); \
    KRD(GL,1); GAPB(o[1]=__builtin_amdgcn_mfma_f32_32x32x16_bf16(PAF(1),VFR(5),o[1],0,0,0), C0,12); \
    KRD(GL,2); GAPB(o[0]=__builtin_amdgcn_mfma_f32_32x32x16_bf16(PAF(2),VFR(2),o[0],0,0,0), C1,0); \
    KRD(GL,3); GAPB(o[1]=__builtin_amdgcn_mfma_f32_32x32x16_bf16(PAF(2),VFR(6),o[1],0,0,0), C1,4); \
    GAPB(o[0]=__builtin_amdgcn_mfma_f32_32x32x16_bf16(PAF(3),VFR(3),o[0],0,0,0), C1,8); \
    GAPB(o[1]=__builtin_amdgcn_mfma_f32_32x32x16_bf16(PAF(3),VFR(7),o[1],0,0,0), C1,12); \
    }while(0)
  int t=1;
  #undef CMASK
  #define CMASK(P0,P1,t) do{}while(0)
  for(;t+5<NT;t+=2){
    STEP(pB0,pB1,pA0,pA1,t,true,true,true);     WAIT_BAR(2); RESC(); ROT();
    STEP(pA0,pA1,pB0,pB1,t+1,true,true,true);   WAIT_BAR(2); RESC(); ROT();
  }
  #undef CMASK
  #define CMASK(P0,P1,t) do{}while(0)
  #define ENDW(tt) do{ if((tt)+3<NT){WAIT_BAR(2);} else if((tt)+2<NT){WAIT_BAR(1);} else {WAIT_BAR(0);} }while(0)
  for(;t+1<NT;t+=2){
    STEP(pB0,pB1,pA0,pA1,t,(t+3<NT),(t+1<NT),(t+1<NT));       ENDW(t);   RESC(); ROT();
    STEP(pA0,pA1,pB0,pB1,t+1,(t+4<NT),(t+2<NT),(t+2<NT));     ENDW(t+1); RESC(); ROT();
  }
  STEP(pB0,pB1,pA0,pA1,NT-1,false,false,false); RESC();
  { float sacc=pB0[0]+pB0[1]; _Pragma("unroll") for(int r=2;r<16;++r)sacc+=pB0[r]; _Pragma("unroll") for(int r=0;r<16;++r)sacc+=pB1[r]; l_reg+=sacc;
    pw0=(u32x4){PKW(pB0,0),PKW(pB0,2),PKW(pB0,4),PKW(pB0,6)};pw1=(u32x4){PKW(pB0,8),PKW(pB0,10),PKW(pB0,12),PKW(pB0,14)};pw2=(u32x4){PKW(pB1,0),PKW(pB1,2),PKW(pB1,4),PKW(pB1,6)};pw3=(u32x4){PKW(pB1,8),PKW(pB1,10),PKW(pB1,12),PKW(pB1,14)};
    SBAR(); pv(o,vb0+sl_cur,PAF(0),PAF(1),PAF(2),PAF(3)); }
  #undef PKW
  #undef PAF
  #undef VFR
  #undef PIN
  #undef MX3
  #undef GAPA
  #undef GAPB
  #undef EX
  #undef VRD
  #undef KRD
  #undef STEP
  #undef ENDW
  {auto rr=__builtin_amdgcn_permlane32_swap(__float_as_uint(l_reg),__float_as_uint(l_reg),false,false);l_reg=__uint_as_float(rr[0])+__uint_as_float(rr[1]);}
  if(hi==0)wsf[32+r32]=l_reg;asm volatile("s_waitcnt lgkmcnt(0)":::"memory");
  float rli[16];
  #pragma unroll
  for(int r=0;r<16;++r)rli[r]=__builtin_amdgcn_rcpf(wsf[32+crow(r,hi)]);
  bf16*Ow=O+(rowbase+q0+wid*QBLK)*PO+h*D;
  { bf16*stg=(bf16*)(shm+LDS_OST)+wid*2048;
    #pragma unroll
    for(int r=0;r<16;++r){const int orow=crow(r,hi);
      #pragma unroll
      for(int d0=0;d0<2;++d0)stg[orow*64+d0*32+r32]=__float2bfloat16(o[d0][r]*rli[r]);}
    asm volatile("s_waitcnt lgkmcnt(0)":::"memory");
    #pragma unroll
    for(int i=0;i<4;++i){const int row=i*8+(lane>>3),ch=lane&7; const u32x4 v=*(const u32x4*)(stg+row*64+ch*8); ATTN_STORE16(Ow+(long)row*PO+ch*8,v);} }
  asm volatile("s_waitcnt lgkmcnt(0)\n\ts_barrier":::"memory");
  #undef DMA_K
  #undef DMA_V
  #undef CMASK
  #undef START
  #undef RESC
  #undef ROT
}
constexpr int ATTN_LDS_BYTES=LDS_BYTES;
struct AttnTensors { const bf16* Q; const bf16* K; const bf16* V; bf16* O; };
constexpr int BAND_HALF=40960, BAND_K=0, BAND_V=16384, BAND_WS=32768, BAND_OST=81920, BAND_LDS_BYTES=BAND_OST+NW*4096;
__device__ __forceinline__ void band_half_unit(int hu,const bf16*__restrict__ QKV,int offq,int offk,int offv,bf16*OBG,float*LSEG,char*shm){
  int tid_=threadIdx.x; asm volatile("":"+v"(tid_)); const int tid=tid_,lane=tid&63,r32=lane&31,hi=lane>>5; const int wid=__builtin_amdgcn_readfirstlane(tid>>6);
  const int half=wid>>2, wq=wid&3;
  const int uh=__builtin_amdgcn_readfirstlane(2*hu+half);
  const int b=uh/192, rem=uh-b*192, head=rem>>4, ck=rem&15, g=head>>2, j=head&3;
  const int dil=(g==0)?1:(g==1)?4:16, sh=(g==0)?4:(g==1)?2:0;
  const int rc=ck>>sh, c=ck&((1<<sh)-1), ntile=(SEQ/64)/dil;
  const long rowbase=(long)b*SEQ;
  bf16*const OG=OBG+(long)g*BATCH*SEQ*256; float*const LG=LSEG+(long)g*BATCH*SEQ*4;
  const unsigned lds0=(unsigned)(uintptr_t)shm+half*BAND_HALF;
  char*hb=shm+half*BAND_HALF;
  typedef __attribute__((address_space(3))) float* lds_fptr;
  const lds_fptr wsf=(lds_fptr)(hb+BAND_WS+wq*256);
  const int mq=128*c+32*wq+r32;
  const bf16*Qrow=QKV+(rowbase+(long)mq*dil+rc)*PQ+offq+head*D;
  bf16x8 qr[4];
  #pragma unroll
  for(int d0=0;d0<4;++d0)qr[d0]=*reinterpret_cast<const bf16x8*>(&Qrow[d0*16+hi*8]);
  const bf16*Kc=QKV+(rowbase+rc)*PQ+offk+head*D, *Vc=QKV+(rowbase+rc)*PQ+offv+head*D;
  #define BAND_DMA(T,slot) do{ const long p0_=(long)(T)*64; \
      _Pragma("unroll") for(int q_=0;q_<2;++q_){ const int cc_=2*wq+q_; \
        glds16(Kc+((p0_+lane)*dil)*PQ+cc_*8,(unsigned)__builtin_amdgcn_readfirstlane(lds0+BAND_K+(slot)*8192+cc_*1024)); \
        glds16(Vc+((p0_+16*(cc_&3)+(lane>>2))*dil)*PQ+(cc_>>2)*32+(lane&3)*8,(unsigned)__builtin_amdgcn_readfirstlane(lds0+BAND_V+(slot)*8192+cc_*1024)); } }while(0)
  const int T0=2*c-1;
  float mrun=-1e30f,l_reg=0.f; f32x16 o[2]; o[0]=f32x16{}; o[1]=f32x16{};
  const int vb0=(int)(lds0+BAND_V)+((lane>>4)&1)*32+(lane&3)*8+(4*hi+((lane&15)>>2))*64;
  { const int T=T0; if(T>=0&&T<ntile) BAND_DMA(T,0); }
  #pragma unroll 1
  for(int s=0;s<4;++s){
    const int T=T0+s, Tn=T+1; const bool vcur=(T>=0&&T<ntile), vnext=(s<3)&&(Tn>=0&&Tn<ntile);
    if(vnext){ BAND_DMA(Tn,(s+1)&1); asm volatile("s_waitcnt vmcnt(4)":::"memory"); } else { asm volatile("s_waitcnt vmcnt(0)":::"memory"); }
    asm volatile("s_barrier":::"memory");
    const bool act=vcur&&(s>=(wq>>1))&&(s<=(wq>>1)+2);
    if(act){
      f32x16 p0,p1; const f32x16 zero=f32x16{};
      qkt(p0,p1,hb+BAND_K+(s&1)*8192,qr,zero,r32,hi);
      const int kb=64*T+4*hi-mq;
      float mx=-1e30f;
      #pragma unroll
      for(int r=0;r<16;++r){ const int d0_=kb+(r&3)+8*(r>>2), d1_=d0_+32;
        p0[r]=(d0_>=-64&&d0_<=64)?p0[r]:-1e30f; p1[r]=(d1_>=-64&&d1_<=64)?p1[r]:-1e30f; mx=__builtin_fmaxf(mx,__builtin_fmaxf(p0[r],p1[r])); }
      mx=__builtin_fmaxf(mx,__shfl_xor(mx,32));
      const float mnew=__builtin_fmaxf(mrun,mx); const float f=__builtin_amdgcn_exp2f(mrun-mnew); mrun=mnew;
      float sacc=0.f;
      #pragma unroll
      for(int r=0;r<16;++r){ p0[r]=(p0[r]>-1e29f)?__builtin_amdgcn_exp2f(p0[r]-mnew):0.f; p1[r]=(p1[r]>-1e29f)?__builtin_amdgcn_exp2f(p1[r]-mnew):0.f; sacc+=p0[r]+p1[r]; }
      l_reg=l_reg*f+sacc;
      if(hi==0)wsf[r32]=f;
      #pragma unroll
      for(int r=0;r<16;++r){ const float fr=wsf[crow(r,hi)]; o[0][r]*=fr; o[1][r]*=fr; }
      u32x4 pw0,pw1,pw2,pw3;
      pw0=(u32x4){cvtpk_s(p0[0],p0[1]),cvtpk_s(p0[2],p0[3]),cvtpk_s(p0[4],p0[5]),cvtpk_s(p0[6],p0[7])}; pw1=(u32x4){cvtpk_s(p0[8],p0[9]),cvtpk_s(p0[10],p0[11]),cvtpk_s(p0[12],p0[13]),cvtpk_s(p0[14],p0[15])};
      pw2=(u32x4){cvtpk_s(p1[0],p1[1]),cvtpk_s(p1[2],p1[3]),cvtpk_s(p1[4],p1[5]),cvtpk_s(p1[6],p1[7])}; pw3=(u32x4){cvtpk_s(p1[8],p1[9]),cvtpk_s(p1[10],p1[11]),cvtpk_s(p1[12],p1[13]),cvtpk_s(p1[14],p1[15])};
      SBAR(); pv(o,vb0+(s&1)*8192,__builtin_bit_cast(bf16x8,pw0),__builtin_bit_cast(bf16x8,pw1),__builtin_bit_cast(bf16x8,pw2),__builtin_bit_cast(bf16x8,pw3));
    }
    asm volatile("s_waitcnt lgkmcnt(0)\n\ts_barrier":::"memory");
  }
  #undef BAND_DMA
  l_reg+=__shfl_xor(l_reg,32);
  if(hi==0)wsf[32+r32]=l_reg;
  float rli[16];
  #pragma unroll
  for(int r=0;r<16;++r)rli[r]=__builtin_amdgcn_rcpf(wsf[32+crow(r,hi)]);
  { bf16*stg=(bf16*)(shm+BAND_OST)+wid*2048;
    #pragma unroll
    for(int r=0;r<16;++r){const int orow=crow(r,hi);
      #pragma unroll
      for(int d0=0;d0<2;++d0)stg[orow*64+d0*32+r32]=__float2bfloat16(o[d0][r]*rli[r]);}
    asm volatile("s_waitcnt lgkmcnt(0)":::"memory");
    #pragma unroll
    for(int i=0;i<4;++i){const int row=i*8+(lane>>3),ch=lane&7; const u32x4 v=*(const u32x4*)(stg+row*64+ch*8);
      const long grow=rowbase+(long)(128*c+32*wq+row)*dil+rc;
      *(u32x4*)(OG+grow*256+j*64+ch*8)=v;} }
  if(hi==0){ const long grow=rowbase+(long)mq*dil+rc; LG[grow*4+j]=mrun+__builtin_log2f(l_reg); }
  asm volatile("s_waitcnt lgkmcnt(0)\n\ts_barrier":::"memory");
}
#undef SBAR
#undef WAIT_BAR
}
#define GAS __attribute__((address_space(1)))
#define LAS __attribute__((address_space(3)))
typedef unsigned short bf16;
typedef unsigned v4u __attribute__((ext_vector_type(4)));
typedef float f32x4 __attribute__((ext_vector_type(4)));
typedef short bf16x8 __attribute__((ext_vector_type(8)));
typedef GAS unsigned gu32;
typedef GAS unsigned long long gu64;
#define RLX_AGENT __ATOMIC_RELAXED, __HIP_MEMORY_SCOPE_AGENT
#define LDS_WAIT() asm volatile("s_waitcnt lgkmcnt(0)" ::: "memory")
#define VM_WAIT() asm volatile("s_waitcnt vmcnt(0)" ::: "memory")
__device__ __forceinline__ unsigned long long rt() { return __builtin_amdgcn_s_memrealtime(); }
__device__ __forceinline__ unsigned f2bf(float f) { unsigned u = __builtin_bit_cast(unsigned, f); return (u + 0x7fffu + ((u >> 16) & 1u)) >> 16; }
__device__ __forceinline__ unsigned pk2(float lo, float hi) { return f2bf(lo) | (f2bf(hi) << 16); }

#define XB_TMO      128
#define XB_XCNT(j)  (256  + 64 * (j))
#define XB_XSUB(j)  (1280 + 64 * (j))
#define XB_XGEN(j)  (2304 + 64 * (j))
#define XB_TOP      3328
#define XB_TOPGEN   3392
#define XCD_BAR_WORDS 3456
#define XB_SPIN_CAP (1u << 24)

__device__ __forceinline__ unsigned xb_ld(unsigned* p)              { return __hip_atomic_load(p, __ATOMIC_RELAXED, __HIP_MEMORY_SCOPE_AGENT); }
__device__ __forceinline__ unsigned xb_add(unsigned* p, unsigned v) { return __hip_atomic_fetch_add(p, v, __ATOMIC_RELAXED, __HIP_MEMORY_SCOPE_AGENT); }
__device__ __forceinline__ unsigned xb_xcc_id() { return (unsigned)__builtin_amdgcn_s_getreg((3 << 11) | 20) & 0xFu; }
#define XB_SPIN(cond, bar) do { unsigned _sp = 0; while (cond) { __builtin_amdgcn_s_sleep(1); \
    if ((++_sp & 255u) == 0u) { if (xb_ld(&(bar)[XB_TMO])) break; if (_sp > XB_SPIN_CAP) { atomicAdd(&(bar)[XB_TMO], 1u); break; } } } } while (0)

struct XcdBarrier {
    unsigned* bar; unsigned x;
    volatile LAS unsigned* st;
};

__device__ __forceinline__ XcdBarrier xcd_barrier_post(unsigned* bar, volatile LAS unsigned* st) {
    XcdBarrier b; b.bar = bar; b.x = xb_xcc_id(); b.st = st;
    if (threadIdx.x == 0) (void)xb_add(&bar[XB_XCNT(b.x)], 1u);
    return b;
}
__device__ __forceinline__ void xcd_barrier_complete(unsigned* bar, unsigned x, unsigned& nloc, unsigned& nx) {
    const unsigned G = gridDim.x * gridDim.y * gridDim.z;
    unsigned sum, cnt, mine, sp = 0u;
    for (;;) {
        sum = 0u; cnt = 0u; mine = 0u;
#pragma unroll
        for (unsigned j = 0; j < 16; ++j) { const unsigned c = xb_ld(&bar[XB_XCNT(j)]); sum += c; cnt += (c > 0u) ? 1u : 0u; mine = (j == x) ? c : mine; }
        if (sum == G) break;
        __builtin_amdgcn_s_sleep(1);
        if ((++sp & 255u) == 0u) { if (xb_ld(&bar[XB_TMO])) break; if (sp > XB_SPIN_CAP) { atomicAdd(&bar[XB_TMO], 1u); break; } }
    }
    nloc = mine > 0u ? mine : 1u; nx = cnt > 0u ? cnt : 1u;
}

__device__ __forceinline__ void xcd_barrier(const XcdBarrier& b) {
    asm volatile("s_waitcnt vmcnt(0)" ::: "memory");
    __syncthreads();
    if (threadIdx.x == 0) {
        unsigned* bar = b.bar;
        __builtin_amdgcn_s_waitcnt(0);
        unsigned nloc = b.st[0], nx = b.st[1];
        if (nloc == 0u) { xcd_barrier_complete(bar, b.x, nloc, nx); b.st[0] = nloc; b.st[1] = nx; }
        const unsigned old = xb_add(&bar[XB_XSUB(b.x)], 1u);
        const unsigned gen = old / nloc;
        if (old + 1u == (gen + 1u) * nloc) {
            __builtin_amdgcn_fence(__ATOMIC_RELEASE, "agent");
            asm volatile("s_waitcnt vmcnt(0)" ::: "memory");
            const unsigned og = xb_add(&bar[XB_TOP], 1u);
            const unsigned tg = og / nx;
            if (og + 1u == (tg + 1u) * nx) xb_add(&bar[XB_TOPGEN], 1u);
            else XB_SPIN(xb_ld(&bar[XB_TOPGEN]) == tg, bar);
            __builtin_amdgcn_fence(__ATOMIC_ACQUIRE, "agent");
            xb_add(&bar[XB_XGEN(b.x)], 1u);
            asm volatile("s_waitcnt vmcnt(0)" ::: "memory");
        } else {
            XB_SPIN(xb_ld(&bar[XB_XGEN(b.x)]) == gen, bar);
            __builtin_amdgcn_fence(__ATOMIC_ACQUIRE, "agent");
            asm volatile("s_waitcnt vmcnt(0)" ::: "memory");
        }
    }
    __syncthreads();
}


constexpr size_t MiB = 1u << 20;
constexpr size_t WS_CTL = 0, CTL_ZERO_BYTES = 1 * MiB;
constexpr size_t WS_STAT0 = 1 * MiB;
constexpr size_t WS_AFF = 2 * MiB;
constexpr size_t WS_INV = 4 * MiB;
constexpr size_t WS_TOK = 5 * MiB;
constexpr size_t WS_LSE = 6 * MiB;
constexpr size_t WS_WIN = 8 * MiB;
constexpr size_t WS_WA = 18 * MiB;
constexpr size_t WS_WB = 19 * MiB;
constexpr size_t WS_WO = 20 * MiB;
constexpr size_t WS_ROPEA = 22 * MiB;
constexpr size_t WS_ROPEB = 23 * MiB;
constexpr size_t ARENA = 32 * MiB;
constexpr size_t A_H0B = ARENA + 0 * MiB;
constexpr size_t A_QKV = ARENA + 64 * MiB;
constexpr size_t A_GATES = ARENA + 256 * MiB;
constexpr size_t A_ATTNA = ARENA + 0 * MiB;
constexpr size_t A_OB = ARENA + 32 * MiB;
constexpr size_t A_OBG = ARENA + 384 * MiB;
constexpr size_t A_MERGED = ARENA + 64 * MiB;
constexpr size_t A_MIX = ARENA + 128 * MiB;
constexpr size_t A_H1B = ARENA + 0 * MiB;
constexpr size_t A_WGU = ARENA + 256 * MiB;
constexpr size_t A_WD = ARENA + 384 * MiB;
constexpr size_t A_XE = ARENA + 128 * MiB;
constexpr size_t A_ACT = ARENA + 0 * MiB;
constexpr size_t A_YE = ARENA + 128 * MiB;
constexpr size_t WS_END = ARENA + 448 * MiB;
constexpr int CW_TMO = 0, CW_BAR = 4096;

constexpr int RING_OFF = 0, RING_BYTES = 131072;
constexpr int LDSCTL_OFF = RING_BYTES, MISC_OFF = LDSCTL_OFF + 320;
constexpr int LDS_BYTES = 147456;

typedef short s16x4v __attribute__((ext_vector_type(4)));
typedef unsigned u32x2 __attribute__((ext_vector_type(2)));

struct Frame {
    LAS unsigned char* lds;
    volatile LAS unsigned* MISC;
    gu32* ctl;
    int tid, lane, wave;
    int vcu, G;
};

__device__ __forceinline__ float wave_sum(float v) {
#pragma unroll
    for (int o = 1; o < 64; o <<= 1) v += __shfl_xor(v, o);
    return v;
}
__device__ __forceinline__ float bf2f(bf16 h) { return __uint_as_float(((unsigned)h) << 16); }

template <class RowMap>
__device__ __forceinline__ void transpose_item(const float* W, int ldw, int k0, int n0, bf16* WT, int ldt, const RowMap& rowmap, LAS float* scr, int lane) {
#pragma unroll 8
    for (int i = 0; i < 32; ++i) { const int kk = 2 * i + (lane >> 5); scr[kk * 33 + (lane & 31)] = W[(size_t)(k0 + kk) * ldw + n0 + (lane & 31)]; }
    LDS_WAIT(); asm volatile("" ::: "memory");
    const int c = lane & 7;
#pragma unroll
    for (int j = 0; j < 4; ++j) { const int n = (lane >> 3) + 8 * j; const LAS float* s = scr + (8 * c) * 33 + n;
        v4u o; o.x = pk2(s[0 * 33], s[1 * 33]); o.y = pk2(s[2 * 33], s[3 * 33]); o.z = pk2(s[4 * 33], s[5 * 33]); o.w = pk2(s[6 * 33], s[7 * 33]);
        *(GAS v4u*)(WT + (size_t)rowmap(n0 + n) * (size_t)ldt + k0 + 8 * c) = o; }
    LDS_WAIT(); asm volatile("" ::: "memory");
}
struct RowOff { size_t off; __device__ __forceinline__ size_t operator()(int n) const { return off + (size_t)n; } };
struct WinRow {
    __device__ __forceinline__ size_t operator()(int ncol) const {
        if (ncol >= QKVW) return (size_t)ncol;
        int pn, wc, d, map;
        if (ncol < OFF_KA) { const int h = ncol >> 6; pn = h >> 2; wc = h & 3; map = 0; }
        else if (ncol < OFF_VA) { pn = 2; wc = (ncol - OFF_KA) >> 6; map = 0; }
        else if (ncol < OFF_QB) { pn = 2; wc = 2 + ((ncol - OFF_VA) >> 6); map = 2; }
        else if (ncol < OFF_KB) { const int h = (ncol - OFF_QB) >> 6; pn = 3 + (h >> 2); wc = h & 3; map = 1; }
        else if (ncol < OFF_VB) { const int h = (ncol - OFF_KB) >> 6; pn = 6 + (h >> 2); wc = h & 3; map = 1; }
        else { const int h = (ncol - OFF_VB) >> 6; pn = 9 + (h >> 2); wc = h & 3; map = 2; }
        d = ncol & 63;
        int bj, fq, n; const int i = d & 3;
        if (map == 0) { n = d >> 5; bj = (d >> 4) & 1; fq = (d >> 2) & 3; }
        else if (map == 1) { fq = d >> 4; bj = (d >> 3) & 1; n = (d >> 2) & 1; }
        else { bj = d >> 5; fq = (d >> 3) & 3; n = (d >> 2) & 1; }
        return (size_t)(pn * 256 + 128 * bj + 32 * wc + 8 * fq + 4 * n + i);
    }
};

struct Ptrs {
    const float *x, *ln0_g, *ln0_b, *w_in, *b_gate, *qn_g, *kn_g, *w_a, *w_b, *w_out, *ln1_g, *ln1_b, *w_router, *w_gate_e, *w_up_e, *w_down_e, *ln2_g, *ln2_b;
    float* out; unsigned char* ws;
};
struct Args { Ptrs p; int ph_lo, ph_hi, li, pad; };
typedef const __attribute__((address_space(4))) Args* KArgsP;
__device__ __forceinline__ KArgsP kargs() { KArgsP k = (KArgsP)__builtin_amdgcn_kernarg_segment_ptr(); asm volatile("" : "+s"(k)); return k; }

__device__ __forceinline__ void sincos_rev(float angle, float& sn, float& cs) {
    const double rev = (double)angle * 0.15915494309189533577; const double fr = rev - __builtin_rint(rev);
    sn = __builtin_amdgcn_sinf((float)fr); cs = __builtin_amdgcn_cosf((float)fr);
}
__device__ __forceinline__ void p0_prologue(Frame& F, KArgsP K) {
    LAS float* scr = (LAS float*)(F.lds + RING_OFF + F.wave * 16384);
    const int gw = F.vcu * NWAVES + F.wave, NGW = F.G * NWAVES;
    bf16* win_t = (bf16*)(K->p.ws + WS_WIN); bf16* wa_t = (bf16*)(K->p.ws + WS_WA); bf16* wb_t = (bf16*)(K->p.ws + WS_WB); bf16* wo_t = (bf16*)(K->p.ws + WS_WO);
    constexpr int I_IN = (1024 / 64) * (5120 / 32), I_A = (512 / 64) * (1024 / 32), I_B = (256 / 64) * (1024 / 32), I_O = (1024 / 64) * (1024 / 32);
    for (int it = gw; it < I_IN + I_A + I_B + I_O; it += NGW) {
        int r = it;
        if (r < I_IN) { const int nb = r % 160, kb = r / 160; transpose_item(K->p.w_in, 5120, kb * 64, nb * 32, win_t, 1024, WinRow{}, scr, F.lane); continue; } r -= I_IN;
        if (r < I_A) { const int nb = r % 32, kb = r / 32; transpose_item(K->p.w_a, 1024, kb * 64, nb * 32, wa_t, 512, RowOff{0}, scr, F.lane); continue; } r -= I_A;
        if (r < I_B) { const int nb = r % 32, kb = r / 32; transpose_item(K->p.w_b, 1024, kb * 64, nb * 32, wb_t, 256, RowOff{0}, scr, F.lane); continue; } r -= I_B;
        { const int nb = r % 32, kb = r / 32; transpose_item(K->p.w_out, 1024, kb * 64, nb * 32, wo_t, 1024, RowOff{0}, scr, F.lane); }
    }
    { float* ra = (float*)(K->p.ws + WS_ROPEA); float* rb = (float*)(K->p.ws + WS_ROPEB);
      for (int it = F.vcu * (NWAVES * 64) + F.tid; it < SEQ * 40; it += F.G * NWAVES * 64) {
          const int t = it / 40, r = it - t * 40; float sn, cs;
          if (r < 32) { const int n = r >> 4, f = r & 15; const float pos = n ? (float)(t & 63) : (float)(t >> 6);
              sincos_rev(pos * exp2f(-(float)f * (13.287712379549449f / 16.f)), sn, cs); ra[t * 64 + n * 32 + f] = cs; ra[t * 64 + n * 32 + 16 + f] = sn; }
          else { const int f = r - 32; sincos_rev((float)t * exp2f(-(float)f * (18.931568569324174f / 8.f)), sn, cs); rb[t * 16 + f] = cs; rb[t * 16 + 8 + f] = sn; }
      } }
    bf16* h0b = (bf16*)(K->p.ws + A_H0B); float* st0 = (float*)(K->p.ws + WS_STAT0);
    f32x4 g[4], bb[4];
#pragma unroll
    for (int j = 0; j < 4; ++j) { g[j] = ((const f32x4*)K->p.ln0_g)[F.lane + 64 * j]; bb[j] = ((const f32x4*)K->p.ln0_b)[F.lane + 64 * j]; }
    for (int m = gw; m < MTOK; m += NGW) {
        const GAS f32x4* xr = (const GAS f32x4*)(K->p.x + (size_t)m * DM) + F.lane;
        f32x4 v[4]; float s = 0.f;
#pragma unroll
        for (int j = 0; j < 4; ++j) { v[j] = xr[64 * j]; s += (v[j].x + v[j].y) + (v[j].z + v[j].w); }
        const float mean = wave_sum(s) * (1.f / DM); float s2 = 0.f;
#pragma unroll
        for (int j = 0; j < 4; ++j) { v[j] = v[j] - mean; s2 += (v[j].x * v[j].x + v[j].y * v[j].y) + (v[j].z * v[j].z + v[j].w * v[j].w); }
        const float rstd = 1.f / sqrtf(wave_sum(s2) * (1.f / DM) + LN_EPS);
        GAS unsigned long long* o8 = (GAS unsigned long long*)(h0b + (size_t)m * DM) + F.lane;
#pragma unroll
        for (int j = 0; j < 4; ++j) { const f32x4 y = v[j] * rstd * g[j] + bb[j]; o8[64 * j] = (unsigned long long)pk2(y.x, y.y) | ((unsigned long long)pk2(y.z, y.w) << 32); }
        if (F.lane == 0) { st0[2 * m] = mean; st0[2 * m + 1] = rstd; }
    }
}

__device__ __forceinline__ void p1b_prep(Frame& F, KArgsP K) {
    const int gw = F.vcu * NWAVES + F.wave, NGW = F.G * NWAVES, d = F.lane;
    bf16* qkv = (bf16*)(K->p.ws + A_QKV);
    const float qg = K->p.qn_g[d], kg = K->p.kn_g[d];
    const float invfA = exp2f(-(float)(d & 15) * (13.287712379549449f / 16.f));
    const float invfB = exp2f(-(float)(d & 7) * (18.931568569324174f / 8.f));
    for (int m = gw; m < MTOK; m += NGW) {
        const int t = m & (SEQ - 1);
        const float posA = (d < 32) ? (float)(t >> 6) : (float)(t & 63);
        float snA, csA, snB, csB; sincos_rev(posA * invfA, snA, csA); sincos_rev((float)t * invfB, snB, csB);
        bf16* row = qkv + (size_t)m * QKVW;
#pragma unroll 2
        for (int hh = 0; hh < 10; ++hh) {
            bf16* p = row + (hh < 8 ? OFF_QA + hh * 64 : OFF_KA + (hh - 8) * 64) + d;
            const float x = bf2f(*p); const float ss = wave_sum(x * x);
            const float y = x * (1.0f / sqrtf(ss * (1.f / 64.f) + QK_EPS)) * (hh < 8 ? qg : kg);
            const float yp = __shfl_xor(y, 16);
            float o = (d & 16) ? (y * csA + yp * snA) : (y * csA - yp * snA);
            if (hh < 8) o *= C2;
            *p = (bf16)f2bf(o);
        }
#pragma unroll 2
        for (int hh = 0; hh < 24; ++hh) {
            const bool isq = hh < 12;
            bf16* p = row + (isq ? OFF_QB + hh * 64 : OFF_KB + (hh - 12) * 64) + d;
            const float y = bf2f(*p); const float yp = __shfl_xor(y, 8);
            float o = y;
            if (d < 16) o = (d & 8) ? (y * csB + yp * snB) : (y * csB - yp * snB);
            if (isq) o *= C2;
            if (isq || d < 16) *p = (bf16)f2bf(o);
        }
    }
}

__device__ __forceinline__ void attnA_naive_unit(Frame& F, KArgsP K, int unit) {
    const int b = unit >> 5, h = (unit >> 2) & 7, qc = unit & 3, kvh = h >> 2;
    const bf16* qkv = (const bf16*)(K->p.ws + A_QKV); bf16* attna = (bf16*)(K->p.ws + A_ATTNA);
    const size_t rowq = (size_t)b * SEQ + qc * 512 + F.tid;
    LAS float* Ks = (LAS float*)(F.lds + RING_OFF); LAS float* Vs = Ks + 64 * 64;
    float q[64], o[64];
    { const v4u* qp = (const v4u*)(qkv + rowq * QKVW + OFF_QA + h * 64);
#pragma unroll
      for (int c = 0; c < 8; ++c) { const v4u w = qp[c]; q[8 * c + 0] = pg8::bf_lo(w.x); q[8 * c + 1] = pg8::bf_hi(w.x); q[8 * c + 2] = pg8::bf_lo(w.y); q[8 * c + 3] = pg8::bf_hi(w.y);
          q[8 * c + 4] = pg8::bf_lo(w.z); q[8 * c + 5] = pg8::bf_hi(w.z); q[8 * c + 6] = pg8::bf_lo(w.w); q[8 * c + 7] = pg8::bf_hi(w.w); } }
#pragma unroll
    for (int dd = 0; dd < 64; ++dd) o[dd] = 0.f;
    float mrun = -1e30f, l = 0.f;
    for (int kt = 0; kt < SEQ / 64; ++kt) {
        __syncthreads();
        { const int kr = F.tid >> 3, ch = F.tid & 7; const size_t rk = ((size_t)b * SEQ + kt * 64 + kr) * QKVW;
          const v4u wk = *(const v4u*)(qkv + rk + OFF_KA + kvh * 64 + ch * 8), wv = *(const v4u*)(qkv + rk + OFF_VA + kvh * 64 + ch * 8);
          LAS f32x4* kd = (LAS f32x4*)(Ks + kr * 64 + ch * 8); LAS f32x4* vd = (LAS f32x4*)(Vs + kr * 64 + ch * 8);
          kd[0] = (f32x4){pg8::bf_lo(wk.x), pg8::bf_hi(wk.x), pg8::bf_lo(wk.y), pg8::bf_hi(wk.y)}; kd[1] = (f32x4){pg8::bf_lo(wk.z), pg8::bf_hi(wk.z), pg8::bf_lo(wk.w), pg8::bf_hi(wk.w)};
          vd[0] = (f32x4){pg8::bf_lo(wv.x), pg8::bf_hi(wv.x), pg8::bf_lo(wv.y), pg8::bf_hi(wv.y)}; vd[1] = (f32x4){pg8::bf_lo(wv.z), pg8::bf_hi(wv.z), pg8::bf_lo(wv.w), pg8::bf_hi(wv.w)}; }
        __syncthreads();
        for (int key = 0; key < 64; ++key) {
            const LAS f32x4* kp = (const LAS f32x4*)(Ks + key * 64); const LAS f32x4* vp = (const LAS f32x4*)(Vs + key * 64);
            float s0 = 0.f, s1 = 0.f;
#pragma unroll
            for (int c = 0; c < 16; c += 2) { const f32x4 k0 = kp[c], k1 = kp[c + 1];
                s0 += q[4 * c] * k0.x + q[4 * c + 1] * k0.y + q[4 * c + 2] * k0.z + q[4 * c + 3] * k0.w;
                s1 += q[4 * c + 4] * k1.x + q[4 * c + 5] * k1.y + q[4 * c + 6] * k1.z + q[4 * c + 7] * k1.w; }
            const float s = s0 + s1;
            const float mn = fmaxf(mrun, s); const float a = exp2f(mrun - mn), pw = exp2f(s - mn);
            l = l * a + pw; mrun = mn;
#pragma unroll
            for (int c = 0; c < 16; ++c) { const f32x4 vv = vp[c];
                o[4 * c] = o[4 * c] * a + pw * vv.x; o[4 * c + 1] = o[4 * c + 1] * a + pw * vv.y; o[4 * c + 2] = o[4 * c + 2] * a + pw * vv.z; o[4 * c + 3] = o[4 * c + 3] * a + pw * vv.w; }
        }
    }
    const float rl = 1.0f / l;
    v4u* op = (v4u*)(attna + rowq * 512 + h * 64);
#pragma unroll
    for (int c = 0; c < 8; ++c) { v4u w; w.x = pk2(o[8 * c] * rl, o[8 * c + 1] * rl); w.y = pk2(o[8 * c + 2] * rl, o[8 * c + 3] * rl); w.z = pk2(o[8 * c + 4] * rl, o[8 * c + 5] * rl); w.w = pk2(o[8 * c + 6] * rl, o[8 * c + 7] * rl); op[c] = w; }
}

__device__ __forceinline__ void attnB_naive_unit(Frame& F, KArgsP K, int unit) {
    const int b = unit >> 4, j = (unit >> 2) & 3, qc = unit & 3;
    const bf16* qkv = (const bf16*)(K->p.ws + A_QKV); bf16* ob = (bf16*)(K->p.ws + A_OB);
    const int t = qc * 512 + F.tid; const size_t rowq = (size_t)b * SEQ + t;
    float q[64], o[64];
#pragma unroll
    for (int dd = 0; dd < 64; ++dd) o[dd] = 0.f;
    float mrun = -1e30f, l = 0.f;
    for (int g = 0; g < 3; ++g) {
        const int head = 4 * g + j, dil = (g == 0) ? 1 : (g == 1) ? 4 : 16;
        { const v4u* qp = (const v4u*)(qkv + rowq * QKVW + OFF_QB + head * 64);
#pragma unroll
          for (int c = 0; c < 8; ++c) { const v4u w = qp[c]; q[8 * c + 0] = pg8::bf_lo(w.x); q[8 * c + 1] = pg8::bf_hi(w.x); q[8 * c + 2] = pg8::bf_lo(w.y); q[8 * c + 3] = pg8::bf_hi(w.y);
              q[8 * c + 4] = pg8::bf_lo(w.z); q[8 * c + 5] = pg8::bf_hi(w.z); q[8 * c + 6] = pg8::bf_lo(w.w); q[8 * c + 7] = pg8::bf_hi(w.w); } }
        for (int jj = -64; jj <= 64; ++jj) {
            const int tk = t + jj * dil;
            if (tk < 0 || tk >= SEQ) continue;
            const size_t rk = ((size_t)b * SEQ + tk) * QKVW;
            const v4u* kp = (const v4u*)(qkv + rk + OFF_KB + head * 64); const v4u* vp = (const v4u*)(qkv + rk + OFF_VB + head * 64);
            float s = 0.f;
#pragma unroll
            for (int c = 0; c < 8; ++c) { const v4u w = kp[c];
                s += q[8 * c] * pg8::bf_lo(w.x) + q[8 * c + 1] * pg8::bf_hi(w.x) + q[8 * c + 2] * pg8::bf_lo(w.y) + q[8 * c + 3] * pg8::bf_hi(w.y)
                   + q[8 * c + 4] * pg8::bf_lo(w.z) + q[8 * c + 5] * pg8::bf_hi(w.z) + q[8 * c + 6] * pg8::bf_lo(w.w) + q[8 * c + 7] * pg8::bf_hi(w.w); }
            const float mn = fmaxf(mrun, s); const float a = exp2f(mrun - mn), pw = exp2f(s - mn);
            l = l * a + pw; mrun = mn;
#pragma unroll
            for (int c = 0; c < 8; ++c) { const v4u w = vp[c];
                o[8 * c] = o[8 * c] * a + pw * pg8::bf_lo(w.x); o[8 * c + 1] = o[8 * c + 1] * a + pw * pg8::bf_hi(w.x); o[8 * c + 2] = o[8 * c + 2] * a + pw * pg8::bf_lo(w.y); o[8 * c + 3] = o[8 * c + 3] * a + pw * pg8::bf_hi(w.y);
                o[8 * c + 4] = o[8 * c + 4] * a + pw * pg8::bf_lo(w.z); o[8 * c + 5] = o[8 * c + 5] * a + pw * pg8::bf_hi(w.z); o[8 * c + 6] = o[8 * c + 6] * a + pw * pg8::bf_lo(w.w); o[8 * c + 7] = o[8 * c + 7] * a + pw * pg8::bf_hi(w.w); }
        }
    }
    const float rl = 1.0f / l;
    v4u* op = (v4u*)(ob + rowq * 256 + j * 64);
#pragma unroll
    for (int c = 0; c < 8; ++c) { v4u w; w.x = pk2(o[8 * c] * rl, o[8 * c + 1] * rl); w.y = pk2(o[8 * c + 2] * rl, o[8 * c + 3] * rl); w.z = pk2(o[8 * c + 4] * rl, o[8 * c + 5] * rl); w.w = pk2(o[8 * c + 6] * rl, o[8 * c + 7] * rl); op[c] = w; }
}

__device__ __forceinline__ void p3b_combine(Frame& F, KArgsP K) {
    const bf16* obg = (const bf16*)(K->p.ws + A_OBG); const float* lse = (const float*)(K->p.ws + WS_LSE); bf16* ob = (bf16*)(K->p.ws + A_OB);
    for (int it = F.vcu; it < MTOK / 16; it += F.G) {
        const int m = it * 16 + (F.tid >> 5), ch = F.tid & 31, j = ch >> 3;
        const float l0 = lse[((size_t)0 * MTOK + m) * 4 + j], l1 = lse[((size_t)1 * MTOK + m) * 4 + j], l2 = lse[((size_t)2 * MTOK + m) * 4 + j];
        const float mx = fmaxf(l0, fmaxf(l1, l2)); float w0 = exp2f(l0 - mx), w1 = exp2f(l1 - mx), w2 = exp2f(l2 - mx); const float rs = 1.0f / (w0 + w1 + w2); w0 *= rs; w1 *= rs; w2 *= rs;
        const v4u a = *(const v4u*)(obg + ((size_t)0 * MTOK + m) * 256 + ch * 8), b = *(const v4u*)(obg + ((size_t)1 * MTOK + m) * 256 + ch * 8), c = *(const v4u*)(obg + ((size_t)2 * MTOK + m) * 256 + ch * 8);
        v4u o;
        o.x = pk2(w0 * pg8::bf_lo(a.x) + w1 * pg8::bf_lo(b.x) + w2 * pg8::bf_lo(c.x), w0 * pg8::bf_hi(a.x) + w1 * pg8::bf_hi(b.x) + w2 * pg8::bf_hi(c.x));
        o.y = pk2(w0 * pg8::bf_lo(a.y) + w1 * pg8::bf_lo(b.y) + w2 * pg8::bf_lo(c.y), w0 * pg8::bf_hi(a.y) + w1 * pg8::bf_hi(b.y) + w2 * pg8::bf_hi(c.y));
        o.z = pk2(w0 * pg8::bf_lo(a.z) + w1 * pg8::bf_lo(b.z) + w2 * pg8::bf_lo(c.z), w0 * pg8::bf_hi(a.z) + w1 * pg8::bf_hi(b.z) + w2 * pg8::bf_hi(c.z));
        o.w = pk2(w0 * pg8::bf_lo(a.w) + w1 * pg8::bf_lo(b.w) + w2 * pg8::bf_lo(c.w), w0 * pg8::bf_hi(a.w) + w1 * pg8::bf_hi(b.w) + w2 * pg8::bf_hi(c.w));
        *(v4u*)(ob + (size_t)m * 256 + ch * 8) = o;
    }
}

__device__ __forceinline__ void p5_ln1_router_convert(Frame& F, KArgsP K) {
    const int gw = F.vcu * NWAVES + F.wave, NGW = F.G * NWAVES;
    { LAS float* scr = (LAS float*)(F.lds + RING_OFF + F.wave * 16384);
      bf16* wgu = (bf16*)(K->p.ws + A_WGU); bf16* wd = (bf16*)(K->p.ws + A_WD);
      constexpr int I_G = 16 * 64, I_D = 32 * 32, PER_E = 2 * I_G + I_D;
      for (int it = gw; it < NEXP * PER_E; it += NGW) {
          const int e = it / PER_E; int r = it % PER_E;
          if (r < I_G) { const int nb = r % 64, kb = r / 64, n0 = nb * 32; transpose_item(K->p.w_gate_e + (size_t)e * DM * DFF, DFF, kb * 64, n0, wgu, 1024, RowOff{(size_t)e * 4096 + (n0 >> 7) * 256 + (n0 & 127) - n0}, scr, F.lane); continue; } r -= I_G;
          if (r < I_G) { const int nb = r % 64, kb = r / 64, n0 = nb * 32; transpose_item(K->p.w_up_e + (size_t)e * DM * DFF, DFF, kb * 64, n0, wgu, 1024, RowOff{(size_t)e * 4096 + (n0 >> 7) * 256 + 128 + (n0 & 127) - n0}, scr, F.lane); continue; } r -= I_G;
          { const int nb = r % 32, kb = r / 32, n0 = nb * 32; transpose_item(K->p.w_down_e + (size_t)e * DFF * DM, DM, kb * 64, n0, wd, 2048, RowOff{(size_t)e * 1024}, scr, F.lane); }
      } }
    const bf16* mix = (const bf16*)(K->p.ws + A_MIX); bf16* h1b = (bf16*)(K->p.ws + A_H1B); const float* st0 = (const float*)(K->p.ws + WS_STAT0); float* aff = (float*)(K->p.ws + WS_AFF);
    for (int m = gw; m < MTOK; m += NGW) {
        const float mean0 = st0[2 * m], rstd0 = st0[2 * m + 1];
        const GAS f32x4* xr = (const GAS f32x4*)(K->p.x + (size_t)m * DM) + F.lane;
        const GAS u32x2* mr = (const GAS u32x2*)(mix + (size_t)m * DM) + F.lane;
        f32x4 v[4]; float s = 0.f;
#pragma unroll
        for (int j = 0; j < 4; ++j) { const f32x4 xv = xr[64 * j]; const u32x2 mw = mr[64 * j];
            const f32x4 g0 = ((const f32x4*)K->p.ln0_g)[F.lane + 64 * j], b0 = ((const f32x4*)K->p.ln0_b)[F.lane + 64 * j];
            const f32x4 h0 = (xv - mean0) * rstd0 * g0 + b0;
            v[j] = h0 * ALPHA + (f32x4){pg8::bf_lo(mw.x), pg8::bf_hi(mw.x), pg8::bf_lo(mw.y), pg8::bf_hi(mw.y)};
            s += (v[j].x + v[j].y) + (v[j].z + v[j].w); }
        const float mean = wave_sum(s) * (1.f / DM); float s2 = 0.f;
#pragma unroll
        for (int j = 0; j < 4; ++j) { v[j] = v[j] - mean; s2 += (v[j].x * v[j].x + v[j].y * v[j].y) + (v[j].z * v[j].z + v[j].w * v[j].w); }
        const float rstd = 1.f / sqrtf(wave_sum(s2) * (1.f / DM) + LN_EPS);
        GAS f32x4* o4 = (GAS f32x4*)(K->p.out + (size_t)m * DM) + F.lane;
        GAS unsigned long long* o8 = (GAS unsigned long long*)(h1b + (size_t)m * DM) + F.lane;
        float lg[16];
#pragma unroll
        for (int e = 0; e < 16; ++e) lg[e] = 0.f;
#pragma unroll
        for (int j = 0; j < 4; ++j) { const f32x4 g1 = ((const f32x4*)K->p.ln1_g)[F.lane + 64 * j], b1 = ((const f32x4*)K->p.ln1_b)[F.lane + 64 * j];
            const f32x4 y = v[j] * rstd * g1 + b1; v[j] = y;
            o4[64 * j] = y; o8[64 * j] = (unsigned long long)pk2(y.x, y.y) | ((unsigned long long)pk2(y.z, y.w) << 32);
            const f32x4* wr = (const f32x4*)(K->p.w_router + (size_t)(4 * F.lane + 256 * j) * 16);
#pragma unroll
            for (int i = 0; i < 4; ++i) { const float yv = y[i];
#pragma unroll
                for (int c = 0; c < 4; ++c) { const f32x4 w = wr[i * 4 + c]; lg[4 * c] += yv * w.x; lg[4 * c + 1] += yv * w.y; lg[4 * c + 2] += yv * w.z; lg[4 * c + 3] += yv * w.w; } } }
#pragma unroll
        for (int e = 0; e < 16; ++e) lg[e] = wave_sum(lg[e]);
        float mx = lg[0];
#pragma unroll
        for (int e = 1; e < 16; ++e) mx = fmaxf(mx, lg[e]);
        float se = 0.f;
#pragma unroll
        for (int e = 0; e < 16; ++e) { lg[e] = expf(lg[e] - mx); se += lg[e]; }
        float mine = 0.f;
#pragma unroll
        for (int e = 0; e < 16; ++e) if (F.lane == e) mine = lg[e] / se;
        if (F.lane < 16) aff[(size_t)m * 16 + F.lane] = mine;
    }
}

__device__ __forceinline__ void p6_topk_unit(Frame& F, KArgsP K, int unit) {
    const int e = unit >> 4, b = unit & 15;
    const float* aff = (const float*)(K->p.ws + WS_AFF); short* inv = (short*)(K->p.ws + WS_INV); int* tok = (int*)(K->p.ws + WS_TOK);
    const bf16* h1b = (const bf16*)(K->p.ws + A_H1B); bf16* xe = (bf16*)(K->p.ws + A_XE);
    LAS unsigned* cnt = (LAS unsigned*)(F.lds + RING_OFF);
    LAS int* ltok = (LAS int*)(F.lds + RING_OFF + 256);
    unsigned key[4];
#pragma unroll
    for (int i = 0; i < 4; ++i) key[i] = __float_as_uint(aff[((size_t)b * SEQ + 4 * F.tid + i) * 16 + e]);
    __syncthreads();
    unsigned thr = 0u;
    for (int bit = 31; bit >= 0; --bit) {
        const unsigned cand = thr | (1u << bit);
        unsigned c = 0;
#pragma unroll
        for (int i = 0; i < 4; ++i) c += (unsigned)__popcll(__ballot(key[i] >= cand));
        LAS unsigned* cb = cnt + ((bit & 1) ? 8 : 0);
        if (F.lane == 0) cb[F.wave] = c;
        __syncthreads();
        unsigned tot = 0;
#pragma unroll
        for (int w = 0; w < 8; ++w) tot += cb[w];
        if (tot >= (unsigned)CAP) thr = cand;
    }
    __syncthreads();
    unsigned cg = 0, ce = 0;
#pragma unroll
    for (int i = 0; i < 4; ++i) { cg += key[i] > thr; ce += key[i] == thr; }
    unsigned pk = cg | (ce << 16), inc = pk;
#pragma unroll
    for (int o = 1; o < 64; o <<= 1) { const unsigned up = __shfl_up(inc, o); if (F.lane >= o) inc += up; }
    if (F.lane == 63) cnt[16 + F.wave] = inc;
    __syncthreads();
    unsigned base = 0, total = 0;
#pragma unroll
    for (int w = 0; w < 8; ++w) { const unsigned tw = cnt[16 + w]; if (w < F.wave) base += tw; total += tw; }
    const unsigned excl = base + inc - pk;
    unsigned pg = excl & 0xffffu, pe = excl >> 16; const unsigned ngt = total & 0xffffu; const unsigned need = (unsigned)CAP - ngt;
#pragma unroll
    for (int i = 0; i < 4; ++i) {
        const int t = 4 * F.tid + i; int slot = -1;
        if (key[i] > thr) { slot = (int)(pg + (pe < need ? pe : need)); ++pg; }
        else if (key[i] == thr) { if (pe < need) slot = (int)(pg + pe); ++pe; }
        inv[((size_t)b * SEQ + t) * 16 + e] = (short)slot;
        if (slot >= 0) { ltok[slot] = t; tok[unit * CAP + slot] = t; }
    }
    __syncthreads();
    for (int c = F.wave; c < CAP; c += NWAVES) {
        const v4u* src = (const v4u*)(h1b + ((size_t)b * SEQ + ltok[c]) * DM); v4u* dst = (v4u*)(xe + ((size_t)unit * CAP + c) * DM);
        const v4u a0 = src[F.lane], a1 = src[F.lane + 64]; dst[F.lane] = a0; dst[F.lane + 64] = a1;
    }
    __syncthreads();
}

__device__ __forceinline__ void p9_final(Frame& F, KArgsP K) {
    const int gw = F.vcu * NWAVES + F.wave, NGW = F.G * NWAVES;
    const float* aff = (const float*)(K->p.ws + WS_AFF); const short* inv = (const short*)(K->p.ws + WS_INV); const bf16* ye = (const bf16*)(K->p.ws + A_YE);
    for (int m = gw; m < MTOK; m += NGW) {
        const int b = m >> 11;
        GAS f32x4* o4 = (GAS f32x4*)(K->p.out + (size_t)m * DM) + F.lane;
        f32x4 v[4];
#pragma unroll
        for (int j = 0; j < 4; ++j) v[j] = o4[64 * j] * ALPHA;
        for (int e = 0; e < NEXP; ++e) {
            const int p = __builtin_amdgcn_readfirstlane((int)inv[(size_t)m * 16 + e]);
            if (p < 0) continue;
            const float gt = aff[(size_t)m * 16 + e];
            const GAS u32x2* yr = (const GAS u32x2*)(ye + ((size_t)(e * 16 + b) * CAP + p) * DM) + F.lane;
#pragma unroll
            for (int j = 0; j < 4; ++j) { const u32x2 w = yr[64 * j]; v[j] += (f32x4){pg8::bf_lo(w.x), pg8::bf_hi(w.x), pg8::bf_lo(w.y), pg8::bf_hi(w.y)} * gt; }
        }
        float s = 0.f;
#pragma unroll
        for (int j = 0; j < 4; ++j) s += (v[j].x + v[j].y) + (v[j].z + v[j].w);
        const float mean = wave_sum(s) * (1.f / DM); float s2 = 0.f;
#pragma unroll
        for (int j = 0; j < 4; ++j) { v[j] = v[j] - mean; s2 += (v[j].x * v[j].x + v[j].y * v[j].y) + (v[j].z * v[j].z + v[j].w * v[j].w); }
        const float rstd = 1.f / sqrtf(wave_sum(s2) * (1.f / DM) + LN_EPS);
#pragma unroll
        for (int j = 0; j < 4; ++j) { const f32x4 g2 = ((const f32x4*)K->p.ln2_g)[F.lane + 64 * j], b2 = ((const f32x4*)K->p.ln2_b)[F.lane + 64 * j]; o4[64 * j] = v[j] * rstd * g2 + b2; }
    }
}

struct OrderUp {
    int hf, vcu;
    __device__ __forceinline__ bool next(int i, pg8::Unit& u) const {
        if (i >= 8) return false;
        const int e = hf * 8 + i, x = vcu >> 5, l = vcu & 31, b = (x >> 1) * 4 + (l & 3), j = (x & 1) * 8 + (l >> 2);
        u.pm = i * 16 + b; u.pn = j; u.am = e * 16 + b; u.bt = e * 16 + j; return true;
    }
    __device__ __forceinline__ void a_ready(const pg8::Unit&) const {}
    __device__ __forceinline__ void done(const pg8::Unit&) const {}
};
struct OrderDown {
    int hf, vcu;
    __device__ __forceinline__ bool next(int i, pg8::Unit& u) const {
        if (i >= 2) return false;
        const int x = vcu >> 5, l = vcu & 31, pml = i * 64 + x * 8 + (l & 7), pn = l >> 3, pmg = hf * 128 + pml;
        u.pm = pmg; u.pn = pn; u.am = pml; u.bt = (pmg >> 4) * 4 + pn; return true;
    }
    __device__ __forceinline__ void a_ready(const pg8::Unit&) const {}
    __device__ __forceinline__ void done(const pg8::Unit&) const {}
};

#ifndef MK_N_LAUNCHES
#define MK_N_LAUNCHES 1
#endif
constexpr int N_PHASES = 13;
__global__ void __launch_bounds__(NWAVES * 64, 2) fwd_kernel(Args args) {
    extern __shared__ __attribute__((aligned(16))) unsigned char lds[];
#define MKFRAME(F) Frame F; { int t_ = threadIdx.x; asm volatile("" : "+v"(t_)); F.lds = (LAS unsigned char*)lds; F.MISC = (volatile LAS unsigned*)(F.lds + MISC_OFF); F.ctl = nullptr; \
        F.tid = t_; F.lane = t_ & 63; F.wave = __builtin_amdgcn_readfirstlane(t_ >> 6); F.G = 256; const int bx_ = blockIdx.x; F.vcu = (bx_ & 7) * 32 + (bx_ >> 3); }
#define BP(off) ((bf16*)(kargs()->p.ws + (off)))
#define SEAM() do { XcdBarrier b_; b_.bar = (unsigned*)(kargs()->p.ws + WS_CTL) + CW_BAR; b_.x = xb_xcc_id(); b_.st = (volatile LAS unsigned*)((LAS unsigned char*)lds + MISC_OFF) + 8; xcd_barrier(b_); } while (0)
    { const int t_ = threadIdx.x;
      for (int u = t_; u < (LDS_BYTES - LDSCTL_OFF) / 4; u += NWAVES * 64) ((LAS unsigned*)((LAS unsigned char*)lds + LDSCTL_OFF))[u] = 0u;
      __syncthreads();
      (void)xcd_barrier_post((unsigned*)(kargs()->p.ws + WS_CTL) + CW_BAR, (volatile LAS unsigned*)((LAS unsigned char*)lds + MISC_OFF) + 8); }

    { MKFRAME(F); p0_prologue(F, kargs()); } SEAM();
    { MKFRAME(F);
      pg8::Gemm g{BP(A_H0B), (const bf16*)(kargs()->p.ws + WS_WIN), MTOK, 5120, 1024}; pg8::StaticOrder S; S.init(MTOK, 5120, 256, (int)blockIdx.x);
      pg8::EpiProj2 E{BP(A_QKV), BP(A_GATES), kargs()->p.b_gate, kargs()->p.qn_g, kargs()->p.kn_g, (const float*)(kargs()->p.ws + WS_ROPEA), (const float*)(kargs()->p.ws + WS_ROPEB)};
      pg8::gemm_phase<pg8::EpiProj2, pg8::StaticOrder, true, true>(F.lds + RING_OFF, g, S, E); } SEAM();
    { MKFRAME(F);
#if defined(NAIVE_ATTN_A)
      attnA_naive_unit(F, kargs(), F.vcu); attnA_naive_unit(F, kargs(), F.vcu + 256);
#else
      { const attn_body::bf16* q_ = (const attn_body::bf16*)BP(A_QKV); attn_body::bf16* o_ = (attn_body::bf16*)BP(A_ATTNA);
        const int g = F.vcu >> 3, s = F.vcu & 7, ab = g >> 1, akvh = g & 1;
#pragma unroll 1
        for (int i = 0; i < 4; ++i) attn_body::attn_unit<8>(ab, akvh * 4 + i, akvh, s, q_ + OFF_QA, q_ + OFF_KA, q_ + OFF_VA, o_, (char*)lds + RING_OFF); }
      __syncthreads();
#endif
    }
#if defined(NAIVE_ATTN_B)
    { MKFRAME(F); attnB_naive_unit(F, kargs(), F.vcu); } SEAM();
#else
    { MKFRAME(F);
#pragma unroll 1
      for (int i = 0; i < 6; ++i) attn_body::band_half_unit(F.vcu + 256 * i, (const attn_body::bf16*)BP(A_QKV), OFF_QB, OFF_KB, OFF_VB, (attn_body::bf16*)BP(A_OBG), (float*)(kargs()->p.ws + WS_LSE), (char*)lds + RING_OFF);
      __syncthreads(); } SEAM();
    { MKFRAME(F); p3b_combine(F, kargs()); }
#endif
    { MKFRAME(F);
      { pg8::Gemm g{BP(A_ATTNA), (const bf16*)(kargs()->p.ws + WS_WA), MTOK, 1024, 512}; pg8::StaticOrder S; S.init(MTOK, 1024, 256, (int)blockIdx.x);
        pg8::EpiGate<false> E{BP(A_MERGED), BP(A_GATES), 0};
        pg8::gemm_phase<pg8::EpiGate<false>, pg8::StaticOrder, true, true>(F.lds + RING_OFF, g, S, E); }
      asm volatile("s_waitcnt vmcnt(0)" ::: "memory"); __syncthreads(); }
#if !defined(NAIVE_ATTN_B)
    SEAM();
#endif
    { MKFRAME(F);
      { pg8::Gemm g{BP(A_OB), (const bf16*)(kargs()->p.ws + WS_WB), MTOK, 1024, 256}; pg8::StaticOrder S; S.init(MTOK, 1024, 256, (int)blockIdx.x);
        pg8::EpiGate<true> E{BP(A_MERGED), BP(A_GATES), 1024};
        pg8::gemm_phase<pg8::EpiGate<true>, pg8::StaticOrder, true, true>(F.lds + RING_OFF, g, S, E); } } SEAM();
    { MKFRAME(F);
      pg8::Gemm g{BP(A_MERGED), (const bf16*)(kargs()->p.ws + WS_WO), MTOK, 1024, 1024}; pg8::StaticOrder S; S.init(MTOK, 1024, 256, (int)blockIdx.x);
      pg8::EpiPlain E{BP(A_MIX), 1024};
      pg8::gemm_phase<pg8::EpiPlain, pg8::StaticOrder, true, true>(F.lds + RING_OFF, g, S, E); } SEAM();
    { MKFRAME(F); p5_ln1_router_convert(F, kargs()); } SEAM();
    { MKFRAME(F); p6_topk_unit(F, kargs(), F.vcu); } SEAM();
    { MKFRAME(F); pg8::Gemm g{BP(A_XE), (const bf16*)(kargs()->p.ws + A_WGU), 0, 0, 1024}; OrderUp S{0, F.vcu}; pg8::EpiSwiglu E{BP(A_ACT)};
      pg8::gemm_phase<pg8::EpiSwiglu, OrderUp, true, true>(F.lds + RING_OFF, g, S, E); } SEAM();
    { MKFRAME(F); pg8::Gemm g{BP(A_ACT), (const bf16*)(kargs()->p.ws + A_WD), 0, 0, 2048}; OrderDown S{0, F.vcu}; pg8::EpiPlain E{BP(A_YE), 1024};
      pg8::gemm_phase<pg8::EpiPlain, OrderDown, true, true>(F.lds + RING_OFF, g, S, E); } SEAM();
    { MKFRAME(F); pg8::Gemm g{BP(A_XE), (const bf16*)(kargs()->p.ws + A_WGU), 0, 0, 1024}; OrderUp S{1, F.vcu}; pg8::EpiSwiglu E{BP(A_ACT)};
      pg8::gemm_phase<pg8::EpiSwiglu, OrderUp, true, true>(F.lds + RING_OFF, g, S, E); } SEAM();
    { MKFRAME(F); pg8::Gemm g{BP(A_ACT), (const bf16*)(kargs()->p.ws + A_WD), 0, 0, 2048}; OrderDown S{1, F.vcu}; pg8::EpiPlain E{BP(A_YE), 1024};
      pg8::gemm_phase<pg8::EpiPlain, OrderDown, true, true>(F.lds + RING_OFF, g, S, E); } SEAM();
    { MKFRAME(F); p9_final(F, kargs()); }
#undef MKFRAME
#undef BP
#undef SEAM
}

extern "C" void kernel_launch(void* const* d_in, const int* in_sizes, int n_in, void* d_out, int out_size, void* d_ws, size_t ws_size, hipStream_t stream) {
    static int grid = 0;
    if (grid == 0) {
        if (n_in != 18 || in_sizes[0] != MTOK * DM || out_size != MTOK * DM || ws_size < WS_END) { fprintf(stderr, "kernel_launch: unexpected shapes / workspace (n_in %d, ws %zu, need %zu)\n", n_in, ws_size, (size_t)WS_END); grid = -1; return; }
        if (hipFuncSetAttribute((const void*)fwd_kernel, hipFuncAttributeMaxDynamicSharedMemorySize, LDS_BYTES) != hipSuccess) { fprintf(stderr, "kernel_launch: hipFuncSetAttribute failed\n"); grid = -1; return; }
        (void)hipGetLastError();
        grid = 256;
    }
    if (grid < 0) return;
    if (hipMemsetAsync((char*)d_ws + WS_CTL, 0, CTL_ZERO_BYTES, stream) != hipSuccess) return;
    Args a{};
    const float** pp = (const float**)&a.p;
    for (int i = 0; i < 18; ++i) pp[i] = (const float*)d_in[i];
    a.p.out = (float*)d_out; a.p.ws = (unsigned char*)d_ws;
    a.ph_lo = 0; a.ph_hi = N_PHASES; a.li = 0;
    hipLaunchKernelGGL(fwd_kernel, dim3(grid), dim3(NWAVES * 64), LDS_BYTES, stream, a);
}
```

```cpp
#include <hip/hip_runtime.h>
#include <cstdio>
#include <cstdint>
constexpr int NWAVES = 8;
constexpr int BATCH = 16, SEQ = 2048, DM = 1024, MTOK = BATCH * SEQ;
constexpr int NEXP = 16, CAP = 256, DFF = 2048, NSLOT = BATCH * NEXP * CAP;
constexpr int QKVW = 3072, GATEW = 2048;
constexpr int OFF_QA = 0, OFF_KA = 512, OFF_VA = 640, OFF_QB = 768, OFF_KB = 1536, OFF_VB = 2304;
constexpr float LN_EPS = 1e-5f, QK_EPS = 1e-6f;
constexpr float ALPHA = 1.189207115002721f;
constexpr float C2 = 0.125f * 1.4426950408889634f;

namespace pg8 {
#define PG8_LAS __attribute__((address_space(3)))
typedef unsigned short bf16_t;
typedef short bf16x8 __attribute__((ext_vector_type(8)));
typedef float f32x4 __attribute__((ext_vector_type(4)));
typedef unsigned u32x4 __attribute__((ext_vector_type(4)));
constexpr int BM = 256, BK = 64, HALF = 128, HTB = HALF * BK * 2  , STAGE_BYTES = 8 * HTB, NXCD = 8, WGM = 8;

__host__ __device__ __forceinline__ int lds_byte(int r, int c) { const int st = (r >> 4) * 2 + (c >> 5), rr = r & 15, cc = c & 31, ob = rr * 64 + cc * 2; return st * 1024 + (ob ^ (((ob >> 9) & 1) << 5)); }
__host__ __device__ __forceinline__ void stage_rc(int b, int& R, int& C) { const int st = b / 1024, sb = b % 1024, swz = sb ^ (((sb >> 9) & 1) << 5); R = (st >> 1) * 16 + swz / 64; C = (st & 1) * 32 + (swz % 64) / 2; }
__host__ __device__ __forceinline__ int perm32(int rho) { const int n = rho >> 4, i = rho & 15; return 8 * (i >> 2) + 4 * n + (i & 3); }

struct Unit { int pm, pn, am, bt; };
struct Gemm { const bf16_t* A; const bf16_t* Bt; int M, N, K; };

struct StaticOrder {
    int nM, nN, nwg, G, c;
    __host__ __device__ void init(int M, int N, int G_, int c_) { nM = M / BM; nN = N / BM; nwg = nM * nN; G = G_; c = c_; }
    __host__ __device__ bool next(int i, Unit& u) const {
        const long L = (long)i * G + c; if (L >= nwg) return false;
        int wgid = (int)L; { const int q = nwg / NXCD, r = nwg % NXCD, xcd = wgid % NXCD, off = wgid / NXCD; wgid = (xcd < r ? xcd * (q + 1) : r * (q + 1) + (xcd - r) * q) + off; }
        const int nig = WGM * nN, gid = wgid / nig, fm = gid * WGM, gsz = (nM - fm) < WGM ? (nM - fm) : WGM;
        u.pm = fm + ((wgid % nig) % gsz); u.pn = (wgid % nig) / gsz; u.am = u.pm; u.bt = u.pn; return true;
    }
    __device__ __forceinline__ void a_ready(const Unit&) const {}
    __device__ __forceinline__ void done(const Unit&) const {}
};

__device__ __forceinline__ unsigned cvt_pk_bf16(float lo, float hi) { unsigned r; asm volatile("v_cvt_pk_bf16_f32 %0, %1, %2" : "=v"(r) : "v"(lo), "v"(hi)); return r; }
__device__ __forceinline__ float bf_lo(unsigned w) { return __uint_as_float(w << 16); }
__device__ __forceinline__ float bf_hi(unsigned w) { return __uint_as_float(w & 0xffff0000u); }
__device__ __forceinline__ float sigmoidf_(float x) { return 1.0f / (1.0f + __expf(-x)); }
__device__ __forceinline__ u32x4 pack8(const f32x4 v0, const f32x4 v1) { u32x4 w; w.x = cvt_pk_bf16(v0[0], v0[1]); w.y = cvt_pk_bf16(v0[2], v0[3]); w.z = cvt_pk_bf16(v1[0], v1[1]); w.w = cvt_pk_bf16(v1[2], v1[3]); return w; }

struct EpiProj {
    static constexpr bool PERM = true, AFTER_DRAIN = false;
    bf16_t* qkv; bf16_t* gates; const float* b_gate;
    __device__ __forceinline__ void operator()(const f32x4 (&acc)[2][2][4][2], const Unit& u, int wr, int wc, int fr, int fq) const {
        const int row0 = u.pm * BM + wr * 64 + fr;
        const bool isg = u.pn >= 12;
        bf16_t* base = isg ? gates : qkv; const int ldc = isg ? 2048 : 3072; const int colt = isg ? (u.pn - 12) * BM : u.pn * BM;
        const int col0 = colt + wc * 32 + 8 * fq;
        f32x4 bv[2][2];
#pragma unroll
        for (int bj = 0; bj < 2; ++bj)
#pragma unroll
            for (int n = 0; n < 2; ++n) bv[bj][n] = isg ? *(const f32x4*)(b_gate + col0 + bj * HALF + 4 * n) : (f32x4){0.f, 0.f, 0.f, 0.f};
#pragma unroll
        for (int ai = 0; ai < 2; ++ai)
#pragma unroll
            for (int m = 0; m < 4; ++m) { bf16_t* rowp = base + (size_t)(row0 + ai * HALF + m * 16) * ldc + col0;
#pragma unroll
                for (int bj = 0; bj < 2; ++bj) { f32x4 v0 = acc[ai][bj][m][0] + bv[bj][0], v1 = acc[ai][bj][m][1] + bv[bj][1];
                    if (isg) {
#pragma unroll
                        for (int i = 0; i < 4; ++i) { v0[i] = sigmoidf_(v0[i]); v1[i] = sigmoidf_(v1[i]); } }
                    *(u32x4*)(rowp + bj * HALF) = pack8(v0, v1); } }
    }
};
struct EpiPlain {
    static constexpr bool PERM = true, AFTER_DRAIN = false;
    bf16_t* O; int ldc;
    __device__ __forceinline__ void operator()(const f32x4 (&acc)[2][2][4][2], const Unit& u, int wr, int wc, int fr, int fq) const {
        const int row0 = u.pm * BM + wr * 64 + fr; const int col0 = u.pn * BM + wc * 32 + 8 * fq;
#pragma unroll
        for (int ai = 0; ai < 2; ++ai)
#pragma unroll
            for (int m = 0; m < 4; ++m) { bf16_t* rowp = O + (size_t)(row0 + ai * HALF + m * 16) * ldc + col0;
#pragma unroll
                for (int bj = 0; bj < 2; ++bj) *(u32x4*)(rowp + bj * HALF) = pack8(acc[ai][bj][m][0], acc[ai][bj][m][1]); }
    }
};
template <bool ACCUM> struct EpiGate {
    static constexpr bool PERM = true, AFTER_DRAIN = false;
    bf16_t* merged; const bf16_t* gates; int goff;
    __device__ __forceinline__ void operator()(const f32x4 (&acc)[2][2][4][2], const Unit& u, int wr, int wc, int fr, int fq) const {
        const int row0 = u.pm * BM + wr * 64 + fr; const int col0 = u.pn * BM + wc * 32 + 8 * fq;
#pragma unroll
        for (int ai = 0; ai < 2; ++ai)
#pragma unroll
            for (int m = 0; m < 4; ++m) { const size_t r = (size_t)(row0 + ai * HALF + m * 16);
#pragma unroll
                for (int bj = 0; bj < 2; ++bj) {
                    const u32x4 g = *(const u32x4*)(gates + r * 2048 + goff + col0 + bj * HALF);
                    f32x4 v0 = acc[ai][bj][m][0], v1 = acc[ai][bj][m][1];
                    v0[0] *= bf_lo(g.x); v0[1] *= bf_hi(g.x); v0[2] *= bf_lo(g.y); v0[3] *= bf_hi(g.y);
                    v1[0] *= bf_lo(g.z); v1[1] *= bf_hi(g.z); v1[2] *= bf_lo(g.w); v1[3] *= bf_hi(g.w);
                    bf16_t* p = merged + r * 1024 + col0 + bj * HALF;
                    if (ACCUM) { const u32x4 o = *(const u32x4*)p;
                        v0[0] += bf_lo(o.x); v0[1] += bf_hi(o.x); v0[2] += bf_lo(o.y); v0[3] += bf_hi(o.y);
                        v1[0] += bf_lo(o.z); v1[1] += bf_hi(o.z); v1[2] += bf_lo(o.w); v1[3] += bf_hi(o.w); }
                    *(u32x4*)p = pack8(v0, v1); } }
    }
};
struct EpiSwiglu {
    static constexpr bool PERM = true, AFTER_DRAIN = false;
    bf16_t* act;
    __device__ __forceinline__ void operator()(const f32x4 (&acc)[2][2][4][2], const Unit& u, int wr, int wc, int fr, int fq) const {
        const int row0 = u.pm * BM + wr * 64 + fr; const int col0 = u.pn * HALF + wc * 32 + 8 * fq;
#pragma unroll
        for (int ai = 0; ai < 2; ++ai)
#pragma unroll
            for (int m = 0; m < 4; ++m) {
                f32x4 v0, v1;
#pragma unroll
                for (int i = 0; i < 4; ++i) { const float g0 = acc[ai][0][m][0][i], g1 = acc[ai][0][m][1][i];
                    v0[i] = g0 * sigmoidf_(g0) * acc[ai][1][m][0][i]; v1[i] = g1 * sigmoidf_(g1) * acc[ai][1][m][1][i]; }
                *(u32x4*)(act + (size_t)(row0 + ai * HALF + m * 16) * 2048 + col0) = pack8(v0, v1); }
    }
};

struct EpiProj2 {
    static constexpr bool PERM = true, AFTER_DRAIN = false;
    bf16_t* qkv; bf16_t* gates; const float* b_gate; const float* qn_g; const float* kn_g; const float* ropeA; const float* ropeB;
    typedef unsigned u32x2_t __attribute__((ext_vector_type(2)));
    __device__ __forceinline__ void operator()(const f32x4 (&acc)[2][2][4][2], const Unit& u, int wr, int wc, int fr, int fq) const {
        const int row0 = u.pm * BM + wr * 64 + fr;
        if (u.pn >= 12) {
            const int col0 = (u.pn - 12) * BM + wc * 32 + 8 * fq;
            f32x4 bv[2][2];
#pragma unroll
            for (int bj = 0; bj < 2; ++bj)
#pragma unroll
                for (int n = 0; n < 2; ++n) bv[bj][n] = *(const f32x4*)(b_gate + col0 + bj * HALF + 4 * n);
#pragma unroll
            for (int ai = 0; ai < 2; ++ai)
#pragma unroll
                for (int m = 0; m < 4; ++m) { bf16_t* rowp = gates + (size_t)(row0 + ai * HALF + m * 16) * 2048 + col0;
#pragma unroll
                    for (int bj = 0; bj < 2; ++bj) { f32x4 v0 = acc[ai][bj][m][0] + bv[bj][0], v1 = acc[ai][bj][m][1] + bv[bj][1];
#pragma unroll
                        for (int i = 0; i < 4; ++i) { v0[i] = sigmoidf_(v0[i]); v1[i] = sigmoidf_(v1[i]); }
                        *(u32x4*)(rowp + bj * HALF) = pack8(v0, v1); } }
            return;
        }
        int kind, colbase;
        if (u.pn < 2) { kind = 0; colbase = OFF_QA + (4 * u.pn + wc) * 64; }
        else if (u.pn == 2) { if (wc < 2) { kind = 1; colbase = OFF_KA + wc * 64; } else { kind = 2; colbase = OFF_VA + (wc - 2) * 64; } }
        else if (u.pn < 6) { kind = 3; colbase = OFF_QB + (4 * (u.pn - 3) + wc) * 64; }
        else if (u.pn < 9) { kind = 4; colbase = OFF_KB + (4 * (u.pn - 6) + wc) * 64; }
        else { kind = 2; colbase = OFF_VB + (4 * (u.pn - 9) + wc) * 64; }
        if (kind <= 1) {
            const float* gn = kind == 0 ? qn_g : kn_g; const float sc = kind == 0 ? C2 : 1.0f;
            f32x4 g[2][2];
#pragma unroll
            for (int bj = 0; bj < 2; ++bj)
#pragma unroll
                for (int n = 0; n < 2; ++n) g[bj][n] = *(const f32x4*)(gn + 32 * n + 16 * bj + 4 * fq) * sc;
#pragma unroll
            for (int ai = 0; ai < 2; ++ai)
#pragma unroll
                for (int m = 0; m < 4; ++m) { const int row = row0 + ai * HALF + m * 16; const float* ta = ropeA + (size_t)(row & (SEQ - 1)) * 64 + 4 * fq;
                    float ss = 0.f;
#pragma unroll
                    for (int bj = 0; bj < 2; ++bj)
#pragma unroll
                        for (int n = 0; n < 2; ++n) { const f32x4 x = acc[ai][bj][m][n]; ss += (x[0] * x[0] + x[1] * x[1]) + (x[2] * x[2] + x[3] * x[3]); }
                    ss += __shfl_xor(ss, 16); ss += __shfl_xor(ss, 32);
                    const float rs = 1.0f / sqrtf(ss * (1.0f / 64.0f) + QK_EPS);
                    bf16_t* rowp = qkv + (size_t)row * QKVW + colbase + 4 * fq;
#pragma unroll
                    for (int n = 0; n < 2; ++n) { const f32x4 cs = *(const f32x4*)(ta + n * 32), sn = *(const f32x4*)(ta + n * 32 + 16);
                        const f32x4 x1 = acc[ai][0][m][n] * rs * g[0][n], x2 = acc[ai][1][m][n] * rs * g[1][n];
                        const f32x4 o1 = x1 * cs - x2 * sn, o2 = x2 * cs + x1 * sn;
                        u32x2_t w1, w2; w1.x = cvt_pk_bf16(o1[0], o1[1]); w1.y = cvt_pk_bf16(o1[2], o1[3]); w2.x = cvt_pk_bf16(o2[0], o2[1]); w2.y = cvt_pk_bf16(o2[2], o2[3]);
                        *(u32x2_t*)(rowp + 32 * n) = w1; *(u32x2_t*)(rowp + 32 * n + 16) = w2; } }
        } else if (kind == 2) {
#pragma unroll
            for (int ai = 0; ai < 2; ++ai)
#pragma unroll
                for (int m = 0; m < 4; ++m) { bf16_t* rowp = qkv + (size_t)(row0 + ai * HALF + m * 16) * QKVW + colbase + 8 * fq;
#pragma unroll
                    for (int bj = 0; bj < 2; ++bj) *(u32x4*)(rowp + 32 * bj) = pack8(acc[ai][bj][m][0], acc[ai][bj][m][1]); }
        } else {
            const float sc = kind == 3 ? C2 : 1.0f;
#pragma unroll
            for (int ai = 0; ai < 2; ++ai)
#pragma unroll
                for (int m = 0; m < 4; ++m) { const int row = row0 + ai * HALF + m * 16; const float* tb = ropeB + (size_t)(row & (SEQ - 1)) * 16;
                    f32x4 a0 = acc[ai][0][m][0], a1 = acc[ai][0][m][1], b0 = acc[ai][1][m][0], b1 = acc[ai][1][m][1];
                    if (fq == 0) { const f32x4 c0 = *(const f32x4*)(tb), c1 = *(const f32x4*)(tb + 4), s0 = *(const f32x4*)(tb + 8), s1 = *(const f32x4*)(tb + 12);
                        const f32x4 o0 = a0 * c0 - b0 * s0, p0 = b0 * c0 + a0 * s0, o1 = a1 * c1 - b1 * s1, p1 = b1 * c1 + a1 * s1; a0 = o0; b0 = p0; a1 = o1; b1 = p1; }
                    a0 = a0 * sc; a1 = a1 * sc; b0 = b0 * sc; b1 = b1 * sc;
                    bf16_t* rowp = qkv + (size_t)row * QKVW + colbase + 16 * fq;
                    *(u32x4*)(rowp) = pack8(a0, a1); *(u32x4*)(rowp + 8) = pack8(b0, b1); }
        }
    }
};
template <class Epi, class Sched, bool ALIGN_EPI = false, bool SP2 = false>
__device__ __forceinline__ void gemm_phase(PG8_LAS unsigned char* lds, const Gemm g, const Sched& S, const Epi& E) {
    int tid_ = threadIdx.x; asm volatile("" : "+v"(tid_));
    const int tid = tid_, wid = __builtin_amdgcn_readfirstlane(tid >> 6), lane = tid & 63, wr = wid >> 2, wc = wid & 3, fr = lane & 15, fq = lane >> 4;
    const int K = g.K, nt = K / BK;
    unsigned voffA[2], voffB[2];
#pragma unroll
    for (int i = 0; i < 2; ++i) { int R, C; stage_rc(tid * 16 + i * 8192, R, C); const int Rb = Epi::PERM ? ((R & ~31) + perm32(R & 31)) : R;
        voffA[i] = (unsigned)(R * K + C) * 2u; voffB[i] = (unsigned)(Rb * K + C) * 2u; }
    const size_t kstep = (size_t)(BK * 2);
    const size_t hstep = (size_t)HALF * K * 2;
    const size_t tstep = 2 * hstep;
    const unsigned ldsw = (unsigned)wid * 1024u;
    const int aoff = lds_byte(wr * 64 + fr, fq * 8), boff = lds_byte(wc * 32 + fr, fq * 8);
#define PG8_SA(b, h) (((b) * 2 + (h)) * HTB)
#define PG8_SB(b, h) ((4 + (b) * 2 + (h)) * HTB)
#define PG8_STAGE(bufoff, gbase, voff) do { _Pragma("unroll") for (int _i = 0; _i < 2; ++_i) \
        __builtin_amdgcn_global_load_lds((const unsigned*)((const char*)(gbase) + (voff)[_i]), (PG8_LAS unsigned*)(lds + (bufoff) + ldsw + _i * 8192), 16, 0, 0); } while (0)
#define PG8_LDA(dst, b, h) do { _Pragma("unroll") for (int m = 0; m < 4; ++m) _Pragma("unroll") for (int k = 0; k < 2; ++k) dst[m][k] = *(const PG8_LAS bf16x8*)(lds + PG8_SA(b, h) + aoff + m * 2048 + k * 1024); } while (0)
#define PG8_LDB(dst, b, h) do { _Pragma("unroll") for (int n = 0; n < 2; ++n) _Pragma("unroll") for (int k = 0; k < 2; ++k) dst[n][k] = *(const PG8_LAS bf16x8*)(lds + PG8_SB(b, h) + boff + n * 2048 + k * 1024); } while (0)
#define PG8_MMA(ai, bj, At, Bt) do { __builtin_amdgcn_s_setprio(1); _Pragma("unroll") for (int m = 0; m < 4; ++m) _Pragma("unroll") for (int n = 0; n < 2; ++n) _Pragma("unroll") for (int k = 0; k < 2; ++k) \
        acc[ai][bj][m][n] = __builtin_amdgcn_mfma_f32_16x16x32_bf16(Bt[n][k], At[m][k], acc[ai][bj][m][n], 0, 0, 0); __builtin_amdgcn_s_setprio(0); } while (0)
#define PG8_WAIT_V(n) asm volatile("s_waitcnt vmcnt(" #n ")" ::: "memory")
#define PG8_WAIT_L(n) asm volatile("s_waitcnt lgkmcnt(" #n ")" ::: "memory")
#define PG8_BAR __builtin_amdgcn_s_barrier()
#define PG8_SCHED __builtin_amdgcn_sched_barrier(0)
    Unit cur, nxt; int ui = 0;
    if (!S.next(0, cur)) return;
    f32x4 acc[2][2][4][2];
#pragma unroll
    for (int a = 0; a < 2; ++a)
#pragma unroll
        for (int b = 0; b < 2; ++b)
#pragma unroll
            for (int m = 0; m < 4; ++m)
#pragma unroll
                for (int n = 0; n < 2; ++n) acc[a][b][m][n] = (f32x4){0.f, 0.f, 0.f, 0.f};
    bf16x8 At[4][2], B0[2][2], B1[2][2];
    const char* cA = (const char*)g.A + (size_t)cur.am * tstep; const char* cB = (const char*)g.Bt + (size_t)cur.bt * tstep;
    S.a_ready(cur);
    if constexpr (SP2) {
        PG8_STAGE(PG8_SB(0, 0), cB, voffB); PG8_STAGE(PG8_SB(0, 1), cB + hstep, voffB); PG8_STAGE(PG8_SA(0, 0), cA, voffA); PG8_STAGE(PG8_SA(0, 1), cA + hstep, voffA);
        if (wr == 1) PG8_BAR;
        PG8_WAIT_V(2); PG8_BAR;
        PG8_STAGE(PG8_SB(1, 0), cB + kstep, voffB); PG8_STAGE(PG8_SA(1, 0), cA + kstep, voffA); PG8_STAGE(PG8_SB(1, 1), cB + hstep + kstep, voffB);
        PG8_WAIT_V(6); PG8_BAR;
    } else {
        PG8_STAGE(PG8_SB(0, 0), cB, voffB); PG8_STAGE(PG8_SA(0, 0), cA, voffA); PG8_STAGE(PG8_SB(0, 1), cB + hstep, voffB); PG8_STAGE(PG8_SA(0, 1), cA + hstep, voffA);
        if (wr == 1) PG8_BAR;
        PG8_WAIT_V(4); PG8_BAR;
        PG8_STAGE(PG8_SB(1, 0), cB + kstep, voffB); PG8_STAGE(PG8_SA(1, 0), cA + kstep, voffA); PG8_STAGE(PG8_SB(1, 1), cB + hstep + kstep, voffB);
        PG8_WAIT_V(6); PG8_BAR;
    }
    for (;;) {
        const bool has_next = S.next(ui + 1, nxt);
        const char* nA = has_next ? (const char*)g.A + (size_t)nxt.am * tstep : cA; const char* nB = has_next ? (const char*)g.Bt + (size_t)nxt.bt * tstep : cB;
        for (int t = 0; t < nt; t += 2) {
            const bool last = (t == nt - 2);
            const char* a1 = cA + (size_t)(t + 1) * kstep;
            const char* a2 = last ? nA : cA + (size_t)(t + 2) * kstep; const char* b2 = last ? nB : cB + (size_t)(t + 2) * kstep;
            const char* a3 = a2 + kstep; const char* b3 = b2 + kstep;
            if (last && has_next) S.a_ready(nxt);
            if constexpr (SP2) {
            PG8_LDB(B0, 0, 0); PG8_LDB(B1, 0, 1); PG8_SCHED; PG8_LDA(At, 0, 0); PG8_STAGE(PG8_SA(1, 1), a1 + hstep, voffA);
            PG8_WAIT_V(8); PG8_WAIT_L(0); PG8_BAR; PG8_MMA(0, 0, At, B0); PG8_MMA(0, 1, At, B1); PG8_BAR; PG8_SCHED;
            PG8_LDA(At, 0, 1); PG8_STAGE(PG8_SB(0, 0), b2, voffB); PG8_STAGE(PG8_SB(0, 1), b2 + hstep, voffB); PG8_STAGE(PG8_SA(0, 0), a2, voffA);
            PG8_WAIT_V(8); PG8_WAIT_L(0); PG8_BAR; PG8_MMA(1, 0, At, B0); PG8_MMA(1, 1, At, B1); PG8_BAR; PG8_SCHED;
            PG8_LDB(B0, 1, 0); PG8_LDB(B1, 1, 1); PG8_SCHED; PG8_LDA(At, 1, 0); PG8_STAGE(PG8_SA(0, 1), a2 + hstep, voffA);
            PG8_WAIT_V(8); PG8_WAIT_L(0); PG8_BAR; PG8_MMA(0, 0, At, B0); PG8_MMA(0, 1, At, B1); PG8_BAR; PG8_SCHED;
            PG8_LDA(At, 1, 1); PG8_STAGE(PG8_SB(1, 0), b3, voffB); PG8_STAGE(PG8_SB(1, 1), b3 + hstep, voffB); PG8_STAGE(PG8_SA(1, 0), a3, voffA);
            PG8_WAIT_V(8); PG8_WAIT_L(0); PG8_BAR; PG8_MMA(1, 0, At, B0); PG8_MMA(1, 1, At, B1); PG8_BAR; PG8_SCHED;
            } else {
            PG8_LDB(B0, 0, 0); PG8_SCHED; PG8_LDA(At, 0, 0); PG8_STAGE(PG8_SA(1, 1), a1 + hstep, voffA);
            PG8_WAIT_L(8); PG8_BAR; PG8_WAIT_L(0); PG8_MMA(0, 0, At, B0); PG8_BAR; PG8_SCHED;
            PG8_LDB(B1, 0, 1); PG8_STAGE(PG8_SB(0, 0), b2, voffB);
            PG8_BAR; PG8_WAIT_L(0); PG8_MMA(0, 1, At, B1); PG8_BAR;
            PG8_LDA(At, 0, 1); PG8_STAGE(PG8_SA(0, 0), a2, voffA);
            PG8_BAR; PG8_WAIT_L(0); PG8_MMA(1, 0, At, B0); PG8_BAR; PG8_SCHED;
            PG8_STAGE(PG8_SB(0, 1), b2 + hstep, voffB);
            PG8_WAIT_V(6); PG8_BAR; PG8_MMA(1, 1, At, B1); PG8_BAR;
            PG8_LDB(B0, 1, 0); PG8_SCHED; PG8_LDA(At, 1, 0); PG8_STAGE(PG8_SA(0, 1), a2 + hstep, voffA);
            PG8_WAIT_L(8); PG8_BAR; PG8_WAIT_L(0); PG8_MMA(0, 0, At, B0); PG8_BAR; PG8_SCHED;
            PG8_LDB(B1, 1, 1); PG8_STAGE(PG8_SB(1, 0), b3, voffB);
            PG8_BAR; PG8_WAIT_L(0); PG8_MMA(0, 1, At, B1); PG8_BAR;
            PG8_LDA(At, 1, 1); PG8_STAGE(PG8_SA(1, 0), a3, voffA);
            PG8_BAR; PG8_WAIT_L(0); PG8_MMA(1, 0, At, B0); PG8_BAR; PG8_SCHED;
            PG8_STAGE(PG8_SB(1, 1), b3 + hstep, voffB);
            PG8_WAIT_V(6); PG8_BAR; PG8_MMA(1, 1, At, B1); PG8_BAR;
            }
        }
        if constexpr (ALIGN_EPI) { if (wr == 0) PG8_BAR; }
        if constexpr (!Epi::AFTER_DRAIN) { E(acc, cur, wr, wc, fr, fq); S.done(cur); }
        if (!has_next) break;
#pragma unroll
        for (int a = 0; a < 2; ++a)
#pragma unroll
            for (int b = 0; b < 2; ++b)
#pragma unroll
                for (int m = 0; m < 4; ++m)
#pragma unroll
                    for (int n = 0; n < 2; ++n) acc[a][b][m][n] = (f32x4){0.f, 0.f, 0.f, 0.f};
        cur = nxt; cA = nA; cB = nB; ++ui;
        if constexpr (ALIGN_EPI) { if (wr == 1) PG8_BAR; }
    }
    PG8_WAIT_V(0);
    if constexpr (!ALIGN_EPI) { if (wr == 0) PG8_BAR; }
    PG8_BAR;
    if constexpr (Epi::AFTER_DRAIN) { E.fused(acc, cur, wr, wc, fr, fq, lds, wid, lane); S.done(cur); }
#undef PG8_SA
#undef PG8_SB
#undef PG8_STAGE
#undef PG8_LDA
#undef PG8_LDB
#undef PG8_MMA
#undef PG8_WAIT_V
#undef PG8_WAIT_L
#undef PG8_BAR
#undef PG8_SCHED
}
}
#include <hip/hip_bf16.h>
#include <cmath>
namespace attn_body {
using bf16=__hip_bfloat16;
using bf16x8=__attribute__((ext_vector_type(8)))short;
using s16x4=__attribute__((ext_vector_type(4)))short;
using f32x16=__attribute__((ext_vector_type(16)))float;
using u32x4=__attribute__((ext_vector_type(4)))unsigned;
constexpr int BATCH=16,NHEAD=8,SEQ=2048,D=64,PQ=3072,PO=512;
constexpr int NW=8,QBLK=32,QB=QBLK*NW,KVBLK=64,NQB=SEQ/QB;
constexpr int ATTN_UNIT_ROWS=QB;
__device__ __forceinline__ int crow(int r,int hi){return (r&3)+8*(r>>2)+4*hi;}
#define SBAR() __builtin_amdgcn_sched_barrier(0)
__device__ __forceinline__ void cmask(f32x16&p0,f32x16&p1,int jb,int qrel,int hi){
  const float NEG=-INFINITY; int kb=64*jb+4*hi;
  #pragma unroll
  for(int r=0;r<16;++r){int kv=kb+(r&3)+8*(r>>2); if(kv>qrel)p0[r]=NEG; if(kv+32>qrel)p1[r]=NEG;}
}

constexpr int NSLOT=3, SLOTB=8192;
constexpr int LDS_K=0, LDS_V=NSLOT*SLOTB, LDS_WS=2*NSLOT*SLOTB, LDS_OST=LDS_WS+NW*64*4, LDS_BYTES=LDS_OST+NW*4096;
constexpr float C2=0.125f*1.4426950408889634f;
__device__ __forceinline__ void glds16(const void*gsrc,unsigned lds_dst){unsigned keep;
  asm volatile("s_mov_b32 %0, m0\n\ts_mov_b32 m0, %2\n\ts_nop 0\n\tglobal_load_lds_dwordx4 %1, off\n\ts_mov_b32 m0, %0":"=&s"(keep):"v"(gsrc),"s"(lds_dst):"memory");}
__device__ __forceinline__ float max3f(float a,float b,float c){float r;asm("v_max3_f32 %0, %1, %2, %3":"=v"(r):"v"(a),"v"(b),"v"(c));return r;}
__device__ __forceinline__ float max2f(float a,float b){float r;asm("v_max_f32_e32 %0, %1, %2":"=v"(r):"v"(a),"v"(b));return r;}
__device__ __forceinline__ float fadd_s(float a,float b){float r;asm("v_add_f32_e32 %0, %1, %2":"=v"(r):"v"(a),"v"(b));return r;}
__device__ __forceinline__ float fsub_s(float a,float b){float r;asm("v_sub_f32_e32 %0, %1, %2":"=v"(r):"v"(a),"v"(b));return r;}
typedef float f32x2_t __attribute__((ext_vector_type(2))); typedef __bf16 bf16x2_t __attribute__((ext_vector_type(2)));
__device__ __forceinline__ unsigned cvtpk_s(float lo,float hi){f32x2_t v={lo,hi};bf16x2_t b=__builtin_convertvector(v,bf16x2_t);return __builtin_bit_cast(unsigned,b);}
#define WAIT_BAR(N) asm volatile("s_waitcnt vmcnt(" #N ") lgkmcnt(0)\n\ts_barrier":::"memory")

__device__ __forceinline__ void qkt(f32x16&p0,f32x16&p1,const char*Kslot,const bf16x8*qr,const f32x16&negm,int r32,int hi){
  const char*kb=Kslot+hi*1024+r32*16;
  #pragma unroll
  for(int d0=0;d0<4;++d0){
    const bf16x8 b0=*reinterpret_cast<const bf16x8*>(kb+d0*2048);
    const bf16x8 b1=*reinterpret_cast<const bf16x8*>(kb+d0*2048+512);
    if(d0==0){p0=__builtin_amdgcn_mfma_f32_32x32x16_bf16(b0,qr[0],negm,0,0,0);p1=__builtin_amdgcn_mfma_f32_32x32x16_bf16(b1,qr[0],negm,0,0,0);}
    else{p0=__builtin_amdgcn_mfma_f32_32x32x16_bf16(b0,qr[d0],p0,0,0,0);p1=__builtin_amdgcn_mfma_f32_32x32x16_bf16(b1,qr[d0],p1,0,0,0);}}
}
typedef __attribute__((address_space(3))) const char* lds_cptr;
typedef short v4i16_t __attribute__((ext_vector_type(4)));
__device__ __forceinline__ void kload8(bf16x8*kf,lds_cptr kp){
  kf[0]=*(const __attribute__((address_space(3))) bf16x8*)(kp);      kf[1]=*(const __attribute__((address_space(3))) bf16x8*)(kp+512);
  kf[2]=*(const __attribute__((address_space(3))) bf16x8*)(kp+2048); kf[3]=*(const __attribute__((address_space(3))) bf16x8*)(kp+2560);
  kf[4]=*(const __attribute__((address_space(3))) bf16x8*)(kp+4096); kf[5]=*(const __attribute__((address_space(3))) bf16x8*)(kp+4608);
  kf[6]=*(const __attribute__((address_space(3))) bf16x8*)(kp+6144); kf[7]=*(const __attribute__((address_space(3))) bf16x8*)(kp+6656);
}
__device__ __forceinline__ void kload2(bf16x8*kf,lds_cptr kp,int j){ kf[2*j]=*(const __attribute__((address_space(3))) bf16x8*)(kp+j*2048); kf[2*j+1]=*(const __attribute__((address_space(3))) bf16x8*)(kp+j*2048+512); }
__device__ __forceinline__ s16x4 vtr(lds_cptr p){ return __builtin_bit_cast(s16x4,__builtin_amdgcn_ds_read_tr16_b64_v4i16((__attribute__((address_space(3))) v4i16_t*)p)); }
__device__ __forceinline__ float rowmax(const f32x16&p0,const f32x16&p1){
  float a=max3f(p0[0],p0[1],p1[0]),b=max3f(p0[2],p0[3],p1[1]);a=max3f(a,p1[2],p1[3]);
  #pragma unroll
  for(int r=4;r<16;r+=4){a=max3f(a,p0[r],p0[r+1]);b=max3f(b,p0[r+2],p0[r+3]);a=max3f(a,p1[r],p1[r+1]);b=max3f(b,p1[r+2],p1[r+3]);}
  const float m=max2f(a,b);
  auto rr=__builtin_amdgcn_permlane32_swap(__float_as_uint(m),__float_as_uint(m),false,false);
  return max2f(__uint_as_float(rr[0]),__uint_as_float(rr[1]));
}
__device__ __forceinline__ void pv(f32x16*o,int vb,bf16x8 pa0,bf16x8 pa1,bf16x8 pa2,bf16x8 pa3){
  #pragma unroll
  for(int d0=0;d0<2;++d0){s16x4 lo[4],hi[4];
    #pragma unroll
    for(int ks=0;ks<4;++ks){
      asm volatile("ds_read_b64_tr_b16 %0,%1 offset:%c2":"=&v"(lo[ks]):"v"(vb),"i"(d0*4096+ks*1024):"memory");
      asm volatile("ds_read_b64_tr_b16 %0,%1 offset:%c2":"=&v"(hi[ks]):"v"(vb),"i"(d0*4096+ks*1024+512):"memory");}
    asm volatile("s_waitcnt lgkmcnt(0)":::"memory");SBAR();
    #define PK(k) (bf16x8){lo[k][0],lo[k][1],lo[k][2],lo[k][3],hi[k][0],hi[k][1],hi[k][2],hi[k][3]}
    o[d0]=__builtin_amdgcn_mfma_f32_32x32x16_bf16(pa0,PK(0),o[d0],0,0,0);
    o[d0]=__builtin_amdgcn_mfma_f32_32x32x16_bf16(pa1,PK(1),o[d0],0,0,0);
    o[d0]=__builtin_amdgcn_mfma_f32_32x32x16_bf16(pa2,PK(2),o[d0],0,0,0);
    o[d0]=__builtin_amdgcn_mfma_f32_32x32x16_bf16(pa3,PK(3),o[d0],0,0,0);
    #undef PK
  }
}

#ifndef ATTN_STORE16
#define ATTN_STORE16(p,v) (*(u32x4*)(p)=(v))
#endif
template<int THRL> __device__ __forceinline__ void attn_unit(int b,int h,int kvh,int qb,const bf16*Q,const bf16*__restrict__ K,const bf16*__restrict__ V,bf16*O,char*shm){
  int tid_=threadIdx.x; asm volatile("":"+v"(tid_)); const int tid=tid_,lane=tid&63,r32=lane&31,hi=lane>>5; const int wid=__builtin_amdgcn_readfirstlane(tid>>6);
  const long rowbase=(long)b*SEQ; const int q0=qb*QB;
  const bf16*Qw=Q+(rowbase+q0+wid*QBLK)*PQ+h*D;
  const bf16*Kh=K+rowbase*PQ+kvh*D,*Vh=V+rowbase*PQ+kvh*D;
  const unsigned lds0=(unsigned)(uintptr_t)shm;
  float*wsf=(float*)(shm+LDS_WS)+wid*64;
  const bf16*ksrc=Kh+(long)lane*PQ+wid*8;
  const bf16*vsrc=Vh+(long)(16*(wid&3)+(lane>>2))*PQ+(wid>>2)*32+(lane&3)*8;
  const unsigned kdst=lds0+LDS_K+wid*1024, vdst=lds0+LDS_V+wid*1024;
  #define DMA_K(t,slot) glds16(ksrc+(long)(t)*KVBLK*PQ,(unsigned)__builtin_amdgcn_readfirstlane(kdst+(slot)))
  #define DMA_V(t,slot) glds16(vsrc+(long)(t)*KVBLK*PQ,(unsigned)__builtin_amdgcn_readfirstlane(vdst+(slot)))
  const int vb0=(int)(lds0+LDS_V)+((lane>>4)&1)*32+(lane&3)*8+(4*hi+((lane&15)>>2))*64;
  const char*Kbase=shm+LDS_K; bf16x8 kf[8];
  const lds_cptr shm3=(lds_cptr)shm; const lds_cptr kp0=shm3+LDS_K+hi*1024+r32*16; const lds_cptr vp0=shm3+LDS_V+((lane>>4)&1)*32+(lane&3)*8+(4*hi+((lane&15)>>2))*64;
  constexpr int NT=SEQ/KVBLK;
  DMA_K(0,0);DMA_V(0,0);DMA_K(1,SLOTB);
  bf16x8 qr[4];
  #pragma unroll
  for(int d0=0;d0<4;++d0)qr[d0]=*reinterpret_cast<const bf16x8*>(&Qw[(long)r32*PQ+d0*16+hi*8]);
  float mhat=0.f,l_reg=0.f;f32x16 o[2];o[0]=f32x16{};o[1]=f32x16{};f32x16 negm=f32x16{};asm volatile("":"+v"(negm));

  #define CMASK(P0,P1,t) do{}while(0)
  bool resc=false;
  #define START(P0,P1) do{ const float rm=rowmax(P0,P1); resc=false; \
    { const float dl=rm; mhat=fadd_s(mhat,dl); \
      _Pragma("unroll") for(int r=0;r<16;++r){P0[r]=fsub_s(P0[r],dl);P1[r]=fsub_s(P1[r],dl);} \
      _Pragma("unroll") for(int r=0;r<16;++r)negm[r]=-mhat; asm volatile("":"+v"(negm)); } \
    _Pragma("unroll") for(int r=0;r<16;++r)P0[r]=__builtin_amdgcn_exp2f(P0[r]); }while(0)
  #define RESC() do{ if(resc){ asm volatile("s_waitcnt lgkmcnt(0)":::"memory"); \
      _Pragma("unroll") for(int d_=0;d_<2;++d_) _Pragma("unroll") for(int r=0;r<16;++r)o[d_][r]*=wsf[crow(r,hi)]; } }while(0)
  f32x16 pA0,pA1,pB0,pB1;
  int sl_prev=0,sl_cur=0,sl_next=SLOTB;
  #define ROT() do{sl_prev=sl_cur;sl_cur=sl_next;sl_next=(sl_next==(NSLOT-1)*SLOTB)?0:sl_next+SLOTB;}while(0)
  DMA_K(2,2*SLOTB);
  WAIT_BAR(3);
  qkt(pA0,pA1,Kbase,qr,negm,r32,hi);asm volatile("s_nop 15\n\ts_nop 7":"+v"(pA0),"+v"(pA1));CMASK(pA0,pA1,0);
  START(pA0,pA1);
  _Pragma("unroll") for(int r=0;r<16;++r)pA1[r]=__builtin_amdgcn_exp2f(pA1[r]);
  WAIT_BAR(0);
  DMA_K(3,0);DMA_V(1,SLOTB);
  ROT();
  kload8(kf,kp0+sl_cur);
  WAIT_BAR(2);
  s16x4 vlo[8],vhi[8]; u32x4 pw0,pw1,pw2,pw3;
  #define PKW(P,B) cvtpk_s(P[B],P[B+1])
  #define PAF(k) __builtin_bit_cast(bf16x8,pw##k)
  #define VFR(i) (bf16x8){vlo[i][0],vlo[i][1],vlo[i][2],vlo[i][3],vhi[i][0],vhi[i][1],vhi[i][2],vhi[i][3]}
  #define PIN(x) asm volatile("":"+v"(x))
  #define MX3(a,b,c) __builtin_fmaxf(__builtin_fmaxf((a),(b)),(c))
  #define GAPA(MF,A0,A1,A2,A3,W0,W1,PW) do{ MF; sacc+=A0; sacc+=A1; sacc+=A2; sacc+=A3; PIN(sacc); W0; W1; PIN(PW); SBAR(); }while(0)
  #define EX(v) __builtin_amdgcn_exp2f(v)
  #define GAPB(MF,X,B) do{ MF; X[B]=EX(X[B]); X[B+1]=EX(X[B+1]); X[B+2]=EX(X[B+2]); X[B+3]=EX(X[B+3]); PIN(X); SBAR(); }while(0)
  #define VRD(i) do{ vlo[i]=vtr(vp_+(((i)>>2)*4096+((i)&3)*1024)); vhi[i]=vtr(vp_+(((i)>>2)*4096+((i)&3)*1024+512)); }while(0)
  #define KRD(G,j) do{ if(G){ kload2(kf,kp0+sl_next,j); SBAR(); } }while(0)
  #define STEP(C0,C1,P0,P1,t,GK,GV,GL) do{ SBAR(); \
    const lds_cptr vp_=vp0+sl_prev; \
    VRD(0); SBAR(); float sacc=(P0[0]+P0[1]); \
    GAPA(C0=__builtin_amdgcn_mfma_f32_32x32x16_bf16(kf[0],qr[0],negm,0,0,0), P0[2],P0[3],P0[4],P0[5],     pw0[0]=PKW(P0,0), pw0[1]=PKW(P0,2), pw0); \
    VRD(4); SBAR(); GAPA(C1=__builtin_amdgcn_mfma_f32_32x32x16_bf16(kf[1],qr[0],negm,0,0,0), P0[6],P0[7],P0[8],P0[9],     pw0[2]=PKW(P0,4), pw0[3]=PKW(P0,6), pw0); \
    VRD(1); SBAR(); GAPA(C0=__builtin_amdgcn_mfma_f32_32x32x16_bf16(kf[2],qr[1],C0,0,0,0),   P0[10],P0[11],P0[12],P0[13], pw1[0]=PKW(P0,8), pw1[1]=PKW(P0,10), pw1); \
    VRD(5); SBAR(); GAPA(C1=__builtin_amdgcn_mfma_f32_32x32x16_bf16(kf[3],qr[1],C1,0,0,0),   P0[14],P0[15],P1[0],P1[1],   pw1[2]=PKW(P0,12),pw1[3]=PKW(P0,14), pw1); \
    VRD(2); SBAR(); GAPA(C0=__builtin_amdgcn_mfma_f32_32x32x16_bf16(kf[4],qr[2],C0,0,0,0),   P1[2],P1[3],P1[4],P1[5],     pw2[0]=PKW(P1,0), pw2[1]=PKW(P1,2), pw2); \
    VRD(6); SBAR(); GAPA(C1=__builtin_amdgcn_mfma_f32_32x32x16_bf16(kf[5],qr[2],C1,0,0,0),   P1[6],P1[7],P1[8],P1[9],     pw2[2]=PKW(P1,4), pw2[3]=PKW(P1,6), pw2); \
    VRD(3); SBAR(); GAPA(C0=__builtin_amdgcn_mfma_f32_32x32x16_bf16(kf[6],qr[3],C0,0,0,0),   P1[10],P1[11],P1[12],P1[13], pw3[0]=PKW(P1,8), pw3[1]=PKW(P1,10), pw3); \
    VRD(7); SBAR(); GAPA(C1=__builtin_amdgcn_mfma_f32_32x32x16_bf16(kf[7],qr[3],C1,0,0,0),   P1[14],P1[15],0.f,0.f,       pw3[2]=PKW(P1,12),pw3[3]=PKW(P1,14), pw3); \
    l_reg+=sacc; \
    if(GK){DMA_K((t)+3,sl_cur);} if(GV){DMA_V((t)+1,sl_next);} \
    CMASK(C0,C1,t); \
    { float a=MX3(C0[0],C0[1],C1[0]),b=MX3(C0[2],C0[3],C1[1]); a=MX3(a,C1[2],C1[3]); \
      _Pragma("unroll") for(int r=4;r<16;r+=4){a=MX3(a,C0[r],C0[r+1]);b=MX3(b,C0[r+2],C0[r+3]);a=MX3(a,C1[r],C1[r+1]);b=MX3(b,C1[r+2],C1[r+3]);} \
      float rm=__builtin_fmaxf(a,b); { auto rr=__builtin_amdgcn_permlane32_swap(__float_as_uint(rm),__float_as_uint(rm),false,false); rm=__builtin_fmaxf(__uint_as_float(rr[0]),__uint_as_float(rr[1])); } \
      resc=false; \
      if(__builtin_expect(__any(rm>(float)THRL),0)){ const float dl=__builtin_fmaxf(rm,0.f); mhat+=dl; \
        _Pragma("unroll") for(int r=0;r<16;++r){C0[r]-=dl;C1[r]-=dl;} \
        _Pragma("unroll") for(int r=0;r<16;++r)negm[r]=-mhat; asm volatile("":"+v"(negm)); \
        const float f=__builtin_amdgcn_exp2f(-dl); l_reg*=f; if(hi==0)wsf[r32]=f; resc=true; } } \
    SBAR(); \
    GAPB(o[0]=__builtin_amdgcn_mfma_f32_32x32x16_bf16(PAF(0),VFR(0),o[0],0,0,0), C0,0); \
    GAPB(o[1]=__builtin_amdgcn_mfma_f32_32x32x16_bf16(PAF(0),VFR(4),o[1],0,0,0), C0,4); \
    KRD(GL,0); GAPB(o[0]=__builtin_amdgcn_mfma_f32_32x32x16_bf16(PAF(1),VFR(1),o[0],0,0,0), C0,8); \
    KRD(GL,1); GAPB(o[1]=__builtin_amdgcn_mfma_f32_32x32x16_bf16(PAF(1),VFR(5),o[1],0,0,0), C0,12); \
    KRD(GL,2); GAPB(o[0]=__builtin_amdgcn_mfma_f32_32x32x16_bf16(PAF(2),VFR(2),o[0],0,0,0), C1,0); \
    KRD(GL,3); GAPB(o[1]=__builtin_amdgcn_mfma_f32_32x32x16_bf16(PAF(2),VFR(6),o[1],0,0,0), C1,4); \
    GAPB(o[0]=__builtin_amdgcn_mfma_f32_32x32x16_bf16(PAF(3),VFR(3),o[0],0,0,0), C1,8); \
    GAPB(o[1]=__builtin_amdgcn_mfma_f32_32x32x16_bf16(PAF(3),VFR(7),o[1],0,0,0), C1,12); \
    }while(0)
  int t=1;
  #undef CMASK
  #define CMASK(P0,P1,t) do{}while(0)
  for(;t+5<NT;t+=2){
    STEP(pB0,pB1,pA0,pA1,t,true,true,true);     WAIT_BAR(2); RESC(); ROT();
    STEP(pA0,pA1,pB0,pB1,t+1,true,true,true);   WAIT_BAR(2); RESC(); ROT();
  }
  #undef CMASK
  #define CMASK(P0,P1,t) do{}while(0)
  #define ENDW(tt) do{ if((tt)+3<NT){WAIT_BAR(2);} else if((tt)+2<NT){WAIT_BAR(1);} else {WAIT_BAR(0);} }while(0)
  for(;t+1<NT;t+=2){
    STEP(pB0,pB1,pA0,pA1,t,(t+3<NT),(t+1<NT),(t+1<NT));       ENDW(t);   RESC(); ROT();
    STEP(pA0,pA1,pB0,pB1,t+1,(t+4<NT),(t+2<NT),(t+2<NT));     ENDW(t+1); RESC(); ROT();
  }
  STEP(pB0,pB1,pA0,pA1,NT-1,false,false,false); RESC();
  { float sacc=pB0[0]+pB0[1]; _Pragma("unroll") for(int r=2;r<16;++r)sacc+=pB0[r]; _Pragma("unroll") for(int r=0;r<16;++r)sacc+=pB1[r]; l_reg+=sacc;
    pw0=(u32x4){PKW(pB0,0),PKW(pB0,2),PKW(pB0,4),PKW(pB0,6)};pw1=(u32x4){PKW(pB0,8),PKW(pB0,10),PKW(pB0,12),PKW(pB0,14)};pw2=(u32x4){PKW(pB1,0),PKW(pB1,2),PKW(pB1,4),PKW(pB1,6)};pw3=(u32x4){PKW(pB1,8),PKW(pB1,10),PKW(pB1,12),PKW(pB1,14)};
    SBAR(); pv(o,vb0+sl_cur,PAF(0),PAF(1),PAF(2),PAF(3)); }
  #undef PKW
  #undef PAF
  #undef VFR
  #undef PIN
  #undef MX3
  #undef GAPA
  #undef GAPB
  #undef EX
  #undef VRD
  #undef KRD
  #undef STEP
  #undef ENDW
  {auto rr=__builtin_amdgcn_permlane32_swap(__float_as_uint(l_reg),__float_as_uint(l_reg),false,false);l_reg=__uint_as_float(rr[0])+__uint_as_float(rr[1]);}
  if(hi==0)wsf[32+r32]=l_reg;asm volatile("s_waitcnt lgkmcnt(0)":::"memory");
  float rli[16];
  #pragma unroll
  for(int r=0;r<16;++r)rli[r]=__builtin_amdgcn_rcpf(wsf[32+crow(r,hi)]);
  bf16*Ow=O+(rowbase+q0+wid*QBLK)*PO+h*D;
  { bf16*stg=(bf16*)(shm+LDS_OST)+wid*2048;
    #pragma unroll
    for(int r=0;r<16;++r){const int orow=crow(r,hi);
      #pragma unroll
      for(int d0=0;d0<2;++d0)stg[orow*64+d0*32+r32]=__float2bfloat16(o[d0][r]*rli[r]);}
    asm volatile("s_waitcnt lgkmcnt(0)":::"memory");
    #pragma unroll
    for(int i=0;i<4;++i){const int row=i*8+(lane>>3),ch=lane&7; const u32x4 v=*(const u32x4*)(stg+row*64+ch*8); ATTN_STORE16(Ow+(long)row*PO+ch*8,v);} }
  asm volatile("s_waitcnt lgkmcnt(0)\n\ts_barrier":::"memory");
  #undef DMA_K
  #undef DMA_V
  #undef CMASK
  #undef START
  #undef RESC
  #undef ROT
}
constexpr int ATTN_LDS_BYTES=LDS_BYTES;
struct AttnTensors { const bf16* Q; const bf16* K; const bf16* V; bf16* O; };
constexpr int BAND_HALF=40960, BAND_K=0, BAND_V=16384, BAND_WS=32768, BAND_OST=81920, BAND_LDS_BYTES=BAND_OST+NW*4096;
__device__ __forceinline__ void band_half_unit(int hu,const bf16*__restrict__ QKV,int offq,int offk,int offv,bf16*OBG,float*LSEG,char*shm){
  int tid_=threadIdx.x; asm volatile("":"+v"(tid_)); const int tid=tid_,lane=tid&63,r32=lane&31,hi=lane>>5; const int wid=__builtin_amdgcn_readfirstlane(tid>>6);
  const int half=wid>>2, wq=wid&3;
  const int uh=__builtin_amdgcn_readfirstlane(2*hu+half);
  const int b=uh/192, rem=uh-b*192, head=rem>>4, ck=rem&15, g=head>>2, j=head&3;
  const int dil=(g==0)?1:(g==1)?4:16, sh=(g==0)?4:(g==1)?2:0;
  const int rc=ck>>sh, c=ck&((1<<sh)-1), ntile=(SEQ/64)/dil;
  const long rowbase=(long)b*SEQ;
  bf16*const OG=OBG+(long)g*BATCH*SEQ*256; float*const LG=LSEG+(long)g*BATCH*SEQ*4;
  const unsigned lds0=(unsigned)(uintptr_t)shm+half*BAND_HALF;
  char*hb=shm+half*BAND_HALF;
  typedef __attribute__((address_space(3))) float* lds_fptr;
  const lds_fptr wsf=(lds_fptr)(hb+BAND_WS+wq*256);
  const int mq=128*c+32*wq+r32;
  const bf16*Qrow=QKV+(rowbase+(long)mq*dil+rc)*PQ+offq+head*D;
  bf16x8 qr[4];
  #pragma unroll
  for(int d0=0;d0<4;++d0)qr[d0]=*reinterpret_cast<const bf16x8*>(&Qrow[d0*16+hi*8]);
  const bf16*Kc=QKV+(rowbase+rc)*PQ+offk+head*D, *Vc=QKV+(rowbase+rc)*PQ+offv+head*D;
  #define BAND_DMA(T,slot) do{ const long p0_=(long)(T)*64; \
      _Pragma("unroll") for(int q_=0;q_<2;++q_){ const int cc_=2*wq+q_; \
        glds16(Kc+((p0_+lane)*dil)*PQ+cc_*8,(unsigned)__builtin_amdgcn_readfirstlane(lds0+BAND_K+(slot)*8192+cc_*1024)); \
        glds16(Vc+((p0_+16*(cc_&3)+(lane>>2))*dil)*PQ+(cc_>>2)*32+(lane&3)*8,(unsigned)__builtin_amdgcn_readfirstlane(lds0+BAND_V+(slot)*8192+cc_*1024)); } }while(0)
  const int T0=2*c-1;
  float mrun=-1e30f,l_reg=0.f; f32x16 o[2]; o[0]=f32x16{}; o[1]=f32x16{};
  const int vb0=(int)(lds0+BAND_V)+((lane>>4)&1)*32+(lane&3)*8+(4*hi+((lane&15)>>2))*64;
  { const int T=T0; if(T>=0&&T<ntile) BAND_DMA(T,0); }
  #pragma unroll 1
  for(int s=0;s<4;++s){
    const int T=T0+s, Tn=T+1; const bool vcur=(T>=0&&T<ntile), vnext=(s<3)&&(Tn>=0&&Tn<ntile);
    if(vnext){ BAND_DMA(Tn,(s+1)&1); asm volatile("s_waitcnt vmcnt(4)":::"memory"); } else { asm volatile("s_waitcnt vmcnt(0)":::"memory"); }
    asm volatile("s_barrier":::"memory");
    const bool act=vcur&&(s>=(wq>>1))&&(s<=(wq>>1)+2);
    if(act){
      f32x16 p0,p1; const f32x16 zero=f32x16{};
      qkt(p0,p1,hb+BAND_K+(s&1)*8192,qr,zero,r32,hi);
      const int kb=64*T+4*hi-mq;
      float mx=-1e30f;
      #pragma unroll
      for(int r=0;r<16;++r){ const int d0_=kb+(r&3)+8*(r>>2), d1_=d0_+32;
        p0[r]=(d0_>=-64&&d0_<=64)?p0[r]:-1e30f; p1[r]=(d1_>=-64&&d1_<=64)?p1[r]:-1e30f; mx=__builtin_fmaxf(mx,__builtin_fmaxf(p0[r],p1[r])); }
      mx=__builtin_fmaxf(mx,__shfl_xor(mx,32));
      const float mnew=__builtin_fmaxf(mrun,mx); const float f=__builtin_amdgcn_exp2f(mrun-mnew); mrun=mnew;
      float sacc=0.f;
      #pragma unroll
      for(int r=0;r<16;++r){ p0[r]=(p0[r]>-1e29f)?__builtin_amdgcn_exp2f(p0[r]-mnew):0.f; p1[r]=(p1[r]>-1e29f)?__builtin_amdgcn_exp2f(p1[r]-mnew):0.f; sacc+=p0[r]+p1[r]; }
      l_reg=l_reg*f+sacc;
      if(hi==0)wsf[r32]=f;
      #pragma unroll
      for(int r=0;r<16;++r){ const float fr=wsf[crow(r,hi)]; o[0][r]*=fr; o[1][r]*=fr; }
      u32x4 pw0,pw1,pw2,pw3;
      pw0=(u32x4){cvtpk_s(p0[0],p0[1]),cvtpk_s(p0[2],p0[3]),cvtpk_s(p0[4],p0[5]),cvtpk_s(p0[6],p0[7])}; pw1=(u32x4){cvtpk_s(p0[8],p0[9]),cvtpk_s(p0[10],p0[11]),cvtpk_s(p0[12],p0[13]),cvtpk_s(p0[14],p0[15])};
      pw2=(u32x4){cvtpk_s(p1[0],p1[1]),cvtpk_s(p1[2],p1[3]),cvtpk_s(p1[4],p1[5]),cvtpk_s(p1[6],p1[7])}; pw3=(u32x4){cvtpk_s(p1[8],p1[9]),cvtpk_s(p1[10],p1[11]),cvtpk_s(p1[12],p1[13]),cvtpk_s(p1[14],p1[15])};
      SBAR(); pv(o,vb0+(s&1)*8192,__builtin_bit_cast(bf16x8,pw0),__builtin_bit_cast(bf16x8,pw1),__builtin_bit_cast(bf16x8,pw2),__builtin_bit_cast(bf16x8,pw3));
    }
    asm volatile("s_waitcnt lgkmcnt(0)\n\ts_barrier":::"memory");
  }
  #undef BAND_DMA
  l_reg+=__shfl_xor(l_reg,32);
  if(hi==0)wsf[32+r32]=l_reg;
  float rli[16];
  #pragma unroll
  for(int r=0;r<16;++r)rli[r]=__builtin_amdgcn_rcpf(wsf[32+crow(r,hi)]);
  { bf16*stg=(bf16*)(shm+BAND_OST)+wid*2048;
    #pragma unroll
    for(int r=0;r<16;++r){const int orow=crow(r,hi);
      #pragma unroll
      for(int d0=0;d0<2;++d0)stg[orow*64+d0*32+r32]=__float2bfloat16(o[d0][r]*rli[r]);}
    asm volatile("s_waitcnt lgkmcnt(0)":::"memory");
    #pragma unroll
    for(int i=0;i<4;++i){const int row=i*8+(lane>>3),ch=lane&7; const u32x4 v=*(const u32x4*)(stg+row*64+ch*8);
      const long grow=rowbase+(long)(128*c+32*wq+row)*dil+rc;
      *(u32x4*)(OG+grow*256+j*64+ch*8)=v;} }
  if(hi==0){ const long grow=rowbase+(long)mq*dil+rc; LG[grow*4+j]=mrun+__builtin_log2f(l_reg); }
  asm volatile("s_waitcnt lgkmcnt(0)\n\ts_barrier":::"memory");
}
#undef SBAR
#undef WAIT_BAR
}
#define GAS __attribute__((address_space(1)))
#define LAS __attribute__((address_space(3)))
typedef unsigned short bf16;
typedef unsigned v4u __attribute__((ext_vector_type(4)));
typedef float f32x4 __attribute__((ext_vector_type(4)));
typedef short bf16x8 __attribute__((ext_vector_type(8)));
typedef GAS unsigned gu32;
typedef GAS unsigned long long gu64;
#define RLX_AGENT __ATOMIC_RELAXED, __HIP_MEMORY_SCOPE_AGENT
#define LDS_WAIT() asm volatile("s_waitcnt lgkmcnt(0)" ::: "memory")
#define VM_WAIT() asm volatile("s_waitcnt vmcnt(0)" ::: "memory")
__device__ __forceinline__ unsigned long long rt() { return __builtin_amdgcn_s_memrealtime(); }
__device__ __forceinline__ unsigned f2bf(float f) { unsigned u = __builtin_bit_cast(unsigned, f); return (u + 0x7fffu + ((u >> 16) & 1u)) >> 16; }
__device__ __forceinline__ unsigned pk2(float lo, float hi) { return f2bf(lo) | (f2bf(hi) << 16); }

#define XB_TMO      128
#define XB_XCNT(j)  (256  + 64 * (j))
#define XB_XSUB(j)  (1280 + 64 * (j))
#define XB_XGEN(j)  (2304 + 64 * (j))
#define XB_TOP      3328
#define XB_TOPGEN   3392
#define XCD_BAR_WORDS 3456
#define XB_SPIN_CAP (1u << 24)

__device__ __forceinline__ unsigned xb_ld(unsigned* p)              { return __hip_atomic_load(p, __ATOMIC_RELAXED, __HIP_MEMORY_SCOPE_AGENT); }
__device__ __forceinline__ unsigned xb_add(unsigned* p, unsigned v) { return __hip_atomic_fetch_add(p, v, __ATOMIC_RELAXED, __HIP_MEMORY_SCOPE_AGENT); }
__device__ __forceinline__ unsigned xb_xcc_id() { return (unsigned)__builtin_amdgcn_s_getreg((3 << 11) | 20) & 0xFu; }
#define XB_SPIN(cond, bar) do { unsigned _sp = 0; while (cond) { __builtin_amdgcn_s_sleep(1); \
    if ((++_sp & 255u) == 0u) { if (xb_ld(&(bar)[XB_TMO])) break; if (_sp > XB_SPIN_CAP) { atomicAdd(&(bar)[XB_TMO], 1u); break; } } } } while (0)

struct XcdBarrier {
    unsigned* bar; unsigned x;
    volatile LAS unsigned* st;
};

__device__ __forceinline__ XcdBarrier xcd_barrier_post(unsigned* bar, volatile LAS unsigned* st) {
    XcdBarrier b; b.bar = bar; b.x = xb_xcc_id(); b.st = st;
    if (threadIdx.x == 0) (void)xb_add(&bar[XB_XCNT(b.x)], 1u);
    return b;
}
__device__ __forceinline__ void xcd_barrier_complete(unsigned* bar, unsigned x, unsigned& nloc, unsigned& nx) {
    const unsigned G = gridDim.x * gridDim.y * gridDim.z;
    unsigned sum, cnt, mine, sp = 0u;
    for (;;) {
        sum = 0u; cnt = 0u; mine = 0u;
#pragma unroll
        for (unsigned j = 0; j < 16; ++j) { const unsigned c = xb_ld(&bar[XB_XCNT(j)]); sum += c; cnt += (c > 0u) ? 1u : 0u; mine = (j == x) ? c : mine; }
        if (sum == G) break;
        __builtin_amdgcn_s_sleep(1);
        if ((++sp & 255u) == 0u) { if (xb_ld(&bar[XB_TMO])) break; if (sp > XB_SPIN_CAP) { atomicAdd(&bar[XB_TMO], 1u); break; } }
    }
    nloc = mine > 0u ? mine : 1u; nx = cnt > 0u ? cnt : 1u;
}

__device__ __forceinline__ void xcd_barrier(const XcdBarrier& b) {
    asm volatile("s_waitcnt vmcnt(0)" ::: "memory");
    __syncthreads();
    if (threadIdx.x == 0) {
        unsigned* bar = b.bar;
        __builtin_amdgcn_s_waitcnt(0);
        unsigned nloc = b.st[0], nx = b.st[1];
        if (nloc == 0u) { xcd_barrier_complete(bar, b.x, nloc, nx); b.st[0] = nloc; b.st[1] = nx; }
        const unsigned old = xb_add(&bar[XB_XSUB(b.x)], 1u);
        const unsigned gen = old / nloc;
        if (old + 1u == (gen + 1u) * nloc) {
            __builtin_amdgcn_fence(__ATOMIC_RELEASE, "agent");
            asm volatile("s_waitcnt vmcnt(0)" ::: "memory");
            const unsigned og = xb_add(&bar[XB_TOP], 1u);
            const unsigned tg = og / nx;
            if (og + 1u == (tg + 1u) * nx) xb_add(&bar[XB_TOPGEN], 1u);
            else XB_SPIN(xb_ld(&bar[XB_TOPGEN]) == tg, bar);
            __builtin_amdgcn_fence(__ATOMIC_ACQUIRE, "agent");
            xb_add(&bar[XB_XGEN(b.x)], 1u);
            asm volatile("s_waitcnt vmcnt(0)" ::: "memory");
        } else {
            XB_SPIN(xb_ld(&bar[XB_XGEN(b.x)]) == gen, bar);
            __builtin_amdgcn_fence(__ATOMIC_ACQUIRE, "agent");
            asm volatile("s_waitcnt vmcnt(0)" ::: "memory");
        }
    }
    __syncthreads();
}


constexpr size_t MiB = 1u << 20;
constexpr size_t WS_CTL = 0, CTL_ZERO_BYTES = 1 * MiB;
constexpr size_t WS_STAT0 = 1 * MiB;
constexpr size_t WS_AFF = 2 * MiB;
constexpr size_t WS_INV = 4 * MiB;
constexpr size_t WS_TOK = 5 * MiB;
constexpr size_t WS_LSE = 6 * MiB;
constexpr size_t WS_WIN = 8 * MiB;
constexpr size_t WS_WA = 18 * MiB;
constexpr size_t WS_WB = 19 * MiB;
constexpr size_t WS_WO = 20 * MiB;
constexpr size_t WS_ROPEA = 22 * MiB;
constexpr size_t WS_ROPEB = 23 * MiB;
constexpr size_t ARENA = 32 * MiB;
constexpr size_t A_H0B = ARENA + 0 * MiB;
constexpr size_t A_QKV = ARENA + 64 * MiB;
constexpr size_t A_GATES = ARENA + 256 * MiB;
constexpr size_t A_ATTNA = ARENA + 0 * MiB;
constexpr size_t A_OB = ARENA + 32 * MiB;
constexpr size_t A_OBG = ARENA + 384 * MiB;
constexpr size_t A_MERGED = ARENA + 64 * MiB;
constexpr size_t A_MIX = ARENA + 128 * MiB;
constexpr size_t A_H1B = ARENA + 0 * MiB;
constexpr size_t A_WGU = ARENA + 256 * MiB;
constexpr size_t A_WD = ARENA + 384 * MiB;
constexpr size_t A_XE = ARENA + 128 * MiB;
constexpr size_t A_ACT = ARENA + 0 * MiB;
constexpr size_t A_YE = ARENA + 128 * MiB;
constexpr size_t WS_END = ARENA + 448 * MiB;
constexpr int CW_TMO = 0, CW_BAR = 4096;

constexpr int RING_OFF = 0, RING_BYTES = 131072;
constexpr int LDSCTL_OFF = RING_BYTES, MISC_OFF = LDSCTL_OFF + 320;
constexpr int LDS_BYTES = 147456;

typedef short s16x4v __attribute__((ext_vector_type(4)));
typedef unsigned u32x2 __attribute__((ext_vector_type(2)));

struct Frame {
    LAS unsigned char* lds;
    volatile LAS unsigned* MISC;
    gu32* ctl;
    int tid, lane, wave;
    int vcu, G;
};

__device__ __forceinline__ float wave_sum(float v) {
#pragma unroll
    for (int o = 1; o < 64; o <<= 1) v += __shfl_xor(v, o);
    return v;
}
__device__ __forceinline__ float bf2f(bf16 h) { return __uint_as_float(((unsigned)h) << 16); }

struct TJob { const float* src; bf16* dst; size_t off; int ldw, ldt, k0, n0, win; };
__device__ __forceinline__ void tjob_load(const TJob& j, f32x4 (&r)[8], int lane) {
    const float* p = j.src + (size_t)(j.k0 + (lane >> 3)) * j.ldw + j.n0 + 4 * (lane & 7);
#pragma unroll
    for (int i = 0; i < 8; ++i) r[i] = *(const GAS f32x4*)(p + (size_t)(8 * i) * j.ldw);
}
struct WinRow {
    __device__ __forceinline__ size_t operator()(int ncol) const {
        if (ncol >= QKVW) return (size_t)ncol;
        int pn, wc, d, map;
        if (ncol < OFF_KA) { const int h = ncol >> 6; pn = h >> 2; wc = h & 3; map = 0; }
        else if (ncol < OFF_VA) { pn = 2; wc = (ncol - OFF_KA) >> 6; map = 0; }
        else if (ncol < OFF_QB) { pn = 2; wc = 2 + ((ncol - OFF_VA) >> 6); map = 2; }
        else if (ncol < OFF_KB) { const int h = (ncol - OFF_QB) >> 6; pn = 3 + (h >> 2); wc = h & 3; map = 1; }
        else if (ncol < OFF_VB) { const int h = (ncol - OFF_KB) >> 6; pn = 6 + (h >> 2); wc = h & 3; map = 1; }
        else { const int h = (ncol - OFF_VB) >> 6; pn = 9 + (h >> 2); wc = h & 3; map = 2; }
        d = ncol & 63;
        int bj, fq, n; const int i = d & 3;
        if (map == 0) { n = d >> 5; bj = (d >> 4) & 1; fq = (d >> 2) & 3; }
        else if (map == 1) { fq = d >> 4; bj = (d >> 3) & 1; n = (d >> 2) & 1; }
        else { bj = d >> 5; fq = (d >> 3) & 3; n = (d >> 2) & 1; }
        return (size_t)(pn * 256 + 128 * bj + 32 * wc + 8 * fq + 4 * n + i);
    }
};

__device__ __forceinline__ void tjob_store(const TJob& j, const f32x4 (&r)[8], LAS float* scr, int lane) {
    { LAS float* w = scr + (4 * (lane & 7)) * 65 + (lane >> 3);
#pragma unroll
      for (int i = 0; i < 8; ++i) { w[8 * i] = r[i].x; w[65 + 8 * i] = r[i].y; w[130 + 8 * i] = r[i].z; w[195 + 8 * i] = r[i].w; } }
    LDS_WAIT(); asm volatile("" ::: "memory");
    const int c = lane & 7;
#pragma unroll
    for (int jj = 0; jj < 4; ++jj) { const int n = (lane >> 3) + 8 * jj; const LAS float* sp = scr + n * 65 + 8 * c;
        v4u o; o.x = pk2(sp[0], sp[1]); o.y = pk2(sp[2], sp[3]); o.z = pk2(sp[4], sp[5]); o.w = pk2(sp[6], sp[7]);
        const size_t row = j.win ? WinRow{}(j.n0 + n) : j.off + (size_t)n;
        *(GAS v4u*)(j.dst + row * (size_t)j.ldt + j.k0 + 8 * c) = o; }
    LDS_WAIT(); asm volatile("" ::: "memory");
}
template <class Decode>
__device__ __forceinline__ void tjobs_run(int first, int stride, int count, const Decode& decode, LAS float* scr, int lane) {
    TJob cur, nxt; f32x4 ra[8], rb[8];
    int it = first; if (it >= count) return;
    decode(it, cur); tjob_load(cur, ra, lane);
    for (;;) {
        const int itn = it + stride; const bool hn = itn < count;
        if (hn) { decode(itn, nxt); tjob_load(nxt, rb, lane); }
        tjob_store(cur, ra, scr, lane);
        if (!hn) break;
        cur = nxt; it = itn;
        ra[0] = rb[0]; ra[1] = rb[1]; ra[2] = rb[2]; ra[3] = rb[3]; ra[4] = rb[4]; ra[5] = rb[5]; ra[6] = rb[6]; ra[7] = rb[7];
    }
}

struct Ptrs {
    const float *x, *ln0_g, *ln0_b, *w_in, *b_gate, *qn_g, *kn_g, *w_a, *w_b, *w_out, *ln1_g, *ln1_b, *w_router, *w_gate_e, *w_up_e, *w_down_e, *ln2_g, *ln2_b;
    float* out; unsigned char* ws;
};
struct Args { Ptrs p; int ph_lo, ph_hi, li, pad; };
typedef const __attribute__((address_space(4))) Args* KArgsP;
__device__ __forceinline__ KArgsP kargs() { KArgsP k = (KArgsP)__builtin_amdgcn_kernarg_segment_ptr(); asm volatile("" : "+s"(k)); return k; }

__device__ __forceinline__ void sincos_rev(float angle, float& sn, float& cs) {
    const double rev = (double)angle * 0.15915494309189533577; const double fr = rev - __builtin_rint(rev);
    sn = __builtin_amdgcn_sinf((float)fr); cs = __builtin_amdgcn_cosf((float)fr);
}
__device__ __forceinline__ void p0_prologue(Frame& F, KArgsP K) {
    LAS float* scr = (LAS float*)(F.lds + RING_OFF + F.wave * 16384);
    const int gw = F.vcu * NWAVES + F.wave, NGW = F.G * NWAVES;
    bf16* win_t = (bf16*)(K->p.ws + WS_WIN); bf16* wa_t = (bf16*)(K->p.ws + WS_WA); bf16* wb_t = (bf16*)(K->p.ws + WS_WB); bf16* wo_t = (bf16*)(K->p.ws + WS_WO);
    constexpr int I_IN = (1024 / 64) * (5120 / 32), I_A = (512 / 64) * (1024 / 32), I_B = (256 / 64) * (1024 / 32), I_O = (1024 / 64) * (1024 / 32);
    { const float* w_in = K->p.w_in; const float* w_a = K->p.w_a; const float* w_b = K->p.w_b; const float* w_o = K->p.w_out;
      auto decode = [&](int it, TJob& j) {
          int r = it; j.off = 0; j.win = 0;
          if (r < I_IN) { j.src = w_in; j.ldw = 5120; j.dst = win_t; j.ldt = 1024; j.k0 = (r / 160) * 64; j.n0 = (r % 160) * 32; j.win = 1; return; } r -= I_IN;
          if (r < I_A) { j.src = w_a; j.ldw = 1024; j.dst = wa_t; j.ldt = 512; j.k0 = (r / 32) * 64; j.n0 = (r % 32) * 32; j.off = (size_t)j.n0; return; } r -= I_A;
          if (r < I_B) { j.src = w_b; j.ldw = 1024; j.dst = wb_t; j.ldt = 256; j.k0 = (r / 32) * 64; j.n0 = (r % 32) * 32; j.off = (size_t)j.n0; return; } r -= I_B;
          j.src = w_o; j.ldw = 1024; j.dst = wo_t; j.ldt = 1024; j.k0 = (r / 32) * 64; j.n0 = (r % 32) * 32; j.off = (size_t)j.n0; };
      tjobs_run(gw, NGW, I_IN + I_A + I_B + I_O, decode, scr, F.lane); }
    { float* ra = (float*)(K->p.ws + WS_ROPEA); float* rb = (float*)(K->p.ws + WS_ROPEB);
      for (int it = F.vcu * (NWAVES * 64) + F.tid; it < SEQ * 40; it += F.G * NWAVES * 64) {
          const int t = it / 40, r = it - t * 40; float sn, cs;
          if (r < 32) { const int n = r >> 4, f = r & 15; const float pos = n ? (float)(t & 63) : (float)(t >> 6);
              sincos_rev(pos * exp2f(-(float)f * (13.287712379549449f / 16.f)), sn, cs); ra[t * 64 + n * 32 + f] = cs; ra[t * 64 + n * 32 + 16 + f] = sn; }
          else { const int f = r - 32; sincos_rev((float)t * exp2f(-(float)f * (18.931568569324174f / 8.f)), sn, cs); rb[t * 16 + f] = cs; rb[t * 16 + 8 + f] = sn; }
      } }
    bf16* h0b = (bf16*)(K->p.ws + A_H0B); float* st0 = (float*)(K->p.ws + WS_STAT0);
    f32x4 g[4], bb[4];
#pragma unroll
    for (int j = 0; j < 4; ++j) { g[j] = ((const f32x4*)K->p.ln0_g)[F.lane + 64 * j]; bb[j] = ((const f32x4*)K->p.ln0_b)[F.lane + 64 * j]; }
    for (int m = gw; m < MTOK; m += NGW) {
        const GAS f32x4* xr = (const GAS f32x4*)(K->p.x + (size_t)m * DM) + F.lane;
        f32x4 v[4]; float s = 0.f;
#pragma unroll
        for (int j = 0; j < 4; ++j) { v[j] = xr[64 * j]; s += (v[j].x + v[j].y) + (v[j].z + v[j].w); }
        const float mean = wave_sum(s) * (1.f / DM); float s2 = 0.f;
#pragma unroll
        for (int j = 0; j < 4; ++j) { v[j] = v[j] - mean; s2 += (v[j].x * v[j].x + v[j].y * v[j].y) + (v[j].z * v[j].z + v[j].w * v[j].w); }
        const float rstd = 1.f / sqrtf(wave_sum(s2) * (1.f / DM) + LN_EPS);
        GAS unsigned long long* o8 = (GAS unsigned long long*)(h0b + (size_t)m * DM) + F.lane;
#pragma unroll
        for (int j = 0; j < 4; ++j) { const f32x4 y = v[j] * rstd * g[j] + bb[j]; o8[64 * j] = (unsigned long long)pk2(y.x, y.y) | ((unsigned long long)pk2(y.z, y.w) << 32); }
        if (F.lane == 0) { st0[2 * m] = mean; st0[2 * m + 1] = rstd; }
    }
}

__device__ __forceinline__ void p1b_prep(Frame& F, KArgsP K) {
    const int gw = F.vcu * NWAVES + F.wave, NGW = F.G * NWAVES, d = F.lane;
    bf16* qkv = (bf16*)(K->p.ws + A_QKV);
    const float qg = K->p.qn_g[d], kg = K->p.kn_g[d];
    const float invfA = exp2f(-(float)(d & 15) * (13.287712379549449f / 16.f));
    const float invfB = exp2f(-(float)(d & 7) * (18.931568569324174f / 8.f));
    for (int m = gw; m < MTOK; m += NGW) {
        const int t = m & (SEQ - 1);
        const float posA = (d < 32) ? (float)(t >> 6) : (float)(t & 63);
        float snA, csA, snB, csB; sincos_rev(posA * invfA, snA, csA); sincos_rev((float)t * invfB, snB, csB);
        bf16* row = qkv + (size_t)m * QKVW;
#pragma unroll 2
        for (int hh = 0; hh < 10; ++hh) {
            bf16* p = row + (hh < 8 ? OFF_QA + hh * 64 : OFF_KA + (hh - 8) * 64) + d;
            const float x = bf2f(*p); const float ss = wave_sum(x * x);
            const float y = x * (1.0f / sqrtf(ss * (1.f / 64.f) + QK_EPS)) * (hh < 8 ? qg : kg);
            const float yp = __shfl_xor(y, 16);
            float o = (d & 16) ? (y * csA + yp * snA) : (y * csA - yp * snA);
            if (hh < 8) o *= C2;
            *p = (bf16)f2bf(o);
        }
#pragma unroll 2
        for (int hh = 0; hh < 24; ++hh) {
            const bool isq = hh < 12;
            bf16* p = row + (isq ? OFF_QB + hh * 64 : OFF_KB + (hh - 12) * 64) + d;
            const float y = bf2f(*p); const float yp = __shfl_xor(y, 8);
            float o = y;
            if (d < 16) o = (d & 8) ? (y * csB + yp * snB) : (y * csB - yp * snB);
            if (isq) o *= C2;
            if (isq || d < 16) *p = (bf16)f2bf(o);
        }
    }
}

__device__ __forceinline__ void attnA_naive_unit(Frame& F, KArgsP K, int unit) {
    const int b = unit >> 5, h = (unit >> 2) & 7, qc = unit & 3, kvh = h >> 2;
    const bf16* qkv = (const bf16*)(K->p.ws + A_QKV); bf16* attna = (bf16*)(K->p.ws + A_ATTNA);
    const size_t rowq = (size_t)b * SEQ + qc * 512 + F.tid;
    LAS float* Ks = (LAS float*)(F.lds + RING_OFF); LAS float* Vs = Ks + 64 * 64;
    float q[64], o[64];
    { const v4u* qp = (const v4u*)(qkv + rowq * QKVW + OFF_QA + h * 64);
#pragma unroll
      for (int c = 0; c < 8; ++c) { const v4u w = qp[c]; q[8 * c + 0] = pg8::bf_lo(w.x); q[8 * c + 1] = pg8::bf_hi(w.x); q[8 * c + 2] = pg8::bf_lo(w.y); q[8 * c + 3] = pg8::bf_hi(w.y);
          q[8 * c + 4] = pg8::bf_lo(w.z); q[8 * c + 5] = pg8::bf_hi(w.z); q[8 * c + 6] = pg8::bf_lo(w.w); q[8 * c + 7] = pg8::bf_hi(w.w); } }
#pragma unroll
    for (int dd = 0; dd < 64; ++dd) o[dd] = 0.f;
    float mrun = -1e30f, l = 0.f;
    for (int kt = 0; kt < SEQ / 64; ++kt) {
        __syncthreads();
        { const int kr = F.tid >> 3, ch = F.tid & 7; const size_t rk = ((size_t)b * SEQ + kt * 64 + kr) * QKVW;
          const v4u wk = *(const v4u*)(qkv + rk + OFF_KA + kvh * 64 + ch * 8), wv = *(const v4u*)(qkv + rk + OFF_VA + kvh * 64 + ch * 8);
          LAS f32x4* kd = (LAS f32x4*)(Ks + kr * 64 + ch * 8); LAS f32x4* vd = (LAS f32x4*)(Vs + kr * 64 + ch * 8);
          kd[0] = (f32x4){pg8::bf_lo(wk.x), pg8::bf_hi(wk.x), pg8::bf_lo(wk.y), pg8::bf_hi(wk.y)}; kd[1] = (f32x4){pg8::bf_lo(wk.z), pg8::bf_hi(wk.z), pg8::bf_lo(wk.w), pg8::bf_hi(wk.w)};
          vd[0] = (f32x4){pg8::bf_lo(wv.x), pg8::bf_hi(wv.x), pg8::bf_lo(wv.y), pg8::bf_hi(wv.y)}; vd[1] = (f32x4){pg8::bf_lo(wv.z), pg8::bf_hi(wv.z), pg8::bf_lo(wv.w), pg8::bf_hi(wv.w)}; }
        __syncthreads();
        for (int key = 0; key < 64; ++key) {
            const LAS f32x4* kp = (const LAS f32x4*)(Ks + key * 64); const LAS f32x4* vp = (const LAS f32x4*)(Vs + key * 64);
            float s0 = 0.f, s1 = 0.f;
#pragma unroll
            for (int c = 0; c < 16; c += 2) { const f32x4 k0 = kp[c], k1 = kp[c + 1];
                s0 += q[4 * c] * k0.x + q[4 * c + 1] * k0.y + q[4 * c + 2] * k0.z + q[4 * c + 3] * k0.w;
                s1 += q[4 * c + 4] * k1.x + q[4 * c + 5] * k1.y + q[4 * c + 6] * k1.z + q[4 * c + 7] * k1.w; }
            const float s = s0 + s1;
            const float mn = fmaxf(mrun, s); const float a = exp2f(mrun - mn), pw = exp2f(s - mn);
            l = l * a + pw; mrun = mn;
#pragma unroll
            for (int c = 0; c < 16; ++c) { const f32x4 vv = vp[c];
                o[4 * c] = o[4 * c] * a + pw * vv.x; o[4 * c + 1] = o[4 * c + 1] * a + pw * vv.y; o[4 * c + 2] = o[4 * c + 2] * a + pw * vv.z; o[4 * c + 3] = o[4 * c + 3] * a + pw * vv.w; }
        }
    }
    const float rl = 1.0f / l;
    v4u* op = (v4u*)(attna + rowq * 512 + h * 64);
#pragma unroll
    for (int c = 0; c < 8; ++c) { v4u w; w.x = pk2(o[8 * c] * rl, o[8 * c + 1] * rl); w.y = pk2(o[8 * c + 2] * rl, o[8 * c + 3] * rl); w.z = pk2(o[8 * c + 4] * rl, o[8 * c + 5] * rl); w.w = pk2(o[8 * c + 6] * rl, o[8 * c + 7] * rl); op[c] = w; }
}

__device__ __forceinline__ void attnB_naive_unit(Frame& F, KArgsP K, int unit) {
    const int b = unit >> 4, j = (unit >> 2) & 3, qc = unit & 3;
    const bf16* qkv = (const bf16*)(K->p.ws + A_QKV); bf16* ob = (bf16*)(K->p.ws + A_OB);
    const int t = qc * 512 + F.tid; const size_t rowq = (size_t)b * SEQ + t;
    float q[64], o[64];
#pragma unroll
    for (int dd = 0; dd < 64; ++dd) o[dd] = 0.f;
    float mrun = -1e30f, l = 0.f;
    for (int g = 0; g < 3; ++g) {
        const int head = 4 * g + j, dil = (g == 0) ? 1 : (g == 1) ? 4 : 16;
        { const v4u* qp = (const v4u*)(qkv + rowq * QKVW + OFF_QB + head * 64);
#pragma unroll
          for (int c = 0; c < 8; ++c) { const v4u w = qp[c]; q[8 * c + 0] = pg8::bf_lo(w.x); q[8 * c + 1] = pg8::bf_hi(w.x); q[8 * c + 2] = pg8::bf_lo(w.y); q[8 * c + 3] = pg8::bf_hi(w.y);
              q[8 * c + 4] = pg8::bf_lo(w.z); q[8 * c + 5] = pg8::bf_hi(w.z); q[8 * c + 6] = pg8::bf_lo(w.w); q[8 * c + 7] = pg8::bf_hi(w.w); } }
        for (int jj = -64; jj <= 64; ++jj) {
            const int tk = t + jj * dil;
            if (tk < 0 || tk >= SEQ) continue;
            const size_t rk = ((size_t)b * SEQ + tk) * QKVW;
            const v4u* kp = (const v4u*)(qkv + rk + OFF_KB + head * 64); const v4u* vp = (const v4u*)(qkv + rk + OFF_VB + head * 64);
            float s = 0.f;
#pragma unroll
            for (int c = 0; c < 8; ++c) { const v4u w = kp[c];
                s += q[8 * c] * pg8::bf_lo(w.x) + q[8 * c + 1] * pg8::bf_hi(w.x) + q[8 * c + 2] * pg8::bf_lo(w.y) + q[8 * c + 3] * pg8::bf_hi(w.y)
                   + q[8 * c + 4] * pg8::bf_lo(w.z) + q[8 * c + 5] * pg8::bf_hi(w.z) + q[8 * c + 6] * pg8::bf_lo(w.w) + q[8 * c + 7] * pg8::bf_hi(w.w); }
            const float mn = fmaxf(mrun, s); const float a = exp2f(mrun - mn), pw = exp2f(s - mn);
            l = l * a + pw; mrun = mn;
#pragma unroll
            for (int c = 0; c < 8; ++c) { const v4u w = vp[c];
                o[8 * c] = o[8 * c] * a + pw * pg8::bf_lo(w.x); o[8 * c + 1] = o[8 * c + 1] * a + pw * pg8::bf_hi(w.x); o[8 * c + 2] = o[8 * c + 2] * a + pw * pg8::bf_lo(w.y); o[8 * c + 3] = o[8 * c + 3] * a + pw * pg8::bf_hi(w.y);
                o[8 * c + 4] = o[8 * c + 4] * a + pw * pg8::bf_lo(w.z); o[8 * c + 5] = o[8 * c + 5] * a + pw * pg8::bf_hi(w.z); o[8 * c + 6] = o[8 * c + 6] * a + pw * pg8::bf_lo(w.w); o[8 * c + 7] = o[8 * c + 7] * a + pw * pg8::bf_hi(w.w); }
        }
    }
    const float rl = 1.0f / l;
    v4u* op = (v4u*)(ob + rowq * 256 + j * 64);
#pragma unroll
    for (int c = 0; c < 8; ++c) { v4u w; w.x = pk2(o[8 * c] * rl, o[8 * c + 1] * rl); w.y = pk2(o[8 * c + 2] * rl, o[8 * c + 3] * rl); w.z = pk2(o[8 * c + 4] * rl, o[8 * c + 5] * rl); w.w = pk2(o[8 * c + 6] * rl, o[8 * c + 7] * rl); op[c] = w; }
}

__device__ __forceinline__ void p3b_combine(Frame& F, KArgsP K) {
    const bf16* obg = (const bf16*)(K->p.ws + A_OBG); const float* lse = (const float*)(K->p.ws + WS_LSE); bf16* ob = (bf16*)(K->p.ws + A_OB);
    for (int it = F.vcu; it < MTOK / 16; it += F.G) {
        const int m = it * 16 + (F.tid >> 5), ch = F.tid & 31, j = ch >> 3;
        const float l0 = lse[((size_t)0 * MTOK + m) * 4 + j], l1 = lse[((size_t)1 * MTOK + m) * 4 + j], l2 = lse[((size_t)2 * MTOK + m) * 4 + j];
        const float mx = fmaxf(l0, fmaxf(l1, l2)); float w0 = exp2f(l0 - mx), w1 = exp2f(l1 - mx), w2 = exp2f(l2 - mx); const float rs = 1.0f / (w0 + w1 + w2); w0 *= rs; w1 *= rs; w2 *= rs;
        const v4u a = *(const v4u*)(obg + ((size_t)0 * MTOK + m) * 256 + ch * 8), b = *(const v4u*)(obg + ((size_t)1 * MTOK + m) * 256 + ch * 8), c = *(const v4u*)(obg + ((size_t)2 * MTOK + m) * 256 + ch * 8);
        v4u o;
        o.x = pk2(w0 * pg8::bf_lo(a.x) + w1 * pg8::bf_lo(b.x) + w2 * pg8::bf_lo(c.x), w0 * pg8::bf_hi(a.x) + w1 * pg8::bf_hi(b.x) + w2 * pg8::bf_hi(c.x));
        o.y = pk2(w0 * pg8::bf_lo(a.y) + w1 * pg8::bf_lo(b.y) + w2 * pg8::bf_lo(c.y), w0 * pg8::bf_hi(a.y) + w1 * pg8::bf_hi(b.y) + w2 * pg8::bf_hi(c.y));
        o.z = pk2(w0 * pg8::bf_lo(a.z) + w1 * pg8::bf_lo(b.z) + w2 * pg8::bf_lo(c.z), w0 * pg8::bf_hi(a.z) + w1 * pg8::bf_hi(b.z) + w2 * pg8::bf_hi(c.z));
        o.w = pk2(w0 * pg8::bf_lo(a.w) + w1 * pg8::bf_lo(b.w) + w2 * pg8::bf_lo(c.w), w0 * pg8::bf_hi(a.w) + w1 * pg8::bf_hi(b.w) + w2 * pg8::bf_hi(c.w));
        *(v4u*)(ob + (size_t)m * 256 + ch * 8) = o;
    }
}

__device__ __forceinline__ void p5_ln1_router_convert(Frame& F, KArgsP K) {
    const int gw = F.vcu * NWAVES + F.wave, NGW = F.G * NWAVES;
    { LAS float* scr = (LAS float*)(F.lds + RING_OFF + F.wave * 16384);
      bf16* wgu = (bf16*)(K->p.ws + A_WGU); bf16* wd = (bf16*)(K->p.ws + A_WD);
      constexpr int I_G = 16 * 64, I_D = 32 * 32, PER_E = 2 * I_G + I_D;
      const float* wg = K->p.w_gate_e; const float* wu = K->p.w_up_e; const float* wdn = K->p.w_down_e;
      auto decode = [&](int it, TJob& j) {
          const int e = it / PER_E; int r = it - e * PER_E; j.win = 0;
          if (r < 2 * I_G) { const int up = r >= I_G; r -= up * I_G; j.src = (up ? wu : wg) + (size_t)e * DM * DFF; j.ldw = DFF; j.dst = wgu; j.ldt = 1024; j.k0 = (r / 64) * 64; j.n0 = (r % 64) * 32;
              j.off = (size_t)e * 4096 + (j.n0 >> 7) * 256 + up * 128 + (j.n0 & 127); return; }
          r -= 2 * I_G; j.src = wdn + (size_t)e * DFF * DM; j.ldw = DM; j.dst = wd; j.ldt = 2048; j.k0 = (r / 32) * 64; j.n0 = (r % 32) * 32; j.off = (size_t)e * 1024 + j.n0; };
      tjobs_run(gw, NGW, NEXP * PER_E, decode, scr, F.lane); }
    __syncthreads();
    { LAS f32x4* wl = (LAS f32x4*)(F.lds + RING_OFF); const f32x4* wr4 = (const f32x4*)K->p.w_router;
      for (int q = F.tid; q < 1024 * 4; q += NWAVES * 64) { const int col = q >> 2, e4 = q & 3; const int l = (col & 255) >> 2, i = col & 3, j = col >> 8;
          wl[((j * 4 + i) * 4 + e4) * 64 + l] = wr4[q]; } }
    __syncthreads();
    const bf16* mix = (const bf16*)(K->p.ws + A_MIX); bf16* h1b = (bf16*)(K->p.ws + A_H1B); const float* st0 = (const float*)(K->p.ws + WS_STAT0); float* aff = (float*)(K->p.ws + WS_AFF);
    for (int m = gw; m < MTOK; m += NGW) {
        const float mean0 = st0[2 * m], rstd0 = st0[2 * m + 1];
        const GAS f32x4* xr = (const GAS f32x4*)(K->p.x + (size_t)m * DM) + F.lane;
        const GAS u32x2* mr = (const GAS u32x2*)(mix + (size_t)m * DM) + F.lane;
        f32x4 v[4]; float s = 0.f;
#pragma unroll
        for (int j = 0; j < 4; ++j) { const f32x4 xv = xr[64 * j]; const u32x2 mw = mr[64 * j];
            const f32x4 g0 = ((const f32x4*)K->p.ln0_g)[F.lane + 64 * j], b0 = ((const f32x4*)K->p.ln0_b)[F.lane + 64 * j];
            const f32x4 h0 = (xv - mean0) * rstd0 * g0 + b0;
            v[j] = h0 * ALPHA + (f32x4){pg8::bf_lo(mw.x), pg8::bf_hi(mw.x), pg8::bf_lo(mw.y), pg8::bf_hi(mw.y)};
            s += (v[j].x + v[j].y) + (v[j].z + v[j].w); }
        const float mean = wave_sum(s) * (1.f / DM); float s2 = 0.f;
#pragma unroll
        for (int j = 0; j < 4; ++j) { v[j] = v[j] - mean; s2 += (v[j].x * v[j].x + v[j].y * v[j].y) + (v[j].z * v[j].z + v[j].w * v[j].w); }
        const float rstd = 1.f / sqrtf(wave_sum(s2) * (1.f / DM) + LN_EPS);
        GAS f32x4* o4 = (GAS f32x4*)(K->p.out + (size_t)m * DM) + F.lane;
        GAS unsigned long long* o8 = (GAS unsigned long long*)(h1b + (size_t)m * DM) + F.lane;
        float lg[16];
#pragma unroll
        for (int e = 0; e < 16; ++e) lg[e] = 0.f;
#pragma unroll
        for (int j = 0; j < 4; ++j) { const f32x4 g1 = ((const f32x4*)K->p.ln1_g)[F.lane + 64 * j], b1 = ((const f32x4*)K->p.ln1_b)[F.lane + 64 * j];
            const f32x4 y = v[j] * rstd * g1 + b1; v[j] = y;
            o4[64 * j] = y; o8[64 * j] = (unsigned long long)pk2(y.x, y.y) | ((unsigned long long)pk2(y.z, y.w) << 32);
            const LAS f32x4* wl = (const LAS f32x4*)(F.lds + RING_OFF) + F.lane;
            asm volatile("" ::: "memory");
#pragma unroll
            for (int i = 0; i < 4; ++i) { const float yv = y[i];
#pragma unroll
                for (int c = 0; c < 4; ++c) { const f32x4 w = wl[((j * 4 + i) * 4 + c) * 64]; lg[4 * c] += yv * w.x; lg[4 * c + 1] += yv * w.y; lg[4 * c + 2] += yv * w.z; lg[4 * c + 3] += yv * w.w; } } }
#pragma unroll
        for (int e = 0; e < 16; ++e) lg[e] = wave_sum(lg[e]);
        float mx = lg[0];
#pragma unroll
        for (int e = 1; e < 16; ++e) mx = fmaxf(mx, lg[e]);
        float se = 0.f;
#pragma unroll
        for (int e = 0; e < 16; ++e) { lg[e] = expf(lg[e] - mx); se += lg[e]; }
        float mine = 0.f;
#pragma unroll
        for (int e = 0; e < 16; ++e) if (F.lane == e) mine = lg[e] / se;
        if (F.lane < 16) aff[(size_t)m * 16 + F.lane] = mine;
    }
}

__device__ __forceinline__ void p6_topk_unit(Frame& F, KArgsP K, int unit) {
    const int e = unit >> 4, b = unit & 15;
    const float* aff = (const float*)(K->p.ws + WS_AFF); short* inv = (short*)(K->p.ws + WS_INV); int* tok = (int*)(K->p.ws + WS_TOK);
    const bf16* h1b = (const bf16*)(K->p.ws + A_H1B); bf16* xe = (bf16*)(K->p.ws + A_XE);
    LAS unsigned* cnt = (LAS unsigned*)(F.lds + RING_OFF);
    LAS int* ltok = (LAS int*)(F.lds + RING_OFF + 256);
    unsigned key[4];
#pragma unroll
    for (int i = 0; i < 4; ++i) key[i] = __float_as_uint(aff[((size_t)b * SEQ + 4 * F.tid + i) * 16 + e]);
    __syncthreads();
    unsigned thr = 0u;
    for (int bit = 31; bit >= 0; --bit) {
        const unsigned cand = thr | (1u << bit);
        unsigned c = 0;
#pragma unroll
        for (int i = 0; i < 4; ++i) c += (unsigned)__popcll(__ballot(key[i] >= cand));
        LAS unsigned* cb = cnt + ((bit & 1) ? 8 : 0);
        if (F.lane == 0) cb[F.wave] = c;
        __syncthreads();
        unsigned tot = 0;
#pragma unroll
        for (int w = 0; w < 8; ++w) tot += cb[w];
        if (tot >= (unsigned)CAP) thr = cand;
    }
    __syncthreads();
    unsigned cg = 0, ce = 0;
#pragma unroll
    for (int i = 0; i < 4; ++i) { cg += key[i] > thr; ce += key[i] == thr; }
    unsigned pk = cg | (ce << 16), inc = pk;
#pragma unroll
    for (int o = 1; o < 64; o <<= 1) { const unsigned up = __shfl_up(inc, o); if (F.lane >= o) inc += up; }
    if (F.lane == 63) cnt[16 + F.wave] = inc;
    __syncthreads();
    unsigned base = 0, total = 0;
#pragma unroll
    for (int w = 0; w < 8; ++w) { const unsigned tw = cnt[16 + w]; if (w < F.wave) base += tw; total += tw; }
    const unsigned excl = base + inc - pk;
    unsigned pg = excl & 0xffffu, pe = excl >> 16; const unsigned ngt = total & 0xffffu; const unsigned need = (unsigned)CAP - ngt;
#pragma unroll
    for (int i = 0; i < 4; ++i) {
        const int t = 4 * F.tid + i; int slot = -1;
        if (key[i] > thr) { slot = (int)(pg + (pe < need ? pe : need)); ++pg; }
        else if (key[i] == thr) { if (pe < need) slot = (int)(pg + pe); ++pe; }
        inv[((size_t)b * SEQ + t) * 16 + e] = (short)slot;
        if (slot >= 0) { ltok[slot] = t; tok[unit * CAP + slot] = t; }
    }
    __syncthreads();
    for (int c = F.wave; c < CAP; c += NWAVES) {
        const v4u* src = (const v4u*)(h1b + ((size_t)b * SEQ + ltok[c]) * DM); v4u* dst = (v4u*)(xe + ((size_t)unit * CAP + c) * DM);
        const v4u a0 = src[F.lane], a1 = src[F.lane + 64]; dst[F.lane] = a0; dst[F.lane + 64] = a1;
    }
    __syncthreads();
}

__device__ __forceinline__ void p9_final(Frame& F, KArgsP K) {
    const int gw = F.vcu * NWAVES + F.wave, NGW = F.G * NWAVES;
    const float* aff = (const float*)(K->p.ws + WS_AFF); const short* inv = (const short*)(K->p.ws + WS_INV); const bf16* ye = (const bf16*)(K->p.ws + A_YE);
    for (int m = gw; m < MTOK; m += NGW) {
        const int b = m >> 11;
        GAS f32x4* o4 = (GAS f32x4*)(K->p.out + (size_t)m * DM) + F.lane;
        f32x4 v[4];
#pragma unroll
        for (int j = 0; j < 4; ++j) v[j] = o4[64 * j] * ALPHA;
        for (int e = 0; e < NEXP; ++e) {
            const int p = __builtin_amdgcn_readfirstlane((int)inv[(size_t)m * 16 + e]);
            if (p < 0) continue;
            const float gt = aff[(size_t)m * 16 + e];
            const GAS u32x2* yr = (const GAS u32x2*)(ye + ((size_t)(e * 16 + b) * CAP + p) * DM) + F.lane;
#pragma unroll
            for (int j = 0; j < 4; ++j) { const u32x2 w = yr[64 * j]; v[j] += (f32x4){pg8::bf_lo(w.x), pg8::bf_hi(w.x), pg8::bf_lo(w.y), pg8::bf_hi(w.y)} * gt; }
        }
        float s = 0.f;
#pragma unroll
        for (int j = 0; j < 4; ++j) s += (v[j].x + v[j].y) + (v[j].z + v[j].w);
        const float mean = wave_sum(s) * (1.f / DM); float s2 = 0.f;
#pragma unroll
        for (int j = 0; j < 4; ++j) { v[j] = v[j] - mean; s2 += (v[j].x * v[j].x + v[j].y * v[j].y) + (v[j].z * v[j].z + v[j].w * v[j].w); }
        const float rstd = 1.f / sqrtf(wave_sum(s2) * (1.f / DM) + LN_EPS);
#pragma unroll
        for (int j = 0; j < 4; ++j) { const f32x4 g2 = ((const f32x4*)K->p.ln2_g)[F.lane + 64 * j], b2 = ((const f32x4*)K->p.ln2_b)[F.lane + 64 * j]; o4[64 * j] = v[j] * rstd * g2 + b2; }
    }
}

struct OrderUp {
    int hf, vcu;
    __device__ __forceinline__ bool next(int i, pg8::Unit& u) const {
        if (i >= 8) return false;
        const int e = hf * 8 + i, x = vcu >> 5, l = vcu & 31, b = (x >> 1) * 4 + (l & 3), j = (x & 1) * 8 + (l >> 2);
        u.pm = i * 16 + b; u.pn = j; u.am = e * 16 + b; u.bt = e * 16 + j; return true;
    }
    __device__ __forceinline__ void a_ready(const pg8::Unit&) const {}
    __device__ __forceinline__ void done(const pg8::Unit&) const {}
};
struct OrderDown {
    int hf, vcu;
    __device__ __forceinline__ bool next(int i, pg8::Unit& u) const {
        if (i >= 2) return false;
        const int x = vcu >> 5, l = vcu & 31, pml = i * 64 + x * 8 + (l & 7), pn = l >> 3, pmg = hf * 128 + pml;
        u.pm = pmg; u.pn = pn; u.am = pml; u.bt = (pmg >> 4) * 4 + pn; return true;
    }
    __device__ __forceinline__ void a_ready(const pg8::Unit&) const {}
    __device__ __forceinline__ void done(const pg8::Unit&) const {}
};

#ifndef MK_N_LAUNCHES
#define MK_N_LAUNCHES 1
#endif
constexpr int N_PHASES = 13;
#ifndef REP_P0
#define REP_P0 1
#endif
#ifndef REP_P1
#define REP_P1 1
#endif
#ifndef REP_DENSE
#define REP_DENSE 1
#endif
#ifndef REP_BAND
#define REP_BAND 1
#endif
#ifndef REP_WOUT
#define REP_WOUT 1
#endif
#ifndef REP_P6
#define REP_P6 1
#endif
#ifndef REP_TOPK
#define REP_TOPK 1
#endif
#ifndef REP_UP
#define REP_UP 1
#endif
#ifndef REP_DOWN
#define REP_DOWN 1
#endif
#define REPEAT(n) _Pragma("unroll 1") for (int rep_ = 0; rep_ < (n); ++rep_)
__global__ void __launch_bounds__(NWAVES * 64, 2) fwd_kernel(Args args) {
    extern __shared__ __attribute__((aligned(16))) unsigned char lds[];
#define MKFRAME(F) Frame F; { int t_ = threadIdx.x; asm volatile("" : "+v"(t_)); F.lds = (LAS unsigned char*)lds; F.MISC = (volatile LAS unsigned*)(F.lds + MISC_OFF); F.ctl = nullptr; \
        F.tid = t_; F.lane = t_ & 63; F.wave = __builtin_amdgcn_readfirstlane(t_ >> 6); F.G = 256; const int bx_ = blockIdx.x; F.vcu = (bx_ & 7) * 32 + (bx_ >> 3); }
#define BP(off) ((bf16*)(kargs()->p.ws + (off)))
#define SEAM() do { XcdBarrier b_; b_.bar = (unsigned*)(kargs()->p.ws + WS_CTL) + CW_BAR; b_.x = xb_xcc_id(); b_.st = (volatile LAS unsigned*)((LAS unsigned char*)lds + MISC_OFF) + 8; xcd_barrier(b_); } while (0)
    { const int t_ = threadIdx.x;
      for (int u = t_; u < (LDS_BYTES - LDSCTL_OFF) / 4; u += NWAVES * 64) ((LAS unsigned*)((LAS unsigned char*)lds + LDSCTL_OFF))[u] = 0u;
      __syncthreads();
      (void)xcd_barrier_post((unsigned*)(kargs()->p.ws + WS_CTL) + CW_BAR, (volatile LAS unsigned*)((LAS unsigned char*)lds + MISC_OFF) + 8); }

    REPEAT(REP_P0) { MKFRAME(F); p0_prologue(F, kargs()); } SEAM();
    REPEAT(REP_P1) { MKFRAME(F);
      pg8::Gemm g{BP(A_H0B), (const bf16*)(kargs()->p.ws + WS_WIN), MTOK, 5120, 1024}; pg8::StaticOrder S; S.init(MTOK, 5120, 256, (int)blockIdx.x);
      pg8::EpiProj2 E{BP(A_QKV), BP(A_GATES), kargs()->p.b_gate, kargs()->p.qn_g, kargs()->p.kn_g, (const float*)(kargs()->p.ws + WS_ROPEA), (const float*)(kargs()->p.ws + WS_ROPEB)};
      pg8::gemm_phase<pg8::EpiProj2, pg8::StaticOrder, true, true>(F.lds + RING_OFF, g, S, E); } SEAM();
    REPEAT(REP_DENSE) { MKFRAME(F);
#if defined(NAIVE_ATTN_A)
      attnA_naive_unit(F, kargs(), F.vcu); attnA_naive_unit(F, kargs(), F.vcu + 256);
#else
      { const attn_body::bf16* q_ = (const attn_body::bf16*)BP(A_QKV); attn_body::bf16* o_ = (attn_body::bf16*)BP(A_ATTNA);
        const int g = F.vcu >> 3, s = F.vcu & 7, ab = g >> 1, akvh = g & 1;
#pragma unroll 1
        for (int i = 0; i < 4; ++i) attn_body::attn_unit<8>(ab, akvh * 4 + i, akvh, s, q_ + OFF_QA, q_ + OFF_KA, q_ + OFF_VA, o_, (char*)lds + RING_OFF); }
      __syncthreads();
#endif
    }
#if defined(NAIVE_ATTN_B)
    { MKFRAME(F); attnB_naive_unit(F, kargs(), F.vcu); } SEAM();
#else
    REPEAT(REP_BAND) { MKFRAME(F);
#pragma unroll 1
      for (int i = 0; i < 6; ++i) attn_body::band_half_unit(F.vcu + 256 * i, (const attn_body::bf16*)BP(A_QKV), OFF_QB, OFF_KB, OFF_VB, (attn_body::bf16*)BP(A_OBG), (float*)(kargs()->p.ws + WS_LSE), (char*)lds + RING_OFF);
      __syncthreads(); } SEAM();
    { MKFRAME(F); p3b_combine(F, kargs()); }
#endif
    { MKFRAME(F);
      { pg8::Gemm g{BP(A_ATTNA), (const bf16*)(kargs()->p.ws + WS_WA), MTOK, 1024, 512}; pg8::StaticOrder S; S.init(MTOK, 1024, 256, (int)blockIdx.x);
        pg8::EpiGate<false> E{BP(A_MERGED), BP(A_GATES), 0};
        pg8::gemm_phase<pg8::EpiGate<false>, pg8::StaticOrder, true, true>(F.lds + RING_OFF, g, S, E); }
      asm volatile("s_waitcnt vmcnt(0)" ::: "memory"); __syncthreads(); }
#if !defined(NAIVE_ATTN_B)
    SEAM();
#endif
    { MKFRAME(F);
      { pg8::Gemm g{BP(A_OB), (const bf16*)(kargs()->p.ws + WS_WB), MTOK, 1024, 256}; pg8::StaticOrder S; S.init(MTOK, 1024, 256, (int)blockIdx.x);
        pg8::EpiGate<true> E{BP(A_MERGED), BP(A_GATES), 1024};
        pg8::gemm_phase<pg8::EpiGate<true>, pg8::StaticOrder, true, true>(F.lds + RING_OFF, g, S, E); } } SEAM();
    REPEAT(REP_WOUT) { MKFRAME(F);
      pg8::Gemm g{BP(A_MERGED), (const bf16*)(kargs()->p.ws + WS_WO), MTOK, 1024, 1024}; pg8::StaticOrder S; S.init(MTOK, 1024, 256, (int)blockIdx.x);
      pg8::EpiPlain E{BP(A_MIX), 1024};
      pg8::gemm_phase<pg8::EpiPlain, pg8::StaticOrder, true, true>(F.lds + RING_OFF, g, S, E); } SEAM();
    REPEAT(REP_P6) { MKFRAME(F); p5_ln1_router_convert(F, kargs()); } SEAM();
    REPEAT(REP_TOPK) { MKFRAME(F); p6_topk_unit(F, kargs(), F.vcu); } SEAM();
    REPEAT(REP_UP) { MKFRAME(F); pg8::Gemm g{BP(A_XE), (const bf16*)(kargs()->p.ws + A_WGU), 0, 0, 1024}; OrderUp S{0, F.vcu}; pg8::EpiSwiglu E{BP(A_ACT)};
      pg8::gemm_phase<pg8::EpiSwiglu, OrderUp, true, true>(F.lds + RING_OFF, g, S, E); } SEAM();
    REPEAT(REP_DOWN) { MKFRAME(F); pg8::Gemm g{BP(A_ACT), (const bf16*)(kargs()->p.ws + A_WD), 0, 0, 2048}; OrderDown S{0, F.vcu}; pg8::EpiPlain E{BP(A_YE), 1024};
      pg8::gemm_phase<pg8::EpiPlain, OrderDown, true, true>(F.lds + RING_OFF, g, S, E); } SEAM();
    { MKFRAME(F); pg8::Gemm g{BP(A_XE), (const bf16*)(kargs()->p.ws + A_WGU), 0, 0, 1024}; OrderUp S{1, F.vcu}; pg8::EpiSwiglu E{BP(A_ACT)};
      pg8::gemm_phase<pg8::EpiSwiglu, OrderUp, true, true>(F.lds + RING_OFF, g, S, E); } SEAM();
    { MKFRAME(F); pg8::Gemm g{BP(A_ACT), (const bf16*)(kargs()->p.ws + A_WD), 0, 0, 2048}; OrderDown S{1, F.vcu}; pg8::EpiPlain E{BP(A_YE), 1024};
      pg8::gemm_phase<pg8::EpiPlain, OrderDown, true, true>(F.lds + RING_OFF, g, S, E); } SEAM();
    { MKFRAME(F); p9_final(F, kargs()); }
#undef MKFRAME
#undef BP
#undef SEAM
}

extern "C" void kernel_launch(void* const* d_in, const int* in_sizes, int n_in, void* d_out, int out_size, void* d_ws, size_t ws_size, hipStream_t stream) {
    static int grid = 0;
    if (grid == 0) {
        if (n_in != 18 || in_sizes[0] != MTOK * DM || out_size != MTOK * DM || ws_size < WS_END) { fprintf(stderr, "kernel_launch: unexpected shapes / workspace (n_in %d, ws %zu, need %zu)\n", n_in, ws_size, (size_t)WS_END); grid = -1; return; }
        if (hipFuncSetAttribute((const void*)fwd_kernel, hipFuncAttributeMaxDynamicSharedMemorySize, LDS_BYTES) != hipSuccess) { fprintf(stderr, "kernel_launch: hipFuncSetAttribute failed\n"); grid = -1; return; }
        (void)hipGetLastError();
        grid = 256;
    }
    if (grid < 0) return;
    if (hipMemsetAsync((char*)d_ws + WS_CTL, 0, CTL_ZERO_BYTES, stream) != hipSuccess) return;
    Args a{};
    const float** pp = (const float**)&a.p;
    for (int i = 0; i < 18; ++i) pp[i] = (const float*)d_in[i];
    a.p.out = (float*)d_out; a.p.ws = (unsigned char*)d_ws;
    a.ph_lo = 0; a.ph_hi = N_PHASES; a.li = 0;
    hipLaunchKernelGGL(fwd_kernel, dim3(grid), dim3(NWAVES * 64), LDS_BYTES, stream, a);
}
```

```cpp
#include <hip/hip_runtime.h>
#include <cstdio>
#include <cstdint>
constexpr int NWAVES = 8;
constexpr int BATCH = 16, SEQ = 2048, DM = 1024, MTOK = BATCH * SEQ;
constexpr int NEXP = 16, CAP = 256, DFF = 2048, NSLOT = BATCH * NEXP * CAP;
constexpr int QKVW = 3072, GATEW = 2048;
constexpr int OFF_QA = 0, OFF_KA = 512, OFF_VA = 640, OFF_QB = 768, OFF_KB = 1536, OFF_VB = 2304;
constexpr float LN_EPS = 1e-5f, QK_EPS = 1e-6f;
constexpr float ALPHA = 1.189207115002721f;
constexpr float C2 = 0.125f * 1.4426950408889634f;

namespace pg8 {
#define PG8_LAS __attribute__((address_space(3)))
typedef unsigned short bf16_t;
typedef short bf16x8 __attribute__((ext_vector_type(8)));
typedef float f32x4 __attribute__((ext_vector_type(4)));
typedef unsigned u32x4 __attribute__((ext_vector_type(4)));
constexpr int BM = 256, BK = 64, HALF = 128, HTB = HALF * BK * 2  , STAGE_BYTES = 8 * HTB, NXCD = 8, WGM = 8;

__host__ __device__ __forceinline__ int lds_byte(int r, int c) { const int st = (r >> 4) * 2 + (c >> 5), rr = r & 15, cc = c & 31, ob = rr * 64 + cc * 2; return st * 1024 + (ob ^ (((ob >> 9) & 1) << 5)); }
__host__ __device__ __forceinline__ void stage_rc(int b, int& R, int& C) { const int st = b / 1024, sb = b % 1024, swz = sb ^ (((sb >> 9) & 1) << 5); R = (st >> 1) * 16 + swz / 64; C = (st & 1) * 32 + (swz % 64) / 2; }
__host__ __device__ __forceinline__ int perm32(int rho) { const int n = rho >> 4, i = rho & 15; return 8 * (i >> 2) + 4 * n + (i & 3); }

struct Unit { int pm, pn, am, bt; };
struct Gemm { const bf16_t* A; const bf16_t* Bt; int M, N, K; };

struct StaticOrder {
    int nM, nN, nwg, G, c;
    __host__ __device__ void init(int M, int N, int G_, int c_) { nM = M / BM; nN = N / BM; nwg = nM * nN; G = G_; c = c_; }
    __host__ __device__ bool next(int i, Unit& u) const {
        const long L = (long)i * G + c; if (L >= nwg) return false;
        int wgid = (int)L; { const int q = nwg / NXCD, r = nwg % NXCD, xcd = wgid % NXCD, off = wgid / NXCD; wgid = (xcd < r ? xcd * (q + 1) : r * (q + 1) + (xcd - r) * q) + off; }
        const int nig = WGM * nN, gid = wgid / nig, fm = gid * WGM, gsz = (nM - fm) < WGM ? (nM - fm) : WGM;
        u.pm = fm + ((wgid % nig) % gsz); u.pn = (wgid % nig) / gsz; u.am = u.pm; u.bt = u.pn; return true;
    }
    __device__ __forceinline__ void a_ready(const Unit&) const {}
    __device__ __forceinline__ void done(const Unit&) const {}
};

typedef float f32x2_cv __attribute__((ext_vector_type(2))); typedef __bf16 bf16x2_cv __attribute__((ext_vector_type(2)));
__device__ __forceinline__ unsigned cvt_pk_bf16(float lo, float hi) { f32x2_cv v = {lo, hi}; bf16x2_cv b = __builtin_convertvector(v, bf16x2_cv); return __builtin_bit_cast(unsigned, b); }
__device__ __forceinline__ float bf_lo(unsigned w) { return __uint_as_float(w << 16); }
__device__ __forceinline__ float bf_hi(unsigned w) { return __uint_as_float(w & 0xffff0000u); }
__device__ __forceinline__ float sigmoidf_(float x) { return __builtin_amdgcn_rcpf(1.0f + __builtin_amdgcn_exp2f(-1.4426950408889634f * x)); }
__device__ __forceinline__ u32x4 pack8(const f32x4 v0, const f32x4 v1) { u32x4 w; w.x = cvt_pk_bf16(v0[0], v0[1]); w.y = cvt_pk_bf16(v0[2], v0[3]); w.z = cvt_pk_bf16(v1[0], v1[1]); w.w = cvt_pk_bf16(v1[2], v1[3]); return w; }

struct EpiProj {
    static constexpr bool PERM = true, AFTER_DRAIN = false;
    bf16_t* qkv; bf16_t* gates; const float* b_gate;
    __device__ __forceinline__ void operator()(const f32x4 (&acc)[2][2][4][2], const Unit& u, int wr, int wc, int fr, int fq) const {
        const int row0 = u.pm * BM + wr * 64 + fr;
        const bool isg = u.pn >= 12;
        bf16_t* base = isg ? gates : qkv; const int ldc = isg ? 2048 : 3072; const int colt = isg ? (u.pn - 12) * BM : u.pn * BM;
        const int col0 = colt + wc * 32 + 8 * fq;
        f32x4 bv[2][2];
#pragma unroll
        for (int bj = 0; bj < 2; ++bj)
#pragma unroll
            for (int n = 0; n < 2; ++n) bv[bj][n] = isg ? *(const f32x4*)(b_gate + col0 + bj * HALF + 4 * n) : (f32x4){0.f, 0.f, 0.f, 0.f};
#pragma unroll
        for (int ai = 0; ai < 2; ++ai)
#pragma unroll
            for (int m = 0; m < 4; ++m) { bf16_t* rowp = base + (size_t)(row0 + ai * HALF + m * 16) * ldc + col0;
#pragma unroll
                for (int bj = 0; bj < 2; ++bj) { f32x4 v0 = acc[ai][bj][m][0] + bv[bj][0], v1 = acc[ai][bj][m][1] + bv[bj][1];
                    if (isg) {
#pragma unroll
                        for (int i = 0; i < 4; ++i) { v0[i] = sigmoidf_(v0[i]); v1[i] = sigmoidf_(v1[i]); } }
                    *(u32x4*)(rowp + bj * HALF) = pack8(v0, v1); } }
    }
};
struct EpiPlain {
    static constexpr bool PERM = true, AFTER_DRAIN = false;
    bf16_t* O; int ldc;
    __device__ __forceinline__ void operator()(const f32x4 (&acc)[2][2][4][2], const Unit& u, int wr, int wc, int fr, int fq) const {
        const int row0 = u.pm * BM + wr * 64 + fr; const int col0 = u.pn * BM + wc * 32 + 8 * fq;
#pragma unroll
        for (int ai = 0; ai < 2; ++ai)
#pragma unroll
            for (int m = 0; m < 4; ++m) { bf16_t* rowp = O + (size_t)(row0 + ai * HALF + m * 16) * ldc + col0;
#pragma unroll
                for (int bj = 0; bj < 2; ++bj) *(u32x4*)(rowp + bj * HALF) = pack8(acc[ai][bj][m][0], acc[ai][bj][m][1]); }
    }
};
template <bool ACCUM> struct EpiGate {
    static constexpr bool PERM = true, AFTER_DRAIN = false;
    bf16_t* merged; const bf16_t* gates; int goff;
    __device__ __forceinline__ void operator()(const f32x4 (&acc)[2][2][4][2], const Unit& u, int wr, int wc, int fr, int fq) const {
        const int row0 = u.pm * BM + wr * 64 + fr; const int col0 = u.pn * BM + wc * 32 + 8 * fq;
#pragma unroll
        for (int ai = 0; ai < 2; ++ai)
#pragma unroll
            for (int m = 0; m < 4; ++m) { const size_t r = (size_t)(row0 + ai * HALF + m * 16);
#pragma unroll
                for (int bj = 0; bj < 2; ++bj) {
                    const u32x4 g = *(const u32x4*)(gates + r * 2048 + goff + col0 + bj * HALF);
                    f32x4 v0 = acc[ai][bj][m][0], v1 = acc[ai][bj][m][1];
                    v0[0] *= bf_lo(g.x); v0[1] *= bf_hi(g.x); v0[2] *= bf_lo(g.y); v0[3] *= bf_hi(g.y);
                    v1[0] *= bf_lo(g.z); v1[1] *= bf_hi(g.z); v1[2] *= bf_lo(g.w); v1[3] *= bf_hi(g.w);
                    bf16_t* p = merged + r * 1024 + col0 + bj * HALF;
                    if (ACCUM) { const u32x4 o = *(const u32x4*)p;
                        v0[0] += bf_lo(o.x); v0[1] += bf_hi(o.x); v0[2] += bf_lo(o.y); v0[3] += bf_hi(o.y);
                        v1[0] += bf_lo(o.z); v1[1] += bf_hi(o.z); v1[2] += bf_lo(o.w); v1[3] += bf_hi(o.w); }
                    *(u32x4*)p = pack8(v0, v1); } }
    }
};
struct EpiSwiglu {
    static constexpr bool PERM = true, AFTER_DRAIN = false;
    bf16_t* act;
    __device__ __forceinline__ void operator()(const f32x4 (&acc)[2][2][4][2], const Unit& u, int wr, int wc, int fr, int fq) const {
        const int row0 = u.pm * BM + wr * 64 + fr; const int col0 = u.pn * HALF + wc * 32 + 8 * fq;
#pragma unroll
        for (int ai = 0; ai < 2; ++ai)
#pragma unroll
            for (int m = 0; m < 4; ++m) {
                f32x4 v0, v1;
#pragma unroll
                for (int i = 0; i < 4; ++i) { const float g0 = acc[ai][0][m][0][i], g1 = acc[ai][0][m][1][i];
                    v0[i] = g0 * sigmoidf_(g0) * acc[ai][1][m][0][i]; v1[i] = g1 * sigmoidf_(g1) * acc[ai][1][m][1][i]; }
                *(u32x4*)(act + (size_t)(row0 + ai * HALF + m * 16) * 2048 + col0) = pack8(v0, v1); }
    }
};

struct EpiProj2 {
    static constexpr bool PERM = true, AFTER_DRAIN = false;
    bf16_t* qkv; bf16_t* gates; const float* b_gate; const float* qn_g; const float* kn_g; const float* ropeA; const float* ropeB;
    typedef unsigned u32x2_t __attribute__((ext_vector_type(2)));
    __device__ __forceinline__ void operator()(const f32x4 (&acc)[2][2][4][2], const Unit& u, int wr, int wc, int fr, int fq) const {
        const int row0 = u.pm * BM + wr * 64 + fr;
        if (u.pn >= 12) {
            const int col0 = (u.pn - 12) * BM + wc * 32 + 8 * fq;
            f32x4 bv[2][2];
#pragma unroll
            for (int bj = 0; bj < 2; ++bj)
#pragma unroll
                for (int n = 0; n < 2; ++n) bv[bj][n] = *(const f32x4*)(b_gate + col0 + bj * HALF + 4 * n);
#pragma unroll
            for (int ai = 0; ai < 2; ++ai)
#pragma unroll
                for (int m = 0; m < 4; ++m) { bf16_t* rowp = gates + (size_t)(row0 + ai * HALF + m * 16) * 2048 + col0;
#pragma unroll
                    for (int bj = 0; bj < 2; ++bj) { f32x4 v0 = acc[ai][bj][m][0] + bv[bj][0], v1 = acc[ai][bj][m][1] + bv[bj][1];
#pragma unroll
                        for (int i = 0; i < 4; ++i) { v0[i] = sigmoidf_(v0[i]); v1[i] = sigmoidf_(v1[i]); }
                        *(u32x4*)(rowp + bj * HALF) = pack8(v0, v1); } }
            return;
        }
        int kind, colbase;
        if (u.pn < 2) { kind = 0; colbase = OFF_QA + (4 * u.pn + wc) * 64; }
        else if (u.pn == 2) { if (wc < 2) { kind = 1; colbase = OFF_KA + wc * 64; } else { kind = 2; colbase = OFF_VA + (wc - 2) * 64; } }
        else if (u.pn < 6) { kind = 3; colbase = OFF_QB + (4 * (u.pn - 3) + wc) * 64; }
        else if (u.pn < 9) { kind = 4; colbase = OFF_KB + (4 * (u.pn - 6) + wc) * 64; }
        else { kind = 2; colbase = OFF_VB + (4 * (u.pn - 9) + wc) * 64; }
        if (kind <= 1) {
            const float* gn = kind == 0 ? qn_g : kn_g; const float sc = kind == 0 ? C2 : 1.0f;
            f32x4 g[2][2];
#pragma unroll
            for (int bj = 0; bj < 2; ++bj)
#pragma unroll
                for (int n = 0; n < 2; ++n) g[bj][n] = *(const f32x4*)(gn + 32 * n + 16 * bj + 4 * fq) * sc;
#pragma unroll
            for (int ai = 0; ai < 2; ++ai)
#pragma unroll
                for (int m = 0; m < 4; ++m) { const int row = row0 + ai * HALF + m * 16; const float* ta = ropeA + (size_t)(row & (SEQ - 1)) * 64 + 4 * fq;
                    float ss = 0.f;
#pragma unroll
                    for (int bj = 0; bj < 2; ++bj)
#pragma unroll
                        for (int n = 0; n < 2; ++n) { const f32x4 x = acc[ai][bj][m][n]; ss += (x[0] * x[0] + x[1] * x[1]) + (x[2] * x[2] + x[3] * x[3]); }
                    ss += __shfl_xor(ss, 16); ss += __shfl_xor(ss, 32);
                    const float rs = 1.0f / sqrtf(ss * (1.0f / 64.0f) + QK_EPS);
                    bf16_t* rowp = qkv + (size_t)row * QKVW + colbase + 4 * fq;
#pragma unroll
                    for (int n = 0; n < 2; ++n) { const f32x4 cs = *(const f32x4*)(ta + n * 32), sn = *(const f32x4*)(ta + n * 32 + 16);
                        const f32x4 x1 = acc[ai][0][m][n] * rs * g[0][n], x2 = acc[ai][1][m][n] * rs * g[1][n];
                        const f32x4 o1 = x1 * cs - x2 * sn, o2 = x2 * cs + x1 * sn;
                        u32x2_t w1, w2; w1.x = cvt_pk_bf16(o1[0], o1[1]); w1.y = cvt_pk_bf16(o1[2], o1[3]); w2.x = cvt_pk_bf16(o2[0], o2[1]); w2.y = cvt_pk_bf16(o2[2], o2[3]);
                        *(u32x2_t*)(rowp + 32 * n) = w1; *(u32x2_t*)(rowp + 32 * n + 16) = w2; } }
        } else if (kind == 2) {
#pragma unroll
            for (int ai = 0; ai < 2; ++ai)
#pragma unroll
                for (int m = 0; m < 4; ++m) { bf16_t* rowp = qkv + (size_t)(row0 + ai * HALF + m * 16) * QKVW + colbase + 8 * fq;
#pragma unroll
                    for (int bj = 0; bj < 2; ++bj) *(u32x4*)(rowp + 32 * bj) = pack8(acc[ai][bj][m][0], acc[ai][bj][m][1]); }
        } else {
            const float sc = kind == 3 ? C2 : 1.0f;
#pragma unroll
            for (int ai = 0; ai < 2; ++ai)
#pragma unroll
                for (int m = 0; m < 4; ++m) { const int row = row0 + ai * HALF + m * 16; const float* tb = ropeB + (size_t)(row & (SEQ - 1)) * 16;
                    f32x4 a0 = acc[ai][0][m][0], a1 = acc[ai][0][m][1], b0 = acc[ai][1][m][0], b1 = acc[ai][1][m][1];
                    if (fq == 0) { const f32x4 c0 = *(const f32x4*)(tb), c1 = *(const f32x4*)(tb + 4), s0 = *(const f32x4*)(tb + 8), s1 = *(const f32x4*)(tb + 12);
                        const f32x4 o0 = a0 * c0 - b0 * s0, p0 = b0 * c0 + a0 * s0, o1 = a1 * c1 - b1 * s1, p1 = b1 * c1 + a1 * s1; a0 = o0; b0 = p0; a1 = o1; b1 = p1; }
                    a0 = a0 * sc; a1 = a1 * sc; b0 = b0 * sc; b1 = b1 * sc;
                    bf16_t* rowp = qkv + (size_t)row * QKVW + colbase + 16 * fq;
                    *(u32x4*)(rowp) = pack8(a0, a1); *(u32x4*)(rowp + 8) = pack8(b0, b1); }
        }
    }
};
template <class Epi, class Sched, bool ALIGN_EPI = false, bool SP2 = false>
__device__ __forceinline__ void gemm_phase(PG8_LAS unsigned char* lds, const Gemm g, const Sched& S, const Epi& E) {
    int tid_ = threadIdx.x; asm volatile("" : "+v"(tid_));
    const int tid = tid_, wid = __builtin_amdgcn_readfirstlane(tid >> 6), lane = tid & 63, wr = wid >> 2, wc = wid & 3, fr = lane & 15, fq = lane >> 4;
    const int K = g.K, nt = K / BK;
    unsigned voffA[2], voffB[2];
#pragma unroll
    for (int i = 0; i < 2; ++i) { int R, C; stage_rc(tid * 16 + i * 8192, R, C); const int Rb = Epi::PERM ? ((R & ~31) + perm32(R & 31)) : R;
        voffA[i] = (unsigned)(R * K + C) * 2u; voffB[i] = (unsigned)(Rb * K + C) * 2u; }
    const size_t kstep = (size_t)(BK * 2);
    const size_t hstep = (size_t)HALF * K * 2;
    const size_t tstep = 2 * hstep;
    const unsigned ldsw = (unsigned)wid * 1024u;
    const int aoff = lds_byte(wr * 64 + fr, fq * 8), boff = lds_byte(wc * 32 + fr, fq * 8);
#define PG8_SA(b, h) (((b) * 2 + (h)) * HTB)
#define PG8_SB(b, h) ((4 + (b) * 2 + (h)) * HTB)
#define PG8_STAGE(bufoff, gbase, voff) do { _Pragma("unroll") for (int _i = 0; _i < 2; ++_i) \
        __builtin_amdgcn_global_load_lds((const unsigned*)((const char*)(gbase) + (voff)[_i]), (PG8_LAS unsigned*)(lds + (bufoff) + ldsw + _i * 8192), 16, 0, 0); } while (0)
#define PG8_LDA(dst, b, h) do { _Pragma("unroll") for (int m = 0; m < 4; ++m) _Pragma("unroll") for (int k = 0; k < 2; ++k) dst[m][k] = *(const PG8_LAS bf16x8*)(lds + PG8_SA(b, h) + aoff + m * 2048 + k * 1024); } while (0)
#define PG8_LDB(dst, b, h) do { _Pragma("unroll") for (int n = 0; n < 2; ++n) _Pragma("unroll") for (int k = 0; k < 2; ++k) dst[n][k] = *(const PG8_LAS bf16x8*)(lds + PG8_SB(b, h) + boff + n * 2048 + k * 1024); } while (0)
#define PG8_MMA(ai, bj, At, Bt) do { __builtin_amdgcn_s_setprio(1); _Pragma("unroll") for (int m = 0; m < 4; ++m) _Pragma("unroll") for (int n = 0; n < 2; ++n) _Pragma("unroll") for (int k = 0; k < 2; ++k) \
        acc[ai][bj][m][n] = __builtin_amdgcn_mfma_f32_16x16x32_bf16(Bt[n][k], At[m][k], acc[ai][bj][m][n], 0, 0, 0); __builtin_amdgcn_s_setprio(0); } while (0)
#define PG8_WAIT_V(n) asm volatile("s_waitcnt vmcnt(" #n ")" ::: "memory")
#define PG8_WAIT_L(n) asm volatile("s_waitcnt lgkmcnt(" #n ")" ::: "memory")
#define PG8_BAR __builtin_amdgcn_s_barrier()
#define PG8_SCHED __builtin_amdgcn_sched_barrier(0)
    Unit cur, nxt; int ui = 0;
    if (!S.next(0, cur)) return;
    f32x4 acc[2][2][4][2];
#pragma unroll
    for (int a = 0; a < 2; ++a)
#pragma unroll
        for (int b = 0; b < 2; ++b)
#pragma unroll
            for (int m = 0; m < 4; ++m)
#pragma unroll
                for (int n = 0; n < 2; ++n) acc[a][b][m][n] = (f32x4){0.f, 0.f, 0.f, 0.f};
    bf16x8 At[4][2], B0[2][2], B1[2][2];
    const char* cA = (const char*)g.A + (size_t)cur.am * tstep; const char* cB = (const char*)g.Bt + (size_t)cur.bt * tstep;
    S.a_ready(cur);
    if constexpr (SP2) {
        PG8_STAGE(PG8_SB(0, 0), cB, voffB); PG8_STAGE(PG8_SB(0, 1), cB + hstep, voffB); PG8_STAGE(PG8_SA(0, 0), cA, voffA); PG8_STAGE(PG8_SA(0, 1), cA + hstep, voffA);
        if (wr == 1) PG8_BAR;
        PG8_WAIT_V(2); PG8_BAR;
        PG8_STAGE(PG8_SB(1, 0), cB + kstep, voffB); PG8_STAGE(PG8_SA(1, 0), cA + kstep, voffA); PG8_STAGE(PG8_SB(1, 1), cB + hstep + kstep, voffB);
        PG8_WAIT_V(6); PG8_BAR;
    } else {
        PG8_STAGE(PG8_SB(0, 0), cB, voffB); PG8_STAGE(PG8_SA(0, 0), cA, voffA); PG8_STAGE(PG8_SB(0, 1), cB + hstep, voffB); PG8_STAGE(PG8_SA(0, 1), cA + hstep, voffA);
        if (wr == 1) PG8_BAR;
        PG8_WAIT_V(4); PG8_BAR;
        PG8_STAGE(PG8_SB(1, 0), cB + kstep, voffB); PG8_STAGE(PG8_SA(1, 0), cA + kstep, voffA); PG8_STAGE(PG8_SB(1, 1), cB + hstep + kstep, voffB);
        PG8_WAIT_V(6); PG8_BAR;
    }
    for (;;) {
        const bool has_next = S.next(ui + 1, nxt);
        const char* nA = has_next ? (const char*)g.A + (size_t)nxt.am * tstep : cA; const char* nB = has_next ? (const char*)g.Bt + (size_t)nxt.bt * tstep : cB;
        for (int t = 0; t < nt; t += 2) {
            const bool last = (t == nt - 2);
            const char* a1 = cA + (size_t)(t + 1) * kstep;
            const char* a2 = last ? nA : cA + (size_t)(t + 2) * kstep; const char* b2 = last ? nB : cB + (size_t)(t + 2) * kstep;
            const char* a3 = a2 + kstep; const char* b3 = b2 + kstep;
            if (last && has_next) S.a_ready(nxt);
            if constexpr (SP2) {
            PG8_LDB(B0, 0, 0); PG8_LDB(B1, 0, 1); PG8_SCHED; PG8_LDA(At, 0, 0); PG8_STAGE(PG8_SA(1, 1), a1 + hstep, voffA);
            PG8_WAIT_V(8); PG8_WAIT_L(0); PG8_BAR; PG8_MMA(0, 0, At, B0); PG8_MMA(0, 1, At, B1); PG8_BAR; PG8_SCHED;
            PG8_LDA(At, 0, 1); PG8_STAGE(PG8_SB(0, 0), b2, voffB); PG8_STAGE(PG8_SB(0, 1), b2 + hstep, voffB); PG8_STAGE(PG8_SA(0, 0), a2, voffA);
            PG8_WAIT_V(8); PG8_WAIT_L(0); PG8_BAR; PG8_MMA(1, 0, At, B0); PG8_MMA(1, 1, At, B1); PG8_BAR; PG8_SCHED;
            PG8_LDB(B0, 1, 0); PG8_LDB(B1, 1, 1); PG8_SCHED; PG8_LDA(At, 1, 0); PG8_STAGE(PG8_SA(0, 1), a2 + hstep, voffA);
            PG8_WAIT_V(8); PG8_WAIT_L(0); PG8_BAR; PG8_MMA(0, 0, At, B0); PG8_MMA(0, 1, At, B1); PG8_BAR; PG8_SCHED;
            PG8_LDA(At, 1, 1); PG8_STAGE(PG8_SB(1, 0), b3, voffB); PG8_STAGE(PG8_SB(1, 1), b3 + hstep, voffB); PG8_STAGE(PG8_SA(1, 0), a3, voffA);
            PG8_WAIT_V(8); PG8_WAIT_L(0); PG8_BAR; PG8_MMA(1, 0, At, B0); PG8_MMA(1, 1, At, B1); PG8_BAR; PG8_SCHED;
            } else {
            PG8_LDB(B0, 0, 0); PG8_SCHED; PG8_LDA(At, 0, 0); PG8_STAGE(PG8_SA(1, 1), a1 + hstep, voffA);
            PG8_WAIT_L(8); PG8_BAR; PG8_WAIT_L(0); PG8_MMA(0, 0, At, B0); PG8_BAR; PG8_SCHED;
            PG8_LDB(B1, 0, 1); PG8_STAGE(PG8_SB(0, 0), b2, voffB);
            PG8_BAR; PG8_WAIT_L(0); PG8_MMA(0, 1, At, B1); PG8_BAR;
            PG8_LDA(At, 0, 1); PG8_STAGE(PG8_SA(0, 0), a2, voffA);
            PG8_BAR; PG8_WAIT_L(0); PG8_MMA(1, 0, At, B0); PG8_BAR; PG8_SCHED;
            PG8_STAGE(PG8_SB(0, 1), b2 + hstep, voffB);
            PG8_WAIT_V(6); PG8_BAR; PG8_MMA(1, 1, At, B1); PG8_BAR;
            PG8_LDB(B0, 1, 0); PG8_SCHED; PG8_LDA(At, 1, 0); PG8_STAGE(PG8_SA(0, 1), a2 + hstep, voffA);
            PG8_WAIT_L(8); PG8_BAR; PG8_WAIT_L(0); PG8_MMA(0, 0, At, B0); PG8_BAR; PG8_SCHED;
            PG8_LDB(B1, 1, 1); PG8_STAGE(PG8_SB(1, 0), b3, voffB);
            PG8_BAR; PG8_WAIT_L(0); PG8_MMA(0, 1, At, B1); PG8_BAR;
            PG8_LDA(At, 1, 1); PG8_STAGE(PG8_SA(1, 0), a3, voffA);
            PG8_BAR; PG8_WAIT_L(0); PG8_MMA(1, 0, At, B0); PG8_BAR; PG8_SCHED;
            PG8_STAGE(PG8_SB(1, 1), b3 + hstep, voffB);
            PG8_WAIT_V(6); PG8_BAR; PG8_MMA(1, 1, At, B1); PG8_BAR;
            }
        }
        if constexpr (ALIGN_EPI) { if (wr == 0) PG8_BAR; }
        if constexpr (!Epi::AFTER_DRAIN) { E(acc, cur, wr, wc, fr, fq); S.done(cur); }
        if (!has_next) break;
#pragma unroll
        for (int a = 0; a < 2; ++a)
#pragma unroll
            for (int b = 0; b < 2; ++b)
#pragma unroll
                for (int m = 0; m < 4; ++m)
#pragma unroll
                    for (int n = 0; n < 2; ++n) acc[a][b][m][n] = (f32x4){0.f, 0.f, 0.f, 0.f};
        cur = nxt; cA = nA; cB = nB; ++ui;
        if constexpr (ALIGN_EPI) { if (wr == 1) PG8_BAR; }
    }
    PG8_WAIT_V(0);
    if constexpr (!ALIGN_EPI) { if (wr == 0) PG8_BAR; }
    PG8_BAR;
    if constexpr (Epi::AFTER_DRAIN) { E.fused(acc, cur, wr, wc, fr, fq, lds, wid, lane); S.done(cur); }
#undef PG8_SA
#undef PG8_SB
#undef PG8_STAGE
#undef PG8_LDA
#undef PG8_LDB
#undef PG8_MMA
#undef PG8_WAIT_V
#undef PG8_WAIT_L
#undef PG8_BAR
#undef PG8_SCHED
}
}
#include <hip/hip_bf16.h>
#include <cmath>
namespace attn_body {
using bf16=__hip_bfloat16;
using bf16x8=__attribute__((ext_vector_type(8)))short;
using s16x4=__attribute__((ext_vector_type(4)))short;
using f32x16=__attribute__((ext_vector_type(16)))float;
using u32x4=__attribute__((ext_vector_type(4)))unsigned;
constexpr int BATCH=16,NHEAD=8,SEQ=2048,D=64,PQ=3072,PO=512;
constexpr int NW=8,QBLK=32,QB=QBLK*NW,KVBLK=64,NQB=SEQ/QB;
constexpr int ATTN_UNIT_ROWS=QB;
__device__ __forceinline__ int crow(int r,int hi){return (r&3)+8*(r>>2)+4*hi;}
#define SBAR() __builtin_amdgcn_sched_barrier(0)
__device__ __forceinline__ void cmask(f32x16&p0,f32x16&p1,int jb,int qrel,int hi){
  const float NEG=-INFINITY; int kb=64*jb+4*hi;
  #pragma unroll
  for(int r=0;r<16;++r){int kv=kb+(r&3)+8*(r>>2); if(kv>qrel)p0[r]=NEG; if(kv+32>qrel)p1[r]=NEG;}
}

constexpr int NSLOT=3, SLOTB=8192;
constexpr int LDS_K=0, LDS_V=NSLOT*SLOTB, LDS_WS=2*NSLOT*SLOTB, LDS_OST=LDS_WS+NW*64*4, LDS_BYTES=LDS_OST+NW*4096;
constexpr float C2=0.125f*1.4426950408889634f;
__device__ __forceinline__ void glds16(const void*gsrc,unsigned lds_dst){unsigned keep;
  asm volatile("s_mov_b32 %0, m0\n\ts_mov_b32 m0, %2\n\ts_nop 0\n\tglobal_load_lds_dwordx4 %1, off\n\ts_mov_b32 m0, %0":"=&s"(keep):"v"(gsrc),"s"(lds_dst):"memory");}
__device__ __forceinline__ float max3f(float a,float b,float c){float r;asm("v_max3_f32 %0, %1, %2, %3":"=v"(r):"v"(a),"v"(b),"v"(c));return r;}
__device__ __forceinline__ float max2f(float a,float b){float r;asm("v_max_f32_e32 %0, %1, %2":"=v"(r):"v"(a),"v"(b));return r;}
__device__ __forceinline__ float fadd_s(float a,float b){float r;asm("v_add_f32_e32 %0, %1, %2":"=v"(r):"v"(a),"v"(b));return r;}
__device__ __forceinline__ float fsub_s(float a,float b){float r;asm("v_sub_f32_e32 %0, %1, %2":"=v"(r):"v"(a),"v"(b));return r;}
typedef float f32x2_t __attribute__((ext_vector_type(2))); typedef __bf16 bf16x2_t __attribute__((ext_vector_type(2)));
__device__ __forceinline__ unsigned cvtpk_s(float lo,float hi){f32x2_t v={lo,hi};bf16x2_t b=__builtin_convertvector(v,bf16x2_t);return __builtin_bit_cast(unsigned,b);}
#define WAIT_BAR(N) asm volatile("s_waitcnt vmcnt(" #N ") lgkmcnt(0)\n\ts_barrier":::"memory")

__device__ __forceinline__ void qkt(f32x16&p0,f32x16&p1,const char*Kslot,const bf16x8*qr,const f32x16&negm,int r32,int hi){
  const char*kb=Kslot+hi*1024+r32*16;
  #pragma unroll
  for(int d0=0;d0<4;++d0){
    const bf16x8 b0=*reinterpret_cast<const bf16x8*>(kb+d0*2048);
    const bf16x8 b1=*reinterpret_cast<const bf16x8*>(kb+d0*2048+512);
    if(d0==0){p0=__builtin_amdgcn_mfma_f32_32x32x16_bf16(b0,qr[0],negm,0,0,0);p1=__builtin_amdgcn_mfma_f32_32x32x16_bf16(b1,qr[0],negm,0,0,0);}
    else{p0=__builtin_amdgcn_mfma_f32_32x32x16_bf16(b0,qr[d0],p0,0,0,0);p1=__builtin_amdgcn_mfma_f32_32x32x16_bf16(b1,qr[d0],p1,0,0,0);}}
}
typedef __attribute__((address_space(3))) const char* lds_cptr;
typedef short v4i16_t __attribute__((ext_vector_type(4)));
__device__ __forceinline__ void kload8(bf16x8*kf,lds_cptr kp){
  kf[0]=*(const __attribute__((address_space(3))) bf16x8*)(kp);      kf[1]=*(const __attribute__((address_space(3))) bf16x8*)(kp+512);
  kf[2]=*(const __attribute__((address_space(3))) bf16x8*)(kp+2048); kf[3]=*(const __attribute__((address_space(3))) bf16x8*)(kp+2560);
  kf[4]=*(const __attribute__((address_space(3))) bf16x8*)(kp+4096); kf[5]=*(const __attribute__((address_space(3))) bf16x8*)(kp+4608);
  kf[6]=*(const __attribute__((address_space(3))) bf16x8*)(kp+6144); kf[7]=*(const __attribute__((address_space(3))) bf16x8*)(kp+6656);
}
__device__ __forceinline__ void kload2(bf16x8*kf,lds_cptr kp,int j){ kf[2*j]=*(const __attribute__((address_space(3))) bf16x8*)(kp+j*2048); kf[2*j+1]=*(const __attribute__((address_space(3))) bf16x8*)(kp+j*2048+512); }
__device__ __forceinline__ s16x4 vtr(lds_cptr p){ return __builtin_bit_cast(s16x4,__builtin_amdgcn_ds_read_tr16_b64_v4i16((__attribute__((address_space(3))) v4i16_t*)p)); }
__device__ __forceinline__ float rowmax(const f32x16&p0,const f32x16&p1){
  float a=max3f(p0[0],p0[1],p1[0]),b=max3f(p0[2],p0[3],p1[1]);a=max3f(a,p1[2],p1[3]);
  #pragma unroll
  for(int r=4;r<16;r+=4){a=max3f(a,p0[r],p0[r+1]);b=max3f(b,p0[r+2],p0[r+3]);a=max3f(a,p1[r],p1[r+1]);b=max3f(b,p1[r+2],p1[r+3]);}
  const float m=max2f(a,b);
  auto rr=__builtin_amdgcn_permlane32_swap(__float_as_uint(m),__float_as_uint(m),false,false);
  return max2f(__uint_as_float(rr[0]),__uint_as_float(rr[1]));
}
__device__ __forceinline__ void pv(f32x16*o,int vb,bf16x8 pa0,bf16x8 pa1,bf16x8 pa2,bf16x8 pa3){
  #pragma unroll
  for(int d0=0;d0<2;++d0){s16x4 lo[4],hi[4];
    #pragma unroll
    for(int ks=0;ks<4;++ks){
      asm volatile("ds_read_b64_tr_b16 %0,%1 offset:%c2":"=&v"(lo[ks]):"v"(vb),"i"(d0*4096+ks*1024):"memory");
      asm volatile("ds_read_b64_tr_b16 %0,%1 offset:%c2":"=&v"(hi[ks]):"v"(vb),"i"(d0*4096+ks*1024+512):"memory");}
    asm volatile("s_waitcnt lgkmcnt(0)":::"memory");SBAR();
    #define PK(k) (bf16x8){lo[k][0],lo[k][1],lo[k][2],lo[k][3],hi[k][0],hi[k][1],hi[k][2],hi[k][3]}
    o[d0]=__builtin_amdgcn_mfma_f32_32x32x16_bf16(pa0,PK(0),o[d0],0,0,0);
    o[d0]=__builtin_amdgcn_mfma_f32_32x32x16_bf16(pa1,PK(1),o[d0],0,0,0);
    o[d0]=__builtin_amdgcn_mfma_f32_32x32x16_bf16(pa2,PK(2),o[d0],0,0,0);
    o[d0]=__builtin_amdgcn_mfma_f32_32x32x16_bf16(pa3,PK(3),o[d0],0,0,0);
    #undef PK
  }
}

#ifndef ATTN_STORE16
#define ATTN_STORE16(p,v) (*(u32x4*)(p)=(v))
#endif
template<int THRL> __device__ __forceinline__ void attn_unit(int b,int h,int kvh,int qb,const bf16*Q,const bf16*__restrict__ K,const bf16*__restrict__ V,bf16*O,char*shm){
  int tid_=threadIdx.x; asm volatile("":"+v"(tid_)); const int tid=tid_,lane=tid&63,r32=lane&31,hi=lane>>5; const int wid=__builtin_amdgcn_readfirstlane(tid>>6);
  const long rowbase=(long)b*SEQ; const int q0=qb*QB;
  const bf16*Qw=Q+(rowbase+q0+wid*QBLK)*PQ+h*D;
  const bf16*Kh=K+rowbase*PQ+kvh*D,*Vh=V+rowbase*PQ+kvh*D;
  const unsigned lds0=(unsigned)(uintptr_t)shm;
  float*wsf=(float*)(shm+LDS_WS)+wid*64;
  const bf16*ksrc=Kh+(long)lane*PQ+wid*8;
  const bf16*vsrc=Vh+(long)(16*(wid&3)+(lane>>2))*PQ+(wid>>2)*32+(lane&3)*8;
  const unsigned kdst=lds0+LDS_K+wid*1024, vdst=lds0+LDS_V+wid*1024;
  #define DMA_K(t,slot) glds16(ksrc+(long)(t)*KVBLK*PQ,(unsigned)__builtin_amdgcn_readfirstlane(kdst+(slot)))
  #define DMA_V(t,slot) glds16(vsrc+(long)(t)*KVBLK*PQ,(unsigned)__builtin_amdgcn_readfirstlane(vdst+(slot)))
  const int vb0=(int)(lds0+LDS_V)+((lane>>4)&1)*32+(lane&3)*8+(4*hi+((lane&15)>>2))*64;
  const char*Kbase=shm+LDS_K; bf16x8 kf[8];
  const lds_cptr shm3=(lds_cptr)shm; const lds_cptr kp0=shm3+LDS_K+hi*1024+r32*16; const lds_cptr vp0=shm3+LDS_V+((lane>>4)&1)*32+(lane&3)*8+(4*hi+((lane&15)>>2))*64;
  constexpr int NT=SEQ/KVBLK;
  DMA_K(0,0);DMA_V(0,0);DMA_K(1,SLOTB);
  bf16x8 qr[4];
  #pragma unroll
  for(int d0=0;d0<4;++d0)qr[d0]=*reinterpret_cast<const bf16x8*>(&Qw[(long)r32*PQ+d0*16+hi*8]);
  float mhat=0.f,l_reg=0.f;f32x16 o[2];o[0]=f32x16{};o[1]=f32x16{};f32x16 negm=f32x16{};asm volatile("":"+v"(negm));

  #define CMASK(P0,P1,t) do{}while(0)
  bool resc=false;
  #define START(P0,P1) do{ const float rm=rowmax(P0,P1); resc=false; \
    { const float dl=rm; mhat=fadd_s(mhat,dl); \
      _Pragma("unroll") for(int r=0;r<16;++r){P0[r]=fsub_s(P0[r],dl);P1[r]=fsub_s(P1[r],dl);} \
      _Pragma("unroll") for(int r=0;r<16;++r)negm[r]=-mhat; asm volatile("":"+v"(negm)); } \
    _Pragma("unroll") for(int r=0;r<16;++r)P0[r]=__builtin_amdgcn_exp2f(P0[r]); }while(0)
  #define RESC() do{ if(resc){ asm volatile("s_waitcnt lgkmcnt(0)":::"memory"); \
      _Pragma("unroll") for(int d_=0;d_<2;++d_) _Pragma("unroll") for(int r=0;r<16;++r)o[d_][r]*=wsf[crow(r,hi)]; } }while(0)
  f32x16 pA0,pA1,pB0,pB1;
  int sl_prev=0,sl_cur=0,sl_next=SLOTB;
  #define ROT() do{sl_prev=sl_cur;sl_cur=sl_next;sl_next=(sl_next==(NSLOT-1)*SLOTB)?0:sl_next+SLOTB;}while(0)
  DMA_K(2,2*SLOTB);
  WAIT_BAR(3);
  qkt(pA0,pA1,Kbase,qr,negm,r32,hi);asm volatile("s_nop 15\n\ts_nop 7":"+v"(pA0),"+v"(pA1));CMASK(pA0,pA1,0);
  START(pA0,pA1);
  _Pragma("unroll") for(int r=0;r<16;++r)pA1[r]=__builtin_amdgcn_exp2f(pA1[r]);
  WAIT_BAR(0);
  DMA_K(3,0);DMA_V(1,SLOTB);
  ROT();
  kload8(kf,kp0+sl_cur);
  WAIT_BAR(2);
  s16x4 vlo[8],vhi[8]; u32x4 pw0,pw1,pw2,pw3;
  #define PKW(P,B) cvtpk_s(P[B],P[B+1])
  #define PAF(k) __builtin_bit_cast(bf16x8,pw##k)
  #define VFR(i) (bf16x8){vlo[i][0],vlo[i][1],vlo[i][2],vlo[i][3],vhi[i][0],vhi[i][1],vhi[i][2],vhi[i][3]}
  #define PIN(x) asm volatile("":"+v"(x))
  #define MX3(a,b,c) __builtin_fmaxf(__builtin_fmaxf((a),(b)),(c))
  #define GAPA(MF,A0,A1,A2,A3,W0,W1,PW) do{ MF; sacc+=A0; sacc+=A1; sacc+=A2; sacc+=A3; PIN(sacc); W0; W1; PIN(PW); SBAR(); }while(0)
  #define EX(v) __builtin_amdgcn_exp2f(v)
  #define GAPB(MF,X,B) do{ MF; X[B]=EX(X[B]); X[B+1]=EX(X[B+1]); X[B+2]=EX(X[B+2]); X[B+3]=EX(X[B+3]); PIN(X); SBAR(); }while(0)
  #define VRD(i) do{ vlo[i]=vtr(vp_+(((i)>>2)*4096+((i)&3)*1024)); vhi[i]=vtr(vp_+(((i)>>2)*4096+((i)&3)*1024+512)); }while(0)
  #define KRD(G,j) do{ if(G){ kload2(kf,kp0+sl_next,j); SBAR(); } }while(0)
  #define STEP(C0,C1,P0,P1,t,GK,GV,GL) do{ SBAR(); \
    const lds_cptr vp_=vp0+sl_prev; \
    VRD(0); SBAR(); float sacc=(P0[0]+P0[1]); \
    GAPA(C0=__builtin_amdgcn_mfma_f32_32x32x16_bf16(kf[0],qr[0],negm,0,0,0), P0[2],P0[3],P0[4],P0[5],     pw0[0]=PKW(P0,0), pw0[1]=PKW(P0,2), pw0); \
    VRD(4); SBAR(); GAPA(C1=__builtin_amdgcn_mfma_f32_32x32x16_bf16(kf[1],qr[0],negm,0,0,0), P0[6],P0[7],P0[8],P0[9],     pw0[2]=PKW(P0,4), pw0[3]=PKW(P0,6), pw0); \
    VRD(1); SBAR(); GAPA(C0=__builtin_amdgcn_mfma_f32_32x32x16_bf16(kf[2],qr[1],C0,0,0,0),   P0[10],P0[11],P0[12],P0[13], pw1[0]=PKW(P0,8), pw1[1]=PKW(P0,10), pw1); \
    VRD(5); SBAR(); GAPA(C1=__builtin_amdgcn_mfma_f32_32x32x16_bf16(kf[3],qr[1],C1,0,0,0),   P0[14],P0[15],P1[0],P1[1],   pw1[2]=PKW(P0,12),pw1[3]=PKW(P0,14), pw1); \
    VRD(2); SBAR(); GAPA(C0=__builtin_amdgcn_mfma_f32_32x32x16_bf16(kf[4],qr[2],C0,0,0,0),   P1[2],P1[3],P1[4],P1[5],     pw2[0]=PKW(P1,0), pw2[1]=PKW(P1,2), pw2); \
    VRD(6); SBAR(); GAPA(C1=__builtin_amdgcn_mfma_f32_32x32x16_bf16(kf[5],qr[2],C1,0,0,0),   P1[6],P1[7],P1[8],P1[9],     pw2[2]=PKW(P1,4), pw2[3]=PKW(P1,6), pw2); \
    VRD(3); SBAR(); GAPA(C0=__builtin_amdgcn_mfma_f32_32x32x16_bf16(kf[6],qr[3],C0,0,0,0),   P1[10],P1[11],P1[12],P1[13], pw3[0]=PKW(P1,8), pw3[1]=PKW(P1,10), pw3); \
    VRD(7); SBAR(); GAPA(C1=__builtin_amdgcn_mfma_f32_32x32x16_bf16(kf[7],qr[3],C1,0,0,0),   P1[14],P1[15],0.f,0.f,       pw3[2]=PKW(P1,12),pw3[3]=PKW(P1,14), pw3); \
    l_reg+=sacc; \
    if(GK){DMA_K((t)+3,sl_cur);} if(GV){DMA_V((t)+1,sl_next);} \
    CMASK(C0,C1,t); \
    { float a=MX3(C0[0],C0[1],C1[0]),b=MX3(C0[2],C0[3],C1[1]); a=MX3(a,C1[2],C1[3]); \
      _Pragma("unroll") for(int r=4;r<16;r+=4){a=MX3(a,C0[r],C0[r+1]);b=MX3(b,C0[r+2],C0[r+3]);a=MX3(a,C1[r],C1[r+1]);b=MX3(b,C1[r+2],C1[r+3]);} \
      float rm=__builtin_fmaxf(a,b); { auto rr=__builtin_amdgcn_permlane32_swap(__float_as_uint(rm),__float_as_uint(rm),false,false); rm=__builtin_fmaxf(__uint_as_float(rr[0]),__uint_as_float(rr[1])); } \
      resc=false; \
      if(__builtin_expect(__any(rm>(float)THRL),0)){ const float dl=__builtin_fmaxf(rm,0.f); mhat+=dl; \
        _Pragma("unroll") for(int r=0;r<16;++r){C0[r]-=dl;C1[r]-=dl;} \
        _Pragma("unroll") for(int r=0;r<16;++r)negm[r]=-mhat; asm volatile("":"+v"(negm)); \
        const float f=__builtin_amdgcn_exp2f(-dl); l_reg*=f; if(hi==0)wsf[r32]=f; resc=true; } } \
    SBAR(); \
    GAPB(o[0]=__builtin_amdgcn_mfma_f32_32x32x16_bf16(PAF(0),VFR(0),o[0],0,0,0), C0,0); \
    GAPB(o[1]=__builtin_amdgcn_mfma_f32_32x32x16_bf16(PAF(0),VFR(4),o[1],0,0,0), C0,4); \
    KRD(GL,0); GAPB(o[0]=__builtin_amdgcn_mfma_f32_32x32x16_bf16(PAF(1),VFR(1),o[0],0,0,0), C0,8); \
    KRD(GL,1); GAPB(o[1]=__builtin_amdgcn_mfma_f32_32x32x16_bf16(PAF(1),VFR(5),o[1],0,0,0), C0,12); \
    KRD(GL,2); GAPB(o[0]=__builtin_amdgcn_mfma_f32_32x32x16_bf16(PAF(2),VFR(2),o[0],0,0,0), C1,0); \
    KRD(GL,3); GAPB(o[1]=__builtin_amdgcn_mfma_f32_32x32x16_bf16(PAF(2),VFR(6),o[1],0,0,0), C1,4); \
    GAPB(o[0]=__builtin_amdgcn_mfma_f32_32x32x16_bf16(PAF(3),VFR(3),o[0],0,0,0), C1,8); \
    GAPB(o[1]=__builtin_amdgcn_mfma_f32_32x32x16_bf16(PAF(3),VFR(7),o[1],0,0,0), C1,12); \
    }while(0)
  int t=1;
  #undef CMASK
  #define CMASK(P0,P1,t) do{}while(0)
  for(;t+5<NT;t+=2){
    STEP(pB0,pB1,pA0,pA1,t,true,true,true);     WAIT_BAR(2); RESC(); ROT();
    STEP(pA0,pA1,pB0,pB1,t+1,true,true,true);   WAIT_BAR(2); RESC(); ROT();
  }
  #undef CMASK
  #define CMASK(P0,P1,t) do{}while(0)
  #define ENDW(tt) do{ if((tt)+3<NT){WAIT_BAR(2);} else if((tt)+2<NT){WAIT_BAR(1);} else {WAIT_BAR(0);} }while(0)
  for(;t+1<NT;t+=2){
    STEP(pB0,pB1,pA0,pA1,t,(t+3<NT),(t+1<NT),(t+1<NT));       ENDW(t);   RESC(); ROT();
    STEP(pA0,pA1,pB0,pB1,t+1,(t+4<NT),(t+2<NT),(t+2<NT));     ENDW(t+1); RESC(); ROT();
  }
  STEP(pB0,pB1,pA0,pA1,NT-1,false,false,false); RESC();
  { float sacc=pB0[0]+pB0[1]; _Pragma("unroll") for(int r=2;r<16;++r)sacc+=pB0[r]; _Pragma("unroll") for(int r=0;r<16;++r)sacc+=pB1[r]; l_reg+=sacc;
    pw0=(u32x4){PKW(pB0,0),PKW(pB0,2),PKW(pB0,4),PKW(pB0,6)};pw1=(u32x4){PKW(pB0,8),PKW(pB0,10),PKW(pB0,12),PKW(pB0,14)};pw2=(u32x4){PKW(pB1,0),PKW(pB1,2),PKW(pB1,4),PKW(pB1,6)};pw3=(u32x4){PKW(pB1,8),PKW(pB1,10),PKW(pB1,12),PKW(pB1,14)};
    SBAR(); pv(o,vb0+sl_cur,PAF(0),PAF(1),PAF(2),PAF(3)); }
  #undef PKW
  #undef PAF
  #undef VFR
  #undef PIN
  #undef MX3
  #undef GAPA
  #undef GAPB
  #undef EX
  #undef VRD
  #undef KRD
  #undef STEP
  #undef ENDW
  {auto rr=__builtin_amdgcn_permlane32_swap(__float_as_uint(l_reg),__float_as_uint(l_reg),false,false);l_reg=__uint_as_float(rr[0])+__uint_as_float(rr[1]);}
  if(hi==0)wsf[32+r32]=l_reg;asm volatile("s_waitcnt lgkmcnt(0)":::"memory");
  float rli[16];
  #pragma unroll
  for(int r=0;r<16;++r)rli[r]=__builtin_amdgcn_rcpf(wsf[32+crow(r,hi)]);
  bf16*Ow=O+(rowbase+q0+wid*QBLK)*PO+h*D;
  { bf16*stg=(bf16*)(shm+LDS_OST)+wid*2048;
    #pragma unroll
    for(int r=0;r<16;++r){const int orow=crow(r,hi);
      #pragma unroll
      for(int d0=0;d0<2;++d0)stg[orow*64+d0*32+r32]=__float2bfloat16(o[d0][r]*rli[r]);}
    asm volatile("s_waitcnt lgkmcnt(0)":::"memory");
    #pragma unroll
    for(int i=0;i<4;++i){const int row=i*8+(lane>>3),ch=lane&7; const u32x4 v=*(const u32x4*)(stg+row*64+ch*8); ATTN_STORE16(Ow+(long)row*PO+ch*8,v);} }
  asm volatile("s_waitcnt lgkmcnt(0)\n\ts_barrier":::"memory");
  #undef DMA_K
  #undef DMA_V
  #undef CMASK
  #undef START
  #undef RESC
  #undef ROT
}
constexpr int ATTN_LDS_BYTES=LDS_BYTES;
struct AttnTensors { const bf16* Q; const bf16* K; const bf16* V; bf16* O; };
constexpr int BAND_HALF=40960, BAND_K=0, BAND_V=16384, BAND_WS=32768, BAND_OST=81920, BAND_LDS_BYTES=BAND_OST+NW*4096;
__device__ __forceinline__ void band_half_unit(int hu,const bf16*__restrict__ QKV,int offq,int offk,int offv,bf16*OBG,float*LSEG,char*shm){
  int tid_=threadIdx.x; asm volatile("":"+v"(tid_)); const int tid=tid_,lane=tid&63,r32=lane&31,hi=lane>>5; const int wid=__builtin_amdgcn_readfirstlane(tid>>6);
  const int half=wid>>2, wq=wid&3;
  const int uh=__builtin_amdgcn_readfirstlane(2*hu+half);
  const int b=uh/192, rem=uh-b*192, head=rem>>4, ck=rem&15, g=head>>2, j=head&3;
  const int dil=(g==0)?1:(g==1)?4:16, sh=(g==0)?4:(g==1)?2:0;
  const int rc=ck>>sh, c=ck&((1<<sh)-1), ntile=(SEQ/64)/dil;
  const long rowbase=(long)b*SEQ;
  bf16*const OG=OBG+(long)g*BATCH*SEQ*256; float*const LG=LSEG+(long)g*BATCH*SEQ*4;
  const unsigned lds0=(unsigned)(uintptr_t)shm+half*BAND_HALF;
  char*hb=shm+half*BAND_HALF;
  typedef __attribute__((address_space(3))) float* lds_fptr;
  const lds_fptr wsf=(lds_fptr)(hb+BAND_WS+wq*256);
  const int mq=128*c+32*wq+r32;
  const bf16*Qrow=QKV+(rowbase+(long)mq*dil+rc)*PQ+offq+head*D;
  bf16x8 qr[4];
  #pragma unroll
  for(int d0=0;d0<4;++d0)qr[d0]=*reinterpret_cast<const bf16x8*>(&Qrow[d0*16+hi*8]);
  const bf16*Kc=QKV+(rowbase+rc)*PQ+offk+head*D, *Vc=QKV+(rowbase+rc)*PQ+offv+head*D;
  #define BAND_DMA(T,slot) do{ const long p0_=(long)(T)*64; \
      _Pragma("unroll") for(int q_=0;q_<2;++q_){ const int cc_=2*wq+q_; \
        glds16(Kc+((p0_+lane)*dil)*PQ+cc_*8,(unsigned)__builtin_amdgcn_readfirstlane(lds0+BAND_K+(slot)*8192+cc_*1024)); \
        glds16(Vc+((p0_+16*(cc_&3)+(lane>>2))*dil)*PQ+(cc_>>2)*32+(lane&3)*8,(unsigned)__builtin_amdgcn_readfirstlane(lds0+BAND_V+(slot)*8192+cc_*1024)); } }while(0)
  const int T0=2*c-1;
  float mrun=-1e30f,l_reg=0.f; f32x16 o[2]; o[0]=f32x16{}; o[1]=f32x16{};
  const int vb0=(int)(lds0+BAND_V)+((lane>>4)&1)*32+(lane&3)*8+(4*hi+((lane&15)>>2))*64;
  { const int T=T0; if(T>=0&&T<ntile) BAND_DMA(T,0); }
  #pragma unroll 1
  for(int s=0;s<4;++s){
    const int T=T0+s, Tn=T+1; const bool vcur=(T>=0&&T<ntile), vnext=(s<3)&&(Tn>=0&&Tn<ntile);
    if(vnext){ BAND_DMA(Tn,(s+1)&1); asm volatile("s_waitcnt vmcnt(4)":::"memory"); } else { asm volatile("s_waitcnt vmcnt(0)":::"memory"); }
    asm volatile("s_barrier":::"memory");
    const bool act=vcur&&(s>=(wq>>1))&&(s<=(wq>>1)+2);
    if(act){
      f32x16 p0,p1; const f32x16 zero=f32x16{};
      qkt(p0,p1,hb+BAND_K+(s&1)*8192,qr,zero,r32,hi);
      const int kb=64*T+4*hi-mq;
      float mx=-1e30f;
      #pragma unroll
      for(int r=0;r<16;++r){ const int d0_=kb+(r&3)+8*(r>>2), d1_=d0_+32;
        p0[r]=(d0_>=-64&&d0_<=64)?p0[r]:-1e30f; p1[r]=(d1_>=-64&&d1_<=64)?p1[r]:-1e30f; mx=__builtin_fmaxf(mx,__builtin_fmaxf(p0[r],p1[r])); }
      mx=__builtin_fmaxf(mx,__shfl_xor(mx,32));
      const float mnew=__builtin_fmaxf(mrun,mx); const float f=__builtin_amdgcn_exp2f(mrun-mnew); mrun=mnew;
      float sacc=0.f;
      #pragma unroll
      for(int r=0;r<16;++r){ p0[r]=(p0[r]>-1e29f)?__builtin_amdgcn_exp2f(p0[r]-mnew):0.f; p1[r]=(p1[r]>-1e29f)?__builtin_amdgcn_exp2f(p1[r]-mnew):0.f; sacc+=p0[r]+p1[r]; }
      l_reg=l_reg*f+sacc;
      if(hi==0)wsf[r32]=f;
      #pragma unroll
      for(int r=0;r<16;++r){ const float fr=wsf[crow(r,hi)]; o[0][r]*=fr; o[1][r]*=fr; }
      u32x4 pw0,pw1,pw2,pw3;
      pw0=(u32x4){cvtpk_s(p0[0],p0[1]),cvtpk_s(p0[2],p0[3]),cvtpk_s(p0[4],p0[5]),cvtpk_s(p0[6],p0[7])}; pw1=(u32x4){cvtpk_s(p0[8],p0[9]),cvtpk_s(p0[10],p0[11]),cvtpk_s(p0[12],p0[13]),cvtpk_s(p0[14],p0[15])};
      pw2=(u32x4){cvtpk_s(p1[0],p1[1]),cvtpk_s(p1[2],p1[3]),cvtpk_s(p1[4],p1[5]),cvtpk_s(p1[6],p1[7])}; pw3=(u32x4){cvtpk_s(p1[8],p1[9]),cvtpk_s(p1[10],p1[11]),cvtpk_s(p1[12],p1[13]),cvtpk_s(p1[14],p1[15])};
      SBAR(); pv(o,vb0+(s&1)*8192,__builtin_bit_cast(bf16x8,pw0),__builtin_bit_cast(bf16x8,pw1),__builtin_bit_cast(bf16x8,pw2),__builtin_bit_cast(bf16x8,pw3));
    }
    asm volatile("s_waitcnt lgkmcnt(0)\n\ts_barrier":::"memory");
  }
  #undef BAND_DMA
  l_reg+=__shfl_xor(l_reg,32);
  if(hi==0)wsf[32+r32]=l_reg;
  float rli[16];
  #pragma unroll
  for(int r=0;r<16;++r)rli[r]=__builtin_amdgcn_rcpf(wsf[32+crow(r,hi)]);
  { bf16*stg=(bf16*)(shm+BAND_OST)+wid*2048;
    #pragma unroll
    for(int r=0;r<16;++r){const int orow=crow(r,hi);
      #pragma unroll
      for(int d0=0;d0<2;++d0)stg[orow*64+d0*32+r32]=__float2bfloat16(o[d0][r]*rli[r]);}
    asm volatile("s_waitcnt lgkmcnt(0)":::"memory");
    #pragma unroll
    for(int i=0;i<4;++i){const int row=i*8+(lane>>3),ch=lane&7; const u32x4 v=*(const u32x4*)(stg+row*64+ch*8);
      const long grow=rowbase+(long)(128*c+32*wq+row)*dil+rc;
      *(u32x4*)(OG+grow*256+j*64+ch*8)=v;} }
  if(hi==0){ const long grow=rowbase+(long)mq*dil+rc; LG[grow*4+j]=mrun+__builtin_log2f(l_reg); }
  asm volatile("s_waitcnt lgkmcnt(0)\n\ts_barrier":::"memory");
}
#undef SBAR
#undef WAIT_BAR
}
#define GAS __attribute__((address_space(1)))
#define LAS __attribute__((address_space(3)))
typedef unsigned short bf16;
typedef unsigned v4u __attribute__((ext_vector_type(4)));
typedef float f32x4 __attribute__((ext_vector_type(4)));
typedef short bf16x8 __attribute__((ext_vector_type(8)));
typedef GAS unsigned gu32;
typedef GAS unsigned long long gu64;
#define RLX_AGENT __ATOMIC_RELAXED, __HIP_MEMORY_SCOPE_AGENT
#define LDS_WAIT() asm volatile("s_waitcnt lgkmcnt(0)" ::: "memory")
#define VM_WAIT() asm volatile("s_waitcnt vmcnt(0)" ::: "memory")
__device__ __forceinline__ unsigned long long rt() { return __builtin_amdgcn_s_memrealtime(); }
__device__ __forceinline__ unsigned f2bf(float f) { unsigned u = __builtin_bit_cast(unsigned, f); return (u + 0x7fffu + ((u >> 16) & 1u)) >> 16; }
__device__ __forceinline__ unsigned pk2(float lo, float hi) { return f2bf(lo) | (f2bf(hi) << 16); }

#define XB_TMO      128
#define XB_XCNT(j)  (256  + 64 * (j))
#define XB_XSUB(j)  (1280 + 64 * (j))
#define XB_XGEN(j)  (2304 + 64 * (j))
#define XB_TOP      3328
#define XB_TOPGEN   3392
#define XCD_BAR_WORDS 3456
#define XB_SPIN_CAP (1u << 24)

__device__ __forceinline__ unsigned xb_ld(unsigned* p)              { return __hip_atomic_load(p, __ATOMIC_RELAXED, __HIP_MEMORY_SCOPE_AGENT); }
__device__ __forceinline__ unsigned xb_add(unsigned* p, unsigned v) { return __hip_atomic_fetch_add(p, v, __ATOMIC_RELAXED, __HIP_MEMORY_SCOPE_AGENT); }
__device__ __forceinline__ unsigned xb_xcc_id() { return (unsigned)__builtin_amdgcn_s_getreg((3 << 11) | 20) & 0xFu; }
#define XB_SPIN(cond, bar) do { unsigned _sp = 0; while (cond) { __builtin_amdgcn_s_sleep(1); \
    if ((++_sp & 255u) == 0u) { if (xb_ld(&(bar)[XB_TMO])) break; if (_sp > XB_SPIN_CAP) { atomicAdd(&(bar)[XB_TMO], 1u); break; } } } } while (0)

struct XcdBarrier {
    unsigned* bar; unsigned x;
    volatile LAS unsigned* st;
};

__device__ __forceinline__ XcdBarrier xcd_barrier_post(unsigned* bar, volatile LAS unsigned* st) {
    XcdBarrier b; b.bar = bar; b.x = xb_xcc_id(); b.st = st;
    if (threadIdx.x == 0) (void)xb_add(&bar[XB_XCNT(b.x)], 1u);
    return b;
}
__device__ __forceinline__ void xcd_barrier_complete(unsigned* bar, unsigned x, unsigned& nloc, unsigned& nx) {
    const unsigned G = gridDim.x * gridDim.y * gridDim.z;
    unsigned sum, cnt, mine, sp = 0u;
    for (;;) {
        sum = 0u; cnt = 0u; mine = 0u;
#pragma unroll
        for (unsigned j = 0; j < 16; ++j) { const unsigned c = xb_ld(&bar[XB_XCNT(j)]); sum += c; cnt += (c > 0u) ? 1u : 0u; mine = (j == x) ? c : mine; }
        if (sum == G) break;
        __builtin_amdgcn_s_sleep(1);
        if ((++sp & 255u) == 0u) { if (xb_ld(&bar[XB_TMO])) break; if (sp > XB_SPIN_CAP) { atomicAdd(&bar[XB_TMO], 1u); break; } }
    }
    nloc = mine > 0u ? mine : 1u; nx = cnt > 0u ? cnt : 1u;
}

__device__ __forceinline__ void xcd_barrier(const XcdBarrier& b) {
    asm volatile("s_waitcnt vmcnt(0)" ::: "memory");
    __syncthreads();
    if (threadIdx.x == 0) {
        unsigned* bar = b.bar;
        __builtin_amdgcn_s_waitcnt(0);
        unsigned nloc = b.st[0], nx = b.st[1];
        if (nloc == 0u) { xcd_barrier_complete(bar, b.x, nloc, nx); b.st[0] = nloc; b.st[1] = nx; }
        const unsigned old = xb_add(&bar[XB_XSUB(b.x)], 1u);
        const unsigned gen = old / nloc;
        if (old + 1u == (gen + 1u) * nloc) {
            __builtin_amdgcn_fence(__ATOMIC_RELEASE, "agent");
            asm volatile("s_waitcnt vmcnt(0)" ::: "memory");
            const unsigned og = xb_add(&bar[XB_TOP], 1u);
            const unsigned tg = og / nx;
            if (og + 1u == (tg + 1u) * nx) xb_add(&bar[XB_TOPGEN], 1u);
            else XB_SPIN(xb_ld(&bar[XB_TOPGEN]) == tg, bar);
            __builtin_amdgcn_fence(__ATOMIC_ACQUIRE, "agent");
            xb_add(&bar[XB_XGEN(b.x)], 1u);
            asm volatile("s_waitcnt vmcnt(0)" ::: "memory");
        } else {
            XB_SPIN(xb_ld(&bar[XB_XGEN(b.x)]) == gen, bar);
            __builtin_amdgcn_fence(__ATOMIC_ACQUIRE, "agent");
            asm volatile("s_waitcnt vmcnt(0)" ::: "memory");
        }
    }
    __syncthreads();
}


constexpr size_t MiB = 1u << 20;
constexpr size_t WS_CTL = 0, CTL_ZERO_BYTES = 1 * MiB;
constexpr size_t WS_STAT0 = 1 * MiB;
constexpr size_t WS_AFF = 2 * MiB;
constexpr size_t WS_INV = 4 * MiB;
constexpr size_t WS_TOK = 5 * MiB;
constexpr size_t WS_LSE = 6 * MiB;
constexpr size_t WS_WIN = 8 * MiB;
constexpr size_t WS_WA = 18 * MiB;
constexpr size_t WS_WB = 19 * MiB;
constexpr size_t WS_WO = 20 * MiB;
constexpr size_t WS_ROPEA = 22 * MiB;
constexpr size_t WS_ROPEB = 23 * MiB;
constexpr size_t ARENA = 24 * MiB;
constexpr size_t A_H0B = ARENA + 0 * MiB;
constexpr size_t A_QKV = ARENA + 64 * MiB;
constexpr size_t A_GATES = ARENA + 256 * MiB;
constexpr size_t A_ATTNA = ARENA + 0 * MiB;
constexpr size_t A_OB = ARENA + 32 * MiB;
constexpr size_t A_OBG = ARENA + 384 * MiB;
constexpr size_t A_MERGED = ARENA + 64 * MiB;
constexpr size_t A_MIX = ARENA + 128 * MiB;
constexpr size_t A_H1B = ARENA + 448 * MiB;
constexpr size_t A_WGU = ARENA + 256 * MiB;
constexpr size_t A_WD = ARENA + 384 * MiB;
constexpr size_t A_XE = ARENA + 128 * MiB;
constexpr size_t A_ACT = ARENA + 0 * MiB;
constexpr size_t A_YE = ARENA + 128 * MiB;
constexpr size_t WS_END = ARENA + 512 * MiB;
constexpr int CW_TMO = 0, CW_BAR = 4096;

constexpr int RING_OFF = 0, RING_BYTES = 131072;
constexpr int LDSCTL_OFF = RING_BYTES, MISC_OFF = LDSCTL_OFF + 320;
constexpr int LDS_BYTES = 147456;

typedef short s16x4v __attribute__((ext_vector_type(4)));
typedef unsigned u32x2 __attribute__((ext_vector_type(2)));

struct Frame {
    LAS unsigned char* lds;
    volatile LAS unsigned* MISC;
    gu32* ctl;
    int tid, lane, wave;
    int vcu, G;
};

__device__ __forceinline__ float wave_sum(float v) {
#pragma unroll
    for (int o = 1; o < 64; o <<= 1) v += __shfl_xor(v, o);
    return v;
}
__device__ __forceinline__ float bf2f(bf16 h) { return __uint_as_float(((unsigned)h) << 16); }

struct TJob { const float* src; bf16* dst; size_t off; int ldw, ldt, k0, n0, win; };
__device__ __forceinline__ void tjob_load(const TJob& j, f32x4 (&r)[8], int lane) {
    const float* p = j.src + (size_t)(j.k0 + (lane >> 3)) * j.ldw + j.n0 + 4 * (lane & 7);
#pragma unroll
    for (int i = 0; i < 8; ++i) r[i] = *(const GAS f32x4*)(p + (size_t)(8 * i) * j.ldw);
}
struct WinRow {
    __device__ __forceinline__ size_t operator()(int ncol) const {
        if (ncol >= QKVW) return (size_t)ncol;
        int pn, wc, d, map;
        if (ncol < OFF_KA) { const int h = ncol >> 6; pn = h >> 2; wc = h & 3; map = 0; }
        else if (ncol < OFF_VA) { pn = 2; wc = (ncol - OFF_KA) >> 6; map = 0; }
        else if (ncol < OFF_QB) { pn = 2; wc = 2 + ((ncol - OFF_VA) >> 6); map = 2; }
        else if (ncol < OFF_KB) { const int h = (ncol - OFF_QB) >> 6; pn = 3 + (h >> 2); wc = h & 3; map = 1; }
        else if (ncol < OFF_VB) { const int h = (ncol - OFF_KB) >> 6; pn = 6 + (h >> 2); wc = h & 3; map = 1; }
        else { const int h = (ncol - OFF_VB) >> 6; pn = 9 + (h >> 2); wc = h & 3; map = 2; }
        d = ncol & 63;
        int bj, fq, n; const int i = d & 3;
        if (map == 0) { n = d >> 5; bj = (d >> 4) & 1; fq = (d >> 2) & 3; }
        else if (map == 1) { fq = d >> 4; bj = (d >> 3) & 1; n = (d >> 2) & 1; }
        else { bj = d >> 5; fq = (d >> 3) & 3; n = (d >> 2) & 1; }
        return (size_t)(pn * 256 + 128 * bj + 32 * wc + 8 * fq + 4 * n + i);
    }
};

__device__ __forceinline__ void tjob_store(const TJob& j, const f32x4 (&r)[8], LAS float* scr, int lane) {
    { LAS float* w = scr + (4 * (lane & 7)) * 65 + (lane >> 3);
#pragma unroll
      for (int i = 0; i < 8; ++i) { w[8 * i] = r[i].x; w[65 + 8 * i] = r[i].y; w[130 + 8 * i] = r[i].z; w[195 + 8 * i] = r[i].w; } }
    LDS_WAIT(); asm volatile("" ::: "memory");
    const int c = lane & 7;
#pragma unroll
    for (int jj = 0; jj < 4; ++jj) { const int n = (lane >> 3) + 8 * jj; const LAS float* sp = scr + n * 65 + 8 * c;
        v4u o; o.x = pk2(sp[0], sp[1]); o.y = pk2(sp[2], sp[3]); o.z = pk2(sp[4], sp[5]); o.w = pk2(sp[6], sp[7]);
        const size_t row = j.win ? WinRow{}(j.n0 + n) : j.off + (size_t)n;
        *(GAS v4u*)(j.dst + row * (size_t)j.ldt + j.k0 + 8 * c) = o; }
    LDS_WAIT(); asm volatile("" ::: "memory");
}
template <class Decode>
__device__ __forceinline__ void tjobs_run(int first, int stride, int count, const Decode& decode, LAS float* scr, int lane) {
    TJob cur, nxt; f32x4 ra[8], rb[8];
    int it = first; if (it >= count) return;
    decode(it, cur); tjob_load(cur, ra, lane);
    for (;;) {
        const int itn = it + stride; const bool hn = itn < count;
        if (hn) { decode(itn, nxt); tjob_load(nxt, rb, lane); }
        tjob_store(cur, ra, scr, lane);
        if (!hn) break;
        cur = nxt; it = itn;
        ra[0] = rb[0]; ra[1] = rb[1]; ra[2] = rb[2]; ra[3] = rb[3]; ra[4] = rb[4]; ra[5] = rb[5]; ra[6] = rb[6]; ra[7] = rb[7];
    }
}

struct Ptrs {
    const float *x, *ln0_g, *ln0_b, *w_in, *b_gate, *qn_g, *kn_g, *w_a, *w_b, *w_out, *ln1_g, *ln1_b, *w_router, *w_gate_e, *w_up_e, *w_down_e, *ln2_g, *ln2_b;
    float* out; unsigned char* ws;
};
struct Args { Ptrs p; int ph_lo, ph_hi, li, pad; };
typedef const __attribute__((address_space(4))) Args* KArgsP;
__device__ __forceinline__ KArgsP kargs() { KArgsP k = (KArgsP)__builtin_amdgcn_kernarg_segment_ptr(); asm volatile("" : "+s"(k)); return k; }

__device__ __forceinline__ void sincos_rev(float angle, float& sn, float& cs) {
    const double rev = (double)angle * 0.15915494309189533577; const double fr = rev - __builtin_rint(rev);
    sn = __builtin_amdgcn_sinf((float)fr); cs = __builtin_amdgcn_cosf((float)fr);
}
__device__ __forceinline__ void p0_prologue(Frame& F, KArgsP K) {
    LAS float* scr = (LAS float*)(F.lds + RING_OFF + F.wave * 16384);
    const int gw = F.vcu * NWAVES + F.wave, NGW = F.G * NWAVES;
    bf16* win_t = (bf16*)(K->p.ws + WS_WIN); bf16* wa_t = (bf16*)(K->p.ws + WS_WA); bf16* wb_t = (bf16*)(K->p.ws + WS_WB); bf16* wo_t = (bf16*)(K->p.ws + WS_WO);
    constexpr int I_IN = (1024 / 64) * (5120 / 32), I_A = (512 / 64) * (1024 / 32), I_B = (256 / 64) * (1024 / 32), I_O = (1024 / 64) * (1024 / 32);
    { const float* w_in = K->p.w_in; const float* w_a = K->p.w_a; const float* w_b = K->p.w_b; const float* w_o = K->p.w_out;
      auto decode = [&](int it, TJob& j) {
          int r = it; j.off = 0; j.win = 0;
          if (r < I_IN) { j.src = w_in; j.ldw = 5120; j.dst = win_t; j.ldt = 1024; j.k0 = (r / 160) * 64; j.n0 = (r % 160) * 32; j.win = 1; return; } r -= I_IN;
          if (r < I_A) { j.src = w_a; j.ldw = 1024; j.dst = wa_t; j.ldt = 512; j.k0 = (r / 32) * 64; j.n0 = (r % 32) * 32; j.off = (size_t)j.n0; return; } r -= I_A;
          if (r < I_B) { j.src = w_b; j.ldw = 1024; j.dst = wb_t; j.ldt = 256; j.k0 = (r / 32) * 64; j.n0 = (r % 32) * 32; j.off = (size_t)j.n0; return; } r -= I_B;
          j.src = w_o; j.ldw = 1024; j.dst = wo_t; j.ldt = 1024; j.k0 = (r / 32) * 64; j.n0 = (r % 32) * 32; j.off = (size_t)j.n0; };
      tjobs_run(gw, NGW, I_IN + I_A + I_B + I_O, decode, scr, F.lane); }
    { float* ra = (float*)(K->p.ws + WS_ROPEA); float* rb = (float*)(K->p.ws + WS_ROPEB);
      for (int it = F.vcu * (NWAVES * 64) + F.tid; it < SEQ * 40; it += F.G * NWAVES * 64) {
          const int t = it / 40, r = it - t * 40; float sn, cs;
          if (r < 32) { const int n = r >> 4, f = r & 15; const float pos = n ? (float)(t & 63) : (float)(t >> 6);
              sincos_rev(pos * exp2f(-(float)f * (13.287712379549449f / 16.f)), sn, cs); ra[t * 64 + n * 32 + f] = cs; ra[t * 64 + n * 32 + 16 + f] = sn; }
          else { const int f = r - 32; sincos_rev((float)t * exp2f(-(float)f * (18.931568569324174f / 8.f)), sn, cs); rb[t * 16 + f] = cs; rb[t * 16 + 8 + f] = sn; }
      } }
    bf16* h0b = (bf16*)(K->p.ws + A_H0B); float* st0 = (float*)(K->p.ws + WS_STAT0);
    f32x4 g[4], bb[4];
#pragma unroll
    for (int j = 0; j < 4; ++j) { g[j] = ((const f32x4*)K->p.ln0_g)[F.lane + 64 * j]; bb[j] = ((const f32x4*)K->p.ln0_b)[F.lane + 64 * j]; }
    for (int m = gw; m < MTOK; m += NGW) {
        const GAS f32x4* xr = (const GAS f32x4*)(K->p.x + (size_t)m * DM) + F.lane;
        f32x4 v[4]; float s = 0.f;
#pragma unroll
        for (int j = 0; j < 4; ++j) { v[j] = xr[64 * j]; s += (v[j].x + v[j].y) + (v[j].z + v[j].w); }
        const float mean = wave_sum(s) * (1.f / DM); float s2 = 0.f;
#pragma unroll
        for (int j = 0; j < 4; ++j) { v[j] = v[j] - mean; s2 += (v[j].x * v[j].x + v[j].y * v[j].y) + (v[j].z * v[j].z + v[j].w * v[j].w); }
        const float rstd = 1.f / sqrtf(wave_sum(s2) * (1.f / DM) + LN_EPS);
        GAS unsigned long long* o8 = (GAS unsigned long long*)(h0b + (size_t)m * DM) + F.lane;
#pragma unroll
        for (int j = 0; j < 4; ++j) { const f32x4 y = v[j] * rstd * g[j] + bb[j]; o8[64 * j] = (unsigned long long)pk2(y.x, y.y) | ((unsigned long long)pk2(y.z, y.w) << 32); }
        if (F.lane == 0) { st0[2 * m] = mean; st0[2 * m + 1] = rstd; }
    }
}

__device__ __forceinline__ void p1b_prep(Frame& F, KArgsP K) {
    const int gw = F.vcu * NWAVES + F.wave, NGW = F.G * NWAVES, d = F.lane;
    bf16* qkv = (bf16*)(K->p.ws + A_QKV);
    const float qg = K->p.qn_g[d], kg = K->p.kn_g[d];
    const float invfA = exp2f(-(float)(d & 15) * (13.287712379549449f / 16.f));
    const float invfB = exp2f(-(float)(d & 7) * (18.931568569324174f / 8.f));
    for (int m = gw; m < MTOK; m += NGW) {
        const int t = m & (SEQ - 1);
        const float posA = (d < 32) ? (float)(t >> 6) : (float)(t & 63);
        float snA, csA, snB, csB; sincos_rev(posA * invfA, snA, csA); sincos_rev((float)t * invfB, snB, csB);
        bf16* row = qkv + (size_t)m * QKVW;
#pragma unroll 2
        for (int hh = 0; hh < 10; ++hh) {
            bf16* p = row + (hh < 8 ? OFF_QA + hh * 64 : OFF_KA + (hh - 8) * 64) + d;
            const float x = bf2f(*p); const float ss = wave_sum(x * x);
            const float y = x * (1.0f / sqrtf(ss * (1.f / 64.f) + QK_EPS)) * (hh < 8 ? qg : kg);
            const float yp = __shfl_xor(y, 16);
            float o = (d & 16) ? (y * csA + yp * snA) : (y * csA - yp * snA);
            if (hh < 8) o *= C2;
            *p = (bf16)f2bf(o);
        }
#pragma unroll 2
        for (int hh = 0; hh < 24; ++hh) {
            const bool isq = hh < 12;
            bf16* p = row + (isq ? OFF_QB + hh * 64 : OFF_KB + (hh - 12) * 64) + d;
            const float y = bf2f(*p); const float yp = __shfl_xor(y, 8);
            float o = y;
            if (d < 16) o = (d & 8) ? (y * csB + yp * snB) : (y * csB - yp * snB);
            if (isq) o *= C2;
            if (isq || d < 16) *p = (bf16)f2bf(o);
        }
    }
}

__device__ __forceinline__ void attnA_naive_unit(Frame& F, KArgsP K, int unit) {
    const int b = unit >> 5, h = (unit >> 2) & 7, qc = unit & 3, kvh = h >> 2;
    const bf16* qkv = (const bf16*)(K->p.ws + A_QKV); bf16* attna = (bf16*)(K->p.ws + A_ATTNA);
    const size_t rowq = (size_t)b * SEQ + qc * 512 + F.tid;
    LAS float* Ks = (LAS float*)(F.lds + RING_OFF); LAS float* Vs = Ks + 64 * 64;
    float q[64], o[64];
    { const v4u* qp = (const v4u*)(qkv + rowq * QKVW + OFF_QA + h * 64);
#pragma unroll
      for (int c = 0; c < 8; ++c) { const v4u w = qp[c]; q[8 * c + 0] = pg8::bf_lo(w.x); q[8 * c + 1] = pg8::bf_hi(w.x); q[8 * c + 2] = pg8::bf_lo(w.y); q[8 * c + 3] = pg8::bf_hi(w.y);
          q[8 * c + 4] = pg8::bf_lo(w.z); q[8 * c + 5] = pg8::bf_hi(w.z); q[8 * c + 6] = pg8::bf_lo(w.w); q[8 * c + 7] = pg8::bf_hi(w.w); } }
#pragma unroll
    for (int dd = 0; dd < 64; ++dd) o[dd] = 0.f;
    float mrun = -1e30f, l = 0.f;
    for (int kt = 0; kt < SEQ / 64; ++kt) {
        __syncthreads();
        { const int kr = F.tid >> 3, ch = F.tid & 7; const size_t rk = ((size_t)b * SEQ + kt * 64 + kr) * QKVW;
          const v4u wk = *(const v4u*)(qkv + rk + OFF_KA + kvh * 64 + ch * 8), wv = *(const v4u*)(qkv + rk + OFF_VA + kvh * 64 + ch * 8);
          LAS f32x4* kd = (LAS f32x4*)(Ks + kr * 64 + ch * 8); LAS f32x4* vd = (LAS f32x4*)(Vs + kr * 64 + ch * 8);
          kd[0] = (f32x4){pg8::bf_lo(wk.x), pg8::bf_hi(wk.x), pg8::bf_lo(wk.y), pg8::bf_hi(wk.y)}; kd[1] = (f32x4){pg8::bf_lo(wk.z), pg8::bf_hi(wk.z), pg8::bf_lo(wk.w), pg8::bf_hi(wk.w)};
          vd[0] = (f32x4){pg8::bf_lo(wv.x), pg8::bf_hi(wv.x), pg8::bf_lo(wv.y), pg8::bf_hi(wv.y)}; vd[1] = (f32x4){pg8::bf_lo(wv.z), pg8::bf_hi(wv.z), pg8::bf_lo(wv.w), pg8::bf_hi(wv.w)}; }
        __syncthreads();
        for (int key = 0; key < 64; ++key) {
            const LAS f32x4* kp = (const LAS f32x4*)(Ks + key * 64); const LAS f32x4* vp = (const LAS f32x4*)(Vs + key * 64);
            float s0 = 0.f, s1 = 0.f;
#pragma unroll
            for (int c = 0; c < 16; c += 2) { const f32x4 k0 = kp[c], k1 = kp[c + 1];
                s0 += q[4 * c] * k0.x + q[4 * c + 1] * k0.y + q[4 * c + 2] * k0.z + q[4 * c + 3] * k0.w;
                s1 += q[4 * c + 4] * k1.x + q[4 * c + 5] * k1.y + q[4 * c + 6] * k1.z + q[4 * c + 7] * k1.w; }
            const float s = s0 + s1;
            const float mn = fmaxf(mrun, s); const float a = exp2f(mrun - mn), pw = exp2f(s - mn);
            l = l * a + pw; mrun = mn;
#pragma unroll
            for (int c = 0; c < 16; ++c) { const f32x4 vv = vp[c];
                o[4 * c] = o[4 * c] * a + pw * vv.x; o[4 * c + 1] = o[4 * c + 1] * a + pw * vv.y; o[4 * c + 2] = o[4 * c + 2] * a + pw * vv.z; o[4 * c + 3] = o[4 * c + 3] * a + pw * vv.w; }
        }
    }
    const float rl = 1.0f / l;
    v4u* op = (v4u*)(attna + rowq * 512 + h * 64);
#pragma unroll
    for (int c = 0; c < 8; ++c) { v4u w; w.x = pk2(o[8 * c] * rl, o[8 * c + 1] * rl); w.y = pk2(o[8 * c + 2] * rl, o[8 * c + 3] * rl); w.z = pk2(o[8 * c + 4] * rl, o[8 * c + 5] * rl); w.w = pk2(o[8 * c + 6] * rl, o[8 * c + 7] * rl); op[c] = w; }
}

__device__ __forceinline__ void attnB_naive_unit(Frame& F, KArgsP K, int unit) {
    const int b = unit >> 4, j = (unit >> 2) & 3, qc = unit & 3;
    const bf16* qkv = (const bf16*)(K->p.ws + A_QKV); bf16* ob = (bf16*)(K->p.ws + A_OB);
    const int t = qc * 512 + F.tid; const size_t rowq = (size_t)b * SEQ + t;
    float q[64], o[64];
#pragma unroll
    for (int dd = 0; dd < 64; ++dd) o[dd] = 0.f;
    float mrun = -1e30f, l = 0.f;
    for (int g = 0; g < 3; ++g) {
        const int head = 4 * g + j, dil = (g == 0) ? 1 : (g == 1) ? 4 : 16;
        { const v4u* qp = (const v4u*)(qkv + rowq * QKVW + OFF_QB + head * 64);
#pragma unroll
          for (int c = 0; c < 8; ++c) { const v4u w = qp[c]; q[8 * c + 0] = pg8::bf_lo(w.x); q[8 * c + 1] = pg8::bf_hi(w.x); q[8 * c + 2] = pg8::bf_lo(w.y); q[8 * c + 3] = pg8::bf_hi(w.y);
              q[8 * c + 4] = pg8::bf_lo(w.z); q[8 * c + 5] = pg8::bf_hi(w.z); q[8 * c + 6] = pg8::bf_lo(w.w); q[8 * c + 7] = pg8::bf_hi(w.w); } }
        for (int jj = -64; jj <= 64; ++jj) {
            const int tk = t + jj * dil;
            if (tk < 0 || tk >= SEQ) continue;
            const size_t rk = ((size_t)b * SEQ + tk) * QKVW;
            const v4u* kp = (const v4u*)(qkv + rk + OFF_KB + head * 64); const v4u* vp = (const v4u*)(qkv + rk + OFF_VB + head * 64);
            float s = 0.f;
#pragma unroll
            for (int c = 0; c < 8; ++c) { const v4u w = kp[c];
                s += q[8 * c] * pg8::bf_lo(w.x) + q[8 * c + 1] * pg8::bf_hi(w.x) + q[8 * c + 2] * pg8::bf_lo(w.y) + q[8 * c + 3] * pg8::bf_hi(w.y)
                   + q[8 * c + 4] * pg8::bf_lo(w.z) + q[8 * c + 5] * pg8::bf_hi(w.z) + q[8 * c + 6] * pg8::bf_lo(w.w) + q[8 * c + 7] * pg8::bf_hi(w.w); }
            const float mn = fmaxf(mrun, s); const float a = exp2f(mrun - mn), pw = exp2f(s - mn);
            l = l * a + pw; mrun = mn;
#pragma unroll
            for (int c = 0; c < 8; ++c) { const v4u w = vp[c];
                o[8 * c] = o[8 * c] * a + pw * pg8::bf_lo(w.x); o[8 * c + 1] = o[8 * c + 1] * a + pw * pg8::bf_hi(w.x); o[8 * c + 2] = o[8 * c + 2] * a + pw * pg8::bf_lo(w.y); o[8 * c + 3] = o[8 * c + 3] * a + pw * pg8::bf_hi(w.y);
                o[8 * c + 4] = o[8 * c + 4] * a + pw * pg8::bf_lo(w.z); o[8 * c + 5] = o[8 * c + 5] * a + pw * pg8::bf_hi(w.z); o[8 * c + 6] = o[8 * c + 6] * a + pw * pg8::bf_lo(w.w); o[8 * c + 7] = o[8 * c + 7] * a + pw * pg8::bf_hi(w.w); }
        }
    }
    const float rl = 1.0f / l;
    v4u* op = (v4u*)(ob + rowq * 256 + j * 64);
#pragma unroll
    for (int c = 0; c < 8; ++c) { v4u w; w.x = pk2(o[8 * c] * rl, o[8 * c + 1] * rl); w.y = pk2(o[8 * c + 2] * rl, o[8 * c + 3] * rl); w.z = pk2(o[8 * c + 4] * rl, o[8 * c + 5] * rl); w.w = pk2(o[8 * c + 6] * rl, o[8 * c + 7] * rl); op[c] = w; }
}

__device__ __forceinline__ void p3b_combine(Frame& F, KArgsP K) {
    const bf16* obg = (const bf16*)(K->p.ws + A_OBG); const float* lse = (const float*)(K->p.ws + WS_LSE); bf16* ob = (bf16*)(K->p.ws + A_OB);
    for (int it = F.vcu; it < MTOK / 16; it += F.G) {
        const int m = it * 16 + (F.tid >> 5), ch = F.tid & 31, j = ch >> 3;
        const float l0 = lse[((size_t)0 * MTOK + m) * 4 + j], l1 = lse[((size_t)1 * MTOK + m) * 4 + j], l2 = lse[((size_t)2 * MTOK + m) * 4 + j];
        const float mx = fmaxf(l0, fmaxf(l1, l2)); float w0 = exp2f(l0 - mx), w1 = exp2f(l1 - mx), w2 = exp2f(l2 - mx); const float rs = 1.0f / (w0 + w1 + w2); w0 *= rs; w1 *= rs; w2 *= rs;
        const v4u a = *(const v4u*)(obg + ((size_t)0 * MTOK + m) * 256 + ch * 8), b = *(const v4u*)(obg + ((size_t)1 * MTOK + m) * 256 + ch * 8), c = *(const v4u*)(obg + ((size_t)2 * MTOK + m) * 256 + ch * 8);
        v4u o;
        o.x = pk2(w0 * pg8::bf_lo(a.x) + w1 * pg8::bf_lo(b.x) + w2 * pg8::bf_lo(c.x), w0 * pg8::bf_hi(a.x) + w1 * pg8::bf_hi(b.x) + w2 * pg8::bf_hi(c.x));
        o.y = pk2(w0 * pg8::bf_lo(a.y) + w1 * pg8::bf_lo(b.y) + w2 * pg8::bf_lo(c.y), w0 * pg8::bf_hi(a.y) + w1 * pg8::bf_hi(b.y) + w2 * pg8::bf_hi(c.y));
        o.z = pk2(w0 * pg8::bf_lo(a.z) + w1 * pg8::bf_lo(b.z) + w2 * pg8::bf_lo(c.z), w0 * pg8::bf_hi(a.z) + w1 * pg8::bf_hi(b.z) + w2 * pg8::bf_hi(c.z));
        o.w = pk2(w0 * pg8::bf_lo(a.w) + w1 * pg8::bf_lo(b.w) + w2 * pg8::bf_lo(c.w), w0 * pg8::bf_hi(a.w) + w1 * pg8::bf_hi(b.w) + w2 * pg8::bf_hi(c.w));
        *(v4u*)(ob + (size_t)m * 256 + ch * 8) = o;
    }
}

__device__ __forceinline__ void p5_ln1_router_convert(Frame& F, KArgsP K) {
    const int gw = F.vcu * NWAVES + F.wave, NGW = F.G * NWAVES;
    { LAS float* scr = (LAS float*)(F.lds + RING_OFF + F.wave * 16384);
      bf16* wgu = (bf16*)(K->p.ws + A_WGU); bf16* wd = (bf16*)(K->p.ws + A_WD);
      constexpr int I_G = 16 * 64, I_D = 32 * 32, PER_E = 2 * I_G + I_D;
      const float* wg = K->p.w_gate_e; const float* wu = K->p.w_up_e; const float* wdn = K->p.w_down_e;
      auto decode = [&](int it, TJob& j) {
          const int e = it / PER_E; int r = it - e * PER_E; j.win = 0;
          if (r < 2 * I_G) { const int up = r >= I_G; r -= up * I_G; j.src = (up ? wu : wg) + (size_t)e * DM * DFF; j.ldw = DFF; j.dst = wgu; j.ldt = 1024; j.k0 = (r / 64) * 64; j.n0 = (r % 64) * 32;
              j.off = (size_t)e * 4096 + (j.n0 >> 7) * 256 + up * 128 + (j.n0 & 127); return; }
          r -= 2 * I_G; j.src = wdn + (size_t)e * DFF * DM; j.ldw = DM; j.dst = wd; j.ldt = 2048; j.k0 = (r / 32) * 64; j.n0 = (r % 32) * 32; j.off = (size_t)e * 1024 + j.n0; };
      tjobs_run(gw, NGW, NEXP * PER_E, decode, scr, F.lane); }
    __syncthreads();
    { LAS f32x4* wl = (LAS f32x4*)(F.lds + RING_OFF); const f32x4* wr4 = (const f32x4*)K->p.w_router;
      for (int q = F.tid; q < 1024 * 4; q += NWAVES * 64) { const int col = q >> 2, e4 = q & 3; const int l = (col & 255) >> 2, i = col & 3, j = col >> 8;
          wl[((j * 4 + i) * 4 + e4) * 64 + l] = wr4[q]; } }
    __syncthreads();
    const bf16* mix = (const bf16*)(K->p.ws + A_MIX); bf16* h1b = (bf16*)(K->p.ws + A_H1B); const float* st0 = (const float*)(K->p.ws + WS_STAT0); float* aff = (float*)(K->p.ws + WS_AFF);
    f32x4 xv[4], xn[4]; u32x2 mw[4], mn[4]; float mean0 = 0.f, rstd0 = 0.f, mean0n = 0.f, rstd0n = 0.f;
    int m = gw;
    if (m < MTOK) { const GAS f32x4* xr = (const GAS f32x4*)(K->p.x + (size_t)m * DM) + F.lane; const GAS u32x2* mr = (const GAS u32x2*)(mix + (size_t)m * DM) + F.lane;
#pragma unroll
        for (int j = 0; j < 4; ++j) { xv[j] = xr[64 * j]; mw[j] = mr[64 * j]; }
        mean0 = st0[2 * m]; rstd0 = st0[2 * m + 1]; }
    for (; m < MTOK; m += NGW) {
        const int mnx = m + NGW;
        if (mnx < MTOK) { const GAS f32x4* xr = (const GAS f32x4*)(K->p.x + (size_t)mnx * DM) + F.lane; const GAS u32x2* mr = (const GAS u32x2*)(mix + (size_t)mnx * DM) + F.lane;
#pragma unroll
            for (int j = 0; j < 4; ++j) { xn[j] = xr[64 * j]; mn[j] = mr[64 * j]; }
            mean0n = st0[2 * mnx]; rstd0n = st0[2 * mnx + 1]; }
        f32x4 v[4]; float s = 0.f;
#pragma unroll
        for (int j = 0; j < 4; ++j) {
            const f32x4 g0 = ((const f32x4*)K->p.ln0_g)[F.lane + 64 * j], b0 = ((const f32x4*)K->p.ln0_b)[F.lane + 64 * j];
            const f32x4 h0 = (xv[j] - mean0) * rstd0 * g0 + b0;
            v[j] = h0 * ALPHA + (f32x4){pg8::bf_lo(mw[j].x), pg8::bf_hi(mw[j].x), pg8::bf_lo(mw[j].y), pg8::bf_hi(mw[j].y)};
            s += (v[j].x + v[j].y) + (v[j].z + v[j].w); }
        const float mean = wave_sum(s) * (1.f / DM); float s2 = 0.f;
#pragma unroll
        for (int j = 0; j < 4; ++j) { v[j] = v[j] - mean; s2 += (v[j].x * v[j].x + v[j].y * v[j].y) + (v[j].z * v[j].z + v[j].w * v[j].w); }
        const float rstd = 1.f / sqrtf(wave_sum(s2) * (1.f / DM) + LN_EPS);
        GAS unsigned long long* o8 = (GAS unsigned long long*)(h1b + (size_t)m * DM) + F.lane;
        float lg[16];
#pragma unroll
        for (int e = 0; e < 16; ++e) lg[e] = 0.f;
#pragma unroll
        for (int j = 0; j < 4; ++j) { const f32x4 g1 = ((const f32x4*)K->p.ln1_g)[F.lane + 64 * j], b1 = ((const f32x4*)K->p.ln1_b)[F.lane + 64 * j];
            const f32x4 y = v[j] * rstd * g1 + b1;
            o8[64 * j] = (unsigned long long)pk2(y.x, y.y) | ((unsigned long long)pk2(y.z, y.w) << 32);
            const LAS f32x4* wl = (const LAS f32x4*)(F.lds + RING_OFF) + F.lane;
            asm volatile("" ::: "memory");
#pragma unroll
            for (int i = 0; i < 4; ++i) { const float yv = y[i];
#pragma unroll
                for (int c = 0; c < 4; ++c) { const f32x4 w = wl[((j * 4 + i) * 4 + c) * 64]; lg[4 * c] += yv * w.x; lg[4 * c + 1] += yv * w.y; lg[4 * c + 2] += yv * w.z; lg[4 * c + 3] += yv * w.w; } } }
#pragma unroll
        for (int e = 0; e < 16; ++e) lg[e] = wave_sum(lg[e]);
        float mx = lg[0];
#pragma unroll
        for (int e = 1; e < 16; ++e) mx = fmaxf(mx, lg[e]);
        float se = 0.f;
#pragma unroll
        for (int e = 0; e < 16; ++e) { lg[e] = expf(lg[e] - mx); se += lg[e]; }
        float mine = 0.f;
#pragma unroll
        for (int e = 0; e < 16; ++e) if (F.lane == e) mine = lg[e] / se;
        if (F.lane < 16) aff[(size_t)m * 16 + F.lane] = mine;
#pragma unroll
        for (int j = 0; j < 4; ++j) { xv[j] = xn[j]; mw[j] = mn[j]; }
        mean0 = mean0n; rstd0 = rstd0n;
    }
}

__device__ __forceinline__ void p6_topk_unit(Frame& F, KArgsP K, int unit) {
    const int e = unit >> 4, b = unit & 15;
    const float* aff = (const float*)(K->p.ws + WS_AFF); short* inv = (short*)(K->p.ws + WS_INV); int* tok = (int*)(K->p.ws + WS_TOK);
    const bf16* h1b = (const bf16*)(K->p.ws + A_H1B); bf16* xe = (bf16*)(K->p.ws + A_XE);
    LAS unsigned* cnt = (LAS unsigned*)(F.lds + RING_OFF);
    LAS int* ltok = (LAS int*)(F.lds + RING_OFF + 256);
    unsigned key[4];
#pragma unroll
    for (int i = 0; i < 4; ++i) key[i] = __float_as_uint(aff[((size_t)b * SEQ + 4 * F.tid + i) * 16 + e]);
    __syncthreads();
    unsigned thr = 0u;
    for (int bit = 31; bit >= 0; --bit) {
        const unsigned cand = thr | (1u << bit);
        unsigned c = 0;
#pragma unroll
        for (int i = 0; i < 4; ++i) c += (unsigned)__popcll(__ballot(key[i] >= cand));
        LAS unsigned* cb = cnt + ((bit & 1) ? 8 : 0);
        if (F.lane == 0) cb[F.wave] = c;
        __syncthreads();
        unsigned tot = 0;
#pragma unroll
        for (int w = 0; w < 8; ++w) tot += cb[w];
        if (tot >= (unsigned)CAP) thr = cand;
    }
    __syncthreads();
    unsigned cg = 0, ce = 0;
#pragma unroll
    for (int i = 0; i < 4; ++i) { cg += key[i] > thr; ce += key[i] == thr; }
    unsigned pk = cg | (ce << 16), inc = pk;
#pragma unroll
    for (int o = 1; o < 64; o <<= 1) { const unsigned up = __shfl_up(inc, o); if (F.lane >= o) inc += up; }
    if (F.lane == 63) cnt[16 + F.wave] = inc;
    __syncthreads();
    unsigned base = 0, total = 0;
#pragma unroll
    for (int w = 0; w < 8; ++w) { const unsigned tw = cnt[16 + w]; if (w < F.wave) base += tw; total += tw; }
    const unsigned excl = base + inc - pk;
    unsigned pg = excl & 0xffffu, pe = excl >> 16; const unsigned ngt = total & 0xffffu; const unsigned need = (unsigned)CAP - ngt;
#pragma unroll
    for (int i = 0; i < 4; ++i) {
        const int t = 4 * F.tid + i; int slot = -1;
        if (key[i] > thr) { slot = (int)(pg + (pe < need ? pe : need)); ++pg; }
        else if (key[i] == thr) { if (pe < need) slot = (int)(pg + pe); ++pe; }
        inv[((size_t)b * SEQ + t) * 16 + e] = (short)slot;
        if (slot >= 0) { ltok[slot] = t; tok[unit * CAP + slot] = t; }
    }
    __syncthreads();
    for (int c0 = F.wave * 4; c0 < CAP; c0 += NWAVES * 4) {
        v4u a[4][2];
#pragma unroll
        for (int q = 0; q < 4; ++q) { const v4u* src = (const v4u*)(h1b + ((size_t)b * SEQ + ltok[c0 + q]) * DM); a[q][0] = src[F.lane]; a[q][1] = src[F.lane + 64]; }
#pragma unroll
        for (int q = 0; q < 4; ++q) { v4u* dst = (v4u*)(xe + ((size_t)unit * CAP + c0 + q) * DM); dst[F.lane] = a[q][0]; dst[F.lane + 64] = a[q][1]; }
    }
    __syncthreads();
}

__device__ __forceinline__ void p9_final(Frame& F, KArgsP K) {
    const int gw = F.vcu * NWAVES + F.wave, NGW = F.G * NWAVES;
    const float* aff = (const float*)(K->p.ws + WS_AFF); const short* inv = (const short*)(K->p.ws + WS_INV); const bf16* ye = (const bf16*)(K->p.ws + A_YE); const bf16* h1b = (const bf16*)(K->p.ws + A_H1B);
    f32x4 g2[2][2], b2[2][2];
#pragma unroll
    for (int jj = 0; jj < 2; ++jj)
#pragma unroll
        for (int q = 0; q < 2; ++q) { g2[jj][q] = *(const f32x4*)(K->p.ln2_g + 512 * jj + 8 * F.lane + 4 * q); b2[jj][q] = *(const f32x4*)(K->p.ln2_b + 512 * jj + 8 * F.lane + 4 * q); }
    for (int m = gw; m < MTOK; m += NGW) {
        const int b = m >> 11;
        const int iv = (F.lane < 16) ? (int)inv[(size_t)m * 16 + F.lane] : -1; const float af = (F.lane < 16) ? aff[(size_t)m * 16 + F.lane] : 0.f;
        const v4u* hr = (const v4u*)(h1b + (size_t)m * DM) + F.lane; const v4u h0 = hr[0], h1v = hr[64];
        unsigned long long mask = __ballot(iv >= 0);
        float v[2][8];
#define UNPK8(D_, W_, S_) do { D_[0] = pg8::bf_lo(W_.x) * (S_); D_[1] = pg8::bf_hi(W_.x) * (S_); D_[2] = pg8::bf_lo(W_.y) * (S_); D_[3] = pg8::bf_hi(W_.y) * (S_); \
                               D_[4] = pg8::bf_lo(W_.z) * (S_); D_[5] = pg8::bf_hi(W_.z) * (S_); D_[6] = pg8::bf_lo(W_[3]) * (S_); D_[7] = pg8::bf_hi(W_[3]) * (S_); } while (0)
#define FMA8(D_, W_, S_) do { D_[0] += pg8::bf_lo(W_.x) * (S_); D_[1] += pg8::bf_hi(W_.x) * (S_); D_[2] += pg8::bf_lo(W_.y) * (S_); D_[3] += pg8::bf_hi(W_.y) * (S_); \
                              D_[4] += pg8::bf_lo(W_.z) * (S_); D_[5] += pg8::bf_hi(W_.z) * (S_); D_[6] += pg8::bf_lo(W_[3]) * (S_); D_[7] += pg8::bf_hi(W_[3]) * (S_); } while (0)
        UNPK8(v[0], h0, ALPHA); UNPK8(v[1], h1v, ALPHA);
        while (mask) {
            const int e0 = __builtin_ctzll(mask); mask &= mask - 1; const bool two = mask != 0; const int e1 = two ? __builtin_ctzll(mask) : e0; if (two) mask &= mask - 1;
            const int p0 = __builtin_amdgcn_readlane(iv, e0), p1 = __builtin_amdgcn_readlane(iv, e1);
            const float gt0 = __builtin_bit_cast(float, __builtin_amdgcn_readlane(__builtin_bit_cast(int, af), e0)), gt1 = two ? __builtin_bit_cast(float, __builtin_amdgcn_readlane(__builtin_bit_cast(int, af), e1)) : 0.f;
            const v4u* y0 = (const v4u*)(ye + ((size_t)(e0 * 16 + b) * CAP + p0) * DM) + F.lane; const v4u* y1 = (const v4u*)(ye + ((size_t)(e1 * 16 + b) * CAP + p1) * DM) + F.lane;
            const v4u a0 = y0[0], a1 = y0[64], c0 = y1[0], c1 = y1[64];
            FMA8(v[0], a0, gt0); FMA8(v[1], a1, gt0); FMA8(v[0], c0, gt1); FMA8(v[1], c1, gt1);
        }
        float s = 0.f;
#pragma unroll
        for (int jj = 0; jj < 2; ++jj)
#pragma unroll
            for (int q = 0; q < 8; ++q) s += v[jj][q];
        const float mean = wave_sum(s) * (1.f / DM); float s2 = 0.f;
#pragma unroll
        for (int jj = 0; jj < 2; ++jj)
#pragma unroll
            for (int q = 0; q < 8; ++q) { v[jj][q] -= mean; s2 += v[jj][q] * v[jj][q]; }
        const float rstd = 1.f / sqrtf(wave_sum(s2) * (1.f / DM) + LN_EPS);
        float* orow = K->p.out + (size_t)m * DM + 8 * F.lane;
#pragma unroll
        for (int jj = 0; jj < 2; ++jj)
#pragma unroll
            for (int q = 0; q < 2; ++q) { f32x4 o; o.x = v[jj][4 * q] * rstd; o.y = v[jj][4 * q + 1] * rstd; o.z = v[jj][4 * q + 2] * rstd; o.w = v[jj][4 * q + 3] * rstd;
                *(GAS f32x4*)(orow + 512 * jj + 4 * q) = o * g2[jj][q] + b2[jj][q]; }
#undef UNPK8
#undef FMA8
    }
}

struct OrderUp {
    int hf, vcu;
    __device__ __forceinline__ bool next(int i, pg8::Unit& u) const {
        if (i >= 8) return false;
        const int e = hf * 8 + i, x = vcu >> 5, l = vcu & 31, b = (x >> 1) * 4 + (l & 3), j = (x & 1) * 8 + (l >> 2);
        u.pm = i * 16 + b; u.pn = j; u.am = e * 16 + b; u.bt = e * 16 + j; return true;
    }
    __device__ __forceinline__ void a_ready(const pg8::Unit&) const {}
    __device__ __forceinline__ void done(const pg8::Unit&) const {}
};
struct OrderDown {
    int hf, vcu;
    __device__ __forceinline__ bool next(int i, pg8::Unit& u) const {
        if (i >= 2) return false;
        const int x = vcu >> 5, l = vcu & 31, pml = i * 64 + x * 8 + (l & 7), pn = l >> 3, pmg = hf * 128 + pml;
        u.pm = pmg; u.pn = pn; u.am = pml; u.bt = (pmg >> 4) * 4 + pn; return true;
    }
    __device__ __forceinline__ void a_ready(const pg8::Unit&) const {}
    __device__ __forceinline__ void done(const pg8::Unit&) const {}
};

#ifndef MK_N_LAUNCHES
#define MK_N_LAUNCHES 1
#endif
constexpr int N_PHASES = 13;
#ifndef REP_P0
#define REP_P0 1
#endif
#ifndef REP_P1
#define REP_P1 1
#endif
#ifndef REP_DENSE
#define REP_DENSE 1
#endif
#ifndef REP_BAND
#define REP_BAND 1
#endif
#ifndef REP_WOUT
#define REP_WOUT 1
#endif
#ifndef REP_P6
#define REP_P6 1
#endif
#ifndef REP_TOPK
#define REP_TOPK 1
#endif
#ifndef REP_UP
#define REP_UP 1
#endif
#ifndef REP_DOWN
#define REP_DOWN 1
#endif
#define REPEAT(n) _Pragma("unroll 1") for (int rep_ = 0; rep_ < (n); ++rep_)
__global__ void __launch_bounds__(NWAVES * 64, 2) fwd_kernel(Args args) {
    extern __shared__ __attribute__((aligned(16))) unsigned char lds[];
#define MKFRAME(F) Frame F; { int t_ = threadIdx.x; asm volatile("" : "+v"(t_)); F.lds = (LAS unsigned char*)lds; F.MISC = (volatile LAS unsigned*)(F.lds + MISC_OFF); F.ctl = nullptr; \
        F.tid = t_; F.lane = t_ & 63; F.wave = __builtin_amdgcn_readfirstlane(t_ >> 6); F.G = 256; const int bx_ = blockIdx.x; F.vcu = (bx_ & 7) * 32 + (bx_ >> 3); }
#define BP(off) ((bf16*)(kargs()->p.ws + (off)))
#define SEAM() do { XcdBarrier b_; b_.bar = (unsigned*)(kargs()->p.ws + WS_CTL) + CW_BAR; b_.x = xb_xcc_id(); b_.st = (volatile LAS unsigned*)((LAS unsigned char*)lds + MISC_OFF) + 8; xcd_barrier(b_); } while (0)
    { const int t_ = threadIdx.x;
      for (int u = t_; u < (LDS_BYTES - LDSCTL_OFF) / 4; u += NWAVES * 64) ((LAS unsigned*)((LAS unsigned char*)lds + LDSCTL_OFF))[u] = 0u;
      __syncthreads();
      (void)xcd_barrier_post((unsigned*)(kargs()->p.ws + WS_CTL) + CW_BAR, (volatile LAS unsigned*)((LAS unsigned char*)lds + MISC_OFF) + 8); }

    REPEAT(REP_P0) { MKFRAME(F); p0_prologue(F, kargs()); } SEAM();
    REPEAT(REP_P1) { MKFRAME(F);
      pg8::Gemm g{BP(A_H0B), (const bf16*)(kargs()->p.ws + WS_WIN), MTOK, 5120, 1024}; pg8::StaticOrder S; S.init(MTOK, 5120, 256, (int)blockIdx.x);
      pg8::EpiProj2 E{BP(A_QKV), BP(A_GATES), kargs()->p.b_gate, kargs()->p.qn_g, kargs()->p.kn_g, (const float*)(kargs()->p.ws + WS_ROPEA), (const float*)(kargs()->p.ws + WS_ROPEB)};
      pg8::gemm_phase<pg8::EpiProj2, pg8::StaticOrder, true, true>(F.lds + RING_OFF, g, S, E); } SEAM();
    REPEAT(REP_DENSE) { MKFRAME(F);
#if defined(NAIVE_ATTN_A)
      attnA_naive_unit(F, kargs(), F.vcu); attnA_naive_unit(F, kargs(), F.vcu + 256);
#else
      { const attn_body::bf16* q_ = (const attn_body::bf16*)BP(A_QKV); attn_body::bf16* o_ = (attn_body::bf16*)BP(A_ATTNA);
        const int g = F.vcu >> 3, s = F.vcu & 7, ab = g >> 1, akvh = g & 1;
#pragma unroll 1
        for (int i = 0; i < 4; ++i) attn_body::attn_unit<8>(ab, akvh * 4 + i, akvh, s, q_ + OFF_QA, q_ + OFF_KA, q_ + OFF_VA, o_, (char*)lds + RING_OFF); }
      __syncthreads();
#endif
    }
#if defined(NAIVE_ATTN_B)
    { MKFRAME(F); attnB_naive_unit(F, kargs(), F.vcu); } SEAM();
#else
    REPEAT(REP_BAND) { MKFRAME(F);
#pragma unroll 1
      for (int i = 0; i < 6; ++i) attn_body::band_half_unit(F.vcu + 256 * i, (const attn_body::bf16*)BP(A_QKV), OFF_QB, OFF_KB, OFF_VB, (attn_body::bf16*)BP(A_OBG), (float*)(kargs()->p.ws + WS_LSE), (char*)lds + RING_OFF);
      __syncthreads(); } SEAM();
    { MKFRAME(F); p3b_combine(F, kargs()); }
#endif
    { MKFRAME(F);
      { pg8::Gemm g{BP(A_ATTNA), (const bf16*)(kargs()->p.ws + WS_WA), MTOK, 1024, 512}; pg8::StaticOrder S; S.init(MTOK, 1024, 256, (int)blockIdx.x);
        pg8::EpiGate<false> E{BP(A_MERGED), BP(A_GATES), 0};
        pg8::gemm_phase<pg8::EpiGate<false>, pg8::StaticOrder, true, true>(F.lds + RING_OFF, g, S, E); }
      asm volatile("s_waitcnt vmcnt(0)" ::: "memory"); __syncthreads(); }
#if !defined(NAIVE_ATTN_B)
    SEAM();
#endif
    { MKFRAME(F);
      { pg8::Gemm g{BP(A_OB), (const bf16*)(kargs()->p.ws + WS_WB), MTOK, 1024, 256}; pg8::StaticOrder S; S.init(MTOK, 1024, 256, (int)blockIdx.x);
        pg8::EpiGate<true> E{BP(A_MERGED), BP(A_GATES), 1024};
        pg8::gemm_phase<pg8::EpiGate<true>, pg8::StaticOrder, true, true>(F.lds + RING_OFF, g, S, E); } } SEAM();
    REPEAT(REP_WOUT) { MKFRAME(F);
      pg8::Gemm g{BP(A_MERGED), (const bf16*)(kargs()->p.ws + WS_WO), MTOK, 1024, 1024}; pg8::StaticOrder S; S.init(MTOK, 1024, 256, (int)blockIdx.x);
      pg8::EpiPlain E{BP(A_MIX), 1024};
      pg8::gemm_phase<pg8::EpiPlain, pg8::StaticOrder, true, true>(F.lds + RING_OFF, g, S, E); } SEAM();
    REPEAT(REP_P6) { MKFRAME(F); p5_ln1_router_convert(F, kargs()); } SEAM();
    REPEAT(REP_TOPK) { MKFRAME(F); p6_topk_unit(F, kargs(), F.vcu); } SEAM();
    REPEAT(REP_UP) { MKFRAME(F); pg8::Gemm g{BP(A_XE), (const bf16*)(kargs()->p.ws + A_WGU), 0, 0, 1024}; OrderUp S{0, F.vcu}; pg8::EpiSwiglu E{BP(A_ACT)};
      pg8::gemm_phase<pg8::EpiSwiglu, OrderUp, true, true>(F.lds + RING_OFF, g, S, E); } SEAM();
    REPEAT(REP_DOWN) { MKFRAME(F); pg8::Gemm g{BP(A_ACT), (const bf16*)(kargs()->p.ws + A_WD), 0, 0, 2048}; OrderDown S{0, F.vcu}; pg8::EpiPlain E{BP(A_YE), 1024};
      pg8::gemm_phase<pg8::EpiPlain, OrderDown, true, true>(F.lds + RING_OFF, g, S, E); } SEAM();
    { MKFRAME(F); pg8::Gemm g{BP(A_XE), (const bf16*)(kargs()->p.ws + A_WGU), 0, 0, 1024}; OrderUp S{1, F.vcu}; pg8::EpiSwiglu E{BP(A_ACT)};
      pg8::gemm_phase<pg8::EpiSwiglu, OrderUp, true, true>(F.lds + RING_OFF, g, S, E); } SEAM();
    { MKFRAME(F); pg8::Gemm g{BP(A_ACT), (const bf16*)(kargs()->p.ws + A_WD), 0, 0, 2048}; OrderDown S{1, F.vcu}; pg8::EpiPlain E{BP(A_YE), 1024};
      pg8::gemm_phase<pg8::EpiPlain, OrderDown, true, true>(F.lds + RING_OFF, g, S, E); } SEAM();
    { MKFRAME(F); p9_final(F, kargs()); }
#undef MKFRAME
#undef BP
#undef SEAM
}

extern "C" void kernel_launch(void* const* d_in, const int* in_sizes, int n_in, void* d_out, int out_size, void* d_ws, size_t ws_size, hipStream_t stream) {
    static int grid = 0;
    if (grid == 0) {
        if (n_in != 18 || in_sizes[0] != MTOK * DM || out_size != MTOK * DM || ws_size < WS_END) { fprintf(stderr, "kernel_launch: unexpected shapes / workspace (n_in %d, ws %zu, need %zu)\n", n_in, ws_size, (size_t)WS_END); grid = -1; return; }
        if (hipFuncSetAttribute((const void*)fwd_kernel, hipFuncAttributeMaxDynamicSharedMemorySize, LDS_BYTES) != hipSuccess) { fprintf(stderr, "kernel_launch: hipFuncSetAttribute failed\n"); grid = -1; return; }
        (void)hipGetLastError();
        grid = 256;
    }
    if (grid < 0) return;
    if (hipMemsetAsync((char*)d_ws + WS_CTL, 0, CTL_ZERO_BYTES, stream) != hipSuccess) return;
    Args a{};
    const float** pp = (const float**)&a.p;
    for (int i = 0; i < 18; ++i) pp[i] = (const float*)d_in[i];
    a.p.out = (float*)d_out; a.p.ws = (unsigned char*)d_ws;
    a.ph_lo = 0; a.ph_hi = N_PHASES; a.li = 0;
    hipLaunchKernelGGL(fwd_kernel, dim3(grid), dim3(NWAVES * 64), LDS_BYTES, stream, a);
}
```

```cpp
#include <hip/hip_runtime.h>
#include <cstdio>
#include <cstdint>
constexpr int NWAVES = 8;
constexpr int BATCH = 16, SEQ = 2048, DM = 1024, MTOK = BATCH * SEQ;
constexpr int NEXP = 16, CAP = 256, DFF = 2048, NSLOT = BATCH * NEXP * CAP;
constexpr int QKVW = 3072, GATEW = 2048;
constexpr int OFF_QA = 0, OFF_KA = 512, OFF_VA = 640, OFF_QB = 768, OFF_KB = 1536, OFF_VB = 2304;
constexpr float LN_EPS = 1e-5f, QK_EPS = 1e-6f;
constexpr float ALPHA = 1.189207115002721f;
constexpr float C2 = 0.125f * 1.4426950408889634f;

namespace pg8 {
#define PG8_LAS __attribute__((address_space(3)))
typedef unsigned short bf16_t;
typedef short bf16x8 __attribute__((ext_vector_type(8)));
typedef float f32x4 __attribute__((ext_vector_type(4)));
typedef unsigned u32x4 __attribute__((ext_vector_type(4)));
constexpr int BM = 256, BK = 64, HALF = 128, HTB = HALF * BK * 2  , STAGE_BYTES = 8 * HTB, NXCD = 8, WGM = 8;

__host__ __device__ __forceinline__ int lds_byte(int r, int c) { const int st = (r >> 4) * 2 + (c >> 5), rr = r & 15, cc = c & 31, ob = rr * 64 + cc * 2; return st * 1024 + (ob ^ (((ob >> 9) & 1) << 5)); }
__host__ __device__ __forceinline__ void stage_rc(int b, int& R, int& C) { const int st = b / 1024, sb = b % 1024, swz = sb ^ (((sb >> 9) & 1) << 5); R = (st >> 1) * 16 + swz / 64; C = (st & 1) * 32 + (swz % 64) / 2; }
__host__ __device__ __forceinline__ int perm32(int rho) { const int n = rho >> 4, i = rho & 15; return 8 * (i >> 2) + 4 * n + (i & 3); }

struct Unit { int pm, pn, am, bt; };
struct Gemm { const bf16_t* A; const bf16_t* Bt; int M, N, K; };

struct StaticOrder {
    int nM, nN, nwg, G, c;
    __host__ __device__ void init(int M, int N, int G_, int c_) { nM = M / BM; nN = N / BM; nwg = nM * nN; G = G_; c = c_; }
    __host__ __device__ bool next(int i, Unit& u) const {
        const long L = (long)i * G + c; if (L >= nwg) return false;
        int wgid = (int)L; { const int q = nwg / NXCD, r = nwg % NXCD, xcd = wgid % NXCD, off = wgid / NXCD; wgid = (xcd < r ? xcd * (q + 1) : r * (q + 1) + (xcd - r) * q) + off; }
        const int nig = WGM * nN, gid = wgid / nig, fm = gid * WGM, gsz = (nM - fm) < WGM ? (nM - fm) : WGM;
        u.pm = fm + ((wgid % nig) % gsz); u.pn = (wgid % nig) / gsz; u.am = u.pm; u.bt = u.pn; return true;
    }
    __device__ __forceinline__ void a_ready(const Unit&) const {}
    __device__ __forceinline__ void done(const Unit&) const {}
};

typedef float f32x2_cv __attribute__((ext_vector_type(2))); typedef __bf16 bf16x2_cv __attribute__((ext_vector_type(2)));
__device__ __forceinline__ unsigned cvt_pk_bf16(float lo, float hi) { f32x2_cv v = {lo, hi}; bf16x2_cv b = __builtin_convertvector(v, bf16x2_cv); return __builtin_bit_cast(unsigned, b); }
__device__ __forceinline__ float bf_lo(unsigned w) { return __uint_as_float(w << 16); }
__device__ __forceinline__ float bf_hi(unsigned w) { return __uint_as_float(w & 0xffff0000u); }
__device__ __forceinline__ float sigmoidf_(float x) { return __builtin_amdgcn_rcpf(1.0f + __builtin_amdgcn_exp2f(-1.4426950408889634f * x)); }
__device__ __forceinline__ u32x4 pack8(const f32x4 v0, const f32x4 v1) { u32x4 w; w.x = cvt_pk_bf16(v0[0], v0[1]); w.y = cvt_pk_bf16(v0[2], v0[3]); w.z = cvt_pk_bf16(v1[0], v1[1]); w.w = cvt_pk_bf16(v1[2], v1[3]); return w; }

struct EpiProj {
    static constexpr bool PERM = true, AFTER_DRAIN = false;
    bf16_t* qkv; bf16_t* gates; const float* b_gate;
    __device__ __forceinline__ void operator()(const f32x4 (&acc)[2][2][4][2], const Unit& u, int wr, int wc, int fr, int fq) const {
        const int row0 = u.pm * BM + wr * 64 + fr;
        const bool isg = u.pn >= 12;
        bf16_t* base = isg ? gates : qkv; const int ldc = isg ? 2048 : 3072; const int colt = isg ? (u.pn - 12) * BM : u.pn * BM;
        const int col0 = colt + wc * 32 + 8 * fq;
        f32x4 bv[2][2];
#pragma unroll
        for (int bj = 0; bj < 2; ++bj)
#pragma unroll
            for (int n = 0; n < 2; ++n) bv[bj][n] = isg ? *(const f32x4*)(b_gate + col0 + bj * HALF + 4 * n) : (f32x4){0.f, 0.f, 0.f, 0.f};
#pragma unroll
        for (int ai = 0; ai < 2; ++ai)
#pragma unroll
            for (int m = 0; m < 4; ++m) { bf16_t* rowp = base + (size_t)(row0 + ai * HALF + m * 16) * ldc + col0;
#pragma unroll
                for (int bj = 0; bj < 2; ++bj) { f32x4 v0 = acc[ai][bj][m][0] + bv[bj][0], v1 = acc[ai][bj][m][1] + bv[bj][1];
                    if (isg) {
#pragma unroll
                        for (int i = 0; i < 4; ++i) { v0[i] = sigmoidf_(v0[i]); v1[i] = sigmoidf_(v1[i]); } }
                    *(u32x4*)(rowp + bj * HALF) = pack8(v0, v1); } }
    }
};
struct EpiPlain {
    static constexpr bool PERM = true, AFTER_DRAIN = false;
    bf16_t* O; int ldc;
    __device__ __forceinline__ void operator()(const f32x4 (&acc)[2][2][4][2], const Unit& u, int wr, int wc, int fr, int fq) const {
        const int row0 = u.pm * BM + wr * 64 + fr; const int col0 = u.pn * BM + wc * 32 + 8 * fq;
#pragma unroll
        for (int ai = 0; ai < 2; ++ai)
#pragma unroll
            for (int m = 0; m < 4; ++m) { bf16_t* rowp = O + (size_t)(row0 + ai * HALF + m * 16) * ldc + col0;
#pragma unroll
                for (int bj = 0; bj < 2; ++bj) *(u32x4*)(rowp + bj * HALF) = pack8(acc[ai][bj][m][0], acc[ai][bj][m][1]); }
    }
};
template <bool ACCUM> struct EpiGate {
    static constexpr bool PERM = true, AFTER_DRAIN = false;
    bf16_t* merged; const bf16_t* gates; int goff;
    __device__ __forceinline__ void operator()(const f32x4 (&acc)[2][2][4][2], const Unit& u, int wr, int wc, int fr, int fq) const {
        const int row0 = u.pm * BM + wr * 64 + fr; const int col0 = u.pn * BM + wc * 32 + 8 * fq;
#pragma unroll
        for (int ai = 0; ai < 2; ++ai)
#pragma unroll
            for (int m = 0; m < 4; ++m) { const size_t r = (size_t)(row0 + ai * HALF + m * 16);
#pragma unroll
                for (int bj = 0; bj < 2; ++bj) {
                    const u32x4 g = *(const u32x4*)(gates + r * 2048 + goff + col0 + bj * HALF);
                    f32x4 v0 = acc[ai][bj][m][0], v1 = acc[ai][bj][m][1];
                    v0[0] *= bf_lo(g.x); v0[1] *= bf_hi(g.x); v0[2] *= bf_lo(g.y); v0[3] *= bf_hi(g.y);
                    v1[0] *= bf_lo(g.z); v1[1] *= bf_hi(g.z); v1[2] *= bf_lo(g.w); v1[3] *= bf_hi(g.w);
                    bf16_t* p = merged + r * 1024 + col0 + bj * HALF;
                    if (ACCUM) { const u32x4 o = *(const u32x4*)p;
                        v0[0] += bf_lo(o.x); v0[1] += bf_hi(o.x); v0[2] += bf_lo(o.y); v0[3] += bf_hi(o.y);
                        v1[0] += bf_lo(o.z); v1[1] += bf_hi(o.z); v1[2] += bf_lo(o.w); v1[3] += bf_hi(o.w); }
                    *(u32x4*)p = pack8(v0, v1); } }
    }
};
struct EpiSwiglu {
    static constexpr bool PERM = true, AFTER_DRAIN = false;
    bf16_t* act;
    __device__ __forceinline__ void operator()(const f32x4 (&acc)[2][2][4][2], const Unit& u, int wr, int wc, int fr, int fq) const {
        const int row0 = u.pm * BM + wr * 64 + fr; const int col0 = u.pn * HALF + wc * 32 + 8 * fq;
#pragma unroll
        for (int ai = 0; ai < 2; ++ai)
#pragma unroll
            for (int m = 0; m < 4; ++m) {
                f32x4 v0, v1;
#pragma unroll
                for (int i = 0; i < 4; ++i) { const float g0 = acc[ai][0][m][0][i], g1 = acc[ai][0][m][1][i];
                    v0[i] = g0 * sigmoidf_(g0) * acc[ai][1][m][0][i]; v1[i] = g1 * sigmoidf_(g1) * acc[ai][1][m][1][i]; }
                *(u32x4*)(act + (size_t)(row0 + ai * HALF + m * 16) * 2048 + col0) = pack8(v0, v1); }
    }
};

struct EpiProj2 {
    static constexpr bool PERM = true, AFTER_DRAIN = false;
    bf16_t* qkv; bf16_t* gates; const float* b_gate; const float* qn_g; const float* kn_g; const float* ropeA; const float* ropeB;
    typedef unsigned u32x2_t __attribute__((ext_vector_type(2)));
    __device__ __forceinline__ void operator()(const f32x4 (&acc)[2][2][4][2], const Unit& u, int wr, int wc, int fr, int fq) const {
        const int row0 = u.pm * BM + wr * 64 + fr;
        if (u.pn >= 12) {
            const int col0 = (u.pn - 12) * BM + wc * 32 + 8 * fq;
            f32x4 bv[2][2];
#pragma unroll
            for (int bj = 0; bj < 2; ++bj)
#pragma unroll
                for (int n = 0; n < 2; ++n) bv[bj][n] = *(const f32x4*)(b_gate + col0 + bj * HALF + 4 * n);
#pragma unroll
            for (int ai = 0; ai < 2; ++ai)
#pragma unroll
                for (int m = 0; m < 4; ++m) { bf16_t* rowp = gates + (size_t)(row0 + ai * HALF + m * 16) * 2048 + col0;
#pragma unroll
                    for (int bj = 0; bj < 2; ++bj) { f32x4 v0 = acc[ai][bj][m][0] + bv[bj][0], v1 = acc[ai][bj][m][1] + bv[bj][1];
#pragma unroll
                        for (int i = 0; i < 4; ++i) { v0[i] = sigmoidf_(v0[i]); v1[i] = sigmoidf_(v1[i]); }
                        *(u32x4*)(rowp + bj * HALF) = pack8(v0, v1); } }
            return;
        }
        int kind, colbase;
        if (u.pn < 2) { kind = 0; colbase = OFF_QA + (4 * u.pn + wc) * 64; }
        else if (u.pn == 2) { if (wc < 2) { kind = 1; colbase = OFF_KA + wc * 64; } else { kind = 2; colbase = OFF_VA + (wc - 2) * 64; } }
        else if (u.pn < 6) { kind = 3; colbase = OFF_QB + (4 * (u.pn - 3) + wc) * 64; }
        else if (u.pn < 9) { kind = 4; colbase = OFF_KB + (4 * (u.pn - 6) + wc) * 64; }
        else { kind = 2; colbase = OFF_VB + (4 * (u.pn - 9) + wc) * 64; }
        if (kind <= 1) {
            const float* gn = kind == 0 ? qn_g : kn_g; const float sc = kind == 0 ? C2 : 1.0f;
            f32x4 g[2][2];
#pragma unroll
            for (int bj = 0; bj < 2; ++bj)
#pragma unroll
                for (int n = 0; n < 2; ++n) g[bj][n] = *(const f32x4*)(gn + 32 * n + 16 * bj + 4 * fq) * sc;
#pragma unroll
            for (int ai = 0; ai < 2; ++ai)
#pragma unroll
                for (int m = 0; m < 4; ++m) { const int row = row0 + ai * HALF + m * 16; const float* ta = ropeA + (size_t)(row & (SEQ - 1)) * 64 + 4 * fq;
                    float ss = 0.f;
#pragma unroll
                    for (int bj = 0; bj < 2; ++bj)
#pragma unroll
                        for (int n = 0; n < 2; ++n) { const f32x4 x = acc[ai][bj][m][n]; ss += (x[0] * x[0] + x[1] * x[1]) + (x[2] * x[2] + x[3] * x[3]); }
                    ss += __shfl_xor(ss, 16); ss += __shfl_xor(ss, 32);
                    const float rs = 1.0f / sqrtf(ss * (1.0f / 64.0f) + QK_EPS);
                    bf16_t* rowp = qkv + (size_t)row * QKVW + colbase + 4 * fq;
#pragma unroll
                    for (int n = 0; n < 2; ++n) { const f32x4 cs = *(const f32x4*)(ta + n * 32), sn = *(const f32x4*)(ta + n * 32 + 16);
                        const f32x4 x1 = acc[ai][0][m][n] * rs * g[0][n], x2 = acc[ai][1][m][n] * rs * g[1][n];
                        const f32x4 o1 = x1 * cs - x2 * sn, o2 = x2 * cs + x1 * sn;
                        u32x2_t w1, w2; w1.x = cvt_pk_bf16(o1[0], o1[1]); w1.y = cvt_pk_bf16(o1[2], o1[3]); w2.x = cvt_pk_bf16(o2[0], o2[1]); w2.y = cvt_pk_bf16(o2[2], o2[3]);
                        *(u32x2_t*)(rowp + 32 * n) = w1; *(u32x2_t*)(rowp + 32 * n + 16) = w2; } }
        } else if (kind == 2) {
#pragma unroll
            for (int ai = 0; ai < 2; ++ai)
#pragma unroll
                for (int m = 0; m < 4; ++m) { bf16_t* rowp = qkv + (size_t)(row0 + ai * HALF + m * 16) * QKVW + colbase + 8 * fq;
#pragma unroll
                    for (int bj = 0; bj < 2; ++bj) *(u32x4*)(rowp + 32 * bj) = pack8(acc[ai][bj][m][0], acc[ai][bj][m][1]); }
        } else {
            const float sc = kind == 3 ? C2 : 1.0f;
#pragma unroll
            for (int ai = 0; ai < 2; ++ai)
#pragma unroll
                for (int m = 0; m < 4; ++m) { const int row = row0 + ai * HALF + m * 16; const float* tb = ropeB + (size_t)(row & (SEQ - 1)) * 16;
                    f32x4 a0 = acc[ai][0][m][0], a1 = acc[ai][0][m][1], b0 = acc[ai][1][m][0], b1 = acc[ai][1][m][1];
                    if (fq == 0) { const f32x4 c0 = *(const f32x4*)(tb), c1 = *(const f32x4*)(tb + 4), s0 = *(const f32x4*)(tb + 8), s1 = *(const f32x4*)(tb + 12);
                        const f32x4 o0 = a0 * c0 - b0 * s0, p0 = b0 * c0 + a0 * s0, o1 = a1 * c1 - b1 * s1, p1 = b1 * c1 + a1 * s1; a0 = o0; b0 = p0; a1 = o1; b1 = p1; }
                    a0 = a0 * sc; a1 = a1 * sc; b0 = b0 * sc; b1 = b1 * sc;
                    bf16_t* rowp = qkv + (size_t)row * QKVW + colbase + 16 * fq;
                    *(u32x4*)(rowp) = pack8(a0, a1); *(u32x4*)(rowp + 8) = pack8(b0, b1); }
        }
    }
};
template <class Epi, class Sched, bool ALIGN_EPI = false, bool SP2 = false>
__device__ __forceinline__ void gemm_phase(PG8_LAS unsigned char* lds, const Gemm g, const Sched& S, const Epi& E) {
    int tid_ = threadIdx.x; asm volatile("" : "+v"(tid_));
    const int tid = tid_, wid = __builtin_amdgcn_readfirstlane(tid >> 6), lane = tid & 63, wr = wid >> 2, wc = wid & 3, fr = lane & 15, fq = lane >> 4;
    const int K = g.K, nt = K / BK;
    unsigned voffA[2], voffB[2];
#pragma unroll
    for (int i = 0; i < 2; ++i) { int R, C; stage_rc(tid * 16 + i * 8192, R, C); const int Rb = Epi::PERM ? ((R & ~31) + perm32(R & 31)) : R;
        voffA[i] = (unsigned)(R * K + C) * 2u; voffB[i] = (unsigned)(Rb * K + C) * 2u; }
    const size_t kstep = (size_t)(BK * 2);
    const size_t hstep = (size_t)HALF * K * 2;
    const size_t tstep = 2 * hstep;
    const unsigned ldsw = (unsigned)wid * 1024u;
    const int aoff = lds_byte(wr * 64 + fr, fq * 8), boff = lds_byte(wc * 32 + fr, fq * 8);
#define PG8_SA(b, h) (((b) * 2 + (h)) * HTB)
#define PG8_SB(b, h) ((4 + (b) * 2 + (h)) * HTB)
#define PG8_STAGE(bufoff, gbase, voff) do { _Pragma("unroll") for (int _i = 0; _i < 2; ++_i) \
        __builtin_amdgcn_global_load_lds((const unsigned*)((const char*)(gbase) + (voff)[_i]), (PG8_LAS unsigned*)(lds + (bufoff) + ldsw + _i * 8192), 16, 0, 0); } while (0)
#define PG8_LDA(dst, b, h) do { _Pragma("unroll") for (int m = 0; m < 4; ++m) _Pragma("unroll") for (int k = 0; k < 2; ++k) dst[m][k] = *(const PG8_LAS bf16x8*)(lds + PG8_SA(b, h) + aoff + m * 2048 + k * 1024); } while (0)
#define PG8_LDB(dst, b, h) do { _Pragma("unroll") for (int n = 0; n < 2; ++n) _Pragma("unroll") for (int k = 0; k < 2; ++k) dst[n][k] = *(const PG8_LAS bf16x8*)(lds + PG8_SB(b, h) + boff + n * 2048 + k * 1024); } while (0)
#define PG8_MMA(ai, bj, At, Bt) do { __builtin_amdgcn_s_setprio(1); _Pragma("unroll") for (int m = 0; m < 4; ++m) _Pragma("unroll") for (int n = 0; n < 2; ++n) _Pragma("unroll") for (int k = 0; k < 2; ++k) \
        acc[ai][bj][m][n] = __builtin_amdgcn_mfma_f32_16x16x32_bf16(Bt[n][k], At[m][k], acc[ai][bj][m][n], 0, 0, 0); __builtin_amdgcn_s_setprio(0); } while (0)
#define PG8_WAIT_V(n) asm volatile("s_waitcnt vmcnt(" #n ")" ::: "memory")
#define PG8_WAIT_L(n) asm volatile("s_waitcnt lgkmcnt(" #n ")" ::: "memory")
#define PG8_BAR __builtin_amdgcn_s_barrier()
#define PG8_SCHED __builtin_amdgcn_sched_barrier(0)
    Unit cur, nxt; int ui = 0;
    if (!S.next(0, cur)) return;
    f32x4 acc[2][2][4][2];
#pragma unroll
    for (int a = 0; a < 2; ++a)
#pragma unroll
        for (int b = 0; b < 2; ++b)
#pragma unroll
            for (int m = 0; m < 4; ++m)
#pragma unroll
                for (int n = 0; n < 2; ++n) acc[a][b][m][n] = (f32x4){0.f, 0.f, 0.f, 0.f};
    bf16x8 At[4][2], B0[2][2], B1[2][2];
    const char* cA = (const char*)g.A + (size_t)cur.am * tstep; const char* cB = (const char*)g.Bt + (size_t)cur.bt * tstep;
    S.a_ready(cur);
    if constexpr (SP2) {
        PG8_STAGE(PG8_SB(0, 0), cB, voffB); PG8_STAGE(PG8_SB(0, 1), cB + hstep, voffB); PG8_STAGE(PG8_SA(0, 0), cA, voffA); PG8_STAGE(PG8_SA(0, 1), cA + hstep, voffA);
        if (wr == 1) PG8_BAR;
        PG8_WAIT_V(2); PG8_BAR;
        PG8_STAGE(PG8_SB(1, 0), cB + kstep, voffB); PG8_STAGE(PG8_SA(1, 0), cA + kstep, voffA); PG8_STAGE(PG8_SB(1, 1), cB + hstep + kstep, voffB);
        PG8_WAIT_V(6); PG8_BAR;
    } else {
        PG8_STAGE(PG8_SB(0, 0), cB, voffB); PG8_STAGE(PG8_SA(0, 0), cA, voffA); PG8_STAGE(PG8_SB(0, 1), cB + hstep, voffB); PG8_STAGE(PG8_SA(0, 1), cA + hstep, voffA);
        if (wr == 1) PG8_BAR;
        PG8_WAIT_V(4); PG8_BAR;
        PG8_STAGE(PG8_SB(1, 0), cB + kstep, voffB); PG8_STAGE(PG8_SA(1, 0), cA + kstep, voffA); PG8_STAGE(PG8_SB(1, 1), cB + hstep + kstep, voffB);
        PG8_WAIT_V(6); PG8_BAR;
    }
    for (;;) {
        const bool has_next = S.next(ui + 1, nxt);
        const char* nA = has_next ? (const char*)g.A + (size_t)nxt.am * tstep : cA; const char* nB = has_next ? (const char*)g.Bt + (size_t)nxt.bt * tstep : cB;
        for (int t = 0; t < nt; t += 2) {
            const bool last = (t == nt - 2);
            const char* a1 = cA + (size_t)(t + 1) * kstep;
            const char* a2 = last ? nA : cA + (size_t)(t + 2) * kstep; const char* b2 = last ? nB : cB + (size_t)(t + 2) * kstep;
            const char* a3 = a2 + kstep; const char* b3 = b2 + kstep;
            if (last && has_next) S.a_ready(nxt);
            if constexpr (SP2) {
            PG8_LDB(B0, 0, 0); PG8_LDB(B1, 0, 1); PG8_SCHED; PG8_LDA(At, 0, 0); PG8_STAGE(PG8_SA(1, 1), a1 + hstep, voffA);
            PG8_WAIT_V(8); PG8_WAIT_L(0); PG8_BAR; PG8_MMA(0, 0, At, B0); PG8_MMA(0, 1, At, B1); PG8_BAR; PG8_SCHED;
            PG8_LDA(At, 0, 1); PG8_STAGE(PG8_SB(0, 0), b2, voffB); PG8_STAGE(PG8_SB(0, 1), b2 + hstep, voffB); PG8_STAGE(PG8_SA(0, 0), a2, voffA);
            PG8_WAIT_V(8); PG8_WAIT_L(0); PG8_BAR; PG8_MMA(1, 0, At, B0); PG8_MMA(1, 1, At, B1); PG8_BAR; PG8_SCHED;
            PG8_LDB(B0, 1, 0); PG8_LDB(B1, 1, 1); PG8_SCHED; PG8_LDA(At, 1, 0); PG8_STAGE(PG8_SA(0, 1), a2 + hstep, voffA);
            PG8_WAIT_V(8); PG8_WAIT_L(0); PG8_BAR; PG8_MMA(0, 0, At, B0); PG8_MMA(0, 1, At, B1); PG8_BAR; PG8_SCHED;
            PG8_LDA(At, 1, 1); PG8_STAGE(PG8_SB(1, 0), b3, voffB); PG8_STAGE(PG8_SB(1, 1), b3 + hstep, voffB); PG8_STAGE(PG8_SA(1, 0), a3, voffA);
            PG8_WAIT_V(8); PG8_WAIT_L(0); PG8_BAR; PG8_MMA(1, 0, At, B0); PG8_MMA(1, 1, At, B1); PG8_BAR; PG8_SCHED;
            } else {
            PG8_LDB(B0, 0, 0); PG8_SCHED; PG8_LDA(At, 0, 0); PG8_STAGE(PG8_SA(1, 1), a1 + hstep, voffA);
            PG8_WAIT_L(8); PG8_BAR; PG8_WAIT_L(0); PG8_MMA(0, 0, At, B0); PG8_BAR; PG8_SCHED;
            PG8_LDB(B1, 0, 1); PG8_STAGE(PG8_SB(0, 0), b2, voffB);
            PG8_BAR; PG8_WAIT_L(0); PG8_MMA(0, 1, At, B1); PG8_BAR;
            PG8_LDA(At, 0, 1); PG8_STAGE(PG8_SA(0, 0), a2, voffA);
            PG8_BAR; PG8_WAIT_L(0); PG8_MMA(1, 0, At, B0); PG8_BAR; PG8_SCHED;
            PG8_STAGE(PG8_SB(0, 1), b2 + hstep, voffB);
            PG8_WAIT_V(6); PG8_BAR; PG8_MMA(1, 1, At, B1); PG8_BAR;
            PG8_LDB(B0, 1, 0); PG8_SCHED; PG8_LDA(At, 1, 0); PG8_STAGE(PG8_SA(0, 1), a2 + hstep, voffA);
            PG8_WAIT_L(8); PG8_BAR; PG8_WAIT_L(0); PG8_MMA(0, 0, At, B0); PG8_BAR; PG8_SCHED;
            PG8_LDB(B1, 1, 1); PG8_STAGE(PG8_SB(1, 0), b3, voffB);
            PG8_BAR; PG8_WAIT_L(0); PG8_MMA(0, 1, At, B1); PG8_BAR;
            PG8_LDA(At, 1, 1); PG8_STAGE(PG8_SA(1, 0), a3, voffA);
            PG8_BAR; PG8_WAIT_L(0); PG8_MMA(1, 0, At, B0); PG8_BAR; PG8_SCHED;
            PG8_STAGE(PG8_SB(1, 1), b3 + hstep, voffB);
            PG8_WAIT_V(6); PG8_BAR; PG8_MMA(1, 1, At, B1); PG8_BAR;
            }
        }
        if constexpr (ALIGN_EPI) { if (wr == 0) PG8_BAR; }
        if constexpr (!Epi::AFTER_DRAIN) { E(acc, cur, wr, wc, fr, fq); S.done(cur); }
        if (!has_next) break;
#pragma unroll
        for (int a = 0; a < 2; ++a)
#pragma unroll
            for (int b = 0; b < 2; ++b)
#pragma unroll
                for (int m = 0; m < 4; ++m)
#pragma unroll
                    for (int n = 0; n < 2; ++n) acc[a][b][m][n] = (f32x4){0.f, 0.f, 0.f, 0.f};
        cur = nxt; cA = nA; cB = nB; ++ui;
        if constexpr (ALIGN_EPI) { if (wr == 1) PG8_BAR; }
    }
    PG8_WAIT_V(0);
    if constexpr (!ALIGN_EPI) { if (wr == 0) PG8_BAR; }
    PG8_BAR;
    if constexpr (Epi::AFTER_DRAIN) { E.fused(acc, cur, wr, wc, fr, fq, lds, wid, lane); S.done(cur); }
#undef PG8_SA
#undef PG8_SB
#undef PG8_STAGE
#undef PG8_LDA
#undef PG8_LDB
#undef PG8_MMA
#undef PG8_WAIT_V
#undef PG8_WAIT_L
#undef PG8_BAR
#undef PG8_SCHED
}
}
#include <hip/hip_bf16.h>
#include <cmath>
namespace attn_body {
using bf16=__hip_bfloat16;
using bf16x8=__attribute__((ext_vector_type(8)))short;
using s16x4=__attribute__((ext_vector_type(4)))short;
using f32x16=__attribute__((ext_vector_type(16)))float;
using u32x4=__attribute__((ext_vector_type(4)))unsigned;
constexpr int BATCH=16,NHEAD=8,SEQ=2048,D=64,PQ=3072,PO=512;
constexpr int NW=8,QBLK=32,QB=QBLK*NW,KVBLK=64,NQB=SEQ/QB;
constexpr int ATTN_UNIT_ROWS=QB;
__device__ __forceinline__ int crow(int r,int hi){return (r&3)+8*(r>>2)+4*hi;}
#define SBAR() __builtin_amdgcn_sched_barrier(0)
__device__ __forceinline__ void cmask(f32x16&p0,f32x16&p1,int jb,int qrel,int hi){
  const float NEG=-INFINITY; int kb=64*jb+4*hi;
  #pragma unroll
  for(int r=0;r<16;++r){int kv=kb+(r&3)+8*(r>>2); if(kv>qrel)p0[r]=NEG; if(kv+32>qrel)p1[r]=NEG;}
}

constexpr int NSLOT=3, SLOTB=8192;
constexpr int LDS_K=0, LDS_V=NSLOT*SLOTB, LDS_WS=2*NSLOT*SLOTB, LDS_OST=LDS_WS+NW*64*4, LDS_BYTES=LDS_OST+NW*4096;
constexpr float C2=0.125f*1.4426950408889634f;
__device__ __forceinline__ void glds16(const void*gsrc,unsigned lds_dst){unsigned keep;
  asm volatile("s_mov_b32 %0, m0\n\ts_mov_b32 m0, %2\n\ts_nop 0\n\tglobal_load_lds_dwordx4 %1, off\n\ts_mov_b32 m0, %0":"=&s"(keep):"v"(gsrc),"s"(lds_dst):"memory");}
__device__ __forceinline__ float max3f(float a,float b,float c){float r;asm("v_max3_f32 %0, %1, %2, %3":"=v"(r):"v"(a),"v"(b),"v"(c));return r;}
__device__ __forceinline__ float max2f(float a,float b){float r;asm("v_max_f32_e32 %0, %1, %2":"=v"(r):"v"(a),"v"(b));return r;}
__device__ __forceinline__ float fadd_s(float a,float b){float r;asm("v_add_f32_e32 %0, %1, %2":"=v"(r):"v"(a),"v"(b));return r;}
__device__ __forceinline__ float fsub_s(float a,float b){float r;asm("v_sub_f32_e32 %0, %1, %2":"=v"(r):"v"(a),"v"(b));return r;}
typedef float f32x2_t __attribute__((ext_vector_type(2))); typedef __bf16 bf16x2_t __attribute__((ext_vector_type(2)));
__device__ __forceinline__ unsigned cvtpk_s(float lo,float hi){f32x2_t v={lo,hi};bf16x2_t b=__builtin_convertvector(v,bf16x2_t);return __builtin_bit_cast(unsigned,b);}
#define WAIT_BAR(N) asm volatile("s_waitcnt vmcnt(" #N ") lgkmcnt(0)\n\ts_barrier":::"memory")

__device__ __forceinline__ void qkt(f32x16&p0,f32x16&p1,const char*Kslot,const bf16x8*qr,const f32x16&negm,int r32,int hi){
  const char*kb=Kslot+hi*1024+r32*16;
  #pragma unroll
  for(int d0=0;d0<4;++d0){
    const bf16x8 b0=*reinterpret_cast<const bf16x8*>(kb+d0*2048);
    const bf16x8 b1=*reinterpret_cast<const bf16x8*>(kb+d0*2048+512);
    if(d0==0){p0=__builtin_amdgcn_mfma_f32_32x32x16_bf16(b0,qr[0],negm,0,0,0);p1=__builtin_amdgcn_mfma_f32_32x32x16_bf16(b1,qr[0],negm,0,0,0);}
    else{p0=__builtin_amdgcn_mfma_f32_32x32x16_bf16(b0,qr[d0],p0,0,0,0);p1=__builtin_amdgcn_mfma_f32_32x32x16_bf16(b1,qr[d0],p1,0,0,0);}}
}
typedef __attribute__((address_space(3))) const char* lds_cptr;
typedef short v4i16_t __attribute__((ext_vector_type(4)));
__device__ __forceinline__ void kload8(bf16x8*kf,lds_cptr kp){
  kf[0]=*(const __attribute__((address_space(3))) bf16x8*)(kp);      kf[1]=*(const __attribute__((address_space(3))) bf16x8*)(kp+512);
  kf[2]=*(const __attribute__((address_space(3))) bf16x8*)(kp+2048); kf[3]=*(const __attribute__((address_space(3))) bf16x8*)(kp+2560);
  kf[4]=*(const __attribute__((address_space(3))) bf16x8*)(kp+4096); kf[5]=*(const __attribute__((address_space(3))) bf16x8*)(kp+4608);
  kf[6]=*(const __attribute__((address_space(3))) bf16x8*)(kp+6144); kf[7]=*(const __attribute__((address_space(3))) bf16x8*)(kp+6656);
}
__device__ __forceinline__ void kload2(bf16x8*kf,lds_cptr kp,int j){ kf[2*j]=*(const __attribute__((address_space(3))) bf16x8*)(kp+j*2048); kf[2*j+1]=*(const __attribute__((address_space(3))) bf16x8*)(kp+j*2048+512); }
__device__ __forceinline__ s16x4 vtr(lds_cptr p){ return __builtin_bit_cast(s16x4,__builtin_amdgcn_ds_read_tr16_b64_v4i16((__attribute__((address_space(3))) v4i16_t*)p)); }
__device__ __forceinline__ float rowmax(const f32x16&p0,const f32x16&p1){
  float a=max3f(p0[0],p0[1],p1[0]),b=max3f(p0[2],p0[3],p1[1]);a=max3f(a,p1[2],p1[3]);
  #pragma unroll
  for(int r=4;r<16;r+=4){a=max3f(a,p0[r],p0[r+1]);b=max3f(b,p0[r+2],p0[r+3]);a=max3f(a,p1[r],p1[r+1]);b=max3f(b,p1[r+2],p1[r+3]);}
  const float m=max2f(a,b);
  auto rr=__builtin_amdgcn_permlane32_swap(__float_as_uint(m),__float_as_uint(m),false,false);
  return max2f(__uint_as_float(rr[0]),__uint_as_float(rr[1]));
}
__device__ __forceinline__ void pv(f32x16*o,int vb,bf16x8 pa0,bf16x8 pa1,bf16x8 pa2,bf16x8 pa3){
  #pragma unroll
  for(int d0=0;d0<2;++d0){s16x4 lo[4],hi[4];
    #pragma unroll
    for(int ks=0;ks<4;++ks){
      asm volatile("ds_read_b64_tr_b16 %0,%1 offset:%c2":"=&v"(lo[ks]):"v"(vb),"i"(d0*4096+ks*1024):"memory");
      asm volatile("ds_read_b64_tr_b16 %0,%1 offset:%c2":"=&v"(hi[ks]):"v"(vb),"i"(d0*4096+ks*1024+512):"memory");}
    asm volatile("s_waitcnt lgkmcnt(0)":::"memory");SBAR();
    #define PK(k) (bf16x8){lo[k][0],lo[k][1],lo[k][2],lo[k][3],hi[k][0],hi[k][1],hi[k][2],hi[k][3]}
    o[d0]=__builtin_amdgcn_mfma_f32_32x32x16_bf16(pa0,PK(0),o[d0],0,0,0);
    o[d0]=__builtin_amdgcn_mfma_f32_32x32x16_bf16(pa1,PK(1),o[d0],0,0,0);
    o[d0]=__builtin_amdgcn_mfma_f32_32x32x16_bf16(pa2,PK(2),o[d0],0,0,0);
    o[d0]=__builtin_amdgcn_mfma_f32_32x32x16_bf16(pa3,PK(3),o[d0],0,0,0);
    #undef PK
  }
}

#ifndef ATTN_STORE16
#define ATTN_STORE16(p,v) (*(u32x4*)(p)=(v))
#endif
template<int THRL> __device__ __forceinline__ void attn_unit(int b,int h,int kvh,int qb,const bf16*Q,const bf16*__restrict__ K,const bf16*__restrict__ V,bf16*O,char*shm){
  int tid_=threadIdx.x; asm volatile("":"+v"(tid_)); const int tid=tid_,lane=tid&63,r32=lane&31,hi=lane>>5; const int wid=__builtin_amdgcn_readfirstlane(tid>>6);
  const long rowbase=(long)b*SEQ; const int q0=qb*QB;
  const bf16*Qw=Q+(rowbase+q0+wid*QBLK)*PQ+h*D;
  const bf16*Kh=K+rowbase*PQ+kvh*D,*Vh=V+rowbase*PQ+kvh*D;
  const unsigned lds0=(unsigned)(uintptr_t)shm;
  float*wsf=(float*)(shm+LDS_WS)+wid*64;
  const bf16*ksrc=Kh+(long)lane*PQ+wid*8;
  const bf16*vsrc=Vh+(long)(16*(wid&3)+(lane>>2))*PQ+(wid>>2)*32+(lane&3)*8;
  const unsigned kdst=lds0+LDS_K+wid*1024, vdst=lds0+LDS_V+wid*1024;
  #define DMA_K(t,slot) glds16(ksrc+(long)(t)*KVBLK*PQ,(unsigned)__builtin_amdgcn_readfirstlane(kdst+(slot)))
  #define DMA_V(t,slot) glds16(vsrc+(long)(t)*KVBLK*PQ,(unsigned)__builtin_amdgcn_readfirstlane(vdst+(slot)))
  const int vb0=(int)(lds0+LDS_V)+((lane>>4)&1)*32+(lane&3)*8+(4*hi+((lane&15)>>2))*64;
  const char*Kbase=shm+LDS_K; bf16x8 kf[8];
  const lds_cptr shm3=(lds_cptr)shm; const lds_cptr kp0=shm3+LDS_K+hi*1024+r32*16; const lds_cptr vp0=shm3+LDS_V+((lane>>4)&1)*32+(lane&3)*8+(4*hi+((lane&15)>>2))*64;
  constexpr int NT=SEQ/KVBLK;
  DMA_K(0,0);DMA_V(0,0);DMA_K(1,SLOTB);
  bf16x8 qr[4];
  #pragma unroll
  for(int d0=0;d0<4;++d0)qr[d0]=*reinterpret_cast<const bf16x8*>(&Qw[(long)r32*PQ+d0*16+hi*8]);
  float mhat=0.f,l_reg=0.f;f32x16 o[2];o[0]=f32x16{};o[1]=f32x16{};f32x16 negm=f32x16{};asm volatile("":"+v"(negm));

  #define CMASK(P0,P1,t) do{}while(0)
  bool resc=false;
  #define START(P0,P1) do{ const float rm=rowmax(P0,P1); resc=false; \
    { const float dl=rm; mhat=fadd_s(mhat,dl); \
      _Pragma("unroll") for(int r=0;r<16;++r){P0[r]=fsub_s(P0[r],dl);P1[r]=fsub_s(P1[r],dl);} \
      _Pragma("unroll") for(int r=0;r<16;++r)negm[r]=-mhat; asm volatile("":"+v"(negm)); } \
    _Pragma("unroll") for(int r=0;r<16;++r)P0[r]=__builtin_amdgcn_exp2f(P0[r]); }while(0)
  #define RESC() do{ if(resc){ asm volatile("s_waitcnt lgkmcnt(0)":::"memory"); \
      _Pragma("unroll") for(int d_=0;d_<2;++d_) _Pragma("unroll") for(int r=0;r<16;++r)o[d_][r]*=wsf[crow(r,hi)]; } }while(0)
  f32x16 pA0,pA1,pB0,pB1;
  int sl_prev=0,sl_cur=0,sl_next=SLOTB;
  #define ROT() do{sl_prev=sl_cur;sl_cur=sl_next;sl_next=(sl_next==(NSLOT-1)*SLOTB)?0:sl_next+SLOTB;}while(0)
  DMA_K(2,2*SLOTB);
  WAIT_BAR(3);
  qkt(pA0,pA1,Kbase,qr,negm,r32,hi);asm volatile("s_nop 15\n\ts_nop 7":"+v"(pA0),"+v"(pA1));CMASK(pA0,pA1,0);
  START(pA0,pA1);
  _Pragma("unroll") for(int r=0;r<16;++r)pA1[r]=__builtin_amdgcn_exp2f(pA1[r]);
  WAIT_BAR(0);
  DMA_K(3,0);DMA_V(1,SLOTB);
  ROT();
  kload8(kf,kp0+sl_cur);
  WAIT_BAR(2);
  s16x4 vlo[8],vhi[8]; u32x4 pw0,pw1,pw2,pw3;
  #define PKW(P,B) cvtpk_s(P[B],P[B+1])
  #define PAF(k) __builtin_bit_cast(bf16x8,pw##k)
  #define VFR(i) (bf16x8){vlo[i][0],vlo[i][1],vlo[i][2],vlo[i][3],vhi[i][0],vhi[i][1],vhi[i][2],vhi[i][3]}
  #define PIN(x) asm volatile("":"+v"(x))
  #define MX3(a,b,c) __builtin_fmaxf(__builtin_fmaxf((a),(b)),(c))
  #define GAPA(MF,A0,A1,A2,A3,W0,W1,PW) do{ MF; sacc+=A0; sacc+=A1; sacc+=A2; sacc+=A3; PIN(sacc); W0; W1; PIN(PW); SBAR(); }while(0)
  #define EX(v) __builtin_amdgcn_exp2f(v)
  #define GAPB(MF,X,B) do{ MF; X[B]=EX(X[B]); X[B+1]=EX(X[B+1]); X[B+2]=EX(X[B+2]); X[B+3]=EX(X[B+3]); PIN(X); SBAR(); }while(0)
  #define VRD(i) do{ vlo[i]=vtr(vp_+(((i)>>2)*4096+((i)&3)*1024)); vhi[i]=vtr(vp_+(((i)>>2)*4096+((i)&3)*1024+512)); }while(0)
  #define KRD(G,j) do{ if(G){ kload2(kf,kp0+sl_next,j); SBAR(); } }while(0)
  #define STEP(C0,C1,P0,P1,t,GK,GV,GL) do{ SBAR(); \
    const lds_cptr vp_=vp0+sl_prev; \
    VRD(0); SBAR(); float sacc=(P0[0]+P0[1]); \
    GAPA(C0=__builtin_amdgcn_mfma_f32_32x32x16_bf16(kf[0],qr[0],negm,0,0,0), P0[2],P0[3],P0[4],P0[5],     pw0[0]=PKW(P0,0), pw0[1]=PKW(P0,2), pw0); \
    VRD(4); SBAR(); GAPA(C1=__builtin_amdgcn_mfma_f32_32x32x16_bf16(kf[1],qr[0],negm,0,0,0), P0[6],P0[7],P0[8],P0[9],     pw0[2]=PKW(P0,4), pw0[3]=PKW(P0,6), pw0); \
    VRD(1); SBAR(); GAPA(C0=__builtin_amdgcn_mfma_f32_32x32x16_bf16(kf[2],qr[1],C0,0,0,0),   P0[10],P0[11],P0[12],P0[13], pw1[0]=PKW(P0,8), pw1[1]=PKW(P0,10), pw1); \
    VRD(5); SBAR(); GAPA(C1=__builtin_amdgcn_mfma_f32_32x32x16_bf16(kf[3],qr[1],C1,0,0,0),   P0[14],P0[15],P1[0],P1[1],   pw1[2]=PKW(P0,12),pw1[3]=PKW(P0,14), pw1); \
    VRD(2); SBAR(); GAPA(C0=__builtin_amdgcn_mfma_f32_32x32x16_bf16(kf[4],qr[2],C0,0,0,0),   P1[2],P1[3],P1[4],P1[5],     pw2[0]=PKW(P1,0), pw2[1]=PKW(P1,2), pw2); \
    VRD(6); SBAR(); GAPA(C1=__builtin_amdgcn_mfma_f32_32x32x16_bf16(kf[5],qr[2],C1,0,0,0),   P1[6],P1[7],P1[8],P1[9],     pw2[2]=PKW(P1,4), pw2[3]=PKW(P1,6), pw2); \
    VRD(3); SBAR(); GAPA(C0=__builtin_amdgcn_mfma_f32_32x32x16_bf16(kf[6],qr[3],C0,0,0,0),   P1[10],P1[11],P1[12],P1[13], pw3[0]=PKW(P1,8), pw3[1]=PKW(P1,10), pw3); \
    VRD(7); SBAR(); GAPA(C1=__builtin_amdgcn_mfma_f32_32x32x16_bf16(kf[7],qr[3],C1,0,0,0),   P1[14],P1[15],0.f,0.f,       pw3[2]=PKW(P1,12),pw3[3]=PKW(P1,14), pw3); \
    l_reg+=sacc; \
    if(GK){DMA_K((t)+3,sl_cur);} if(GV){DMA_V((t)+1,sl_next);} \
    CMASK(C0,C1,t); \
    { float a=MX3(C0[0],C0[1],C1[0]),b=MX3(C0[2],C0[3],C1[1]); a=MX3(a,C1[2],C1[3]); \
      _Pragma("unroll") for(int r=4;r<16;r+=4){a=MX3(a,C0[r],C0[r+1]);b=MX3(b,C0[r+2],C0[r+3]);a=MX3(a,C1[r],C1[r+1]);b=MX3(b,C1[r+2],C1[r+3]);} \
      float rm=__builtin_fmaxf(a,b); { auto rr=__builtin_amdgcn_permlane32_swap(__float_as_uint(rm),__float_as_uint(rm),false,false); rm=__builtin_fmaxf(__uint_as_float(rr[0]),__uint_as_float(rr[1])); } \
      resc=false; \
      if(__builtin_expect(__any(rm>(float)THRL),0)){ const float dl=__builtin_fmaxf(rm,0.f); mhat+=dl; \
        _Pragma("unroll") for(int r=0;r<16;++r){C0[r]-=dl;C1[r]-=dl;} \
        _Pragma("unroll") for(int r=0;r<16;++r)negm[r]=-mhat; asm volatile("":"+v"(negm)); \
        const float f=__builtin_amdgcn_exp2f(-dl); l_reg*=f; if(hi==0)wsf[r32]=f; resc=true; } } \
    SBAR(); \
    GAPB(o[0]=__builtin_amdgcn_mfma_f32_32x32x16_bf16(PAF(0),VFR(0),o[0],0,0,0), C0,0); \
    GAPB(o[1]=__builtin_amdgcn_mfma_f32_32x32x16_bf16(PAF(0),VFR(4),o[1],0,0,0), C0,4); \
    KRD(GL,0); GAPB(o[0]=__builtin_amdgcn_mfma_f32_32x32x16_bf16(PAF(1),VFR(1),o[0],0,0,0), C0,8); \
    KRD(GL,1); GAPB(o[1]=__builtin_amdgcn_mfma_f32_32x32x16_bf16(PAF(1),VFR(5),o[1],0,0,0), C0,12); \
    KRD(GL,2); GAPB(o[0]=__builtin_amdgcn_mfma_f32_32x32x16_bf16(PAF(2),VFR(2),o[0],0,0,0), C1,0); \
    KRD(GL,3); GAPB(o[1]=__builtin_amdgcn_mfma_f32_32x32x16_bf16(PAF(2),VFR(6),o[1],0,0,0), C1,4); \
    GAPB(o[0]=__builtin_amdgcn_mfma_f32_32x32x16_bf16(PAF(3),VFR(3),o[0],0,0,0), C1,8); \
    GAPB(o[1]=__builtin_amdgcn_mfma_f32_32x32x16_bf16(PAF(3),VFR(7),o[1],0,0,0), C1,12); \
    }while(0)
  int t=1;
  #undef CMASK
  #define CMASK(P0,P1,t) do{}while(0)
  for(;t+5<NT;t+=2){
    STEP(pB0,pB1,pA0,pA1,t,true,true,true);     WAIT_BAR(2); RESC(); ROT();
    STEP(pA0,pA1,pB0,pB1,t+1,true,true,true);   WAIT_BAR(2); RESC(); ROT();
  }
  #undef CMASK
  #define CMASK(P0,P1,t) do{}while(0)
  #define ENDW(tt) do{ if((tt)+3<NT){WAIT_BAR(2);} else if((tt)+2<NT){WAIT_BAR(1);} else {WAIT_BAR(0);} }while(0)
  for(;t+1<NT;t+=2){
    STEP(pB0,pB1,pA0,pA1,t,(t+3<NT),(t+1<NT),(t+1<NT));       ENDW(t);   RESC(); ROT();
    STEP(pA0,pA1,pB0,pB1,t+1,(t+4<NT),(t+2<NT),(t+2<NT));     ENDW(t+1); RESC(); ROT();
  }
  STEP(pB0,pB1,pA0,pA1,NT-1,false,false,false); RESC();
  { float sacc=pB0[0]+pB0[1]; _Pragma("unroll") for(int r=2;r<16;++r)sacc+=pB0[r]; _Pragma("unroll") for(int r=0;r<16;++r)sacc+=pB1[r]; l_reg+=sacc;
    pw0=(u32x4){PKW(pB0,0),PKW(pB0,2),PKW(pB0,4),PKW(pB0,6)};pw1=(u32x4){PKW(pB0,8),PKW(pB0,10),PKW(pB0,12),PKW(pB0,14)};pw2=(u32x4){PKW(pB1,0),PKW(pB1,2),PKW(pB1,4),PKW(pB1,6)};pw3=(u32x4){PKW(pB1,8),PKW(pB1,10),PKW(pB1,12),PKW(pB1,14)};
    SBAR(); pv(o,vb0+sl_cur,PAF(0),PAF(1),PAF(2),PAF(3)); }
  #undef PKW
  #undef PAF
  #undef VFR
  #undef PIN
  #undef MX3
  #undef GAPA
  #undef GAPB
  #undef EX
  #undef VRD
  #undef KRD
  #undef STEP
  #undef ENDW
  {auto rr=__builtin_amdgcn_permlane32_swap(__float_as_uint(l_reg),__float_as_uint(l_reg),false,false);l_reg=__uint_as_float(rr[0])+__uint_as_float(rr[1]);}
  if(hi==0)wsf[32+r32]=l_reg;asm volatile("s_waitcnt lgkmcnt(0)":::"memory");
  float rli[16];
  #pragma unroll
  for(int r=0;r<16;++r)rli[r]=__builtin_amdgcn_rcpf(wsf[32+crow(r,hi)]);
  bf16*Ow=O+(rowbase+q0+wid*QBLK)*PO+h*D;
  { bf16*stg=(bf16*)(shm+LDS_OST)+wid*2048;
    #pragma unroll
    for(int r=0;r<16;++r){const int orow=crow(r,hi);
      #pragma unroll
      for(int d0=0;d0<2;++d0)stg[orow*64+d0*32+r32]=__float2bfloat16(o[d0][r]*rli[r]);}
    asm volatile("s_waitcnt lgkmcnt(0)":::"memory");
    #pragma unroll
    for(int i=0;i<4;++i){const int row=i*8+(lane>>3),ch=lane&7; const u32x4 v=*(const u32x4*)(stg+row*64+ch*8); ATTN_STORE16(Ow+(long)row*PO+ch*8,v);} }
  asm volatile("s_waitcnt lgkmcnt(0)\n\ts_barrier":::"memory");
  #undef DMA_K
  #undef DMA_V
  #undef CMASK
  #undef START
  #undef RESC
  #undef ROT
}
constexpr int ATTN_LDS_BYTES=LDS_BYTES;
struct AttnTensors { const bf16* Q; const bf16* K; const bf16* V; bf16* O; };
constexpr int BAND_HALF=40960, BAND_K=0, BAND_V=16384, BAND_WS=32768, BAND_OST=81920, BAND_LDS_BYTES=BAND_OST+NW*4096;
__device__ __forceinline__ void band_half_unit(int hu,const bf16*__restrict__ QKV,int offq,int offk,int offv,bf16*OBG,float*LSEG,char*shm){
  int tid_=threadIdx.x; asm volatile("":"+v"(tid_)); const int tid=tid_,lane=tid&63,r32=lane&31,hi=lane>>5; const int wid=__builtin_amdgcn_readfirstlane(tid>>6);
  const int half=wid>>2, wq=wid&3;
  const int uh=__builtin_amdgcn_readfirstlane(2*hu+half);
  const int b=uh/192, rem=uh-b*192, head=rem>>4, ck=rem&15, g=head>>2, j=head&3;
  const int dil=(g==0)?1:(g==1)?4:16, sh=(g==0)?4:(g==1)?2:0;
  const int rc=ck>>sh, c=ck&((1<<sh)-1), ntile=(SEQ/64)/dil;
  const long rowbase=(long)b*SEQ;
  bf16*const OG=OBG+(long)g*BATCH*SEQ*256; float*const LG=LSEG+(long)g*BATCH*SEQ*4;
  const unsigned lds0=(unsigned)(uintptr_t)shm+half*BAND_HALF;
  char*hb=shm+half*BAND_HALF;
  typedef __attribute__((address_space(3))) float* lds_fptr;
  const lds_fptr wsf=(lds_fptr)(hb+BAND_WS+wq*256);
  const int mq=128*c+32*wq+r32;
  const bf16*Qrow=QKV+(rowbase+(long)mq*dil+rc)*PQ+offq+head*D;
  bf16x8 qr[4];
  #pragma unroll
  for(int d0=0;d0<4;++d0)qr[d0]=*reinterpret_cast<const bf16x8*>(&Qrow[d0*16+hi*8]);
  const bf16*Kc=QKV+(rowbase+rc)*PQ+offk+head*D, *Vc=QKV+(rowbase+rc)*PQ+offv+head*D;
  #define BAND_DMA(T,slot) do{ const long p0_=(long)(T)*64; \
      _Pragma("unroll") for(int q_=0;q_<2;++q_){ const int cc_=2*wq+q_; \
        glds16(Kc+((p0_+lane)*dil)*PQ+cc_*8,(unsigned)__builtin_amdgcn_readfirstlane(lds0+BAND_K+(slot)*8192+cc_*1024)); \
        glds16(Vc+((p0_+16*(cc_&3)+(lane>>2))*dil)*PQ+(cc_>>2)*32+(lane&3)*8,(unsigned)__builtin_amdgcn_readfirstlane(lds0+BAND_V+(slot)*8192+cc_*1024)); } }while(0)
  const int T0=2*c-1;
  float mrun=-1e30f,l_reg=0.f; f32x16 o[2]; o[0]=f32x16{}; o[1]=f32x16{};
  const int vb0=(int)(lds0+BAND_V)+((lane>>4)&1)*32+(lane&3)*8+(4*hi+((lane&15)>>2))*64;
  { const int T=T0; if(T>=0&&T<ntile) BAND_DMA(T,0); }
  #pragma unroll 1
  for(int s=0;s<4;++s){
    const int T=T0+s, Tn=T+1; const bool vcur=(T>=0&&T<ntile), vnext=(s<3)&&(Tn>=0&&Tn<ntile);
    if(vnext){ BAND_DMA(Tn,(s+1)&1); asm volatile("s_waitcnt vmcnt(4)":::"memory"); } else { asm volatile("s_waitcnt vmcnt(0)":::"memory"); }
    asm volatile("s_barrier":::"memory");
    const bool act=vcur&&(s>=(wq>>1))&&(s<=(wq>>1)+2);
    if(act){
      f32x16 p0,p1; const f32x16 zero=f32x16{};
      qkt(p0,p1,hb+BAND_K+(s&1)*8192,qr,zero,r32,hi);
      const int kb=64*T+4*hi-mq;
      float mx=-1e30f;
      #pragma unroll
      for(int r=0;r<16;++r){ const int d0_=kb+(r&3)+8*(r>>2), d1_=d0_+32;
        p0[r]=(d0_>=-64&&d0_<=64)?p0[r]:-1e30f; p1[r]=(d1_>=-64&&d1_<=64)?p1[r]:-1e30f; mx=__builtin_fmaxf(mx,__builtin_fmaxf(p0[r],p1[r])); }
      mx=__builtin_fmaxf(mx,__shfl_xor(mx,32));
      const float mnew=__builtin_fmaxf(mrun,mx); const float f=__builtin_amdgcn_exp2f(mrun-mnew); mrun=mnew;
      float sacc=0.f;
      #pragma unroll
      for(int r=0;r<16;++r){ p0[r]=(p0[r]>-1e29f)?__builtin_amdgcn_exp2f(p0[r]-mnew):0.f; p1[r]=(p1[r]>-1e29f)?__builtin_amdgcn_exp2f(p1[r]-mnew):0.f; sacc+=p0[r]+p1[r]; }
      l_reg=l_reg*f+sacc;
      if(hi==0)wsf[r32]=f;
      #pragma unroll
      for(int r=0;r<16;++r){ const float fr=wsf[crow(r,hi)]; o[0][r]*=fr; o[1][r]*=fr; }
      u32x4 pw0,pw1,pw2,pw3;
      pw0=(u32x4){cvtpk_s(p0[0],p0[1]),cvtpk_s(p0[2],p0[3]),cvtpk_s(p0[4],p0[5]),cvtpk_s(p0[6],p0[7])}; pw1=(u32x4){cvtpk_s(p0[8],p0[9]),cvtpk_s(p0[10],p0[11]),cvtpk_s(p0[12],p0[13]),cvtpk_s(p0[14],p0[15])};
      pw2=(u32x4){cvtpk_s(p1[0],p1[1]),cvtpk_s(p1[2],p1[3]),cvtpk_s(p1[4],p1[5]),cvtpk_s(p1[6],p1[7])}; pw3=(u32x4){cvtpk_s(p1[8],p1[9]),cvtpk_s(p1[10],p1[11]),cvtpk_s(p1[12],p1[13]),cvtpk_s(p1[14],p1[15])};
      SBAR(); pv(o,vb0+(s&1)*8192,__builtin_bit_cast(bf16x8,pw0),__builtin_bit_cast(bf16x8,pw1),__builtin_bit_cast(bf16x8,pw2),__builtin_bit_cast(bf16x8,pw3));
    }
    asm volatile("s_waitcnt lgkmcnt(0)\n\ts_barrier":::"memory");
  }
  #undef BAND_DMA
  l_reg+=__shfl_xor(l_reg,32);
  if(hi==0)wsf[32+r32]=l_reg;
  float rli[16];
  #pragma unroll
  for(int r=0;r<16;++r)rli[r]=__builtin_amdgcn_rcpf(wsf[32+crow(r,hi)]);
  { bf16*stg=(bf16*)(shm+BAND_OST)+wid*2048;
    #pragma unroll
    for(int r=0;r<16;++r){const int orow=crow(r,hi);
      #pragma unroll
      for(int d0=0;d0<2;++d0)stg[orow*64+d0*32+r32]=__float2bfloat16(o[d0][r]*rli[r]);}
    asm volatile("s_waitcnt lgkmcnt(0)":::"memory");
    #pragma unroll
    for(int i=0;i<4;++i){const int row=i*8+(lane>>3),ch=lane&7; const u32x4 v=*(const u32x4*)(stg+row*64+ch*8);
      const long grow=rowbase+(long)(128*c+32*wq+row)*dil+rc;
      *(u32x4*)(OG+grow*256+j*64+ch*8)=v;} }
  if(hi==0){ const long grow=rowbase+(long)mq*dil+rc; LG[grow*4+j]=mrun+__builtin_log2f(l_reg); }
  asm volatile("s_waitcnt lgkmcnt(0)\n\ts_barrier":::"memory");
}
#undef SBAR
#undef WAIT_BAR
}
#define GAS __attribute__((address_space(1)))
#define LAS __attribute__((address_space(3)))
typedef unsigned short bf16;
typedef unsigned v4u __attribute__((ext_vector_type(4)));
typedef float f32x4 __attribute__((ext_vector_type(4)));
typedef short bf16x8 __attribute__((ext_vector_type(8)));
typedef GAS unsigned gu32;
typedef GAS unsigned long long gu64;
#define RLX_AGENT __ATOMIC_RELAXED, __HIP_MEMORY_SCOPE_AGENT
#define LDS_WAIT() asm volatile("s_waitcnt lgkmcnt(0)" ::: "memory")
#define VM_WAIT() asm volatile("s_waitcnt vmcnt(0)" ::: "memory")
__device__ __forceinline__ unsigned long long rt() { return __builtin_amdgcn_s_memrealtime(); }
__device__ __forceinline__ unsigned f2bf(float f) { unsigned u = __builtin_bit_cast(unsigned, f); return (u + 0x7fffu + ((u >> 16) & 1u)) >> 16; }
__device__ __forceinline__ unsigned pk2(float lo, float hi) { return f2bf(lo) | (f2bf(hi) << 16); }

#define XB_TMO      128
#define XB_XCNT(j)  (256  + 64 * (j))
#define XB_XSUB(j)  (1280 + 64 * (j))
#define XB_XGEN(j)  (2304 + 64 * (j))
#define XB_TOP      3328
#define XB_TOPGEN   3392
#define XCD_BAR_WORDS 3456
#define XB_SPIN_CAP (1u << 24)

__device__ __forceinline__ unsigned xb_ld(unsigned* p)              { return __hip_atomic_load(p, __ATOMIC_RELAXED, __HIP_MEMORY_SCOPE_AGENT); }
__device__ __forceinline__ unsigned xb_add(unsigned* p, unsigned v) { return __hip_atomic_fetch_add(p, v, __ATOMIC_RELAXED, __HIP_MEMORY_SCOPE_AGENT); }
__device__ __forceinline__ unsigned xb_xcc_id() { return (unsigned)__builtin_amdgcn_s_getreg((3 << 11) | 20) & 0xFu; }
#define XB_SPIN(cond, bar) do { unsigned _sp = 0; while (cond) { __builtin_amdgcn_s_sleep(1); \
    if ((++_sp & 255u) == 0u) { if (xb_ld(&(bar)[XB_TMO])) break; if (_sp > XB_SPIN_CAP) { atomicAdd(&(bar)[XB_TMO], 1u); break; } } } } while (0)

struct XcdBarrier {
    unsigned* bar; unsigned x;
    volatile LAS unsigned* st;
};

__device__ __forceinline__ XcdBarrier xcd_barrier_post(unsigned* bar, volatile LAS unsigned* st) {
    XcdBarrier b; b.bar = bar; b.x = xb_xcc_id(); b.st = st;
    if (threadIdx.x == 0) (void)xb_add(&bar[XB_XCNT(b.x)], 1u);
    return b;
}
__device__ __forceinline__ void xcd_barrier_complete(unsigned* bar, unsigned x, unsigned& nloc, unsigned& nx) {
    const unsigned G = gridDim.x * gridDim.y * gridDim.z;
    unsigned sum, cnt, mine, sp = 0u;
    for (;;) {
        sum = 0u; cnt = 0u; mine = 0u;
#pragma unroll
        for (unsigned j = 0; j < 16; ++j) { const unsigned c = xb_ld(&bar[XB_XCNT(j)]); sum += c; cnt += (c > 0u) ? 1u : 0u; mine = (j == x) ? c : mine; }
        if (sum == G) break;
        __builtin_amdgcn_s_sleep(1);
        if ((++sp & 255u) == 0u) { if (xb_ld(&bar[XB_TMO])) break; if (sp > XB_SPIN_CAP) { atomicAdd(&bar[XB_TMO], 1u); break; } }
    }
    nloc = mine > 0u ? mine : 1u; nx = cnt > 0u ? cnt : 1u;
}

__device__ __forceinline__ void xcd_barrier(const XcdBarrier& b) {
    asm volatile("s_waitcnt vmcnt(0)" ::: "memory");
    __syncthreads();
    if (threadIdx.x == 0) {
        unsigned* bar = b.bar;
        __builtin_amdgcn_s_waitcnt(0);
        unsigned nloc = b.st[0], nx = b.st[1];
        if (nloc == 0u) { xcd_barrier_complete(bar, b.x, nloc, nx); b.st[0] = nloc; b.st[1] = nx; }
        const unsigned old = xb_add(&bar[XB_XSUB(b.x)], 1u);
        const unsigned gen = old / nloc;
        if (old + 1u == (gen + 1u) * nloc) {
            __builtin_amdgcn_fence(__ATOMIC_RELEASE, "agent");
            asm volatile("s_waitcnt vmcnt(0)" ::: "memory");
            const unsigned og = xb_add(&bar[XB_TOP], 1u);
            const unsigned tg = og / nx;
            if (og + 1u == (tg + 1u) * nx) xb_add(&bar[XB_TOPGEN], 1u);
            else XB_SPIN(xb_ld(&bar[XB_TOPGEN]) == tg, bar);
            __builtin_amdgcn_fence(__ATOMIC_ACQUIRE, "agent");
            xb_add(&bar[XB_XGEN(b.x)], 1u);
            asm volatile("s_waitcnt vmcnt(0)" ::: "memory");
        } else {
            XB_SPIN(xb_ld(&bar[XB_XGEN(b.x)]) == gen, bar);
            __builtin_amdgcn_fence(__ATOMIC_ACQUIRE, "agent");
            asm volatile("s_waitcnt vmcnt(0)" ::: "memory");
        }
    }
    __syncthreads();
}


constexpr size_t MiB = 1u << 20;
constexpr size_t WS_CTL = 0, CTL_ZERO_BYTES = 1 * MiB;
constexpr size_t WS_STAT0 = 1 * MiB;
constexpr size_t WS_AFF = 2 * MiB;
constexpr size_t WS_INV = 4 * MiB;
constexpr size_t WS_TOK = 5 * MiB;
constexpr size_t WS_LSE = 6 * MiB;
constexpr size_t WS_WIN = 8 * MiB;
constexpr size_t WS_WA = 18 * MiB;
constexpr size_t WS_WB = 19 * MiB;
constexpr size_t WS_WO = 20 * MiB;
constexpr size_t WS_ROPEA = 22 * MiB;
constexpr size_t WS_ROPEB = 23 * MiB;
constexpr size_t ARENA = 24 * MiB;
constexpr size_t A_H0B = ARENA + 0 * MiB;
constexpr size_t A_QKV = ARENA + 64 * MiB;
constexpr size_t A_GATES = ARENA + 256 * MiB;
constexpr size_t A_ATTNA = ARENA + 0 * MiB;
constexpr size_t A_OB = ARENA + 32 * MiB;
constexpr size_t A_OBG = ARENA + 384 * MiB;
constexpr size_t A_MERGED = ARENA + 64 * MiB;
constexpr size_t A_MIX = ARENA + 128 * MiB;
constexpr size_t A_H1B = ARENA + 384 * MiB;
constexpr size_t A_WD = ARENA + 448 * MiB;
constexpr size_t A_XE = ARENA + 256 * MiB;
constexpr size_t A_ACT = ARENA + 0 * MiB;
constexpr size_t A_YE = ARENA + 256 * MiB;
constexpr size_t WS_END = ARENA + 512 * MiB;
constexpr int CW_TMO = 0, CW_BAR = 4096;

constexpr int RING_OFF = 0, RING_BYTES = 131072;
constexpr int LDSCTL_OFF = RING_BYTES, MISC_OFF = LDSCTL_OFF + 320;
constexpr int LDS_BYTES = 147456;

typedef short s16x4v __attribute__((ext_vector_type(4)));
typedef unsigned u32x2 __attribute__((ext_vector_type(2)));

struct Frame {
    LAS unsigned char* lds;
    volatile LAS unsigned* MISC;
    gu32* ctl;
    int tid, lane, wave;
    int vcu, G;
};

__device__ __forceinline__ float wave_sum(float v) {
#pragma unroll
    for (int o = 1; o < 64; o <<= 1) v += __shfl_xor(v, o);
    return v;
}
__device__ __forceinline__ float bf2f(bf16 h) { return __uint_as_float(((unsigned)h) << 16); }

struct TJob { const float* src; bf16* dst; size_t off; int ldw, ldt, k0, n0, win; };
__device__ __forceinline__ void tjob_load(const TJob& j, f32x4 (&r)[8], int lane) {
    const float* p = j.src + (size_t)(j.k0 + (lane >> 3)) * j.ldw + j.n0 + 4 * (lane & 7);
#pragma unroll
    for (int i = 0; i < 8; ++i) r[i] = *(const GAS f32x4*)(p + (size_t)(8 * i) * j.ldw);
}
struct WinRow {
    __device__ __forceinline__ size_t operator()(int ncol) const {
        if (ncol >= QKVW) return (size_t)ncol;
        int pn, wc, d, map;
        if (ncol < OFF_KA) { const int h = ncol >> 6; pn = h >> 2; wc = h & 3; map = 0; }
        else if (ncol < OFF_VA) { pn = 2; wc = (ncol - OFF_KA) >> 6; map = 0; }
        else if (ncol < OFF_QB) { pn = 2; wc = 2 + ((ncol - OFF_VA) >> 6); map = 2; }
        else if (ncol < OFF_KB) { const int h = (ncol - OFF_QB) >> 6; pn = 3 + (h >> 2); wc = h & 3; map = 1; }
        else if (ncol < OFF_VB) { const int h = (ncol - OFF_KB) >> 6; pn = 6 + (h >> 2); wc = h & 3; map = 1; }
        else { const int h = (ncol - OFF_VB) >> 6; pn = 9 + (h >> 2); wc = h & 3; map = 2; }
        d = ncol & 63;
        int bj, fq, n; const int i = d & 3;
        if (map == 0) { n = d >> 5; bj = (d >> 4) & 1; fq = (d >> 2) & 3; }
        else if (map == 1) { fq = d >> 4; bj = (d >> 3) & 1; n = (d >> 2) & 1; }
        else { bj = d >> 5; fq = (d >> 3) & 3; n = (d >> 2) & 1; }
        return (size_t)(pn * 256 + 128 * bj + 32 * wc + 8 * fq + 4 * n + i);
    }
};

__device__ __forceinline__ void tjob_store(const TJob& j, const f32x4 (&r)[8], LAS float* scr, int lane) {
    { LAS float* w = scr + (4 * (lane & 7)) * 65 + (lane >> 3);
#pragma unroll
      for (int i = 0; i < 8; ++i) { w[8 * i] = r[i].x; w[65 + 8 * i] = r[i].y; w[130 + 8 * i] = r[i].z; w[195 + 8 * i] = r[i].w; } }
    LDS_WAIT(); asm volatile("" ::: "memory");
    const int c = lane & 7;
#pragma unroll
    for (int jj = 0; jj < 4; ++jj) { const int n = (lane >> 3) + 8 * jj; const LAS float* sp = scr + n * 65 + 8 * c;
        v4u o; o.x = pk2(sp[0], sp[1]); o.y = pk2(sp[2], sp[3]); o.z = pk2(sp[4], sp[5]); o.w = pk2(sp[6], sp[7]);
        const size_t row = j.win ? WinRow{}(j.n0 + n) : j.off + (size_t)n;
        *(GAS v4u*)(j.dst + row * (size_t)j.ldt + j.k0 + 8 * c) = o; }
    LDS_WAIT(); asm volatile("" ::: "memory");
}
template <class Decode>
__device__ __forceinline__ void tjobs_run(int first, int stride, int count, const Decode& decode, LAS float* scr, int lane) {
    TJob cur, nxt; f32x4 ra[8], rb[8];
    int it = first; if (it >= count) return;
    decode(it, cur); tjob_load(cur, ra, lane);
    for (;;) {
        const int itn = it + stride; const bool hn = itn < count;
        if (hn) { decode(itn, nxt); tjob_load(nxt, rb, lane); }
        tjob_store(cur, ra, scr, lane);
        if (!hn) break;
        cur = nxt; it = itn;
        ra[0] = rb[0]; ra[1] = rb[1]; ra[2] = rb[2]; ra[3] = rb[3]; ra[4] = rb[4]; ra[5] = rb[5]; ra[6] = rb[6]; ra[7] = rb[7];
    }
}

struct Ptrs {
    const float *x, *ln0_g, *ln0_b, *w_in, *b_gate, *qn_g, *kn_g, *w_a, *w_b, *w_out, *ln1_g, *ln1_b, *w_router, *w_gate_e, *w_up_e, *w_down_e, *ln2_g, *ln2_b;
    float* out; unsigned char* ws;
};
struct Args { Ptrs p; int ph_lo, ph_hi, li, pad; };
typedef const __attribute__((address_space(4))) Args* KArgsP;
__device__ __forceinline__ KArgsP kargs() { KArgsP k = (KArgsP)__builtin_amdgcn_kernarg_segment_ptr(); asm volatile("" : "+s"(k)); return k; }

__device__ __forceinline__ void sincos_rev(float angle, float& sn, float& cs) {
    const double rev = (double)angle * 0.15915494309189533577; const double fr = rev - __builtin_rint(rev);
    sn = __builtin_amdgcn_sinf((float)fr); cs = __builtin_amdgcn_cosf((float)fr);
}
__device__ __forceinline__ void p0_prologue(Frame& F, KArgsP K) {
    LAS float* scr = (LAS float*)(F.lds + RING_OFF + F.wave * 16384);
    const int gw = F.vcu * NWAVES + F.wave, NGW = F.G * NWAVES;
    bf16* win_t = (bf16*)(K->p.ws + WS_WIN); bf16* wa_t = (bf16*)(K->p.ws + WS_WA); bf16* wb_t = (bf16*)(K->p.ws + WS_WB); bf16* wo_t = (bf16*)(K->p.ws + WS_WO);
    constexpr int I_IN = (1024 / 64) * (5120 / 32), I_A = (512 / 64) * (1024 / 32), I_B = (256 / 64) * (1024 / 32), I_O = (1024 / 64) * (1024 / 32);
    { const float* w_in = K->p.w_in; const float* w_a = K->p.w_a; const float* w_b = K->p.w_b; const float* w_o = K->p.w_out;
      auto decode = [&](int it, TJob& j) {
          int r = it; j.off = 0; j.win = 0;
          if (r < I_IN) { j.src = w_in; j.ldw = 5120; j.dst = win_t; j.ldt = 1024; j.k0 = (r / 160) * 64; j.n0 = (r % 160) * 32; j.win = 1; return; } r -= I_IN;
          if (r < I_A) { j.src = w_a; j.ldw = 1024; j.dst = wa_t; j.ldt = 512; j.k0 = (r / 32) * 64; j.n0 = (r % 32) * 32; j.off = (size_t)j.n0; return; } r -= I_A;
          if (r < I_B) { j.src = w_b; j.ldw = 1024; j.dst = wb_t; j.ldt = 256; j.k0 = (r / 32) * 64; j.n0 = (r % 32) * 32; j.off = (size_t)j.n0; return; } r -= I_B;
          j.src = w_o; j.ldw = 1024; j.dst = wo_t; j.ldt = 1024; j.k0 = (r / 32) * 64; j.n0 = (r % 32) * 32; j.off = (size_t)j.n0; };
      tjobs_run(gw, NGW, I_IN + I_A + I_B + I_O, decode, scr, F.lane); }
    { float* ra = (float*)(K->p.ws + WS_ROPEA); float* rb = (float*)(K->p.ws + WS_ROPEB);
      for (int it = F.vcu * (NWAVES * 64) + F.tid; it < SEQ * 40; it += F.G * NWAVES * 64) {
          const int t = it / 40, r = it - t * 40; float sn, cs;
          if (r < 32) { const int n = r >> 4, f = r & 15; const float pos = n ? (float)(t & 63) : (float)(t >> 6);
              sincos_rev(pos * exp2f(-(float)f * (13.287712379549449f / 16.f)), sn, cs); ra[t * 64 + n * 32 + f] = cs; ra[t * 64 + n * 32 + 16 + f] = sn; }
          else { const int f = r - 32; sincos_rev((float)t * exp2f(-(float)f * (18.931568569324174f / 8.f)), sn, cs); rb[t * 16 + f] = cs; rb[t * 16 + 8 + f] = sn; }
      } }
    bf16* h0b = (bf16*)(K->p.ws + A_H0B); float* st0 = (float*)(K->p.ws + WS_STAT0);
    f32x4 g[4], bb[4];
#pragma unroll
    for (int j = 0; j < 4; ++j) { g[j] = ((const f32x4*)K->p.ln0_g)[F.lane + 64 * j]; bb[j] = ((const f32x4*)K->p.ln0_b)[F.lane + 64 * j]; }
    for (int m = gw; m < MTOK; m += NGW) {
        const GAS f32x4* xr = (const GAS f32x4*)(K->p.x + (size_t)m * DM) + F.lane;
        f32x4 v[4]; float s = 0.f;
#pragma unroll
        for (int j = 0; j < 4; ++j) { v[j] = xr[64 * j]; s += (v[j].x + v[j].y) + (v[j].z + v[j].w); }
        const float mean = wave_sum(s) * (1.f / DM); float s2 = 0.f;
#pragma unroll
        for (int j = 0; j < 4; ++j) { v[j] = v[j] - mean; s2 += (v[j].x * v[j].x + v[j].y * v[j].y) + (v[j].z * v[j].z + v[j].w * v[j].w); }
        const float rstd = 1.f / sqrtf(wave_sum(s2) * (1.f / DM) + LN_EPS);
        GAS unsigned long long* o8 = (GAS unsigned long long*)(h0b + (size_t)m * DM) + F.lane;
#pragma unroll
        for (int j = 0; j < 4; ++j) { const f32x4 y = v[j] * rstd * g[j] + bb[j]; o8[64 * j] = (unsigned long long)pk2(y.x, y.y) | ((unsigned long long)pk2(y.z, y.w) << 32); }
        if (F.lane == 0) { st0[2 * m] = mean; st0[2 * m + 1] = rstd; }
    }
}

__device__ __forceinline__ void p1b_prep(Frame& F, KArgsP K) {
    const int gw = F.vcu * NWAVES + F.wave, NGW = F.G * NWAVES, d = F.lane;
    bf16* qkv = (bf16*)(K->p.ws + A_QKV);
    const float qg = K->p.qn_g[d], kg = K->p.kn_g[d];
    const float invfA = exp2f(-(float)(d & 15) * (13.287712379549449f / 16.f));
    const float invfB = exp2f(-(float)(d & 7) * (18.931568569324174f / 8.f));
    for (int m = gw; m < MTOK; m += NGW) {
        const int t = m & (SEQ - 1);
        const float posA = (d < 32) ? (float)(t >> 6) : (float)(t & 63);
        float snA, csA, snB, csB; sincos_rev(posA * invfA, snA, csA); sincos_rev((float)t * invfB, snB, csB);
        bf16* row = qkv + (size_t)m * QKVW;
#pragma unroll 2
        for (int hh = 0; hh < 10; ++hh) {
            bf16* p = row + (hh < 8 ? OFF_QA + hh * 64 : OFF_KA + (hh - 8) * 64) + d;
            const float x = bf2f(*p); const float ss = wave_sum(x * x);
            const float y = x * (1.0f / sqrtf(ss * (1.f / 64.f) + QK_EPS)) * (hh < 8 ? qg : kg);
            const float yp = __shfl_xor(y, 16);
            float o = (d & 16) ? (y * csA + yp * snA) : (y * csA - yp * snA);
            if (hh < 8) o *= C2;
            *p = (bf16)f2bf(o);
        }
#pragma unroll 2
        for (int hh = 0; hh < 24; ++hh) {
            const bool isq = hh < 12;
            bf16* p = row + (isq ? OFF_QB + hh * 64 : OFF_KB + (hh - 12) * 64) + d;
            const float y = bf2f(*p); const float yp = __shfl_xor(y, 8);
            float o = y;
            if (d < 16) o = (d & 8) ? (y * csB + yp * snB) : (y * csB - yp * snB);
            if (isq) o *= C2;
            if (isq || d < 16) *p = (bf16)f2bf(o);
        }
    }
}

__device__ __forceinline__ void attnA_naive_unit(Frame& F, KArgsP K, int unit) {
    const int b = unit >> 5, h = (unit >> 2) & 7, qc = unit & 3, kvh = h >> 2;
    const bf16* qkv = (const bf16*)(K->p.ws + A_QKV); bf16* attna = (bf16*)(K->p.ws + A_ATTNA);
    const size_t rowq = (size_t)b * SEQ + qc * 512 + F.tid;
    LAS float* Ks = (LAS float*)(F.lds + RING_OFF); LAS float* Vs = Ks + 64 * 64;
    float q[64], o[64];
    { const v4u* qp = (const v4u*)(qkv + rowq * QKVW + OFF_QA + h * 64);
#pragma unroll
      for (int c = 0; c < 8; ++c) { const v4u w = qp[c]; q[8 * c + 0] = pg8::bf_lo(w.x); q[8 * c + 1] = pg8::bf_hi(w.x); q[8 * c + 2] = pg8::bf_lo(w.y); q[8 * c + 3] = pg8::bf_hi(w.y);
          q[8 * c + 4] = pg8::bf_lo(w.z); q[8 * c + 5] = pg8::bf_hi(w.z); q[8 * c + 6] = pg8::bf_lo(w.w); q[8 * c + 7] = pg8::bf_hi(w.w); } }
#pragma unroll
    for (int dd = 0; dd < 64; ++dd) o[dd] = 0.f;
    float mrun = -1e30f, l = 0.f;
    for (int kt = 0; kt < SEQ / 64; ++kt) {
        __syncthreads();
        { const int kr = F.tid >> 3, ch = F.tid & 7; const size_t rk = ((size_t)b * SEQ + kt * 64 + kr) * QKVW;
          const v4u wk = *(const v4u*)(qkv + rk + OFF_KA + kvh * 64 + ch * 8), wv = *(const v4u*)(qkv + rk + OFF_VA + kvh * 64 + ch * 8);
          LAS f32x4* kd = (LAS f32x4*)(Ks + kr * 64 + ch * 8); LAS f32x4* vd = (LAS f32x4*)(Vs + kr * 64 + ch * 8);
          kd[0] = (f32x4){pg8::bf_lo(wk.x), pg8::bf_hi(wk.x), pg8::bf_lo(wk.y), pg8::bf_hi(wk.y)}; kd[1] = (f32x4){pg8::bf_lo(wk.z), pg8::bf_hi(wk.z), pg8::bf_lo(wk.w), pg8::bf_hi(wk.w)};
          vd[0] = (f32x4){pg8::bf_lo(wv.x), pg8::bf_hi(wv.x), pg8::bf_lo(wv.y), pg8::bf_hi(wv.y)}; vd[1] = (f32x4){pg8::bf_lo(wv.z), pg8::bf_hi(wv.z), pg8::bf_lo(wv.w), pg8::bf_hi(wv.w)}; }
        __syncthreads();
        for (int key = 0; key < 64; ++key) {
            const LAS f32x4* kp = (const LAS f32x4*)(Ks + key * 64); const LAS f32x4* vp = (const LAS f32x4*)(Vs + key * 64);
            float s0 = 0.f, s1 = 0.f;
#pragma unroll
            for (int c = 0; c < 16; c += 2) { const f32x4 k0 = kp[c], k1 = kp[c + 1];
                s0 += q[4 * c] * k0.x + q[4 * c + 1] * k0.y + q[4 * c + 2] * k0.z + q[4 * c + 3] * k0.w;
                s1 += q[4 * c + 4] * k1.x + q[4 * c + 5] * k1.y + q[4 * c + 6] * k1.z + q[4 * c + 7] * k1.w; }
            const float s = s0 + s1;
            const float mn = fmaxf(mrun, s); const float a = exp2f(mrun - mn), pw = exp2f(s - mn);
            l = l * a + pw; mrun = mn;
#pragma unroll
            for (int c = 0; c < 16; ++c) { const f32x4 vv = vp[c];
                o[4 * c] = o[4 * c] * a + pw * vv.x; o[4 * c + 1] = o[4 * c + 1] * a + pw * vv.y; o[4 * c + 2] = o[4 * c + 2] * a + pw * vv.z; o[4 * c + 3] = o[4 * c + 3] * a + pw * vv.w; }
        }
    }
    const float rl = 1.0f / l;
    v4u* op = (v4u*)(attna + rowq * 512 + h * 64);
#pragma unroll
    for (int c = 0; c < 8; ++c) { v4u w; w.x = pk2(o[8 * c] * rl, o[8 * c + 1] * rl); w.y = pk2(o[8 * c + 2] * rl, o[8 * c + 3] * rl); w.z = pk2(o[8 * c + 4] * rl, o[8 * c + 5] * rl); w.w = pk2(o[8 * c + 6] * rl, o[8 * c + 7] * rl); op[c] = w; }
}

__device__ __forceinline__ void attnB_naive_unit(Frame& F, KArgsP K, int unit) {
    const int b = unit >> 4, j = (unit >> 2) & 3, qc = unit & 3;
    const bf16* qkv = (const bf16*)(K->p.ws + A_QKV); bf16* ob = (bf16*)(K->p.ws + A_OB);
    const int t = qc * 512 + F.tid; const size_t rowq = (size_t)b * SEQ + t;
    float q[64], o[64];
#pragma unroll
    for (int dd = 0; dd < 64; ++dd) o[dd] = 0.f;
    float mrun = -1e30f, l = 0.f;
    for (int g = 0; g < 3; ++g) {
        const int head = 4 * g + j, dil = (g == 0) ? 1 : (g == 1) ? 4 : 16;
        { const v4u* qp = (const v4u*)(qkv + rowq * QKVW + OFF_QB + head * 64);
#pragma unroll
          for (int c = 0; c < 8; ++c) { const v4u w = qp[c]; q[8 * c + 0] = pg8::bf_lo(w.x); q[8 * c + 1] = pg8::bf_hi(w.x); q[8 * c + 2] = pg8::bf_lo(w.y); q[8 * c + 3] = pg8::bf_hi(w.y);
              q[8 * c + 4] = pg8::bf_lo(w.z); q[8 * c + 5] = pg8::bf_hi(w.z); q[8 * c + 6] = pg8::bf_lo(w.w); q[8 * c + 7] = pg8::bf_hi(w.w); } }
        for (int jj = -64; jj <= 64; ++jj) {
            const int tk = t + jj * dil;
            if (tk < 0 || tk >= SEQ) continue;
            const size_t rk = ((size_t)b * SEQ + tk) * QKVW;
            const v4u* kp = (const v4u*)(qkv + rk + OFF_KB + head * 64); const v4u* vp = (const v4u*)(qkv + rk + OFF_VB + head * 64);
            float s = 0.f;
#pragma unroll
            for (int c = 0; c < 8; ++c) { const v4u w = kp[c];
                s += q[8 * c] * pg8::bf_lo(w.x) + q[8 * c + 1] * pg8::bf_hi(w.x) + q[8 * c + 2] * pg8::bf_lo(w.y) + q[8 * c + 3] * pg8::bf_hi(w.y)
                   + q[8 * c + 4] * pg8::bf_lo(w.z) + q[8 * c + 5] * pg8::bf_hi(w.z) + q[8 * c + 6] * pg8::bf_lo(w.w) + q[8 * c + 7] * pg8::bf_hi(w.w); }
            const float mn = fmaxf(mrun, s); const float a = exp2f(mrun - mn), pw = exp2f(s - mn);
            l = l * a + pw; mrun = mn;
#pragma unroll
            for (int c = 0; c < 8; ++c) { const v4u w = vp[c];
                o[8 * c] = o[8 * c] * a + pw * pg8::bf_lo(w.x); o[8 * c + 1] = o[8 * c + 1] * a + pw * pg8::bf_hi(w.x); o[8 * c + 2] = o[8 * c + 2] * a + pw * pg8::bf_lo(w.y); o[8 * c + 3] = o[8 * c + 3] * a + pw * pg8::bf_hi(w.y);
                o[8 * c + 4] = o[8 * c + 4] * a + pw * pg8::bf_lo(w.z); o[8 * c + 5] = o[8 * c + 5] * a + pw * pg8::bf_hi(w.z); o[8 * c + 6] = o[8 * c + 6] * a + pw * pg8::bf_lo(w.w); o[8 * c + 7] = o[8 * c + 7] * a + pw * pg8::bf_hi(w.w); }
        }
    }
    const float rl = 1.0f / l;
    v4u* op = (v4u*)(ob + rowq * 256 + j * 64);
#pragma unroll
    for (int c = 0; c < 8; ++c) { v4u w; w.x = pk2(o[8 * c] * rl, o[8 * c + 1] * rl); w.y = pk2(o[8 * c + 2] * rl, o[8 * c + 3] * rl); w.z = pk2(o[8 * c + 4] * rl, o[8 * c + 5] * rl); w.w = pk2(o[8 * c + 6] * rl, o[8 * c + 7] * rl); op[c] = w; }
}

__device__ __forceinline__ void p3b_combine(Frame& F, KArgsP K) {
    const bf16* obg = (const bf16*)(K->p.ws + A_OBG); const float* lse = (const float*)(K->p.ws + WS_LSE); bf16* ob = (bf16*)(K->p.ws + A_OB);
    for (int it = F.vcu; it < MTOK / 16; it += F.G) {
        const int m = it * 16 + (F.tid >> 5), ch = F.tid & 31, j = ch >> 3;
        const float l0 = lse[((size_t)0 * MTOK + m) * 4 + j], l1 = lse[((size_t)1 * MTOK + m) * 4 + j], l2 = lse[((size_t)2 * MTOK + m) * 4 + j];
        const float mx = fmaxf(l0, fmaxf(l1, l2)); float w0 = exp2f(l0 - mx), w1 = exp2f(l1 - mx), w2 = exp2f(l2 - mx); const float rs = 1.0f / (w0 + w1 + w2); w0 *= rs; w1 *= rs; w2 *= rs;
        const v4u a = *(const v4u*)(obg + ((size_t)0 * MTOK + m) * 256 + ch * 8), b = *(const v4u*)(obg + ((size_t)1 * MTOK + m) * 256 + ch * 8), c = *(const v4u*)(obg + ((size_t)2 * MTOK + m) * 256 + ch * 8);
        v4u o;
        o.x = pk2(w0 * pg8::bf_lo(a.x) + w1 * pg8::bf_lo(b.x) + w2 * pg8::bf_lo(c.x), w0 * pg8::bf_hi(a.x) + w1 * pg8::bf_hi(b.x) + w2 * pg8::bf_hi(c.x));
        o.y = pk2(w0 * pg8::bf_lo(a.y) + w1 * pg8::bf_lo(b.y) + w2 * pg8::bf_lo(c.y), w0 * pg8::bf_hi(a.y) + w1 * pg8::bf_hi(b.y) + w2 * pg8::bf_hi(c.y));
        o.z = pk2(w0 * pg8::bf_lo(a.z) + w1 * pg8::bf_lo(b.z) + w2 * pg8::bf_lo(c.z), w0 * pg8::bf_hi(a.z) + w1 * pg8::bf_hi(b.z) + w2 * pg8::bf_hi(c.z));
        o.w = pk2(w0 * pg8::bf_lo(a.w) + w1 * pg8::bf_lo(b.w) + w2 * pg8::bf_lo(c.w), w0 * pg8::bf_hi(a.w) + w1 * pg8::bf_hi(b.w) + w2 * pg8::bf_hi(c.w));
        *(v4u*)(ob + (size_t)m * 256 + ch * 8) = o;
    }
}

__device__ __forceinline__ void convert_experts(Frame& F, KArgsP K) {
    const int gw = F.vcu * NWAVES + F.wave, NGW = F.G * NWAVES;
    { LAS float* scr = (LAS float*)(F.lds + RING_OFF + F.wave * 16384);
      bf16* wgu = (bf16*)K->p.out; bf16* wd = (bf16*)(K->p.ws + A_WD);
      constexpr int I_G = 16 * 64, I_D = 32 * 32, PER_E = 2 * I_G + I_D;
      const float* wg = K->p.w_gate_e; const float* wu = K->p.w_up_e; const float* wdn = K->p.w_down_e;
      auto decode = [&](int it, TJob& j) {
          const int e = it / PER_E; int r = it - e * PER_E; j.win = 0;
          if (r < 2 * I_G) { const int up = r >= I_G; r -= up * I_G; j.src = (up ? wu : wg) + (size_t)e * DM * DFF; j.ldw = DFF; j.dst = wgu; j.ldt = 1024; j.k0 = (r / 64) * 64; j.n0 = (r % 64) * 32;
              j.off = (size_t)e * 4096 + (j.n0 >> 7) * 256 + up * 128 + (j.n0 & 127); return; }
          r -= 2 * I_G; j.src = wdn + (size_t)e * DFF * DM; j.ldw = DM; j.dst = wd; j.ldt = 2048; j.k0 = (r / 32) * 64; j.n0 = (r % 32) * 32; j.off = (size_t)e * 1024 + j.n0; };
      tjobs_run(gw, NGW, NEXP * PER_E, decode, scr, F.lane); }
}

__device__ __forceinline__ void p5_ln1_router_convert(Frame& F, KArgsP K) {
    const int gw = F.vcu * NWAVES + F.wave, NGW = F.G * NWAVES;
    __syncthreads();
    { LAS f32x4* wl = (LAS f32x4*)(F.lds + RING_OFF); const f32x4* wr4 = (const f32x4*)K->p.w_router;
      for (int q = F.tid; q < 1024 * 4; q += NWAVES * 64) { const int col = q >> 2, e4 = q & 3; const int l = (col & 255) >> 2, i = col & 3, j = col >> 8;
          wl[((j * 4 + i) * 4 + e4) * 64 + l] = wr4[q]; } }
    __syncthreads();
    const bf16* mix = (const bf16*)(K->p.ws + A_MIX); bf16* h1b = (bf16*)(K->p.ws + A_H1B); const float* st0 = (const float*)(K->p.ws + WS_STAT0); float* aff = (float*)(K->p.ws + WS_AFF);
    f32x4 xv[4], xn[4]; u32x2 mw[4], mn[4]; float mean0 = 0.f, rstd0 = 0.f, mean0n = 0.f, rstd0n = 0.f;
    int m = gw;
    if (m < MTOK) { const GAS f32x4* xr = (const GAS f32x4*)(K->p.x + (size_t)m * DM) + F.lane; const GAS u32x2* mr = (const GAS u32x2*)(mix + (size_t)m * DM) + F.lane;
#pragma unroll
        for (int j = 0; j < 4; ++j) { xv[j] = xr[64 * j]; mw[j] = mr[64 * j]; }
        mean0 = st0[2 * m]; rstd0 = st0[2 * m + 1]; }
    for (; m < MTOK; m += NGW) {
        const int mnx = m + NGW;
        if (mnx < MTOK) { const GAS f32x4* xr = (const GAS f32x4*)(K->p.x + (size_t)mnx * DM) + F.lane; const GAS u32x2* mr = (const GAS u32x2*)(mix + (size_t)mnx * DM) + F.lane;
#pragma unroll
            for (int j = 0; j < 4; ++j) { xn[j] = xr[64 * j]; mn[j] = mr[64 * j]; }
            mean0n = st0[2 * mnx]; rstd0n = st0[2 * mnx + 1]; }
        f32x4 v[4]; float s = 0.f;
#pragma unroll
        for (int j = 0; j < 4; ++j) {
            const f32x4 g0 = ((const f32x4*)K->p.ln0_g)[F.lane + 64 * j], b0 = ((const f32x4*)K->p.ln0_b)[F.lane + 64 * j];
            const f32x4 h0 = (xv[j] - mean0) * rstd0 * g0 + b0;
            v[j] = h0 * ALPHA + (f32x4){pg8::bf_lo(mw[j].x), pg8::bf_hi(mw[j].x), pg8::bf_lo(mw[j].y), pg8::bf_hi(mw[j].y)};
            s += (v[j].x + v[j].y) + (v[j].z + v[j].w); }
        const float mean = wave_sum(s) * (1.f / DM); float s2 = 0.f;
#pragma unroll
        for (int j = 0; j < 4; ++j) { v[j] = v[j] - mean; s2 += (v[j].x * v[j].x + v[j].y * v[j].y) + (v[j].z * v[j].z + v[j].w * v[j].w); }
        const float rstd = 1.f / sqrtf(wave_sum(s2) * (1.f / DM) + LN_EPS);
        GAS unsigned long long* o8 = (GAS unsigned long long*)(h1b + (size_t)m * DM) + F.lane;
        float lg[16];
#pragma unroll
        for (int e = 0; e < 16; ++e) lg[e] = 0.f;
#pragma unroll
        for (int j = 0; j < 4; ++j) { const f32x4 g1 = ((const f32x4*)K->p.ln1_g)[F.lane + 64 * j], b1 = ((const f32x4*)K->p.ln1_b)[F.lane + 64 * j];
            const f32x4 y = v[j] * rstd * g1 + b1;
            o8[64 * j] = (unsigned long long)pk2(y.x, y.y) | ((unsigned long long)pk2(y.z, y.w) << 32);
            const LAS f32x4* wl = (const LAS f32x4*)(F.lds + RING_OFF) + F.lane;
            asm volatile("" ::: "memory");
#pragma unroll
            for (int i = 0; i < 4; ++i) { const float yv = y[i];
#pragma unroll
                for (int c = 0; c < 4; ++c) { const f32x4 w = wl[((j * 4 + i) * 4 + c) * 64]; lg[4 * c] += yv * w.x; lg[4 * c + 1] += yv * w.y; lg[4 * c + 2] += yv * w.z; lg[4 * c + 3] += yv * w.w; } } }
#pragma unroll
        for (int e = 0; e < 16; ++e) lg[e] = wave_sum(lg[e]);
        float mx = lg[0];
#pragma unroll
        for (int e = 1; e < 16; ++e) mx = fmaxf(mx, lg[e]);
        float se = 0.f;
#pragma unroll
        for (int e = 0; e < 16; ++e) { lg[e] = expf(lg[e] - mx); se += lg[e]; }
        float mine = 0.f;
#pragma unroll
        for (int e = 0; e < 16; ++e) if (F.lane == e) mine = lg[e] / se;
        if (F.lane < 16) aff[(size_t)m * 16 + F.lane] = mine;
#pragma unroll
        for (int j = 0; j < 4; ++j) { xv[j] = xn[j]; mw[j] = mn[j]; }
        mean0 = mean0n; rstd0 = rstd0n;
    }
}

__device__ __forceinline__ void p6_topk_unit(Frame& F, KArgsP K, int unit) {
    const int e = unit >> 4, b = unit & 15;
    const float* aff = (const float*)(K->p.ws + WS_AFF); short* inv = (short*)(K->p.ws + WS_INV); int* tok = (int*)(K->p.ws + WS_TOK);
    const bf16* h1b = (const bf16*)(K->p.ws + A_H1B); bf16* xe = (bf16*)(K->p.ws + A_XE);
    LAS unsigned* cnt = (LAS unsigned*)(F.lds + RING_OFF);
    LAS int* ltok = (LAS int*)(F.lds + RING_OFF + 256);
    unsigned key[4];
#pragma unroll
    for (int i = 0; i < 4; ++i) key[i] = __float_as_uint(aff[((size_t)b * SEQ + 4 * F.tid + i) * 16 + e]);
    __syncthreads();
    unsigned thr = 0u;
    for (int bit = 31; bit >= 0; --bit) {
        const unsigned cand = thr | (1u << bit);
        unsigned c = 0;
#pragma unroll
        for (int i = 0; i < 4; ++i) c += (unsigned)__popcll(__ballot(key[i] >= cand));
        LAS unsigned* cb = cnt + ((bit & 1) ? 8 : 0);
        if (F.lane == 0) cb[F.wave] = c;
        __syncthreads();
        unsigned tot = 0;
#pragma unroll
        for (int w = 0; w < 8; ++w) tot += cb[w];
        if (tot >= (unsigned)CAP) thr = cand;
    }
    __syncthreads();
    unsigned cg = 0, ce = 0;
#pragma unroll
    for (int i = 0; i < 4; ++i) { cg += key[i] > thr; ce += key[i] == thr; }
    unsigned pk = cg | (ce << 16), inc = pk;
#pragma unroll
    for (int o = 1; o < 64; o <<= 1) { const unsigned up = __shfl_up(inc, o); if (F.lane >= o) inc += up; }
    if (F.lane == 63) cnt[16 + F.wave] = inc;
    __syncthreads();
    unsigned base = 0, total = 0;
#pragma unroll
    for (int w = 0; w < 8; ++w) { const unsigned tw = cnt[16 + w]; if (w < F.wave) base += tw; total += tw; }
    const unsigned excl = base + inc - pk;
    unsigned pg = excl & 0xffffu, pe = excl >> 16; const unsigned ngt = total & 0xffffu; const unsigned need = (unsigned)CAP - ngt;
#pragma unroll
    for (int i = 0; i < 4; ++i) {
        const int t = 4 * F.tid + i; int slot = -1;
        if (key[i] > thr) { slot = (int)(pg + (pe < need ? pe : need)); ++pg; }
        else if (key[i] == thr) { if (pe < need) slot = (int)(pg + pe); ++pe; }
        inv[((size_t)b * SEQ + t) * 16 + e] = (short)slot;
        if (slot >= 0) { ltok[slot] = t; tok[unit * CAP + slot] = t; }
    }
    __syncthreads();
    for (int c0 = F.wave * 4; c0 < CAP; c0 += NWAVES * 4) {
        v4u a[4][2];
#pragma unroll
        for (int q = 0; q < 4; ++q) { const v4u* src = (const v4u*)(h1b + ((size_t)b * SEQ + ltok[c0 + q]) * DM); a[q][0] = src[F.lane]; a[q][1] = src[F.lane + 64]; }
#pragma unroll
        for (int q = 0; q < 4; ++q) { v4u* dst = (v4u*)(xe + ((size_t)unit * CAP + c0 + q) * DM); dst[F.lane] = a[q][0]; dst[F.lane + 64] = a[q][1]; }
    }
    __syncthreads();
}

__device__ __forceinline__ void p9_final(Frame& F, KArgsP K) {
    const int gw = F.vcu * NWAVES + F.wave, NGW = F.G * NWAVES;
    const float* aff = (const float*)(K->p.ws + WS_AFF); const short* inv = (const short*)(K->p.ws + WS_INV); const bf16* ye = (const bf16*)(K->p.ws + A_YE); const bf16* h1b = (const bf16*)(K->p.ws + A_H1B);
    f32x4 g2[2][2], b2[2][2];
#pragma unroll
    for (int jj = 0; jj < 2; ++jj)
#pragma unroll
        for (int q = 0; q < 2; ++q) { g2[jj][q] = *(const f32x4*)(K->p.ln2_g + 512 * jj + 8 * F.lane + 4 * q); b2[jj][q] = *(const f32x4*)(K->p.ln2_b + 512 * jj + 8 * F.lane + 4 * q); }
    for (int m = gw; m < MTOK; m += NGW) {
        const int b = m >> 11;
        const int iv = (F.lane < 16) ? (int)inv[(size_t)m * 16 + F.lane] : -1; const float af = (F.lane < 16) ? aff[(size_t)m * 16 + F.lane] : 0.f;
        const v4u* hr = (const v4u*)(h1b + (size_t)m * DM) + F.lane; const v4u h0 = hr[0], h1v = hr[64];
        unsigned long long mask = __ballot(iv >= 0);
        float v[2][8];
#define UNPK8(D_, W_, S_) do { D_[0] = pg8::bf_lo(W_.x) * (S_); D_[1] = pg8::bf_hi(W_.x) * (S_); D_[2] = pg8::bf_lo(W_.y) * (S_); D_[3] = pg8::bf_hi(W_.y) * (S_); \
                               D_[4] = pg8::bf_lo(W_.z) * (S_); D_[5] = pg8::bf_hi(W_.z) * (S_); D_[6] = pg8::bf_lo(W_[3]) * (S_); D_[7] = pg8::bf_hi(W_[3]) * (S_); } while (0)
#define FMA8(D_, W_, S_) do { D_[0] += pg8::bf_lo(W_.x) * (S_); D_[1] += pg8::bf_hi(W_.x) * (S_); D_[2] += pg8::bf_lo(W_.y) * (S_); D_[3] += pg8::bf_hi(W_.y) * (S_); \
                              D_[4] += pg8::bf_lo(W_.z) * (S_); D_[5] += pg8::bf_hi(W_.z) * (S_); D_[6] += pg8::bf_lo(W_[3]) * (S_); D_[7] += pg8::bf_hi(W_[3]) * (S_); } while (0)
        UNPK8(v[0], h0, ALPHA); UNPK8(v[1], h1v, ALPHA);
        while (mask) {
            const int e0 = __builtin_ctzll(mask); mask &= mask - 1; const bool two = mask != 0; const int e1 = two ? __builtin_ctzll(mask) : e0; if (two) mask &= mask - 1;
            const int p0 = __builtin_amdgcn_readlane(iv, e0), p1 = __builtin_amdgcn_readlane(iv, e1);
            const float gt0 = __builtin_bit_cast(float, __builtin_amdgcn_readlane(__builtin_bit_cast(int, af), e0)), gt1 = two ? __builtin_bit_cast(float, __builtin_amdgcn_readlane(__builtin_bit_cast(int, af), e1)) : 0.f;
            const v4u* y0 = (const v4u*)(ye + ((size_t)(e0 * 16 + b) * CAP + p0) * DM) + F.lane; const v4u* y1 = (const v4u*)(ye + ((size_t)(e1 * 16 + b) * CAP + p1) * DM) + F.lane;
            const v4u a0 = y0[0], a1 = y0[64], c0 = y1[0], c1 = y1[64];
            FMA8(v[0], a0, gt0); FMA8(v[1], a1, gt0); FMA8(v[0], c0, gt1); FMA8(v[1], c1, gt1);
        }
        float s = 0.f;
#pragma unroll
        for (int jj = 0; jj < 2; ++jj)
#pragma unroll
            for (int q = 0; q < 8; ++q) s += v[jj][q];
        const float mean = wave_sum(s) * (1.f / DM); float s2 = 0.f;
#pragma unroll
        for (int jj = 0; jj < 2; ++jj)
#pragma unroll
            for (int q = 0; q < 8; ++q) { v[jj][q] -= mean; s2 += v[jj][q] * v[jj][q]; }
        const float rstd = 1.f / sqrtf(wave_sum(s2) * (1.f / DM) + LN_EPS);
        float* orow = K->p.out + (size_t)m * DM + 8 * F.lane;
#pragma unroll
        for (int jj = 0; jj < 2; ++jj)
#pragma unroll
            for (int q = 0; q < 2; ++q) { f32x4 o; o.x = v[jj][4 * q] * rstd; o.y = v[jj][4 * q + 1] * rstd; o.z = v[jj][4 * q + 2] * rstd; o.w = v[jj][4 * q + 3] * rstd;
                *(GAS f32x4*)(orow + 512 * jj + 4 * q) = o * g2[jj][q] + b2[jj][q]; }
#undef UNPK8
#undef FMA8
    }
}

struct OrderUp {
    int vcu;
    __device__ __forceinline__ bool next(int i, pg8::Unit& u) const {
        if (i >= NEXP) return false;
        const int e = i, x = vcu >> 5, l = vcu & 31, b = (x >> 1) * 4 + (l & 3), j = (x & 1) * 8 + (l >> 2);
        u.pm = e * 16 + b; u.pn = j; u.am = e * 16 + b; u.bt = e * 16 + j; return true;
    }
    __device__ __forceinline__ void a_ready(const pg8::Unit&) const {}
    __device__ __forceinline__ void done(const pg8::Unit&) const {}
};
struct OrderDown {
    int vcu;
    __device__ __forceinline__ bool next(int i, pg8::Unit& u) const {
        if (i >= 4) return false;
        const int x = vcu >> 5, l = vcu & 31, pm = i * 64 + x * 8 + (l & 7), pn = l >> 3;
        u.pm = pm; u.pn = pn; u.am = pm; u.bt = (pm >> 4) * 4 + pn; return true;
    }
    __device__ __forceinline__ void a_ready(const pg8::Unit&) const {}
    __device__ __forceinline__ void done(const pg8::Unit&) const {}
};

#ifndef MK_N_LAUNCHES
#define MK_N_LAUNCHES 1
#endif
constexpr int N_PHASES = 13;
#ifndef REP_P0
#define REP_P0 1
#endif
#ifndef REP_P1
#define REP_P1 1
#endif
#ifndef REP_DENSE
#define REP_DENSE 1
#endif
#ifndef REP_BAND
#define REP_BAND 1
#endif
#ifndef REP_WOUT
#define REP_WOUT 1
#endif
#ifndef REP_P6
#define REP_P6 1
#endif
#ifndef REP_TOPK
#define REP_TOPK 1
#endif
#ifndef REP_UP
#define REP_UP 1
#endif
#ifndef REP_DOWN
#define REP_DOWN 1
#endif
#define REPEAT(n) _Pragma("unroll 1") for (int rep_ = 0; rep_ < (n); ++rep_)
__global__ void __launch_bounds__(NWAVES * 64, 2) fwd_kernel(Args args) {
    extern __shared__ __attribute__((aligned(16))) unsigned char lds[];
#define MKFRAME(F) Frame F; { int t_ = threadIdx.x; asm volatile("" : "+v"(t_)); F.lds = (LAS unsigned char*)lds; F.MISC = (volatile LAS unsigned*)(F.lds + MISC_OFF); F.ctl = nullptr; \
        F.tid = t_; F.lane = t_ & 63; F.wave = __builtin_amdgcn_readfirstlane(t_ >> 6); F.G = 256; const int bx_ = blockIdx.x; F.vcu = (bx_ & 7) * 32 + (bx_ >> 3); }
#define BP(off) ((bf16*)(kargs()->p.ws + (off)))
#define SEAM() do { XcdBarrier b_; b_.bar = (unsigned*)(kargs()->p.ws + WS_CTL) + CW_BAR; b_.x = xb_xcc_id(); b_.st = (volatile LAS unsigned*)((LAS unsigned char*)lds + MISC_OFF) + 8; xcd_barrier(b_); } while (0)
    { const int t_ = threadIdx.x;
      for (int u = t_; u < (LDS_BYTES - LDSCTL_OFF) / 4; u += NWAVES * 64) ((LAS unsigned*)((LAS unsigned char*)lds + LDSCTL_OFF))[u] = 0u;
      __syncthreads();
      (void)xcd_barrier_post((unsigned*)(kargs()->p.ws + WS_CTL) + CW_BAR, (volatile LAS unsigned*)((LAS unsigned char*)lds + MISC_OFF) + 8); }

    REPEAT(REP_P0) { MKFRAME(F); p0_prologue(F, kargs()); } SEAM();
    REPEAT(REP_P1) { MKFRAME(F);
      pg8::Gemm g{BP(A_H0B), (const bf16*)(kargs()->p.ws + WS_WIN), MTOK, 5120, 1024}; pg8::StaticOrder S; S.init(MTOK, 5120, 256, (int)blockIdx.x);
      pg8::EpiProj2 E{BP(A_QKV), BP(A_GATES), kargs()->p.b_gate, kargs()->p.qn_g, kargs()->p.kn_g, (const float*)(kargs()->p.ws + WS_ROPEA), (const float*)(kargs()->p.ws + WS_ROPEB)};
      pg8::gemm_phase<pg8::EpiProj2, pg8::StaticOrder, true, true>(F.lds + RING_OFF, g, S, E); } SEAM();
    REPEAT(REP_DENSE) { MKFRAME(F);
#if defined(NAIVE_ATTN_A)
      attnA_naive_unit(F, kargs(), F.vcu); attnA_naive_unit(F, kargs(), F.vcu + 256);
#else
      { const attn_body::bf16* q_ = (const attn_body::bf16*)BP(A_QKV); attn_body::bf16* o_ = (attn_body::bf16*)BP(A_ATTNA);
        const int g = F.vcu >> 3, s = F.vcu & 7, ab = g >> 1, akvh = g & 1;
        const int cpos = F.vcu % 5;
#pragma unroll 1
        for (int i = 0; i < 5; ++i) {
            if (i == cpos) { convert_experts(F, kargs()); asm volatile("s_waitcnt vmcnt(0) lgkmcnt(0)" ::: "memory"); __syncthreads(); }
            if (i < 4) attn_body::attn_unit<8>(ab, akvh * 4 + i, akvh, s, q_ + OFF_QA, q_ + OFF_KA, q_ + OFF_VA, o_, (char*)lds + RING_OFF);
        } }
      __syncthreads();
#endif
    }
#if defined(NAIVE_ATTN_B)
    { MKFRAME(F); attnB_naive_unit(F, kargs(), F.vcu); } SEAM();
#else
    REPEAT(REP_BAND) { MKFRAME(F);
#pragma unroll 1
      for (int i = 0; i < 6; ++i) attn_body::band_half_unit(F.vcu + 256 * i, (const attn_body::bf16*)BP(A_QKV), OFF_QB, OFF_KB, OFF_VB, (attn_body::bf16*)BP(A_OBG), (float*)(kargs()->p.ws + WS_LSE), (char*)lds + RING_OFF);
      __syncthreads(); } SEAM();
    { MKFRAME(F); p3b_combine(F, kargs()); }
#endif
    { MKFRAME(F);
      { pg8::Gemm g{BP(A_ATTNA), (const bf16*)(kargs()->p.ws + WS_WA), MTOK, 1024, 512}; pg8::StaticOrder S; S.init(MTOK, 1024, 256, (int)blockIdx.x);
        pg8::EpiGate<false> E{BP(A_MERGED), BP(A_GATES), 0};
        pg8::gemm_phase<pg8::EpiGate<false>, pg8::StaticOrder, true, true>(F.lds + RING_OFF, g, S, E); }
      asm volatile("s_waitcnt vmcnt(0)" ::: "memory"); __syncthreads(); }
#if !defined(NAIVE_ATTN_B)
    SEAM();
#endif
    { MKFRAME(F);
      { pg8::Gemm g{BP(A_OB), (const bf16*)(kargs()->p.ws + WS_WB), MTOK, 1024, 256}; pg8::StaticOrder S; S.init(MTOK, 1024, 256, (int)blockIdx.x);
        pg8::EpiGate<true> E{BP(A_MERGED), BP(A_GATES), 1024};
        pg8::gemm_phase<pg8::EpiGate<true>, pg8::StaticOrder, true, true>(F.lds + RING_OFF, g, S, E); } } SEAM();
    REPEAT(REP_WOUT) { MKFRAME(F);
      pg8::Gemm g{BP(A_MERGED), (const bf16*)(kargs()->p.ws + WS_WO), MTOK, 1024, 1024}; pg8::StaticOrder S; S.init(MTOK, 1024, 256, (int)blockIdx.x);
      pg8::EpiPlain E{BP(A_MIX), 1024};
      pg8::gemm_phase<pg8::EpiPlain, pg8::StaticOrder, true, true>(F.lds + RING_OFF, g, S, E); } SEAM();
    REPEAT(REP_P6) { MKFRAME(F); p5_ln1_router_convert(F, kargs()); } SEAM();
    REPEAT(REP_TOPK) { MKFRAME(F); p6_topk_unit(F, kargs(), F.vcu); } SEAM();
    REPEAT(REP_UP) { MKFRAME(F); pg8::Gemm g{BP(A_XE), (const bf16*)kargs()->p.out, 0, 0, 1024}; OrderUp S{F.vcu}; pg8::EpiSwiglu E{BP(A_ACT)};
      pg8::gemm_phase<pg8::EpiSwiglu, OrderUp, true, true>(F.lds + RING_OFF, g, S, E); } SEAM();
    REPEAT(REP_DOWN) { MKFRAME(F); pg8::Gemm g{BP(A_ACT), (const bf16*)(kargs()->p.ws + A_WD), 0, 0, 2048}; OrderDown S{F.vcu}; pg8::EpiPlain E{BP(A_YE), 1024};
      pg8::gemm_phase<pg8::EpiPlain, OrderDown, true, true>(F.lds + RING_OFF, g, S, E); } SEAM();
    { MKFRAME(F); p9_final(F, kargs()); }
#undef MKFRAME
#undef BP
#undef SEAM
}

extern "C" void kernel_launch(void* const* d_in, const int* in_sizes, int n_in, void* d_out, int out_size, void* d_ws, size_t ws_size, hipStream_t stream) {
    static int grid = 0;
    if (grid == 0) {
        if (n_in != 18 || in_sizes[0] != MTOK * DM || out_size != MTOK * DM || ws_size < WS_END) { fprintf(stderr, "kernel_launch: unexpected shapes / workspace (n_in %d, ws %zu, need %zu)\n", n_in, ws_size, (size_t)WS_END); grid = -1; return; }
        if (hipFuncSetAttribute((const void*)fwd_kernel, hipFuncAttributeMaxDynamicSharedMemorySize, LDS_BYTES) != hipSuccess) { fprintf(stderr, "kernel_launch: hipFuncSetAttribute failed\n"); grid = -1; return; }
        (void)hipGetLastError();
        grid = 256;
    }
    if (grid < 0) return;
    if (hipMemsetAsync((char*)d_ws + WS_CTL, 0, CTL_ZERO_BYTES, stream) != hipSuccess) return;
    Args a{};
    const float** pp = (const float**)&a.p;
    for (int i = 0; i < 18; ++i) pp[i] = (const float*)d_in[i];
    a.p.out = (float*)d_out; a.p.ws = (unsigned char*)d_ws;
    a.ph_lo = 0; a.ph_hi = N_PHASES; a.li = 0;
    hipLaunchKernelGGL(fwd_kernel, dim3(grid), dim3(NWAVES * 64), LDS_BYTES, stream, a);
}
```

```cpp
#include <hip/hip_runtime.h>
#include <cstdio>
#include <cstdint>
constexpr int NWAVES = 8;
constexpr int BATCH = 16, SEQ = 2048, DM = 1024, MTOK = BATCH * SEQ;
constexpr int NEXP = 16, CAP = 256, DFF = 2048, NSLOT = BATCH * NEXP * CAP;
constexpr int QKVW = 3072, GATEW = 2048;
constexpr int OFF_QA = 0, OFF_KA = 512, OFF_VA = 640, OFF_QB = 768, OFF_KB = 1536, OFF_VB = 2304;
constexpr float LN_EPS = 1e-5f, QK_EPS = 1e-6f;
constexpr float ALPHA = 1.189207115002721f;
constexpr float C2 = 0.125f * 1.4426950408889634f;

namespace pg8 {
#define PG8_LAS __attribute__((address_space(3)))
typedef unsigned short bf16_t;
typedef short bf16x8 __attribute__((ext_vector_type(8)));
typedef float f32x4 __attribute__((ext_vector_type(4)));
typedef unsigned u32x4 __attribute__((ext_vector_type(4)));
constexpr int BM = 256, BK = 64, HALF = 128, HTB = HALF * BK * 2  , STAGE_BYTES = 8 * HTB, NXCD = 8, WGM = 8;

__host__ __device__ __forceinline__ int lds_byte(int r, int c) { const int st = (r >> 4) * 2 + (c >> 5), rr = r & 15, cc = c & 31, ob = rr * 64 + cc * 2; return st * 1024 + (ob ^ (((ob >> 9) & 1) << 5)); }
__host__ __device__ __forceinline__ void stage_rc(int b, int& R, int& C) { const int st = b / 1024, sb = b % 1024, swz = sb ^ (((sb >> 9) & 1) << 5); R = (st >> 1) * 16 + swz / 64; C = (st & 1) * 32 + (swz % 64) / 2; }
__host__ __device__ __forceinline__ int perm32(int rho) { const int n = rho >> 4, i = rho & 15; return 8 * (i >> 2) + 4 * n + (i & 3); }

struct Unit { int pm, pn, am, bt; };
struct Gemm { const bf16_t* A; const bf16_t* Bt; int M, N, K; };

struct StaticOrder {
    int nM, nN, nwg, G, c;
    __host__ __device__ void init(int M, int N, int G_, int c_) { nM = M / BM; nN = N / BM; nwg = nM * nN; G = G_; c = c_; }
    __host__ __device__ bool next(int i, Unit& u) const {
        const long L = (long)i * G + c; if (L >= nwg) return false;
        int wgid = (int)L; { const int q = nwg / NXCD, r = nwg % NXCD, xcd = wgid % NXCD, off = wgid / NXCD; wgid = (xcd < r ? xcd * (q + 1) : r * (q + 1) + (xcd - r) * q) + off; }
        const int nig = WGM * nN, gid = wgid / nig, fm = gid * WGM, gsz = (nM - fm) < WGM ? (nM - fm) : WGM;
        u.pm = fm + ((wgid % nig) % gsz); u.pn = (wgid % nig) / gsz; u.am = u.pm; u.bt = u.pn; return true;
    }
    __device__ __forceinline__ void a_ready(const Unit&) const {}
    __device__ __forceinline__ void done(const Unit&) const {}
};

typedef float f32x2_cv __attribute__((ext_vector_type(2))); typedef __bf16 bf16x2_cv __attribute__((ext_vector_type(2)));
__device__ __forceinline__ unsigned cvt_pk_bf16(float lo, float hi) { f32x2_cv v = {lo, hi}; bf16x2_cv b = __builtin_convertvector(v, bf16x2_cv); return __builtin_bit_cast(unsigned, b); }
__device__ __forceinline__ float bf_lo(unsigned w) { return __uint_as_float(w << 16); }
__device__ __forceinline__ float bf_hi(unsigned w) { return __uint_as_float(w & 0xffff0000u); }
__device__ __forceinline__ float sigmoidf_(float x) { return __builtin_amdgcn_rcpf(1.0f + __builtin_amdgcn_exp2f(-1.4426950408889634f * x)); }
__device__ __forceinline__ u32x4 pack8(const f32x4 v0, const f32x4 v1) { u32x4 w; w.x = cvt_pk_bf16(v0[0], v0[1]); w.y = cvt_pk_bf16(v0[2], v0[3]); w.z = cvt_pk_bf16(v1[0], v1[1]); w.w = cvt_pk_bf16(v1[2], v1[3]); return w; }

struct EpiProj {
    static constexpr bool PERM = true, AFTER_DRAIN = false; static constexpr int MID_TILES = 0;
    bf16_t* qkv; bf16_t* gates; const float* b_gate;
    __device__ __forceinline__ void operator()(const f32x4 (&acc)[2][2][4][2], const Unit& u, int wr, int wc, int fr, int fq) const {
        const int row0 = u.pm * BM + wr * 64 + fr;
        const bool isg = u.pn >= 12;
        bf16_t* base = isg ? gates : qkv; const int ldc = isg ? 2048 : 3072; const int colt = isg ? (u.pn - 12) * BM : u.pn * BM;
        const int col0 = colt + wc * 32 + 8 * fq;
        f32x4 bv[2][2];
#pragma unroll
        for (int bj = 0; bj < 2; ++bj)
#pragma unroll
            for (int n = 0; n < 2; ++n) bv[bj][n] = isg ? *(const f32x4*)(b_gate + col0 + bj * HALF + 4 * n) : (f32x4){0.f, 0.f, 0.f, 0.f};
#pragma unroll
        for (int ai = 0; ai < 2; ++ai)
#pragma unroll
            for (int m = 0; m < 4; ++m) { bf16_t* rowp = base + (size_t)(row0 + ai * HALF + m * 16) * ldc + col0;
#pragma unroll
                for (int bj = 0; bj < 2; ++bj) { f32x4 v0 = acc[ai][bj][m][0] + bv[bj][0], v1 = acc[ai][bj][m][1] + bv[bj][1];
                    if (isg) {
#pragma unroll
                        for (int i = 0; i < 4; ++i) { v0[i] = sigmoidf_(v0[i]); v1[i] = sigmoidf_(v1[i]); } }
                    *(u32x4*)(rowp + bj * HALF) = pack8(v0, v1); } }
    }
};
struct EpiPlain {
    static constexpr bool PERM = true, AFTER_DRAIN = false; static constexpr int MID_TILES = 0;
    bf16_t* O; int ldc;
    __device__ __forceinline__ void operator()(const f32x4 (&acc)[2][2][4][2], const Unit& u, int wr, int wc, int fr, int fq) const {
        const int row0 = u.pm * BM + wr * 64 + fr; const int col0 = u.pn * BM + wc * 32 + 8 * fq;
#pragma unroll
        for (int ai = 0; ai < 2; ++ai)
#pragma unroll
            for (int m = 0; m < 4; ++m) { bf16_t* rowp = O + (size_t)(row0 + ai * HALF + m * 16) * ldc + col0;
#pragma unroll
                for (int bj = 0; bj < 2; ++bj) *(u32x4*)(rowp + bj * HALF) = pack8(acc[ai][bj][m][0], acc[ai][bj][m][1]); }
    }
};
template <bool ACCUM> struct EpiGate {
    static constexpr bool PERM = true, AFTER_DRAIN = false; static constexpr int MID_TILES = 0;
    bf16_t* merged; const bf16_t* gates; int goff;
    __device__ __forceinline__ void operator()(const f32x4 (&acc)[2][2][4][2], const Unit& u, int wr, int wc, int fr, int fq) const {
        const int row0 = u.pm * BM + wr * 64 + fr; const int col0 = u.pn * BM + wc * 32 + 8 * fq;
#pragma unroll
        for (int ai = 0; ai < 2; ++ai)
#pragma unroll
            for (int m = 0; m < 4; ++m) { const size_t r = (size_t)(row0 + ai * HALF + m * 16);
#pragma unroll
                for (int bj = 0; bj < 2; ++bj) {
                    const u32x4 g = *(const u32x4*)(gates + r * 2048 + goff + col0 + bj * HALF);
                    f32x4 v0 = acc[ai][bj][m][0], v1 = acc[ai][bj][m][1];
                    v0[0] *= bf_lo(g.x); v0[1] *= bf_hi(g.x); v0[2] *= bf_lo(g.y); v0[3] *= bf_hi(g.y);
                    v1[0] *= bf_lo(g.z); v1[1] *= bf_hi(g.z); v1[2] *= bf_lo(g.w); v1[3] *= bf_hi(g.w);
                    bf16_t* p = merged + r * 1024 + col0 + bj * HALF;
                    if (ACCUM) { const u32x4 o = *(const u32x4*)p;
                        v0[0] += bf_lo(o.x); v0[1] += bf_hi(o.x); v0[2] += bf_lo(o.y); v0[3] += bf_hi(o.y);
                        v1[0] += bf_lo(o.z); v1[1] += bf_hi(o.z); v1[2] += bf_lo(o.w); v1[3] += bf_hi(o.w); }
                    *(u32x4*)p = pack8(v0, v1); } }
    }
};
struct EpiSwiglu {
    static constexpr bool PERM = true, AFTER_DRAIN = false; static constexpr int MID_TILES = 0;
    bf16_t* act;
    __device__ __forceinline__ void operator()(const f32x4 (&acc)[2][2][4][2], const Unit& u, int wr, int wc, int fr, int fq) const {
        const int row0 = u.pm * BM + wr * 64 + fr; const int col0 = u.pn * HALF + wc * 32 + 8 * fq;
#pragma unroll
        for (int ai = 0; ai < 2; ++ai)
#pragma unroll
            for (int m = 0; m < 4; ++m) {
                f32x4 v0, v1;
#pragma unroll
                for (int i = 0; i < 4; ++i) { const float g0 = acc[ai][0][m][0][i], g1 = acc[ai][0][m][1][i];
                    v0[i] = g0 * sigmoidf_(g0) * acc[ai][1][m][0][i]; v1[i] = g1 * sigmoidf_(g1) * acc[ai][1][m][1][i]; }
                *(u32x4*)(act + (size_t)(row0 + ai * HALF + m * 16) * 2048 + col0) = pack8(v0, v1); }
    }
};

struct EpiProj2 {
    static constexpr bool PERM = true, AFTER_DRAIN = false; static constexpr int MID_TILES = 0;
    bf16_t* qkv; bf16_t* gates; const float* b_gate; const float* qn_g; const float* kn_g; const float* ropeA; const float* ropeB;
    typedef unsigned u32x2_t __attribute__((ext_vector_type(2)));
    __device__ __forceinline__ void operator()(const f32x4 (&acc)[2][2][4][2], const Unit& u, int wr, int wc, int fr, int fq) const {
        const int row0 = u.pm * BM + wr * 64 + fr;
        if (u.pn >= 12) {
            const int col0 = (u.pn - 12) * BM + wc * 32 + 8 * fq;
            f32x4 bv[2][2];
#pragma unroll
            for (int bj = 0; bj < 2; ++bj)
#pragma unroll
                for (int n = 0; n < 2; ++n) bv[bj][n] = *(const f32x4*)(b_gate + col0 + bj * HALF + 4 * n);
#pragma unroll
            for (int ai = 0; ai < 2; ++ai)
#pragma unroll
                for (int m = 0; m < 4; ++m) { bf16_t* rowp = gates + (size_t)(row0 + ai * HALF + m * 16) * 2048 + col0;
#pragma unroll
                    for (int bj = 0; bj < 2; ++bj) { f32x4 v0 = acc[ai][bj][m][0] + bv[bj][0], v1 = acc[ai][bj][m][1] + bv[bj][1];
#pragma unroll
                        for (int i = 0; i < 4; ++i) { v0[i] = sigmoidf_(v0[i]); v1[i] = sigmoidf_(v1[i]); }
                        *(u32x4*)(rowp + bj * HALF) = pack8(v0, v1); } }
            return;
        }
        int kind, colbase;
        if (u.pn < 2) { kind = 0; colbase = OFF_QA + (4 * u.pn + wc) * 64; }
        else if (u.pn == 2) { if (wc < 2) { kind = 1; colbase = OFF_KA + wc * 64; } else { kind = 2; colbase = OFF_VA + (wc - 2) * 64; } }
        else if (u.pn < 6) { kind = 3; colbase = OFF_QB + (4 * (u.pn - 3) + wc) * 64; }
        else if (u.pn < 9) { kind = 4; colbase = OFF_KB + (4 * (u.pn - 6) + wc) * 64; }
        else { kind = 2; colbase = OFF_VB + (4 * (u.pn - 9) + wc) * 64; }
        if (kind <= 1) {
            const float* gn = kind == 0 ? qn_g : kn_g; const float sc = kind == 0 ? C2 : 1.0f;
            f32x4 g[2][2];
#pragma unroll
            for (int bj = 0; bj < 2; ++bj)
#pragma unroll
                for (int n = 0; n < 2; ++n) g[bj][n] = *(const f32x4*)(gn + 32 * n + 16 * bj + 4 * fq) * sc;
#pragma unroll
            for (int ai = 0; ai < 2; ++ai)
#pragma unroll
                for (int m = 0; m < 4; ++m) { const int row = row0 + ai * HALF + m * 16; const float* ta = ropeA + (size_t)(row & (SEQ - 1)) * 64 + 4 * fq;
                    float ss = 0.f;
#pragma unroll
                    for (int bj = 0; bj < 2; ++bj)
#pragma unroll
                        for (int n = 0; n < 2; ++n) { const f32x4 x = acc[ai][bj][m][n]; ss += (x[0] * x[0] + x[1] * x[1]) + (x[2] * x[2] + x[3] * x[3]); }
                    ss += __shfl_xor(ss, 16); ss += __shfl_xor(ss, 32);
                    const float rs = 1.0f / sqrtf(ss * (1.0f / 64.0f) + QK_EPS);
                    bf16_t* rowp = qkv + (size_t)row * QKVW + colbase + 4 * fq;
#pragma unroll
                    for (int n = 0; n < 2; ++n) { const f32x4 cs = *(const f32x4*)(ta + n * 32), sn = *(const f32x4*)(ta + n * 32 + 16);
                        const f32x4 x1 = acc[ai][0][m][n] * rs * g[0][n], x2 = acc[ai][1][m][n] * rs * g[1][n];
                        const f32x4 o1 = x1 * cs - x2 * sn, o2 = x2 * cs + x1 * sn;
                        u32x2_t w1, w2; w1.x = cvt_pk_bf16(o1[0], o1[1]); w1.y = cvt_pk_bf16(o1[2], o1[3]); w2.x = cvt_pk_bf16(o2[0], o2[1]); w2.y = cvt_pk_bf16(o2[2], o2[3]);
                        *(u32x2_t*)(rowp + 32 * n) = w1; *(u32x2_t*)(rowp + 32 * n + 16) = w2; } }
        } else if (kind == 2) {
#pragma unroll
            for (int ai = 0; ai < 2; ++ai)
#pragma unroll
                for (int m = 0; m < 4; ++m) { bf16_t* rowp = qkv + (size_t)(row0 + ai * HALF + m * 16) * QKVW + colbase + 8 * fq;
#pragma unroll
                    for (int bj = 0; bj < 2; ++bj) *(u32x4*)(rowp + 32 * bj) = pack8(acc[ai][bj][m][0], acc[ai][bj][m][1]); }
        } else {
            const float sc = kind == 3 ? C2 : 1.0f;
#pragma unroll
            for (int ai = 0; ai < 2; ++ai)
#pragma unroll
                for (int m = 0; m < 4; ++m) { const int row = row0 + ai * HALF + m * 16; const float* tb = ropeB + (size_t)(row & (SEQ - 1)) * 16;
                    f32x4 a0 = acc[ai][0][m][0], a1 = acc[ai][0][m][1], b0 = acc[ai][1][m][0], b1 = acc[ai][1][m][1];
                    if (fq == 0) { const f32x4 c0 = *(const f32x4*)(tb), c1 = *(const f32x4*)(tb + 4), s0 = *(const f32x4*)(tb + 8), s1 = *(const f32x4*)(tb + 12);
                        const f32x4 o0 = a0 * c0 - b0 * s0, p0 = b0 * c0 + a0 * s0, o1 = a1 * c1 - b1 * s1, p1 = b1 * c1 + a1 * s1; a0 = o0; b0 = p0; a1 = o1; b1 = p1; }
                    a0 = a0 * sc; a1 = a1 * sc; b0 = b0 * sc; b1 = b1 * sc;
                    bf16_t* rowp = qkv + (size_t)row * QKVW + colbase + 16 * fq;
                    *(u32x4*)(rowp) = pack8(a0, a1); *(u32x4*)(rowp + 8) = pack8(b0, b1); }
        }
    }
};

struct EpiGateMerge {
    static constexpr bool PERM = true, AFTER_DRAIN = false; static constexpr int MID_TILES = 8;
    bf16_t* merged; const bf16_t* gates;
    __device__ __forceinline__ void mid(f32x4 (&acc)[2][2][4][2], const Unit& u, int wr, int wc, int fr, int fq) const {
        asm volatile("" : "+v"(fr), "+v"(fq));
        const int row0 = u.pm * BM + wr * 64 + fr; const int col0 = u.pn * BM + wc * 32 + 8 * fq;
#pragma unroll
        for (int ai = 0; ai < 2; ++ai)
#pragma unroll
            for (int m = 0; m < 4; ++m) { const bf16_t* gp = gates + (size_t)(row0 + ai * HALF + m * 16) * 2048 + col0;
#pragma unroll
                for (int bj = 0; bj < 2; ++bj) {
                    const u32x4 a = *(const u32x4*)(gp + bj * HALF), b = *(const u32x4*)(gp + 1024 + bj * HALF);
                    f32x4 r0, r1;
                    r0[0] = bf_lo(a.x) * __builtin_amdgcn_rcpf(bf_lo(b.x)); r0[1] = bf_hi(a.x) * __builtin_amdgcn_rcpf(bf_hi(b.x)); r0[2] = bf_lo(a.y) * __builtin_amdgcn_rcpf(bf_lo(b.y)); r0[3] = bf_hi(a.y) * __builtin_amdgcn_rcpf(bf_hi(b.y));
                    r1[0] = bf_lo(a.z) * __builtin_amdgcn_rcpf(bf_lo(b.z)); r1[1] = bf_hi(a.z) * __builtin_amdgcn_rcpf(bf_hi(b.z)); r1[2] = bf_lo(a.w) * __builtin_amdgcn_rcpf(bf_lo(b.w)); r1[3] = bf_hi(a.w) * __builtin_amdgcn_rcpf(bf_hi(b.w));
                    acc[ai][bj][m][0] = acc[ai][bj][m][0] * r0; acc[ai][bj][m][1] = acc[ai][bj][m][1] * r1; } }
    }
    __device__ __forceinline__ void operator()(const f32x4 (&acc)[2][2][4][2], const Unit& u, int wr, int wc, int fr, int fq) const {
        asm volatile("" : "+v"(fr), "+v"(fq));
        const int row0 = u.pm * BM + wr * 64 + fr; const int col0 = u.pn * BM + wc * 32 + 8 * fq;
#pragma unroll
        for (int ai = 0; ai < 2; ++ai)
#pragma unroll
            for (int m = 0; m < 4; ++m) { const size_t r = (size_t)(row0 + ai * HALF + m * 16);
#pragma unroll
                for (int bj = 0; bj < 2; ++bj) {
                    const u32x4 g = *(const u32x4*)(gates + r * 2048 + 1024 + col0 + bj * HALF);
                    f32x4 v0 = acc[ai][bj][m][0], v1 = acc[ai][bj][m][1];
                    v0[0] *= bf_lo(g.x); v0[1] *= bf_hi(g.x); v0[2] *= bf_lo(g.y); v0[3] *= bf_hi(g.y);
                    v1[0] *= bf_lo(g.z); v1[1] *= bf_hi(g.z); v1[2] *= bf_lo(g.w); v1[3] *= bf_hi(g.w);
                    *(u32x4*)(merged + r * 1024 + col0 + bj * HALF) = pack8(v0, v1); } }
    }
};
template <class Epi, class Sched, bool ALIGN_EPI = false, bool SP2 = false>
__device__ __forceinline__ void gemm_phase(PG8_LAS unsigned char* lds, const Gemm g, const Sched& S, const Epi& E) {
    int tid_ = threadIdx.x; asm volatile("" : "+v"(tid_));
    const int tid = tid_, wid = __builtin_amdgcn_readfirstlane(tid >> 6), lane = tid & 63, wr = wid >> 2, wc = wid & 3, fr = lane & 15, fq = lane >> 4;
    const int K = g.K, nt = K / BK;
    unsigned voffA[2], voffB[2];
#pragma unroll
    for (int i = 0; i < 2; ++i) { int R, C; stage_rc(tid * 16 + i * 8192, R, C); const int Rb = Epi::PERM ? ((R & ~31) + perm32(R & 31)) : R;
        voffA[i] = (unsigned)(R * K + C) * 2u; voffB[i] = (unsigned)(Rb * K + C) * 2u; }
    const size_t kstep = (size_t)(BK * 2);
    const size_t hstep = (size_t)HALF * K * 2;
    const size_t tstep = 2 * hstep;
    const unsigned ldsw = (unsigned)wid * 1024u;
    const int aoff = lds_byte(wr * 64 + fr, fq * 8), boff = lds_byte(wc * 32 + fr, fq * 8);
#define PG8_SA(b, h) (((b) * 2 + (h)) * HTB)
#define PG8_SB(b, h) ((4 + (b) * 2 + (h)) * HTB)
#define PG8_STAGE(bufoff, gbase, voff) do { _Pragma("unroll") for (int _i = 0; _i < 2; ++_i) \
        __builtin_amdgcn_global_load_lds((const unsigned*)((const char*)(gbase) + (voff)[_i]), (PG8_LAS unsigned*)(lds + (bufoff) + ldsw + _i * 8192), 16, 0, 0); } while (0)
#define PG8_LDA(dst, b, h) do { _Pragma("unroll") for (int m = 0; m < 4; ++m) _Pragma("unroll") for (int k = 0; k < 2; ++k) dst[m][k] = *(const PG8_LAS bf16x8*)(lds + PG8_SA(b, h) + aoff + m * 2048 + k * 1024); } while (0)
#define PG8_LDB(dst, b, h) do { _Pragma("unroll") for (int n = 0; n < 2; ++n) _Pragma("unroll") for (int k = 0; k < 2; ++k) dst[n][k] = *(const PG8_LAS bf16x8*)(lds + PG8_SB(b, h) + boff + n * 2048 + k * 1024); } while (0)
#define PG8_MMA(ai, bj, At, Bt) do { __builtin_amdgcn_s_setprio(1); _Pragma("unroll") for (int m = 0; m < 4; ++m) _Pragma("unroll") for (int n = 0; n < 2; ++n) _Pragma("unroll") for (int k = 0; k < 2; ++k) \
        acc[ai][bj][m][n] = __builtin_amdgcn_mfma_f32_16x16x32_bf16(Bt[n][k], At[m][k], acc[ai][bj][m][n], 0, 0, 0); __builtin_amdgcn_s_setprio(0); } while (0)
#define PG8_WAIT_V(n) asm volatile("s_waitcnt vmcnt(" #n ")" ::: "memory")
#define PG8_WAIT_L(n) asm volatile("s_waitcnt lgkmcnt(" #n ")" ::: "memory")
#define PG8_BAR __builtin_amdgcn_s_barrier()
#define PG8_SCHED __builtin_amdgcn_sched_barrier(0)
    Unit cur, nxt; int ui = 0;
    if (!S.next(0, cur)) return;
    f32x4 acc[2][2][4][2];
#pragma unroll
    for (int a = 0; a < 2; ++a)
#pragma unroll
        for (int b = 0; b < 2; ++b)
#pragma unroll
            for (int m = 0; m < 4; ++m)
#pragma unroll
                for (int n = 0; n < 2; ++n) acc[a][b][m][n] = (f32x4){0.f, 0.f, 0.f, 0.f};
    bf16x8 At[4][2], B0[2][2], B1[2][2];
    const char* cA = (const char*)g.A + (size_t)cur.am * tstep; const char* cB = (const char*)g.Bt + (size_t)cur.bt * tstep;
    S.a_ready(cur);
    if constexpr (SP2) {
        PG8_STAGE(PG8_SB(0, 0), cB, voffB); PG8_STAGE(PG8_SB(0, 1), cB + hstep, voffB); PG8_STAGE(PG8_SA(0, 0), cA, voffA); PG8_STAGE(PG8_SA(0, 1), cA + hstep, voffA);
        if (wr == 1) PG8_BAR;
        PG8_WAIT_V(2); PG8_BAR;
        PG8_STAGE(PG8_SB(1, 0), cB + kstep, voffB); PG8_STAGE(PG8_SA(1, 0), cA + kstep, voffA); PG8_STAGE(PG8_SB(1, 1), cB + hstep + kstep, voffB);
        PG8_WAIT_V(6); PG8_BAR;
    } else {
        PG8_STAGE(PG8_SB(0, 0), cB, voffB); PG8_STAGE(PG8_SA(0, 0), cA, voffA); PG8_STAGE(PG8_SB(0, 1), cB + hstep, voffB); PG8_STAGE(PG8_SA(0, 1), cA + hstep, voffA);
        if (wr == 1) PG8_BAR;
        PG8_WAIT_V(4); PG8_BAR;
        PG8_STAGE(PG8_SB(1, 0), cB + kstep, voffB); PG8_STAGE(PG8_SA(1, 0), cA + kstep, voffA); PG8_STAGE(PG8_SB(1, 1), cB + hstep + kstep, voffB);
        PG8_WAIT_V(6); PG8_BAR;
    }
    for (;;) {
        const bool has_next = S.next(ui + 1, nxt);
        const char* nA = has_next ? (const char*)g.A + (size_t)nxt.am * tstep : cA; const char* nB = has_next ? (const char*)g.Bt + (size_t)nxt.bt * tstep : cB;
        for (int t = 0; t < nt; t += 2) {
            const bool last = (t == nt - 2);
            const char* a1 = cA + (size_t)(t + 1) * kstep;
            const char* a2 = last ? nA : cA + (size_t)(t + 2) * kstep; const char* b2 = last ? nB : cB + (size_t)(t + 2) * kstep;
            const char* a3 = a2 + kstep; const char* b3 = b2 + kstep;
            if (last && has_next) S.a_ready(nxt);
            if constexpr (SP2) {
            PG8_LDB(B0, 0, 0); PG8_LDB(B1, 0, 1); PG8_SCHED; PG8_LDA(At, 0, 0); PG8_STAGE(PG8_SA(1, 1), a1 + hstep, voffA);
            PG8_WAIT_V(8); PG8_WAIT_L(0); PG8_BAR; PG8_MMA(0, 0, At, B0); PG8_MMA(0, 1, At, B1); PG8_BAR; PG8_SCHED;
            PG8_LDA(At, 0, 1); PG8_STAGE(PG8_SB(0, 0), b2, voffB); PG8_STAGE(PG8_SB(0, 1), b2 + hstep, voffB); PG8_STAGE(PG8_SA(0, 0), a2, voffA);
            PG8_WAIT_V(8); PG8_WAIT_L(0); PG8_BAR; PG8_MMA(1, 0, At, B0); PG8_MMA(1, 1, At, B1); PG8_BAR; PG8_SCHED;
            PG8_LDB(B0, 1, 0); PG8_LDB(B1, 1, 1); PG8_SCHED; PG8_LDA(At, 1, 0); PG8_STAGE(PG8_SA(0, 1), a2 + hstep, voffA);
            PG8_WAIT_V(8); PG8_WAIT_L(0); PG8_BAR; PG8_MMA(0, 0, At, B0); PG8_MMA(0, 1, At, B1); PG8_BAR; PG8_SCHED;
            PG8_LDA(At, 1, 1); PG8_STAGE(PG8_SB(1, 0), b3, voffB); PG8_STAGE(PG8_SB(1, 1), b3 + hstep, voffB); PG8_STAGE(PG8_SA(1, 0), a3, voffA);
            PG8_WAIT_V(8); PG8_WAIT_L(0); PG8_BAR; PG8_MMA(1, 0, At, B0); PG8_MMA(1, 1, At, B1); PG8_BAR; PG8_SCHED;
            } else {
            PG8_LDB(B0, 0, 0); PG8_SCHED; PG8_LDA(At, 0, 0); PG8_STAGE(PG8_SA(1, 1), a1 + hstep, voffA);
            PG8_WAIT_L(8); PG8_BAR; PG8_WAIT_L(0); PG8_MMA(0, 0, At, B0); PG8_BAR; PG8_SCHED;
            PG8_LDB(B1, 0, 1); PG8_STAGE(PG8_SB(0, 0), b2, voffB);
            PG8_BAR; PG8_WAIT_L(0); PG8_MMA(0, 1, At, B1); PG8_BAR;
            PG8_LDA(At, 0, 1); PG8_STAGE(PG8_SA(0, 0), a2, voffA);
            PG8_BAR; PG8_WAIT_L(0); PG8_MMA(1, 0, At, B0); PG8_BAR; PG8_SCHED;
            PG8_STAGE(PG8_SB(0, 1), b2 + hstep, voffB);
            PG8_WAIT_V(6); PG8_BAR; PG8_MMA(1, 1, At, B1); PG8_BAR;
            PG8_LDB(B0, 1, 0); PG8_SCHED; PG8_LDA(At, 1, 0); PG8_STAGE(PG8_SA(0, 1), a2 + hstep, voffA);
            PG8_WAIT_L(8); PG8_BAR; PG8_WAIT_L(0); PG8_MMA(0, 0, At, B0); PG8_BAR; PG8_SCHED;
            PG8_LDB(B1, 1, 1); PG8_STAGE(PG8_SB(1, 0), b3, voffB);
            PG8_BAR; PG8_WAIT_L(0); PG8_MMA(0, 1, At, B1); PG8_BAR;
            PG8_LDA(At, 1, 1); PG8_STAGE(PG8_SA(1, 0), a3, voffA);
            PG8_BAR; PG8_WAIT_L(0); PG8_MMA(1, 0, At, B0); PG8_BAR; PG8_SCHED;
            PG8_STAGE(PG8_SB(1, 1), b3 + hstep, voffB);
            PG8_WAIT_V(6); PG8_BAR; PG8_MMA(1, 1, At, B1); PG8_BAR;
            }
            if constexpr (Epi::MID_TILES > 0) { if (t + 2 == Epi::MID_TILES) E.mid(acc, cur, wr, wc, fr, fq); }
        }
        if constexpr (ALIGN_EPI) { if (wr == 0) PG8_BAR; }
        if constexpr (!Epi::AFTER_DRAIN) { E(acc, cur, wr, wc, fr, fq); S.done(cur); }
        if (!has_next) break;
#pragma unroll
        for (int a = 0; a < 2; ++a)
#pragma unroll
            for (int b = 0; b < 2; ++b)
#pragma unroll
                for (int m = 0; m < 4; ++m)
#pragma unroll
                    for (int n = 0; n < 2; ++n) acc[a][b][m][n] = (f32x4){0.f, 0.f, 0.f, 0.f};
        cur = nxt; cA = nA; cB = nB; ++ui;
        if constexpr (ALIGN_EPI) { if (wr == 1) PG8_BAR; }
    }
    PG8_WAIT_V(0);
    if constexpr (!ALIGN_EPI) { if (wr == 0) PG8_BAR; }
    PG8_BAR;
    if constexpr (Epi::AFTER_DRAIN) { E.fused(acc, cur, wr, wc, fr, fq, lds, wid, lane); S.done(cur); }
#undef PG8_SA
#undef PG8_SB
#undef PG8_STAGE
#undef PG8_LDA
#undef PG8_LDB
#undef PG8_MMA
#undef PG8_WAIT_V
#undef PG8_WAIT_L
#undef PG8_BAR
#undef PG8_SCHED
}
}
#include <hip/hip_bf16.h>
#include <cmath>
namespace attn_body {
using bf16=__hip_bfloat16;
using bf16x8=__attribute__((ext_vector_type(8)))short;
using s16x4=__attribute__((ext_vector_type(4)))short;
using f32x16=__attribute__((ext_vector_type(16)))float;
using u32x4=__attribute__((ext_vector_type(4)))unsigned;
constexpr int BATCH=16,NHEAD=8,SEQ=2048,D=64,PQ=3072,PO=768;
constexpr int NW=8,QBLK=32,QB=QBLK*NW,KVBLK=64,NQB=SEQ/QB;
constexpr int ATTN_UNIT_ROWS=QB;
__device__ __forceinline__ int crow(int r,int hi){return (r&3)+8*(r>>2)+4*hi;}
#define SBAR() __builtin_amdgcn_sched_barrier(0)
__device__ __forceinline__ void cmask(f32x16&p0,f32x16&p1,int jb,int qrel,int hi){
  const float NEG=-INFINITY; int kb=64*jb+4*hi;
  #pragma unroll
  for(int r=0;r<16;++r){int kv=kb+(r&3)+8*(r>>2); if(kv>qrel)p0[r]=NEG; if(kv+32>qrel)p1[r]=NEG;}
}

constexpr int NSLOT=3, SLOTB=8192;
constexpr int LDS_K=0, LDS_V=NSLOT*SLOTB, LDS_WS=2*NSLOT*SLOTB, LDS_OST=LDS_WS+NW*64*4, LDS_BYTES=LDS_OST+NW*4096;
constexpr float C2=0.125f*1.4426950408889634f;
__device__ __forceinline__ void glds16(const void*gsrc,unsigned lds_dst){unsigned keep;
  asm volatile("s_mov_b32 %0, m0\n\ts_mov_b32 m0, %2\n\ts_nop 0\n\tglobal_load_lds_dwordx4 %1, off\n\ts_mov_b32 m0, %0":"=&s"(keep):"v"(gsrc),"s"(lds_dst):"memory");}
__device__ __forceinline__ float max3f(float a,float b,float c){float r;asm("v_max3_f32 %0, %1, %2, %3":"=v"(r):"v"(a),"v"(b),"v"(c));return r;}
__device__ __forceinline__ float max2f(float a,float b){float r;asm("v_max_f32_e32 %0, %1, %2":"=v"(r):"v"(a),"v"(b));return r;}
__device__ __forceinline__ float fadd_s(float a,float b){float r;asm("v_add_f32_e32 %0, %1, %2":"=v"(r):"v"(a),"v"(b));return r;}
__device__ __forceinline__ float fsub_s(float a,float b){float r;asm("v_sub_f32_e32 %0, %1, %2":"=v"(r):"v"(a),"v"(b));return r;}
typedef float f32x2_t __attribute__((ext_vector_type(2))); typedef __bf16 bf16x2_t __attribute__((ext_vector_type(2)));
__device__ __forceinline__ unsigned cvtpk_s(float lo,float hi){f32x2_t v={lo,hi};bf16x2_t b=__builtin_convertvector(v,bf16x2_t);return __builtin_bit_cast(unsigned,b);}
#define WAIT_BAR(N) asm volatile("s_waitcnt vmcnt(" #N ") lgkmcnt(0)\n\ts_barrier":::"memory")

__device__ __forceinline__ void qkt(f32x16&p0,f32x16&p1,const char*Kslot,const bf16x8*qr,const f32x16&negm,int r32,int hi){
  const char*kb=Kslot+hi*1024+r32*16;
  #pragma unroll
  for(int d0=0;d0<4;++d0){
    const bf16x8 b0=*reinterpret_cast<const bf16x8*>(kb+d0*2048);
    const bf16x8 b1=*reinterpret_cast<const bf16x8*>(kb+d0*2048+512);
    if(d0==0){p0=__builtin_amdgcn_mfma_f32_32x32x16_bf16(b0,qr[0],negm,0,0,0);p1=__builtin_amdgcn_mfma_f32_32x32x16_bf16(b1,qr[0],negm,0,0,0);}
    else{p0=__builtin_amdgcn_mfma_f32_32x32x16_bf16(b0,qr[d0],p0,0,0,0);p1=__builtin_amdgcn_mfma_f32_32x32x16_bf16(b1,qr[d0],p1,0,0,0);}}
}
typedef __attribute__((address_space(3))) const char* lds_cptr;
typedef short v4i16_t __attribute__((ext_vector_type(4)));
__device__ __forceinline__ void kload8(bf16x8*kf,lds_cptr kp){
  kf[0]=*(const __attribute__((address_space(3))) bf16x8*)(kp);      kf[1]=*(const __attribute__((address_space(3))) bf16x8*)(kp+512);
  kf[2]=*(const __attribute__((address_space(3))) bf16x8*)(kp+2048); kf[3]=*(const __attribute__((address_space(3))) bf16x8*)(kp+2560);
  kf[4]=*(const __attribute__((address_space(3))) bf16x8*)(kp+4096); kf[5]=*(const __attribute__((address_space(3))) bf16x8*)(kp+4608);
  kf[6]=*(const __attribute__((address_space(3))) bf16x8*)(kp+6144); kf[7]=*(const __attribute__((address_space(3))) bf16x8*)(kp+6656);
}
__device__ __forceinline__ void kload2(bf16x8*kf,lds_cptr kp,int j){ kf[2*j]=*(const __attribute__((address_space(3))) bf16x8*)(kp+j*2048); kf[2*j+1]=*(const __attribute__((address_space(3))) bf16x8*)(kp+j*2048+512); }
__device__ __forceinline__ s16x4 vtr(lds_cptr p){ return __builtin_bit_cast(s16x4,__builtin_amdgcn_ds_read_tr16_b64_v4i16((__attribute__((address_space(3))) v4i16_t*)p)); }
__device__ __forceinline__ float rowmax(const f32x16&p0,const f32x16&p1){
  float a=max3f(p0[0],p0[1],p1[0]),b=max3f(p0[2],p0[3],p1[1]);a=max3f(a,p1[2],p1[3]);
  #pragma unroll
  for(int r=4;r<16;r+=4){a=max3f(a,p0[r],p0[r+1]);b=max3f(b,p0[r+2],p0[r+3]);a=max3f(a,p1[r],p1[r+1]);b=max3f(b,p1[r+2],p1[r+3]);}
  const float m=max2f(a,b);
  auto rr=__builtin_amdgcn_permlane32_swap(__float_as_uint(m),__float_as_uint(m),false,false);
  return max2f(__uint_as_float(rr[0]),__uint_as_float(rr[1]));
}
__device__ __forceinline__ void pv(f32x16*o,int vb,bf16x8 pa0,bf16x8 pa1,bf16x8 pa2,bf16x8 pa3){
  #pragma unroll
  for(int d0=0;d0<2;++d0){s16x4 lo[4],hi[4];
    #pragma unroll
    for(int ks=0;ks<4;++ks){
      asm volatile("ds_read_b64_tr_b16 %0,%1 offset:%c2":"=&v"(lo[ks]):"v"(vb),"i"(d0*4096+ks*1024):"memory");
      asm volatile("ds_read_b64_tr_b16 %0,%1 offset:%c2":"=&v"(hi[ks]):"v"(vb),"i"(d0*4096+ks*1024+512):"memory");}
    asm volatile("s_waitcnt lgkmcnt(0)":::"memory");SBAR();
    #define PK(k) (bf16x8){lo[k][0],lo[k][1],lo[k][2],lo[k][3],hi[k][0],hi[k][1],hi[k][2],hi[k][3]}
    o[d0]=__builtin_amdgcn_mfma_f32_32x32x16_bf16(pa0,PK(0),o[d0],0,0,0);
    o[d0]=__builtin_amdgcn_mfma_f32_32x32x16_bf16(pa1,PK(1),o[d0],0,0,0);
    o[d0]=__builtin_amdgcn_mfma_f32_32x32x16_bf16(pa2,PK(2),o[d0],0,0,0);
    o[d0]=__builtin_amdgcn_mfma_f32_32x32x16_bf16(pa3,PK(3),o[d0],0,0,0);
    #undef PK
  }
}

#ifndef ATTN_STORE16
#define ATTN_STORE16(p,v) (*(u32x4*)(p)=(v))
#endif
template<int THRL> __device__ __forceinline__ void attn_unit(int b,int h,int kvh,int qb,const bf16*Q,const bf16*__restrict__ K,const bf16*__restrict__ V,bf16*O,char*shm){
  int tid_=threadIdx.x; asm volatile("":"+v"(tid_)); const int tid=tid_,lane=tid&63,r32=lane&31,hi=lane>>5; const int wid=__builtin_amdgcn_readfirstlane(tid>>6);
  const long rowbase=(long)b*SEQ; const int q0=qb*QB;
  const bf16*Qw=Q+(rowbase+q0+wid*QBLK)*PQ+h*D;
  const bf16*Kh=K+rowbase*PQ+kvh*D,*Vh=V+rowbase*PQ+kvh*D;
  const unsigned lds0=(unsigned)(uintptr_t)shm;
  float*wsf=(float*)(shm+LDS_WS)+wid*64;
  const bf16*ksrc=Kh+(long)lane*PQ+wid*8;
  const bf16*vsrc=Vh+(long)(16*(wid&3)+(lane>>2))*PQ+(wid>>2)*32+(lane&3)*8;
  const unsigned kdst=lds0+LDS_K+wid*1024, vdst=lds0+LDS_V+wid*1024;
  #define DMA_K(t,slot) glds16(ksrc+(long)(t)*KVBLK*PQ,(unsigned)__builtin_amdgcn_readfirstlane(kdst+(slot)))
  #define DMA_V(t,slot) glds16(vsrc+(long)(t)*KVBLK*PQ,(unsigned)__builtin_amdgcn_readfirstlane(vdst+(slot)))
  const int vb0=(int)(lds0+LDS_V)+((lane>>4)&1)*32+(lane&3)*8+(4*hi+((lane&15)>>2))*64;
  const char*Kbase=shm+LDS_K; bf16x8 kf[8];
  const lds_cptr shm3=(lds_cptr)shm; const lds_cptr kp0=shm3+LDS_K+hi*1024+r32*16; const lds_cptr vp0=shm3+LDS_V+((lane>>4)&1)*32+(lane&3)*8+(4*hi+((lane&15)>>2))*64;
  constexpr int NT=SEQ/KVBLK;
  DMA_K(0,0);DMA_V(0,0);DMA_K(1,SLOTB);
  bf16x8 qr[4];
  #pragma unroll
  for(int d0=0;d0<4;++d0)qr[d0]=*reinterpret_cast<const bf16x8*>(&Qw[(long)r32*PQ+d0*16+hi*8]);
  float mhat=0.f,l_reg=0.f;f32x16 o[2];o[0]=f32x16{};o[1]=f32x16{};f32x16 negm=f32x16{};asm volatile("":"+v"(negm));

  #define CMASK(P0,P1,t) do{}while(0)
  bool resc=false;
  #define START(P0,P1) do{ const float rm=rowmax(P0,P1); resc=false; \
    { const float dl=rm; mhat=fadd_s(mhat,dl); \
      _Pragma("unroll") for(int r=0;r<16;++r){P0[r]=fsub_s(P0[r],dl);P1[r]=fsub_s(P1[r],dl);} \
      _Pragma("unroll") for(int r=0;r<16;++r)negm[r]=-mhat; asm volatile("":"+v"(negm)); } \
    _Pragma("unroll") for(int r=0;r<16;++r)P0[r]=__builtin_amdgcn_exp2f(P0[r]); }while(0)
  #define RESC() do{ if(resc){ asm volatile("s_waitcnt lgkmcnt(0)":::"memory"); \
      _Pragma("unroll") for(int d_=0;d_<2;++d_) _Pragma("unroll") for(int r=0;r<16;++r)o[d_][r]*=wsf[crow(r,hi)]; } }while(0)
  f32x16 pA0,pA1,pB0,pB1;
  int sl_prev=0,sl_cur=0,sl_next=SLOTB;
  #define ROT() do{sl_prev=sl_cur;sl_cur=sl_next;sl_next=(sl_next==(NSLOT-1)*SLOTB)?0:sl_next+SLOTB;}while(0)
  DMA_K(2,2*SLOTB);
  WAIT_BAR(3);
  qkt(pA0,pA1,Kbase,qr,negm,r32,hi);asm volatile("s_nop 15\n\ts_nop 7":"+v"(pA0),"+v"(pA1));CMASK(pA0,pA1,0);
  START(pA0,pA1);
  _Pragma("unroll") for(int r=0;r<16;++r)pA1[r]=__builtin_amdgcn_exp2f(pA1[r]);
  WAIT_BAR(0);
  DMA_K(3,0);DMA_V(1,SLOTB);
  ROT();
  kload8(kf,kp0+sl_cur);
  WAIT_BAR(2);
  s16x4 vlo[8],vhi[8]; u32x4 pw0,pw1,pw2,pw3;
  #define PKW(P,B) cvtpk_s(P[B],P[B+1])
  #define PAF(k) __builtin_bit_cast(bf16x8,pw##k)
  #define VFR(i) (bf16x8){vlo[i][0],vlo[i][1],vlo[i][2],vlo[i][3],vhi[i][0],vhi[i][1],vhi[i][2],vhi[i][3]}
  #define PIN(x) asm volatile("":"+v"(x))
  #define MX3(a,b,c) __builtin_fmaxf(__builtin_fmaxf((a),(b)),(c))
  #define GAPA(MF,A0,A1,A2,A3,W0,W1,PW) do{ MF; sacc+=A0; sacc+=A1; sacc+=A2; sacc+=A3; PIN(sacc); W0; W1; PIN(PW); SBAR(); }while(0)
  #define EX(v) __builtin_amdgcn_exp2f(v)
  #define GAPB(MF,X,B) do{ MF; X[B]=EX(X[B]); X[B+1]=EX(X[B+1]); X[B+2]=EX(X[B+2]); X[B+3]=EX(X[B+3]); PIN(X); SBAR(); }while(0)
  #define VRD(i) do{ vlo[i]=vtr(vp_+(((i)>>2)*4096+((i)&3)*1024)); vhi[i]=vtr(vp_+(((i)>>2)*4096+((i)&3)*1024+512)); }while(0)
  #define KRD(G,j) do{ if(G){ kload2(kf,kp0+sl_next,j); SBAR(); } }while(0)
  #define STEP(C0,C1,P0,P1,t,GK,GV,GL) do{ SBAR(); \
    const lds_cptr vp_=vp0+sl_prev; \
    VRD(0); SBAR(); float sacc=(P0[0]+P0[1]); \
    GAPA(C0=__builtin_amdgcn_mfma_f32_32x32x16_bf16(kf[0],qr[0],negm,0,0,0), P0[2],P0[3],P0[4],P0[5],     pw0[0]=PKW(P0,0), pw0[1]=PKW(P0,2), pw0); \
    VRD(4); SBAR(); GAPA(C1=__builtin_amdgcn_mfma_f32_32x32x16_bf16(kf[1],qr[0],negm,0,0,0), P0[6],P0[7],P0[8],P0[9],     pw0[2]=PKW(P0,4), pw0[3]=PKW(P0,6), pw0); \
    VRD(1); SBAR(); GAPA(C0=__builtin_amdgcn_mfma_f32_32x32x16_bf16(kf[2],qr[1],C0,0,0,0),   P0[10],P0[11],P0[12],P0[13], pw1[0]=PKW(P0,8), pw1[1]=PKW(P0,10), pw1); \
    VRD(5); SBAR(); GAPA(C1=__builtin_amdgcn_mfma_f32_32x32x16_bf16(kf[3],qr[1],C1,0,0,0),   P0[14],P0[15],P1[0],P1[1],   pw1[2]=PKW(P0,12),pw1[3]=PKW(P0,14), pw1); \
    VRD(2); SBAR(); GAPA(C0=__builtin_amdgcn_mfma_f32_32x32x16_bf16(kf[4],qr[2],C0,0,0,0),   P1[2],P1[3],P1[4],P1[5],     pw2[0]=PKW(P1,0), pw2[1]=PKW(P1,2), pw2); \
    VRD(6); SBAR(); GAPA(C1=__builtin_amdgcn_mfma_f32_32x32x16_bf16(kf[5],qr[2],C1,0,0,0),   P1[6],P1[7],P1[8],P1[9],     pw2[2]=PKW(P1,4), pw2[3]=PKW(P1,6), pw2); \
    VRD(3); SBAR(); GAPA(C0=__builtin_amdgcn_mfma_f32_32x32x16_bf16(kf[6],qr[3],C0,0,0,0),   P1[10],P1[11],P1[12],P1[13], pw3[0]=PKW(P1,8), pw3[1]=PKW(P1,10), pw3); \
    VRD(7); SBAR(); GAPA(C1=__builtin_amdgcn_mfma_f32_32x32x16_bf16(kf[7],qr[3],C1,0,0,0),   P1[14],P1[15],0.f,0.f,       pw3[2]=PKW(P1,12),pw3[3]=PKW(P1,14), pw3); \
    l_reg+=sacc; \
    if(GK){DMA_K((t)+3,sl_cur);} if(GV){DMA_V((t)+1,sl_next);} \
    CMASK(C0,C1,t); \
    { float a=MX3(C0[0],C0[1],C1[0]),b=MX3(C0[2],C0[3],C1[1]); a=MX3(a,C1[2],C1[3]); \
      _Pragma("unroll") for(int r=4;r<16;r+=4){a=MX3(a,C0[r],C0[r+1]);b=MX3(b,C0[r+2],C0[r+3]);a=MX3(a,C1[r],C1[r+1]);b=MX3(b,C1[r+2],C1[r+3]);} \
      float rm=__builtin_fmaxf(a,b); { auto rr=__builtin_amdgcn_permlane32_swap(__float_as_uint(rm),__float_as_uint(rm),false,false); rm=__builtin_fmaxf(__uint_as_float(rr[0]),__uint_as_float(rr[1])); } \
      resc=false; \
      if(__builtin_expect(__any(rm>(float)THRL),0)){ const float dl=__builtin_fmaxf(rm,0.f); mhat+=dl; \
        _Pragma("unroll") for(int r=0;r<16;++r){C0[r]-=dl;C1[r]-=dl;} \
        _Pragma("unroll") for(int r=0;r<16;++r)negm[r]=-mhat; asm volatile("":"+v"(negm)); \
        const float f=__builtin_amdgcn_exp2f(-dl); l_reg*=f; if(hi==0)wsf[r32]=f; resc=true; } } \
    SBAR(); \
    GAPB(o[0]=__builtin_amdgcn_mfma_f32_32x32x16_bf16(PAF(0),VFR(0),o[0],0,0,0), C0,0); \
    GAPB(o[1]=__builtin_amdgcn_mfma_f32_32x32x16_bf16(PAF(0),VFR(4),o[1],0,0,0), C0,4); \
    KRD(GL,0); GAPB(o[0]=__builtin_amdgcn_mfma_f32_32x32x16_bf16(PAF(1),VFR(1),o[0],0,0,0), C0,8); \
    KRD(GL,1); GAPB(o[1]=__builtin_amdgcn_mfma_f32_32x32x16_bf16(PAF(1),VFR(5),o[1],0,0,0), C0,12); \
    KRD(GL,2); GAPB(o[0]=__builtin_amdgcn_mfma_f32_32x32x16_bf16(PAF(2),VFR(2),o[0],0,0,0), C1,0); \
    KRD(GL,3); GAPB(o[1]=__builtin_amdgcn_mfma_f32_32x32x16_bf16(PAF(2),VFR(6),o[1],0,0,0), C1,4); \
    GAPB(o[0]=__builtin_amdgcn_mfma_f32_32x32x16_bf16(PAF(3),VFR(3),o[0],0,0,0), C1,8); \
    GAPB(o[1]=__builtin_amdgcn_mfma_f32_32x32x16_bf16(PAF(3),VFR(7),o[1],0,0,0), C1,12); \
    }while(0)
  int t=1;
  #undef CMASK
  #define CMASK(P0,P1,t) do{}while(0)
  for(;t+5<NT;t+=2){
    STEP(pB0,pB1,pA0,pA1,t,true,true,true);     WAIT_BAR(2); RESC(); ROT();
    STEP(pA0,pA1,pB0,pB1,t+1,true,true,true);   WAIT_BAR(2); RESC(); ROT();
  }
  #undef CMASK
  #define CMASK(P0,P1,t) do{}while(0)
  #define ENDW(tt) do{ if((tt)+3<NT){WAIT_BAR(2);} else if((tt)+2<NT){WAIT_BAR(1);} else {WAIT_BAR(0);} }while(0)
  for(;t+1<NT;t+=2){
    STEP(pB0,pB1,pA0,pA1,t,(t+3<NT),(t+1<NT),(t+1<NT));       ENDW(t);   RESC(); ROT();
    STEP(pA0,pA1,pB0,pB1,t+1,(t+4<NT),(t+2<NT),(t+2<NT));     ENDW(t+1); RESC(); ROT();
  }
  STEP(pB0,pB1,pA0,pA1,NT-1,false,false,false); RESC();
  { float sacc=pB0[0]+pB0[1]; _Pragma("unroll") for(int r=2;r<16;++r)sacc+=pB0[r]; _Pragma("unroll") for(int r=0;r<16;++r)sacc+=pB1[r]; l_reg+=sacc;
    pw0=(u32x4){PKW(pB0,0),PKW(pB0,2),PKW(pB0,4),PKW(pB0,6)};pw1=(u32x4){PKW(pB0,8),PKW(pB0,10),PKW(pB0,12),PKW(pB0,14)};pw2=(u32x4){PKW(pB1,0),PKW(pB1,2),PKW(pB1,4),PKW(pB1,6)};pw3=(u32x4){PKW(pB1,8),PKW(pB1,10),PKW(pB1,12),PKW(pB1,14)};
    SBAR(); pv(o,vb0+sl_cur,PAF(0),PAF(1),PAF(2),PAF(3)); }
  #undef PKW
  #undef PAF
  #undef VFR
  #undef PIN
  #undef MX3
  #undef GAPA
  #undef GAPB
  #undef EX
  #undef VRD
  #undef KRD
  #undef STEP
  #undef ENDW
  {auto rr=__builtin_amdgcn_permlane32_swap(__float_as_uint(l_reg),__float_as_uint(l_reg),false,false);l_reg=__uint_as_float(rr[0])+__uint_as_float(rr[1]);}
  if(hi==0)wsf[32+r32]=l_reg;asm volatile("s_waitcnt lgkmcnt(0)":::"memory");
  float rli[16];
  #pragma unroll
  for(int r=0;r<16;++r)rli[r]=__builtin_amdgcn_rcpf(wsf[32+crow(r,hi)]);
  bf16*Ow=O+(rowbase+q0+wid*QBLK)*PO+h*D;
  { bf16*stg=(bf16*)(shm+LDS_OST)+wid*2048;
    #pragma unroll
    for(int r=0;r<16;++r){const int orow=crow(r,hi);
      #pragma unroll
      for(int d0=0;d0<2;++d0)stg[orow*64+d0*32+r32]=__float2bfloat16(o[d0][r]*rli[r]);}
    asm volatile("s_waitcnt lgkmcnt(0)":::"memory");
    #pragma unroll
    for(int i=0;i<4;++i){const int row=i*8+(lane>>3),ch=lane&7; const u32x4 v=*(const u32x4*)(stg+row*64+ch*8); ATTN_STORE16(Ow+(long)row*PO+ch*8,v);} }
  asm volatile("s_waitcnt lgkmcnt(0)\n\ts_barrier":::"memory");
  #undef DMA_K
  #undef DMA_V
  #undef CMASK
  #undef START
  #undef RESC
  #undef ROT
}
constexpr int ATTN_LDS_BYTES=LDS_BYTES;
struct AttnTensors { const bf16* Q; const bf16* K; const bf16* V; bf16* O; };
constexpr int BAND_HALF=40960, BAND_K=0, BAND_V=16384, BAND_WS=32768, BAND_OST=81920, BAND_LDS_BYTES=BAND_OST+NW*4096;
__device__ __forceinline__ void band_half_unit(int hu,const bf16*__restrict__ QKV,int offq,int offk,int offv,bf16*OBG,float*LSEG,char*shm){
  int tid_=threadIdx.x; asm volatile("":"+v"(tid_)); const int tid=tid_,lane=tid&63,r32=lane&31,hi=lane>>5; const int wid=__builtin_amdgcn_readfirstlane(tid>>6);
  const int half=wid>>2, wq=wid&3;
  const int uh=__builtin_amdgcn_readfirstlane(2*hu+half);
  const int b=uh/192, rem=uh-b*192, head=rem>>4, ck=rem&15, g=head>>2, j=head&3;
  const int dil=(g==0)?1:(g==1)?4:16, sh=(g==0)?4:(g==1)?2:0;
  const int rc=ck>>sh, c=ck&((1<<sh)-1), ntile=(SEQ/64)/dil;
  const long rowbase=(long)b*SEQ;
  bf16*const OG=OBG+(long)g*BATCH*SEQ*256; float*const LG=LSEG+(long)g*BATCH*SEQ*4;
  const unsigned lds0=(unsigned)(uintptr_t)shm+half*BAND_HALF;
  char*hb=shm+half*BAND_HALF;
  typedef __attribute__((address_space(3))) float* lds_fptr;
  const lds_fptr wsf=(lds_fptr)(hb+BAND_WS+wq*256);
  const int mq=128*c+32*wq+r32;
  const bf16*Qrow=QKV+(rowbase+(long)mq*dil+rc)*PQ+offq+head*D;
  bf16x8 qr[4];
  #pragma unroll
  for(int d0=0;d0<4;++d0)qr[d0]=*reinterpret_cast<const bf16x8*>(&Qrow[d0*16+hi*8]);
  const bf16*Kc=QKV+(rowbase+rc)*PQ+offk+head*D, *Vc=QKV+(rowbase+rc)*PQ+offv+head*D;
  #define BAND_DMA(T,slot) do{ const long p0_=(long)(T)*64; \
      _Pragma("unroll") for(int q_=0;q_<2;++q_){ const int cc_=2*wq+q_; \
        glds16(Kc+((p0_+lane)*dil)*PQ+cc_*8,(unsigned)__builtin_amdgcn_readfirstlane(lds0+BAND_K+(slot)*8192+cc_*1024)); \
        glds16(Vc+((p0_+16*(cc_&3)+(lane>>2))*dil)*PQ+(cc_>>2)*32+(lane&3)*8,(unsigned)__builtin_amdgcn_readfirstlane(lds0+BAND_V+(slot)*8192+cc_*1024)); } }while(0)
  const int T0=2*c-1;
  float mrun=-1e30f,l_reg=0.f; f32x16 o[2]; o[0]=f32x16{}; o[1]=f32x16{};
  const int vb0=(int)(lds0+BAND_V)+((lane>>4)&1)*32+(lane&3)*8+(4*hi+((lane&15)>>2))*64;
  { const int T=T0; if(T>=0&&T<ntile) BAND_DMA(T,0); }
  #pragma unroll 1
  for(int s=0;s<4;++s){
    const int T=T0+s, Tn=T+1; const bool vcur=(T>=0&&T<ntile), vnext=(s<3)&&(Tn>=0&&Tn<ntile);
    if(vnext){ BAND_DMA(Tn,(s+1)&1); asm volatile("s_waitcnt vmcnt(4)":::"memory"); } else { asm volatile("s_waitcnt vmcnt(0)":::"memory"); }
    asm volatile("s_barrier":::"memory");
    const bool act=vcur&&(s>=(wq>>1))&&(s<=(wq>>1)+2);
    if(act){
      f32x16 p0,p1; const f32x16 zero=f32x16{};
      qkt(p0,p1,hb+BAND_K+(s&1)*8192,qr,zero,r32,hi);
      const int kb=64*T+4*hi-mq;
      float mx=-1e30f;
      #pragma unroll
      for(int r=0;r<16;++r){ const int d0_=kb+(r&3)+8*(r>>2), d1_=d0_+32;
        p0[r]=(d0_>=-64&&d0_<=64)?p0[r]:-1e30f; p1[r]=(d1_>=-64&&d1_<=64)?p1[r]:-1e30f; mx=__builtin_fmaxf(mx,__builtin_fmaxf(p0[r],p1[r])); }
      mx=__builtin_fmaxf(mx,__shfl_xor(mx,32));
      const float mnew=__builtin_fmaxf(mrun,mx); const float f=__builtin_amdgcn_exp2f(mrun-mnew); mrun=mnew;
      float sacc=0.f;
      #pragma unroll
      for(int r=0;r<16;++r){ p0[r]=(p0[r]>-1e29f)?__builtin_amdgcn_exp2f(p0[r]-mnew):0.f; p1[r]=(p1[r]>-1e29f)?__builtin_amdgcn_exp2f(p1[r]-mnew):0.f; sacc+=p0[r]+p1[r]; }
      l_reg=l_reg*f+sacc;
      if(hi==0)wsf[r32]=f;
      #pragma unroll
      for(int r=0;r<16;++r){ const float fr=wsf[crow(r,hi)]; o[0][r]*=fr; o[1][r]*=fr; }
      u32x4 pw0,pw1,pw2,pw3;
      pw0=(u32x4){cvtpk_s(p0[0],p0[1]),cvtpk_s(p0[2],p0[3]),cvtpk_s(p0[4],p0[5]),cvtpk_s(p0[6],p0[7])}; pw1=(u32x4){cvtpk_s(p0[8],p0[9]),cvtpk_s(p0[10],p0[11]),cvtpk_s(p0[12],p0[13]),cvtpk_s(p0[14],p0[15])};
      pw2=(u32x4){cvtpk_s(p1[0],p1[1]),cvtpk_s(p1[2],p1[3]),cvtpk_s(p1[4],p1[5]),cvtpk_s(p1[6],p1[7])}; pw3=(u32x4){cvtpk_s(p1[8],p1[9]),cvtpk_s(p1[10],p1[11]),cvtpk_s(p1[12],p1[13]),cvtpk_s(p1[14],p1[15])};
      SBAR(); pv(o,vb0+(s&1)*8192,__builtin_bit_cast(bf16x8,pw0),__builtin_bit_cast(bf16x8,pw1),__builtin_bit_cast(bf16x8,pw2),__builtin_bit_cast(bf16x8,pw3));
    }
    asm volatile("s_waitcnt lgkmcnt(0)\n\ts_barrier":::"memory");
  }
  #undef BAND_DMA
  l_reg+=__shfl_xor(l_reg,32);
  if(hi==0)wsf[32+r32]=l_reg;
  float rli[16];
  #pragma unroll
  for(int r=0;r<16;++r)rli[r]=__builtin_amdgcn_rcpf(wsf[32+crow(r,hi)]);
  { bf16*stg=(bf16*)(shm+BAND_OST)+wid*2048;
    #pragma unroll
    for(int r=0;r<16;++r){const int orow=crow(r,hi);
      #pragma unroll
      for(int d0=0;d0<2;++d0)stg[orow*64+d0*32+r32]=__float2bfloat16(o[d0][r]*rli[r]);}
    asm volatile("s_waitcnt lgkmcnt(0)":::"memory");
    #pragma unroll
    for(int i=0;i<4;++i){const int row=i*8+(lane>>3),ch=lane&7; const u32x4 v=*(const u32x4*)(stg+row*64+ch*8);
      const long grow=rowbase+(long)(128*c+32*wq+row)*dil+rc;
      *(u32x4*)(OG+grow*256+j*64+ch*8)=v;} }
  if(hi==0){ const long grow=rowbase+(long)mq*dil+rc; LG[grow*4+j]=mrun+__builtin_log2f(l_reg); }
  asm volatile("s_waitcnt lgkmcnt(0)\n\ts_barrier":::"memory");
}
#undef SBAR
#undef WAIT_BAR
}
#define GAS __attribute__((address_space(1)))
#define LAS __attribute__((address_space(3)))
typedef unsigned short bf16;
typedef unsigned v4u __attribute__((ext_vector_type(4)));
typedef float f32x4 __attribute__((ext_vector_type(4)));
typedef short bf16x8 __attribute__((ext_vector_type(8)));
typedef GAS unsigned gu32;
typedef GAS unsigned long long gu64;
#define RLX_AGENT __ATOMIC_RELAXED, __HIP_MEMORY_SCOPE_AGENT
#define LDS_WAIT() asm volatile("s_waitcnt lgkmcnt(0)" ::: "memory")
#define VM_WAIT() asm volatile("s_waitcnt vmcnt(0)" ::: "memory")
__device__ __forceinline__ unsigned long long rt() { return __builtin_amdgcn_s_memrealtime(); }
__device__ __forceinline__ unsigned f2bf(float f) { unsigned u = __builtin_bit_cast(unsigned, f); return (u + 0x7fffu + ((u >> 16) & 1u)) >> 16; }
__device__ __forceinline__ unsigned pk2(float lo, float hi) { return f2bf(lo) | (f2bf(hi) << 16); }

#define XB_TMO      128
#define XB_XCNT(j)  (256  + 64 * (j))
#define XB_XSUB(j)  (1280 + 64 * (j))
#define XB_XGEN(j)  (2304 + 64 * (j))
#define XB_TOP      3328
#define XB_TOPGEN   3392
#define XCD_BAR_WORDS 3456
#define XB_SPIN_CAP (1u << 24)

__device__ __forceinline__ unsigned xb_ld(unsigned* p)              { return __hip_atomic_load(p, __ATOMIC_RELAXED, __HIP_MEMORY_SCOPE_AGENT); }
__device__ __forceinline__ unsigned xb_add(unsigned* p, unsigned v) { return __hip_atomic_fetch_add(p, v, __ATOMIC_RELAXED, __HIP_MEMORY_SCOPE_AGENT); }
__device__ __forceinline__ unsigned xb_xcc_id() { return (unsigned)__builtin_amdgcn_s_getreg((3 << 11) | 20) & 0xFu; }
#define XB_SPIN(cond, bar) do { unsigned _sp = 0; while (cond) { __builtin_amdgcn_s_sleep(1); \
    if ((++_sp & 255u) == 0u) { if (xb_ld(&(bar)[XB_TMO])) break; if (_sp > XB_SPIN_CAP) { atomicAdd(&(bar)[XB_TMO], 1u); break; } } } } while (0)

struct XcdBarrier {
    unsigned* bar; unsigned x;
    volatile LAS unsigned* st;
};

__device__ __forceinline__ XcdBarrier xcd_barrier_post(unsigned* bar, volatile LAS unsigned* st) {
    XcdBarrier b; b.bar = bar; b.x = xb_xcc_id(); b.st = st;
    if (threadIdx.x == 0) (void)xb_add(&bar[XB_XCNT(b.x)], 1u);
    return b;
}
__device__ __forceinline__ void xcd_barrier_complete(unsigned* bar, unsigned x, unsigned& nloc, unsigned& nx) {
    const unsigned G = gridDim.x * gridDim.y * gridDim.z;
    unsigned sum, cnt, mine, sp = 0u;
    for (;;) {
        sum = 0u; cnt = 0u; mine = 0u;
#pragma unroll
        for (unsigned j = 0; j < 16; ++j) { const unsigned c = xb_ld(&bar[XB_XCNT(j)]); sum += c; cnt += (c > 0u) ? 1u : 0u; mine = (j == x) ? c : mine; }
        if (sum == G) break;
        __builtin_amdgcn_s_sleep(1);
        if ((++sp & 255u) == 0u) { if (xb_ld(&bar[XB_TMO])) break; if (sp > XB_SPIN_CAP) { atomicAdd(&bar[XB_TMO], 1u); break; } }
    }
    nloc = mine > 0u ? mine : 1u; nx = cnt > 0u ? cnt : 1u;
}

__device__ __forceinline__ void xcd_barrier(const XcdBarrier& b) {
    asm volatile("s_waitcnt vmcnt(0)" ::: "memory");
    __syncthreads();
    if (threadIdx.x == 0) {
        unsigned* bar = b.bar;
        __builtin_amdgcn_s_waitcnt(0);
        unsigned nloc = b.st[0], nx = b.st[1];
        if (nloc == 0u) { xcd_barrier_complete(bar, b.x, nloc, nx); b.st[0] = nloc; b.st[1] = nx; }
        const unsigned old = xb_add(&bar[XB_XSUB(b.x)], 1u);
        const unsigned gen = old / nloc;
        if (old + 1u == (gen + 1u) * nloc) {
            __builtin_amdgcn_fence(__ATOMIC_RELEASE, "agent");
            asm volatile("s_waitcnt vmcnt(0)" ::: "memory");
            const unsigned og = xb_add(&bar[XB_TOP], 1u);
            const unsigned tg = og / nx;
            if (og + 1u == (tg + 1u) * nx) xb_add(&bar[XB_TOPGEN], 1u);
            else XB_SPIN(xb_ld(&bar[XB_TOPGEN]) == tg, bar);
            __builtin_amdgcn_fence(__ATOMIC_ACQUIRE, "agent");
            xb_add(&bar[XB_XGEN(b.x)], 1u);
            asm volatile("s_waitcnt vmcnt(0)" ::: "memory");
        } else {
            XB_SPIN(xb_ld(&bar[XB_XGEN(b.x)]) == gen, bar);
            __builtin_amdgcn_fence(__ATOMIC_ACQUIRE, "agent");
            asm volatile("s_waitcnt vmcnt(0)" ::: "memory");
        }
    }
    __syncthreads();
}


constexpr size_t MiB = 1u << 20;
constexpr size_t WS_CTL = 0, CTL_ZERO_BYTES = 1 * MiB;
constexpr size_t WS_STAT0 = 1 * MiB;
constexpr size_t WS_AFF = 2 * MiB;
constexpr size_t WS_INV = 4 * MiB;
constexpr size_t WS_TOK = 5 * MiB;
constexpr size_t WS_LSE = 6 * MiB;
constexpr size_t WS_WIN = 8 * MiB;
constexpr size_t WS_WA = 18 * MiB;
constexpr size_t WS_WO = 20 * MiB;
constexpr size_t WS_ROPEA = 22 * MiB;
constexpr size_t WS_ROPEB = 23 * MiB;
constexpr size_t ARENA = 24 * MiB;
constexpr size_t A_H0B = ARENA + 0 * MiB;
constexpr size_t A_QKV = ARENA + 64 * MiB;
constexpr size_t A_GATES = ARENA + 256 * MiB;
constexpr size_t A_ATTNA = ARENA + 0 * MiB;
constexpr size_t A_OBG = ARENA + 384 * MiB;
constexpr size_t A_MERGED = ARENA + 64 * MiB;
constexpr size_t A_MIX = ARENA + 128 * MiB;
constexpr size_t A_H1B = ARENA + 384 * MiB;
constexpr size_t A_WD = ARENA + 448 * MiB;
constexpr size_t A_XE = ARENA + 256 * MiB;
constexpr size_t A_ACT = ARENA + 0 * MiB;
constexpr size_t A_YE = ARENA + 256 * MiB;
constexpr size_t WS_END = ARENA + 512 * MiB;
constexpr int CW_TMO = 0, CW_BAR = 4096;

constexpr int RING_OFF = 0, RING_BYTES = 131072;
constexpr int LDSCTL_OFF = RING_BYTES, MISC_OFF = LDSCTL_OFF + 320;
constexpr int LDS_BYTES = 147456;

typedef short s16x4v __attribute__((ext_vector_type(4)));
typedef unsigned u32x2 __attribute__((ext_vector_type(2)));

struct Frame {
    LAS unsigned char* lds;
    volatile LAS unsigned* MISC;
    gu32* ctl;
    int tid, lane, wave;
    int vcu, G;
};

__device__ __forceinline__ float wave_sum(float v) {
#pragma unroll
    for (int o = 1; o < 64; o <<= 1) v += __shfl_xor(v, o);
    return v;
}
__device__ __forceinline__ float bf2f(bf16 h) { return __uint_as_float(((unsigned)h) << 16); }

struct TJob { const float* src; bf16* dst; size_t off; int ldw, ldt, k0, n0, win, kdo; };
__device__ __forceinline__ void tjob_load(const TJob& j, f32x4 (&r)[8], int lane) {
    const float* p = j.src + (size_t)(j.k0 + (lane >> 3)) * j.ldw + j.n0 + 4 * (lane & 7);
#pragma unroll
    for (int i = 0; i < 8; ++i) r[i] = *(const GAS f32x4*)(p + (size_t)(8 * i) * j.ldw);
}
struct WinRow {
    __device__ __forceinline__ size_t operator()(int ncol) const {
        if (ncol >= QKVW) return (size_t)ncol;
        int pn, wc, d, map;
        if (ncol < OFF_KA) { const int h = ncol >> 6; pn = h >> 2; wc = h & 3; map = 0; }
        else if (ncol < OFF_VA) { pn = 2; wc = (ncol - OFF_KA) >> 6; map = 0; }
        else if (ncol < OFF_QB) { pn = 2; wc = 2 + ((ncol - OFF_VA) >> 6); map = 2; }
        else if (ncol < OFF_KB) { const int h = (ncol - OFF_QB) >> 6; pn = 3 + (h >> 2); wc = h & 3; map = 1; }
        else if (ncol < OFF_VB) { const int h = (ncol - OFF_KB) >> 6; pn = 6 + (h >> 2); wc = h & 3; map = 1; }
        else { const int h = (ncol - OFF_VB) >> 6; pn = 9 + (h >> 2); wc = h & 3; map = 2; }
        d = ncol & 63;
        int bj, fq, n; const int i = d & 3;
        if (map == 0) { n = d >> 5; bj = (d >> 4) & 1; fq = (d >> 2) & 3; }
        else if (map == 1) { fq = d >> 4; bj = (d >> 3) & 1; n = (d >> 2) & 1; }
        else { bj = d >> 5; fq = (d >> 3) & 3; n = (d >> 2) & 1; }
        return (size_t)(pn * 256 + 128 * bj + 32 * wc + 8 * fq + 4 * n + i);
    }
};

__device__ __forceinline__ void tjob_store(const TJob& j, const f32x4 (&r)[8], LAS float* scr, int lane) {
    { LAS float* w = scr + (4 * (lane & 7)) * 65 + (lane >> 3);
#pragma unroll
      for (int i = 0; i < 8; ++i) { w[8 * i] = r[i].x; w[65 + 8 * i] = r[i].y; w[130 + 8 * i] = r[i].z; w[195 + 8 * i] = r[i].w; } }
    LDS_WAIT(); asm volatile("" ::: "memory");
    const int c = lane & 7;
#pragma unroll
    for (int jj = 0; jj < 4; ++jj) { const int n = (lane >> 3) + 8 * jj; const LAS float* sp = scr + n * 65 + 8 * c;
        v4u o; o.x = pk2(sp[0], sp[1]); o.y = pk2(sp[2], sp[3]); o.z = pk2(sp[4], sp[5]); o.w = pk2(sp[6], sp[7]);
        const size_t row = j.win ? WinRow{}(j.n0 + n) : j.off + (size_t)n;
        *(GAS v4u*)(j.dst + row * (size_t)j.ldt + j.kdo + j.k0 + 8 * c) = o; }
    LDS_WAIT(); asm volatile("" ::: "memory");
}
template <class Decode>
__device__ __forceinline__ void tjobs_run(int first, int stride, int count, const Decode& decode, LAS float* scr, int lane) {
    TJob cur, nxt; f32x4 ra[8], rb[8];
    int it = first; if (it >= count) return;
    decode(it, cur); tjob_load(cur, ra, lane);
    for (;;) {
        const int itn = it + stride; const bool hn = itn < count;
        if (hn) { decode(itn, nxt); tjob_load(nxt, rb, lane); }
        tjob_store(cur, ra, scr, lane);
        if (!hn) break;
        cur = nxt; it = itn;
        ra[0] = rb[0]; ra[1] = rb[1]; ra[2] = rb[2]; ra[3] = rb[3]; ra[4] = rb[4]; ra[5] = rb[5]; ra[6] = rb[6]; ra[7] = rb[7];
    }
}

struct Ptrs {
    const float *x, *ln0_g, *ln0_b, *w_in, *b_gate, *qn_g, *kn_g, *w_a, *w_b, *w_out, *ln1_g, *ln1_b, *w_router, *w_gate_e, *w_up_e, *w_down_e, *ln2_g, *ln2_b;
    float* out; unsigned char* ws;
};
struct Args { Ptrs p; int ph_lo, ph_hi, li, pad; };
typedef const __attribute__((address_space(4))) Args* KArgsP;
__device__ __forceinline__ KArgsP kargs() { KArgsP k = (KArgsP)__builtin_amdgcn_kernarg_segment_ptr(); asm volatile("" : "+s"(k)); return k; }

__device__ __forceinline__ void sincos_rev(float angle, float& sn, float& cs) {
    const double rev = (double)angle * 0.15915494309189533577; const double fr = rev - __builtin_rint(rev);
    sn = __builtin_amdgcn_sinf((float)fr); cs = __builtin_amdgcn_cosf((float)fr);
}
__device__ __forceinline__ void p0_prologue(Frame& F, KArgsP K) {
    LAS float* scr = (LAS float*)(F.lds + RING_OFF + F.wave * 16384);
    const int gw = F.vcu * NWAVES + F.wave, NGW = F.G * NWAVES;
    bf16* win_t = (bf16*)(K->p.ws + WS_WIN); bf16* wa_t = (bf16*)(K->p.ws + WS_WA); bf16* wo_t = (bf16*)(K->p.ws + WS_WO);
    constexpr int I_IN = (1024 / 64) * (5120 / 32), I_A = (512 / 64) * (1024 / 32), I_B = (256 / 64) * (1024 / 32), I_O = (1024 / 64) * (1024 / 32);
    { const float* w_in = K->p.w_in; const float* w_a = K->p.w_a; const float* w_b = K->p.w_b; const float* w_o = K->p.w_out;
      auto decode = [&](int it, TJob& j) {
          int r = it; j.off = 0; j.win = 0; j.kdo = 0;
          if (r < I_IN) { j.src = w_in; j.ldw = 5120; j.dst = win_t; j.ldt = 1024; j.k0 = (r / 160) * 64; j.n0 = (r % 160) * 32; j.win = 1; return; } r -= I_IN;
          if (r < I_A) { j.src = w_a; j.ldw = 1024; j.dst = wa_t; j.ldt = 768; j.k0 = (r / 32) * 64; j.n0 = (r % 32) * 32; j.off = (size_t)j.n0; return; } r -= I_A;
          if (r < I_B) { j.src = w_b; j.ldw = 1024; j.dst = wa_t; j.ldt = 768; j.kdo = 512; j.k0 = (r / 32) * 64; j.n0 = (r % 32) * 32; j.off = (size_t)j.n0; return; } r -= I_B;
          j.src = w_o; j.ldw = 1024; j.dst = wo_t; j.ldt = 1024; j.k0 = (r / 32) * 64; j.n0 = (r % 32) * 32; j.off = (size_t)j.n0; };
      tjobs_run(gw, NGW, I_IN + I_A + I_B + I_O, decode, scr, F.lane); }
    { float* ra = (float*)(K->p.ws + WS_ROPEA); float* rb = (float*)(K->p.ws + WS_ROPEB);
      for (int it = F.vcu * (NWAVES * 64) + F.tid; it < SEQ * 40; it += F.G * NWAVES * 64) {
          const int t = it / 40, r = it - t * 40; float sn, cs;
          if (r < 32) { const int n = r >> 4, f = r & 15; const float pos = n ? (float)(t & 63) : (float)(t >> 6);
              sincos_rev(pos * exp2f(-(float)f * (13.287712379549449f / 16.f)), sn, cs); ra[t * 64 + n * 32 + f] = cs; ra[t * 64 + n * 32 + 16 + f] = sn; }
          else { const int f = r - 32; sincos_rev((float)t * exp2f(-(float)f * (18.931568569324174f / 8.f)), sn, cs); rb[t * 16 + f] = cs; rb[t * 16 + 8 + f] = sn; }
      } }
    bf16* h0b = (bf16*)(K->p.ws + A_H0B); float* st0 = (float*)(K->p.ws + WS_STAT0);
    f32x4 g[4], bb[4];
#pragma unroll
    for (int j = 0; j < 4; ++j) { g[j] = ((const f32x4*)K->p.ln0_g)[F.lane + 64 * j]; bb[j] = ((const f32x4*)K->p.ln0_b)[F.lane + 64 * j]; }
    for (int m = gw; m < MTOK; m += NGW) {
        const GAS f32x4* xr = (const GAS f32x4*)(K->p.x + (size_t)m * DM) + F.lane;
        f32x4 v[4]; float s = 0.f;
#pragma unroll
        for (int j = 0; j < 4; ++j) { v[j] = xr[64 * j]; s += (v[j].x + v[j].y) + (v[j].z + v[j].w); }
        const float mean = wave_sum(s) * (1.f / DM); float s2 = 0.f;
#pragma unroll
        for (int j = 0; j < 4; ++j) { v[j] = v[j] - mean; s2 += (v[j].x * v[j].x + v[j].y * v[j].y) + (v[j].z * v[j].z + v[j].w * v[j].w); }
        const float rstd = 1.f / sqrtf(wave_sum(s2) * (1.f / DM) + LN_EPS);
        GAS unsigned long long* o8 = (GAS unsigned long long*)(h0b + (size_t)m * DM) + F.lane;
#pragma unroll
        for (int j = 0; j < 4; ++j) { const f32x4 y = v[j] * rstd * g[j] + bb[j]; o8[64 * j] = (unsigned long long)pk2(y.x, y.y) | ((unsigned long long)pk2(y.z, y.w) << 32); }
        if (F.lane == 0) { st0[2 * m] = mean; st0[2 * m + 1] = rstd; }
    }
}

__device__ __forceinline__ void p3b_combine(Frame& F, KArgsP K) {
    const bf16* obg = (const bf16*)(K->p.ws + A_OBG); const float* lse = (const float*)(K->p.ws + WS_LSE); bf16* ob = (bf16*)(K->p.ws + A_ATTNA) + 512;
    for (int it = F.vcu; it < MTOK / 16; it += F.G) {
        const int m = it * 16 + (F.tid >> 5), ch = F.tid & 31, j = ch >> 3;
        const float l0 = lse[((size_t)0 * MTOK + m) * 4 + j], l1 = lse[((size_t)1 * MTOK + m) * 4 + j], l2 = lse[((size_t)2 * MTOK + m) * 4 + j];
        const float mx = fmaxf(l0, fmaxf(l1, l2)); float w0 = exp2f(l0 - mx), w1 = exp2f(l1 - mx), w2 = exp2f(l2 - mx); const float rs = 1.0f / (w0 + w1 + w2); w0 *= rs; w1 *= rs; w2 *= rs;
        const v4u a = *(const v4u*)(obg + ((size_t)0 * MTOK + m) * 256 + ch * 8), b = *(const v4u*)(obg + ((size_t)1 * MTOK + m) * 256 + ch * 8), c = *(const v4u*)(obg + ((size_t)2 * MTOK + m) * 256 + ch * 8);
        v4u o;
        o.x = pk2(w0 * pg8::bf_lo(a.x) + w1 * pg8::bf_lo(b.x) + w2 * pg8::bf_lo(c.x), w0 * pg8::bf_hi(a.x) + w1 * pg8::bf_hi(b.x) + w2 * pg8::bf_hi(c.x));
        o.y = pk2(w0 * pg8::bf_lo(a.y) + w1 * pg8::bf_lo(b.y) + w2 * pg8::bf_lo(c.y), w0 * pg8::bf_hi(a.y) + w1 * pg8::bf_hi(b.y) + w2 * pg8::bf_hi(c.y));
        o.z = pk2(w0 * pg8::bf_lo(a.z) + w1 * pg8::bf_lo(b.z) + w2 * pg8::bf_lo(c.z), w0 * pg8::bf_hi(a.z) + w1 * pg8::bf_hi(b.z) + w2 * pg8::bf_hi(c.z));
        o.w = pk2(w0 * pg8::bf_lo(a.w) + w1 * pg8::bf_lo(b.w) + w2 * pg8::bf_lo(c.w), w0 * pg8::bf_hi(a.w) + w1 * pg8::bf_hi(b.w) + w2 * pg8::bf_hi(c.w));
        *(v4u*)(ob + (size_t)m * 768 + ch * 8) = o;
    }
}

__device__ __forceinline__ void convert_experts(Frame& F, KArgsP K) {
    const int gw = F.vcu * NWAVES + F.wave, NGW = F.G * NWAVES;
    { LAS float* scr = (LAS float*)(F.lds + RING_OFF + F.wave * 16384);
      bf16* wgu = (bf16*)K->p.out; bf16* wd = (bf16*)(K->p.ws + A_WD);
      constexpr int I_G = 16 * 64, I_D = 32 * 32, PER_E = 2 * I_G + I_D;
      const float* wg = K->p.w_gate_e; const float* wu = K->p.w_up_e; const float* wdn = K->p.w_down_e;
      auto decode = [&](int it, TJob& j) {
          const int e = it / PER_E; int r = it - e * PER_E; j.win = 0; j.kdo = 0;
          if (r < 2 * I_G) { const int up = r >= I_G; r -= up * I_G; j.src = (up ? wu : wg) + (size_t)e * DM * DFF; j.ldw = DFF; j.dst = wgu; j.ldt = 1024; j.k0 = (r / 64) * 64; j.n0 = (r % 64) * 32;
              j.off = (size_t)e * 4096 + (j.n0 >> 7) * 256 + up * 128 + (j.n0 & 127); return; }
          r -= 2 * I_G; j.src = wdn + (size_t)e * DFF * DM; j.ldw = DM; j.dst = wd; j.ldt = 2048; j.k0 = (r / 32) * 64; j.n0 = (r % 32) * 32; j.off = (size_t)e * 1024 + j.n0; };
      tjobs_run(gw, NGW, NEXP * PER_E, decode, scr, F.lane); }
}

__device__ __forceinline__ void p5_ln1_router_convert(Frame& F, KArgsP K) {
    const int gw = F.vcu * NWAVES + F.wave, NGW = F.G * NWAVES;
    __syncthreads();
    { LAS f32x4* wl = (LAS f32x4*)(F.lds + RING_OFF); const f32x4* wr4 = (const f32x4*)K->p.w_router;
      for (int q = F.tid; q < 1024 * 4; q += NWAVES * 64) { const int col = q >> 2, e4 = q & 3; const int l = (col & 255) >> 2, i = col & 3, j = col >> 8;
          wl[((j * 4 + i) * 4 + e4) * 64 + l] = wr4[q]; } }
    __syncthreads();
    const bf16* mix = (const bf16*)(K->p.ws + A_MIX); bf16* h1b = (bf16*)(K->p.ws + A_H1B); const float* st0 = (const float*)(K->p.ws + WS_STAT0); float* aff = (float*)(K->p.ws + WS_AFF);
    f32x4 xv[4], xn[4]; u32x2 mw[4], mn[4]; float mean0 = 0.f, rstd0 = 0.f, mean0n = 0.f, rstd0n = 0.f;
    int m = gw;
    if (m < MTOK) { const GAS f32x4* xr = (const GAS f32x4*)(K->p.x + (size_t)m * DM) + F.lane; const GAS u32x2* mr = (const GAS u32x2*)(mix + (size_t)m * DM) + F.lane;
#pragma unroll
        for (int j = 0; j < 4; ++j) { xv[j] = xr[64 * j]; mw[j] = mr[64 * j]; }
        mean0 = st0[2 * m]; rstd0 = st0[2 * m + 1]; }
    for (; m < MTOK; m += NGW) {
        const int mnx = m + NGW;
        if (mnx < MTOK) { const GAS f32x4* xr = (const GAS f32x4*)(K->p.x + (size_t)mnx * DM) + F.lane; const GAS u32x2* mr = (const GAS u32x2*)(mix + (size_t)mnx * DM) + F.lane;
#pragma unroll
            for (int j = 0; j < 4; ++j) { xn[j] = xr[64 * j]; mn[j] = mr[64 * j]; }
            mean0n = st0[2 * mnx]; rstd0n = st0[2 * mnx + 1]; }
        f32x4 v[4]; float s = 0.f;
#pragma unroll
        for (int j = 0; j < 4; ++j) {
            const f32x4 g0 = ((const f32x4*)K->p.ln0_g)[F.lane + 64 * j], b0 = ((const f32x4*)K->p.ln0_b)[F.lane + 64 * j];
            const f32x4 h0 = (xv[j] - mean0) * rstd0 * g0 + b0;
            v[j] = h0 * ALPHA + (f32x4){pg8::bf_lo(mw[j].x), pg8::bf_hi(mw[j].x), pg8::bf_lo(mw[j].y), pg8::bf_hi(mw[j].y)};
            s += (v[j].x + v[j].y) + (v[j].z + v[j].w); }
        const float mean = wave_sum(s) * (1.f / DM); float s2 = 0.f;
#pragma unroll
        for (int j = 0; j < 4; ++j) { v[j] = v[j] - mean; s2 += (v[j].x * v[j].x + v[j].y * v[j].y) + (v[j].z * v[j].z + v[j].w * v[j].w); }
        const float rstd = 1.f / sqrtf(wave_sum(s2) * (1.f / DM) + LN_EPS);
        GAS unsigned long long* o8 = (GAS unsigned long long*)(h1b + (size_t)m * DM) + F.lane;
        float lg[16];
#pragma unroll
        for (int e = 0; e < 16; ++e) lg[e] = 0.f;
#pragma unroll
        for (int j = 0; j < 4; ++j) { const f32x4 g1 = ((const f32x4*)K->p.ln1_g)[F.lane + 64 * j], b1 = ((const f32x4*)K->p.ln1_b)[F.lane + 64 * j];
            const f32x4 y = v[j] * rstd * g1 + b1;
            o8[64 * j] = (unsigned long long)pk2(y.x, y.y) | ((unsigned long long)pk2(y.z, y.w) << 32);
            const LAS f32x4* wl = (const LAS f32x4*)(F.lds + RING_OFF) + F.lane;
            asm volatile("" ::: "memory");
#pragma unroll
            for (int i = 0; i < 4; ++i) { const float yv = y[i];
#pragma unroll
                for (int c = 0; c < 4; ++c) { const f32x4 w = wl[((j * 4 + i) * 4 + c) * 64]; lg[4 * c] += yv * w.x; lg[4 * c + 1] += yv * w.y; lg[4 * c + 2] += yv * w.z; lg[4 * c + 3] += yv * w.w; } } }
#pragma unroll
        for (int e = 0; e < 16; ++e) lg[e] = wave_sum(lg[e]);
        float mx = lg[0];
#pragma unroll
        for (int e = 1; e < 16; ++e) mx = fmaxf(mx, lg[e]);
        float se = 0.f;
#pragma unroll
        for (int e = 0; e < 16; ++e) { lg[e] = expf(lg[e] - mx); se += lg[e]; }
        float mine = 0.f;
#pragma unroll
        for (int e = 0; e < 16; ++e) if (F.lane == e) mine = lg[e] / se;
        if (F.lane < 16) aff[(size_t)m * 16 + F.lane] = mine;
#pragma unroll
        for (int j = 0; j < 4; ++j) { xv[j] = xn[j]; mw[j] = mn[j]; }
        mean0 = mean0n; rstd0 = rstd0n;
    }
}

__device__ __forceinline__ void p6_topk_unit(Frame& F, KArgsP K, int unit) {
    const int e = unit >> 4, b = unit & 15;
    const float* aff = (const float*)(K->p.ws + WS_AFF); short* inv = (short*)(K->p.ws + WS_INV); int* tok = (int*)(K->p.ws + WS_TOK);
    const bf16* h1b = (const bf16*)(K->p.ws + A_H1B); bf16* xe = (bf16*)(K->p.ws + A_XE);
    LAS unsigned* cnt = (LAS unsigned*)(F.lds + RING_OFF);
    LAS int* ltok = (LAS int*)(F.lds + RING_OFF + 256);
    unsigned key[4];
#pragma unroll
    for (int i = 0; i < 4; ++i) key[i] = __float_as_uint(aff[((size_t)b * SEQ + 4 * F.tid + i) * 16 + e]);
    __syncthreads();
    unsigned thr = 0u;
    for (int bit = 31; bit >= 0; --bit) {
        const unsigned cand = thr | (1u << bit);
        unsigned c = 0;
#pragma unroll
        for (int i = 0; i < 4; ++i) c += (unsigned)__popcll(__ballot(key[i] >= cand));
        LAS unsigned* cb = cnt + ((bit & 1) ? 8 : 0);
        if (F.lane == 0) cb[F.wave] = c;
        __syncthreads();
        unsigned tot = 0;
#pragma unroll
        for (int w = 0; w < 8; ++w) tot += cb[w];
        if (tot >= (unsigned)CAP) thr = cand;
    }
    __syncthreads();
    unsigned cg = 0, ce = 0;
#pragma unroll
    for (int i = 0; i < 4; ++i) { cg += key[i] > thr; ce += key[i] == thr; }
    unsigned pk = cg | (ce << 16), inc = pk;
#pragma unroll
    for (int o = 1; o < 64; o <<= 1) { const unsigned up = __shfl_up(inc, o); if (F.lane >= o) inc += up; }
    if (F.lane == 63) cnt[16 + F.wave] = inc;
    __syncthreads();
    unsigned base = 0, total = 0;
#pragma unroll
    for (int w = 0; w < 8; ++w) { const unsigned tw = cnt[16 + w]; if (w < F.wave) base += tw; total += tw; }
    const unsigned excl = base + inc - pk;
    unsigned pg = excl & 0xffffu, pe = excl >> 16; const unsigned ngt = total & 0xffffu; const unsigned need = (unsigned)CAP - ngt;
#pragma unroll
    for (int i = 0; i < 4; ++i) {
        const int t = 4 * F.tid + i; int slot = -1;
        if (key[i] > thr) { slot = (int)(pg + (pe < need ? pe : need)); ++pg; }
        else if (key[i] == thr) { if (pe < need) slot = (int)(pg + pe); ++pe; }
        inv[((size_t)b * SEQ + t) * 16 + e] = (short)slot;
        if (slot >= 0) { ltok[slot] = t; tok[unit * CAP + slot] = t; }
    }
    __syncthreads();
    for (int c0 = F.wave * 4; c0 < CAP; c0 += NWAVES * 4) {
        v4u a[4][2];
#pragma unroll
        for (int q = 0; q < 4; ++q) { const v4u* src = (const v4u*)(h1b + ((size_t)b * SEQ + ltok[c0 + q]) * DM); a[q][0] = src[F.lane]; a[q][1] = src[F.lane + 64]; }
#pragma unroll
        for (int q = 0; q < 4; ++q) { v4u* dst = (v4u*)(xe + ((size_t)unit * CAP + c0 + q) * DM); dst[F.lane] = a[q][0]; dst[F.lane + 64] = a[q][1]; }
    }
    __syncthreads();
}

__device__ __forceinline__ void p9_final(Frame& F, KArgsP K) {
    const int gw = F.vcu * NWAVES + F.wave, NGW = F.G * NWAVES;
    const float* aff = (const float*)(K->p.ws + WS_AFF); const short* inv = (const short*)(K->p.ws + WS_INV); const bf16* ye = (const bf16*)(K->p.ws + A_YE); const bf16* h1b = (const bf16*)(K->p.ws + A_H1B);
    f32x4 g2[2][2], b2[2][2];
#pragma unroll
    for (int jj = 0; jj < 2; ++jj)
#pragma unroll
        for (int q = 0; q < 2; ++q) { g2[jj][q] = *(const f32x4*)(K->p.ln2_g + 512 * jj + 8 * F.lane + 4 * q); b2[jj][q] = *(const f32x4*)(K->p.ln2_b + 512 * jj + 8 * F.lane + 4 * q); }
    for (int m = gw; m < MTOK; m += NGW) {
        const int b = m >> 11;
        const int iv = (F.lane < 16) ? (int)inv[(size_t)m * 16 + F.lane] : -1; const float af = (F.lane < 16) ? aff[(size_t)m * 16 + F.lane] : 0.f;
        const v4u* hr = (const v4u*)(h1b + (size_t)m * DM) + F.lane; const v4u h0 = hr[0], h1v = hr[64];
        unsigned long long mask = __ballot(iv >= 0);
        float v[2][8];
#define UNPK8(D_, W_, S_) do { D_[0] = pg8::bf_lo(W_.x) * (S_); D_[1] = pg8::bf_hi(W_.x) * (S_); D_[2] = pg8::bf_lo(W_.y) * (S_); D_[3] = pg8::bf_hi(W_.y) * (S_); \
                               D_[4] = pg8::bf_lo(W_.z) * (S_); D_[5] = pg8::bf_hi(W_.z) * (S_); D_[6] = pg8::bf_lo(W_[3]) * (S_); D_[7] = pg8::bf_hi(W_[3]) * (S_); } while (0)
#define FMA8(D_, W_, S_) do { D_[0] += pg8::bf_lo(W_.x) * (S_); D_[1] += pg8::bf_hi(W_.x) * (S_); D_[2] += pg8::bf_lo(W_.y) * (S_); D_[3] += pg8::bf_hi(W_.y) * (S_); \
                              D_[4] += pg8::bf_lo(W_.z) * (S_); D_[5] += pg8::bf_hi(W_.z) * (S_); D_[6] += pg8::bf_lo(W_[3]) * (S_); D_[7] += pg8::bf_hi(W_[3]) * (S_); } while (0)
        UNPK8(v[0], h0, ALPHA); UNPK8(v[1], h1v, ALPHA);
        while (mask) {
            const int e0 = __builtin_ctzll(mask); mask &= mask - 1; const bool two = mask != 0; const int e1 = two ? __builtin_ctzll(mask) : e0; if (two) mask &= mask - 1;
            const int p0 = __builtin_amdgcn_readlane(iv, e0), p1 = __builtin_amdgcn_readlane(iv, e1);
            const float gt0 = __builtin_bit_cast(float, __builtin_amdgcn_readlane(__builtin_bit_cast(int, af), e0)), gt1 = two ? __builtin_bit_cast(float, __builtin_amdgcn_readlane(__builtin_bit_cast(int, af), e1)) : 0.f;
            const v4u* y0 = (const v4u*)(ye + ((size_t)(e0 * 16 + b) * CAP + p0) * DM) + F.lane; const v4u* y1 = (const v4u*)(ye + ((size_t)(e1 * 16 + b) * CAP + p1) * DM) + F.lane;
            const v4u a0 = y0[0], a1 = y0[64], c0 = y1[0], c1 = y1[64];
            FMA8(v[0], a0, gt0); FMA8(v[1], a1, gt0); FMA8(v[0], c0, gt1); FMA8(v[1], c1, gt1);
        }
        float s = 0.f;
#pragma unroll
        for (int jj = 0; jj < 2; ++jj)
#pragma unroll
            for (int q = 0; q < 8; ++q) s += v[jj][q];
        const float mean = wave_sum(s) * (1.f / DM); float s2 = 0.f;
#pragma unroll
        for (int jj = 0; jj < 2; ++jj)
#pragma unroll
            for (int q = 0; q < 8; ++q) { v[jj][q] -= mean; s2 += v[jj][q] * v[jj][q]; }
        const float rstd = 1.f / sqrtf(wave_sum(s2) * (1.f / DM) + LN_EPS);
        float* orow = K->p.out + (size_t)m * DM + 8 * F.lane;
#pragma unroll
        for (int jj = 0; jj < 2; ++jj)
#pragma unroll
            for (int q = 0; q < 2; ++q) { f32x4 o; o.x = v[jj][4 * q] * rstd; o.y = v[jj][4 * q + 1] * rstd; o.z = v[jj][4 * q + 2] * rstd; o.w = v[jj][4 * q + 3] * rstd;
                *(GAS f32x4*)(orow + 512 * jj + 4 * q) = o * g2[jj][q] + b2[jj][q]; }
#undef UNPK8
#undef FMA8
    }
}

struct OrderUp {
    int vcu;
    __device__ __forceinline__ bool next(int i, pg8::Unit& u) const {
        if (i >= NEXP) return false;
        const int e = i, x = vcu >> 5, l = vcu & 31, b = (x >> 1) * 4 + (l & 3), j = (x & 1) * 8 + (l >> 2);
        u.pm = e * 16 + b; u.pn = j; u.am = e * 16 + b; u.bt = e * 16 + j; return true;
    }
    __device__ __forceinline__ void a_ready(const pg8::Unit&) const {}
    __device__ __forceinline__ void done(const pg8::Unit&) const {}
};
struct OrderDown {
    int vcu;
    __device__ __forceinline__ bool next(int i, pg8::Unit& u) const {
        if (i >= 4) return false;
        const int x = vcu >> 5, l = vcu & 31, pm = i * 64 + x * 8 + (l & 7), pn = l >> 3;
        u.pm = pm; u.pn = pn; u.am = pm; u.bt = (pm >> 4) * 4 + pn; return true;
    }
    __device__ __forceinline__ void a_ready(const pg8::Unit&) const {}
    __device__ __forceinline__ void done(const pg8::Unit&) const {}
};

#ifndef MK_N_LAUNCHES
#define MK_N_LAUNCHES 1
#endif
constexpr int N_PHASES = 13;
#ifndef REP_P0
#define REP_P0 1
#endif
#ifndef REP_P1
#define REP_P1 1
#endif
#ifndef REP_DENSE
#define REP_DENSE 1
#endif
#ifndef REP_BAND
#define REP_BAND 1
#endif
#ifndef REP_WOUT
#define REP_WOUT 1
#endif
#ifndef REP_P6
#define REP_P6 1
#endif
#ifndef REP_TOPK
#define REP_TOPK 1
#endif
#ifndef REP_UP
#define REP_UP 1
#endif
#ifndef REP_DOWN
#define REP_DOWN 1
#endif
#define REPEAT(n) _Pragma("unroll 1") for (int rep_ = 0; rep_ < (n); ++rep_)
__global__ void __launch_bounds__(NWAVES * 64, 2) fwd_kernel(Args args) {
    extern __shared__ __attribute__((aligned(16))) unsigned char lds[];
#define MKFRAME(F) Frame F; { int t_ = threadIdx.x; asm volatile("" : "+v"(t_)); F.lds = (LAS unsigned char*)lds; F.MISC = (volatile LAS unsigned*)(F.lds + MISC_OFF); F.ctl = nullptr; \
        F.tid = t_; F.lane = t_ & 63; F.wave = __builtin_amdgcn_readfirstlane(t_ >> 6); F.G = 256; const int bx_ = blockIdx.x; F.vcu = (bx_ & 7) * 32 + (bx_ >> 3); }
#define BP(off) ((bf16*)(kargs()->p.ws + (off)))
#define SEAM() do { XcdBarrier b_; b_.bar = (unsigned*)(kargs()->p.ws + WS_CTL) + CW_BAR; b_.x = xb_xcc_id(); b_.st = (volatile LAS unsigned*)((LAS unsigned char*)lds + MISC_OFF) + 8; xcd_barrier(b_); } while (0)
    { const int t_ = threadIdx.x;
      for (int u = t_; u < (LDS_BYTES - LDSCTL_OFF) / 4; u += NWAVES * 64) ((LAS unsigned*)((LAS unsigned char*)lds + LDSCTL_OFF))[u] = 0u;
      __syncthreads();
      (void)xcd_barrier_post((unsigned*)(kargs()->p.ws + WS_CTL) + CW_BAR, (volatile LAS unsigned*)((LAS unsigned char*)lds + MISC_OFF) + 8); }

    REPEAT(REP_P0) { MKFRAME(F); p0_prologue(F, kargs()); } SEAM();
    REPEAT(REP_P1) { MKFRAME(F);
      pg8::Gemm g{BP(A_H0B), (const bf16*)(kargs()->p.ws + WS_WIN), MTOK, 5120, 1024}; pg8::StaticOrder S; S.init(MTOK, 5120, 256, (int)blockIdx.x);
      pg8::EpiProj2 E{BP(A_QKV), BP(A_GATES), kargs()->p.b_gate, kargs()->p.qn_g, kargs()->p.kn_g, (const float*)(kargs()->p.ws + WS_ROPEA), (const float*)(kargs()->p.ws + WS_ROPEB)};
      pg8::gemm_phase<pg8::EpiProj2, pg8::StaticOrder, true, true>(F.lds + RING_OFF, g, S, E); } SEAM();
    REPEAT(REP_DENSE) { MKFRAME(F);
      { const attn_body::bf16* q_ = (const attn_body::bf16*)BP(A_QKV); attn_body::bf16* o_ = (attn_body::bf16*)BP(A_ATTNA);
        const int g = F.vcu >> 3, s = F.vcu & 7, ab = g >> 1, akvh = g & 1;
        const int cpos = F.vcu % 5;
#pragma unroll 1
        for (int i = 0; i < 5; ++i) {
            if (i == cpos) { convert_experts(F, kargs()); asm volatile("s_waitcnt vmcnt(0) lgkmcnt(0)" ::: "memory"); __syncthreads(); }
            if (i < 4) attn_body::attn_unit<8>(ab, akvh * 4 + i, akvh, s, q_ + OFF_QA, q_ + OFF_KA, q_ + OFF_VA, o_, (char*)lds + RING_OFF);
        } }
      __syncthreads();
    }
    REPEAT(REP_BAND) { MKFRAME(F);
#pragma unroll 1
      for (int i = 0; i < 6; ++i) attn_body::band_half_unit(F.vcu + 256 * i, (const attn_body::bf16*)BP(A_QKV), OFF_QB, OFF_KB, OFF_VB, (attn_body::bf16*)BP(A_OBG), (float*)(kargs()->p.ws + WS_LSE), (char*)lds + RING_OFF);
      __syncthreads(); } SEAM();
    { MKFRAME(F); p3b_combine(F, kargs()); } SEAM();
    { MKFRAME(F);
      pg8::Gemm g{BP(A_ATTNA), (const bf16*)(kargs()->p.ws + WS_WA), MTOK, 1024, 768}; pg8::StaticOrder S; S.init(MTOK, 1024, 256, (int)blockIdx.x);
      pg8::EpiGateMerge E{BP(A_MERGED), BP(A_GATES)};
      pg8::gemm_phase<pg8::EpiGateMerge, pg8::StaticOrder, true, true>(F.lds + RING_OFF, g, S, E); } SEAM();
    REPEAT(REP_WOUT) { MKFRAME(F);
      pg8::Gemm g{BP(A_MERGED), (const bf16*)(kargs()->p.ws + WS_WO), MTOK, 1024, 1024}; pg8::StaticOrder S; S.init(MTOK, 1024, 256, (int)blockIdx.x);
      pg8::EpiPlain E{BP(A_MIX), 1024};
      pg8::gemm_phase<pg8::EpiPlain, pg8::StaticOrder, true, true>(F.lds + RING_OFF, g, S, E); } SEAM();
    REPEAT(REP_P6) { MKFRAME(F); p5_ln1_router_convert(F, kargs()); } SEAM();
    REPEAT(REP_TOPK) { MKFRAME(F); p6_topk_unit(F, kargs(), F.vcu); } SEAM();
    REPEAT(REP_UP) { MKFRAME(F); pg8::Gemm g{BP(A_XE), (const bf16*)kargs()->p.out, 0, 0, 1024}; OrderUp S{F.vcu}; pg8::EpiSwiglu E{BP(A_ACT)};
      pg8::gemm_phase<pg8::EpiSwiglu, OrderUp, true, true>(F.lds + RING_OFF, g, S, E); } SEAM();
    REPEAT(REP_DOWN) { MKFRAME(F); pg8::Gemm g{BP(A_ACT), (const bf16*)(kargs()->p.ws + A_WD), 0, 0, 2048}; OrderDown S{F.vcu}; pg8::EpiPlain E{BP(A_YE), 1024};
      pg8::gemm_phase<pg8::EpiPlain, OrderDown, true, true>(F.lds + RING_OFF, g, S, E); } SEAM();
    { MKFRAME(F); p9_final(F, kargs()); }
#undef MKFRAME
#undef BP
#undef SEAM
}

extern "C" void kernel_launch(void* const* d_in, const int* in_sizes, int n_in, void* d_out, int out_size, void* d_ws, size_t ws_size, hipStream_t stream) {
    static int grid = 0;
    if (grid == 0) {
        if (n_in != 18 || in_sizes[0] != MTOK * DM || out_size != MTOK * DM || ws_size < WS_END) { fprintf(stderr, "kernel_launch: unexpected shapes / workspace (n_in %d, ws %zu, need %zu)\n", n_in, ws_size, (size_t)WS_END); grid = -1; return; }
        if (hipFuncSetAttribute((const void*)fwd_kernel, hipFuncAttributeMaxDynamicSharedMemorySize, LDS_BYTES) != hipSuccess) { fprintf(stderr, "kernel_launch: hipFuncSetAttribute failed\n"); grid = -1; return; }
        (void)hipGetLastError();
        grid = 256;
    }
    if (grid < 0) return;
    if (hipMemsetAsync((char*)d_ws + WS_CTL, 0, CTL_ZERO_BYTES, stream) != hipSuccess) return;
    Args a{};
    const float** pp = (const float**)&a.p;
    for (int i = 0; i < 18; ++i) pp[i] = (const float*)d_in[i];
    a.p.out = (float*)d_out; a.p.ws = (unsigned char*)d_ws;
    a.ph_lo = 0; a.ph_hi = N_PHASES; a.li = 0;
    hipLaunchKernelGGL(fwd_kernel, dim3(grid), dim3(NWAVES * 64), LDS_BYTES, stream, a);
}
```

```cpp
#include <hip/hip_runtime.h>
#include <cstdio>
#include <cstdint>
constexpr int NWAVES = 8;
constexpr int BATCH = 16, SEQ = 2048, DM = 1024, MTOK = BATCH * SEQ;
constexpr int NEXP = 16, CAP = 256, DFF = 2048, NSLOT = BATCH * NEXP * CAP;
constexpr int QKVW = 3072, GATEW = 2048;
constexpr int OFF_QA = 0, OFF_KA = 512, OFF_VA = 640, OFF_QB = 768, OFF_KB = 1536, OFF_VB = 2304;
constexpr float LN_EPS = 1e-5f, QK_EPS = 1e-6f;
constexpr float ALPHA = 1.189207115002721f;
constexpr float C2 = 0.125f * 1.4426950408889634f;

namespace pg8 {
#define PG8_LAS __attribute__((address_space(3)))
typedef unsigned short bf16_t;
typedef short bf16x8 __attribute__((ext_vector_type(8)));
typedef float f32x4 __attribute__((ext_vector_type(4)));
typedef unsigned u32x4 __attribute__((ext_vector_type(4)));
constexpr int BM = 256, BK = 64, HALF = 128, HTB = HALF * BK * 2  , STAGE_BYTES = 8 * HTB, NXCD = 8, WGM = 8;

__host__ __device__ __forceinline__ int lds_byte(int r, int c) { const int st = (r >> 4) * 2 + (c >> 5), rr = r & 15, cc = c & 31, ob = rr * 64 + cc * 2; return st * 1024 + (ob ^ (((ob >> 9) & 1) << 5)); }
__host__ __device__ __forceinline__ void stage_rc(int b, int& R, int& C) { const int st = b / 1024, sb = b % 1024, swz = sb ^ (((sb >> 9) & 1) << 5); R = (st >> 1) * 16 + swz / 64; C = (st & 1) * 32 + (swz % 64) / 2; }
__host__ __device__ __forceinline__ int perm32(int rho) { const int n = rho >> 4, i = rho & 15; return 8 * (i >> 2) + 4 * n + (i & 3); }

struct Unit { int pm, pn, am, bt; };
struct Gemm { const bf16_t* A; const bf16_t* Bt; int M, N, K; };

struct StaticOrder {
    int nM, nN, nwg, G, c;
    __host__ __device__ void init(int M, int N, int G_, int c_) { nM = M / BM; nN = N / BM; nwg = nM * nN; G = G_; c = c_; }
    __host__ __device__ bool next(int i, Unit& u) const {
        const long L = (long)i * G + c; if (L >= nwg) return false;
        int wgid = (int)L; { const int q = nwg / NXCD, r = nwg % NXCD, xcd = wgid % NXCD, off = wgid / NXCD; wgid = (xcd < r ? xcd * (q + 1) : r * (q + 1) + (xcd - r) * q) + off; }
        const int nig = WGM * nN, gid = wgid / nig, fm = gid * WGM, gsz = (nM - fm) < WGM ? (nM - fm) : WGM;
        u.pm = fm + ((wgid % nig) % gsz); u.pn = (wgid % nig) / gsz; u.am = u.pm; u.bt = u.pn; return true;
    }
    __device__ __forceinline__ void a_ready(const Unit&) const {}
    __device__ __forceinline__ void done(const Unit&) const {}
};

typedef float f32x2_cv __attribute__((ext_vector_type(2))); typedef __bf16 bf16x2_cv __attribute__((ext_vector_type(2)));
__device__ __forceinline__ unsigned cvt_pk_bf16(float lo, float hi) { f32x2_cv v = {lo, hi}; bf16x2_cv b = __builtin_convertvector(v, bf16x2_cv); return __builtin_bit_cast(unsigned, b); }
__device__ __forceinline__ float bf_lo(unsigned w) { return __uint_as_float(w << 16); }
__device__ __forceinline__ float bf_hi(unsigned w) { return __uint_as_float(w & 0xffff0000u); }
__device__ __forceinline__ float sigmoidf_(float x) { return __builtin_amdgcn_rcpf(1.0f + __builtin_amdgcn_exp2f(-1.4426950408889634f * x)); }
__device__ __forceinline__ u32x4 pack8(const f32x4 v0, const f32x4 v1) { u32x4 w; w.x = cvt_pk_bf16(v0[0], v0[1]); w.y = cvt_pk_bf16(v0[2], v0[3]); w.z = cvt_pk_bf16(v1[0], v1[1]); w.w = cvt_pk_bf16(v1[2], v1[3]); return w; }

struct EpiProj {
    static constexpr bool PERM = true, AFTER_DRAIN = false; static constexpr int MID_TILES = 0;
    bf16_t* qkv; bf16_t* gates; const float* b_gate;
    __device__ __forceinline__ void operator()(const f32x4 (&acc)[2][2][4][2], const Unit& u, int wr, int wc, int fr, int fq) const {
        const int row0 = u.pm * BM + wr * 64 + fr;
        const bool isg = u.pn >= 12;
        bf16_t* base = isg ? gates : qkv; const int ldc = isg ? 2048 : 3072; const int colt = isg ? (u.pn - 12) * BM : u.pn * BM;
        const int col0 = colt + wc * 32 + 8 * fq;
        f32x4 bv[2][2];
#pragma unroll
        for (int bj = 0; bj < 2; ++bj)
#pragma unroll
            for (int n = 0; n < 2; ++n) bv[bj][n] = isg ? *(const f32x4*)(b_gate + col0 + bj * HALF + 4 * n) : (f32x4){0.f, 0.f, 0.f, 0.f};
#pragma unroll
        for (int ai = 0; ai < 2; ++ai)
#pragma unroll
            for (int m = 0; m < 4; ++m) { bf16_t* rowp = base + (size_t)(row0 + ai * HALF + m * 16) * ldc + col0;
#pragma unroll
                for (int bj = 0; bj < 2; ++bj) { f32x4 v0 = acc[ai][bj][m][0] + bv[bj][0], v1 = acc[ai][bj][m][1] + bv[bj][1];
                    if (isg) {
#pragma unroll
                        for (int i = 0; i < 4; ++i) { v0[i] = sigmoidf_(v0[i]); v1[i] = sigmoidf_(v1[i]); } }
                    *(u32x4*)(rowp + bj * HALF) = pack8(v0, v1); } }
    }
};
struct EpiPlain {
    static constexpr bool PERM = true, AFTER_DRAIN = false; static constexpr int MID_TILES = 0;
    bf16_t* O; int ldc;
    __device__ __forceinline__ void operator()(const f32x4 (&acc)[2][2][4][2], const Unit& u, int wr, int wc, int fr, int fq) const {
        const int row0 = u.pm * BM + wr * 64 + fr; const int col0 = u.pn * BM + wc * 32 + 8 * fq;
#pragma unroll
        for (int ai = 0; ai < 2; ++ai)
#pragma unroll
            for (int m = 0; m < 4; ++m) { bf16_t* rowp = O + (size_t)(row0 + ai * HALF + m * 16) * ldc + col0;
#pragma unroll
                for (int bj = 0; bj < 2; ++bj) *(u32x4*)(rowp + bj * HALF) = pack8(acc[ai][bj][m][0], acc[ai][bj][m][1]); }
    }
};
template <bool ACCUM> struct EpiGate {
    static constexpr bool PERM = true, AFTER_DRAIN = false; static constexpr int MID_TILES = 0;
    bf16_t* merged; const bf16_t* gates; int goff;
    __device__ __forceinline__ void operator()(const f32x4 (&acc)[2][2][4][2], const Unit& u, int wr, int wc, int fr, int fq) const {
        const int row0 = u.pm * BM + wr * 64 + fr; const int col0 = u.pn * BM + wc * 32 + 8 * fq;
#pragma unroll
        for (int ai = 0; ai < 2; ++ai)
#pragma unroll
            for (int m = 0; m < 4; ++m) { const size_t r = (size_t)(row0 + ai * HALF + m * 16);
#pragma unroll
                for (int bj = 0; bj < 2; ++bj) {
                    const u32x4 g = *(const u32x4*)(gates + r * 2048 + goff + col0 + bj * HALF);
                    f32x4 v0 = acc[ai][bj][m][0], v1 = acc[ai][bj][m][1];
                    v0[0] *= bf_lo(g.x); v0[1] *= bf_hi(g.x); v0[2] *= bf_lo(g.y); v0[3] *= bf_hi(g.y);
                    v1[0] *= bf_lo(g.z); v1[1] *= bf_hi(g.z); v1[2] *= bf_lo(g.w); v1[3] *= bf_hi(g.w);
                    bf16_t* p = merged + r * 1024 + col0 + bj * HALF;
                    if (ACCUM) { const u32x4 o = *(const u32x4*)p;
                        v0[0] += bf_lo(o.x); v0[1] += bf_hi(o.x); v0[2] += bf_lo(o.y); v0[3] += bf_hi(o.y);
                        v1[0] += bf_lo(o.z); v1[1] += bf_hi(o.z); v1[2] += bf_lo(o.w); v1[3] += bf_hi(o.w); }
                    *(u32x4*)p = pack8(v0, v1); } }
    }
};
struct EpiSwiglu {
    static constexpr bool PERM = true, AFTER_DRAIN = false; static constexpr int MID_TILES = 0;
    bf16_t* act;
    __device__ __forceinline__ void operator()(const f32x4 (&acc)[2][2][4][2], const Unit& u, int wr, int wc, int fr, int fq) const {
        const int row0 = u.pm * BM + wr * 64 + fr; const int col0 = u.pn * HALF + wc * 32 + 8 * fq;
#pragma unroll
        for (int ai = 0; ai < 2; ++ai)
#pragma unroll
            for (int m = 0; m < 4; ++m) {
                f32x4 v0, v1;
#pragma unroll
                for (int i = 0; i < 4; ++i) { const float g0 = acc[ai][0][m][0][i], g1 = acc[ai][0][m][1][i];
                    v0[i] = g0 * sigmoidf_(g0) * acc[ai][1][m][0][i]; v1[i] = g1 * sigmoidf_(g1) * acc[ai][1][m][1][i]; }
                *(u32x4*)(act + (size_t)(row0 + ai * HALF + m * 16) * 2048 + col0) = pack8(v0, v1); }
    }
};

struct EpiProj2 {
    static constexpr bool PERM = true, AFTER_DRAIN = false; static constexpr int MID_TILES = 0;
    bf16_t* qkv; bf16_t* gates; const float* b_gate; const float* qn_g; const float* kn_g; const float* ropeA; const float* ropeB;
    typedef unsigned u32x2_t __attribute__((ext_vector_type(2)));
    __device__ __forceinline__ void operator()(const f32x4 (&acc)[2][2][4][2], const Unit& u, int wr, int wc, int fr, int fq) const {
        const int row0 = u.pm * BM + wr * 64 + fr;
        if (u.pn >= 12) {
            const int col0 = (u.pn - 12) * BM + wc * 32 + 8 * fq;
            f32x4 bv[2][2];
#pragma unroll
            for (int bj = 0; bj < 2; ++bj)
#pragma unroll
                for (int n = 0; n < 2; ++n) bv[bj][n] = *(const f32x4*)(b_gate + col0 + bj * HALF + 4 * n);
#pragma unroll
            for (int ai = 0; ai < 2; ++ai)
#pragma unroll
                for (int m = 0; m < 4; ++m) { bf16_t* rowp = gates + (size_t)(row0 + ai * HALF + m * 16) * 2048 + col0;
#pragma unroll
                    for (int bj = 0; bj < 2; ++bj) { f32x4 v0 = acc[ai][bj][m][0] + bv[bj][0], v1 = acc[ai][bj][m][1] + bv[bj][1];
#pragma unroll
                        for (int i = 0; i < 4; ++i) { v0[i] = sigmoidf_(v0[i]); v1[i] = sigmoidf_(v1[i]); }
                        *(u32x4*)(rowp + bj * HALF) = pack8(v0, v1); } }
            return;
        }
        int kind, colbase;
        if (u.pn < 2) { kind = 0; colbase = OFF_QA + (4 * u.pn + wc) * 64; }
        else if (u.pn == 2) { if (wc < 2) { kind = 1; colbase = OFF_KA + wc * 64; } else { kind = 2; colbase = OFF_VA + (wc - 2) * 64; } }
        else if (u.pn < 6) { kind = 3; colbase = OFF_QB + (4 * (u.pn - 3) + wc) * 64; }
        else if (u.pn < 9) { kind = 4; colbase = OFF_KB + (4 * (u.pn - 6) + wc) * 64; }
        else { kind = 2; colbase = OFF_VB + (4 * (u.pn - 9) + wc) * 64; }
        if (kind <= 1) {
            const float* gn = kind == 0 ? qn_g : kn_g; const float sc = kind == 0 ? C2 : 1.0f;
            f32x4 g[2][2];
#pragma unroll
            for (int bj = 0; bj < 2; ++bj)
#pragma unroll
                for (int n = 0; n < 2; ++n) g[bj][n] = *(const f32x4*)(gn + 32 * n + 16 * bj + 4 * fq) * sc;
#pragma unroll
            for (int ai = 0; ai < 2; ++ai)
#pragma unroll
                for (int m = 0; m < 4; ++m) { const int row = row0 + ai * HALF + m * 16; const float* ta = ropeA + (size_t)(row & (SEQ - 1)) * 64 + 4 * fq;
                    float ss = 0.f;
#pragma unroll
                    for (int bj = 0; bj < 2; ++bj)
#pragma unroll
                        for (int n = 0; n < 2; ++n) { const f32x4 x = acc[ai][bj][m][n]; ss += (x[0] * x[0] + x[1] * x[1]) + (x[2] * x[2] + x[3] * x[3]); }
                    ss += __shfl_xor(ss, 16); ss += __shfl_xor(ss, 32);
                    const float rs = 1.0f / sqrtf(ss * (1.0f / 64.0f) + QK_EPS);
                    bf16_t* rowp = qkv + (size_t)row * QKVW + colbase + 4 * fq;
#pragma unroll
                    for (int n = 0; n < 2; ++n) { const f32x4 cs = *(const f32x4*)(ta + n * 32), sn = *(const f32x4*)(ta + n * 32 + 16);
                        const f32x4 x1 = acc[ai][0][m][n] * rs * g[0][n], x2 = acc[ai][1][m][n] * rs * g[1][n];
                        const f32x4 o1 = x1 * cs - x2 * sn, o2 = x2 * cs + x1 * sn;
                        u32x2_t w1, w2; w1.x = cvt_pk_bf16(o1[0], o1[1]); w1.y = cvt_pk_bf16(o1[2], o1[3]); w2.x = cvt_pk_bf16(o2[0], o2[1]); w2.y = cvt_pk_bf16(o2[2], o2[3]);
                        *(u32x2_t*)(rowp + 32 * n) = w1; *(u32x2_t*)(rowp + 32 * n + 16) = w2; } }
        } else if (kind == 2) {
#pragma unroll
            for (int ai = 0; ai < 2; ++ai)
#pragma unroll
                for (int m = 0; m < 4; ++m) { bf16_t* rowp = qkv + (size_t)(row0 + ai * HALF + m * 16) * QKVW + colbase + 8 * fq;
#pragma unroll
                    for (int bj = 0; bj < 2; ++bj) *(u32x4*)(rowp + 32 * bj) = pack8(acc[ai][bj][m][0], acc[ai][bj][m][1]); }
        } else {
            const float sc = kind == 3 ? C2 : 1.0f;
#pragma unroll
            for (int ai = 0; ai < 2; ++ai)
#pragma unroll
                for (int m = 0; m < 4; ++m) { const int row = row0 + ai * HALF + m * 16; const float* tb = ropeB + (size_t)(row & (SEQ - 1)) * 16;
                    f32x4 a0 = acc[ai][0][m][0], a1 = acc[ai][0][m][1], b0 = acc[ai][1][m][0], b1 = acc[ai][1][m][1];
                    if (fq == 0) { const f32x4 c0 = *(const f32x4*)(tb), c1 = *(const f32x4*)(tb + 4), s0 = *(const f32x4*)(tb + 8), s1 = *(const f32x4*)(tb + 12);
                        const f32x4 o0 = a0 * c0 - b0 * s0, p0 = b0 * c0 + a0 * s0, o1 = a1 * c1 - b1 * s1, p1 = b1 * c1 + a1 * s1; a0 = o0; b0 = p0; a1 = o1; b1 = p1; }
                    a0 = a0 * sc; a1 = a1 * sc; b0 = b0 * sc; b1 = b1 * sc;
                    bf16_t* rowp = qkv + (size_t)row * QKVW + colbase + 16 * fq;
                    *(u32x4*)(rowp) = pack8(a0, a1); *(u32x4*)(rowp + 8) = pack8(b0, b1); }
        }
    }
};

struct EpiGateMerge {
    static constexpr bool PERM = true, AFTER_DRAIN = false; static constexpr int MID_TILES = 8;
    bf16_t* merged; const bf16_t* gates;
    __device__ __forceinline__ void mid(f32x4 (&acc)[2][2][4][2], const Unit& u, int wr, int wc, int fr, int fq) const {
        asm volatile("" : "+v"(fr), "+v"(fq));
        const int row0 = u.pm * BM + wr * 64 + fr; const int col0 = u.pn * BM + wc * 32 + 8 * fq;
#pragma unroll
        for (int ai = 0; ai < 2; ++ai)
#pragma unroll
            for (int m = 0; m < 4; ++m) { const bf16_t* gp = gates + (size_t)(row0 + ai * HALF + m * 16) * 2048 + col0;
#pragma unroll
                for (int bj = 0; bj < 2; ++bj) {
                    const u32x4 a = *(const u32x4*)(gp + bj * HALF), b = *(const u32x4*)(gp + 1024 + bj * HALF);
                    f32x4 r0, r1;
                    r0[0] = bf_lo(a.x) * __builtin_amdgcn_rcpf(bf_lo(b.x)); r0[1] = bf_hi(a.x) * __builtin_amdgcn_rcpf(bf_hi(b.x)); r0[2] = bf_lo(a.y) * __builtin_amdgcn_rcpf(bf_lo(b.y)); r0[3] = bf_hi(a.y) * __builtin_amdgcn_rcpf(bf_hi(b.y));
                    r1[0] = bf_lo(a.z) * __builtin_amdgcn_rcpf(bf_lo(b.z)); r1[1] = bf_hi(a.z) * __builtin_amdgcn_rcpf(bf_hi(b.z)); r1[2] = bf_lo(a.w) * __builtin_amdgcn_rcpf(bf_lo(b.w)); r1[3] = bf_hi(a.w) * __builtin_amdgcn_rcpf(bf_hi(b.w));
                    acc[ai][bj][m][0] = acc[ai][bj][m][0] * r0; acc[ai][bj][m][1] = acc[ai][bj][m][1] * r1; } }
    }
    __device__ __forceinline__ void operator()(const f32x4 (&acc)[2][2][4][2], const Unit& u, int wr, int wc, int fr, int fq) const {
        asm volatile("" : "+v"(fr), "+v"(fq));
        const int row0 = u.pm * BM + wr * 64 + fr; const int col0 = u.pn * BM + wc * 32 + 8 * fq;
#pragma unroll
        for (int ai = 0; ai < 2; ++ai)
#pragma unroll
            for (int m = 0; m < 4; ++m) { const size_t r = (size_t)(row0 + ai * HALF + m * 16);
#pragma unroll
                for (int bj = 0; bj < 2; ++bj) {
                    const u32x4 g = *(const u32x4*)(gates + r * 2048 + 1024 + col0 + bj * HALF);
                    f32x4 v0 = acc[ai][bj][m][0], v1 = acc[ai][bj][m][1];
                    v0[0] *= bf_lo(g.x); v0[1] *= bf_hi(g.x); v0[2] *= bf_lo(g.y); v0[3] *= bf_hi(g.y);
                    v1[0] *= bf_lo(g.z); v1[1] *= bf_hi(g.z); v1[2] *= bf_lo(g.w); v1[3] *= bf_hi(g.w);
                    *(u32x4*)(merged + r * 1024 + col0 + bj * HALF) = pack8(v0, v1); } }
    }
};
template <class Epi, class Sched, bool ALIGN_EPI = false, bool SP2 = false>
__device__ __forceinline__ void gemm_phase(PG8_LAS unsigned char* lds, const Gemm g, const Sched& S, const Epi& E) {
    int tid_ = threadIdx.x; asm volatile("" : "+v"(tid_));
    const int tid = tid_, wid = __builtin_amdgcn_readfirstlane(tid >> 6), lane = tid & 63, wr = wid >> 2, wc = wid & 3, fr = lane & 15, fq = lane >> 4;
    const int K = g.K, nt = K / BK;
    unsigned voffA[2], voffB[2];
#pragma unroll
    for (int i = 0; i < 2; ++i) { int R, C; stage_rc(tid * 16 + i * 8192, R, C); const int Rb = Epi::PERM ? ((R & ~31) + perm32(R & 31)) : R;
        voffA[i] = (unsigned)(R * K + C) * 2u; voffB[i] = (unsigned)(Rb * K + C) * 2u; }
    const size_t kstep = (size_t)(BK * 2);
    const size_t hstep = (size_t)HALF * K * 2;
    const size_t tstep = 2 * hstep;
    const unsigned ldsw = (unsigned)wid * 1024u;
    const int aoff = lds_byte(wr * 64 + fr, fq * 8), boff = lds_byte(wc * 32 + fr, fq * 8);
#define PG8_SA(b, h) (((b) * 2 + (h)) * HTB)
#define PG8_SB(b, h) ((4 + (b) * 2 + (h)) * HTB)
#define PG8_STAGE(bufoff, gbase, voff) do { _Pragma("unroll") for (int _i = 0; _i < 2; ++_i) \
        __builtin_amdgcn_global_load_lds((const unsigned*)((const char*)(gbase) + (voff)[_i]), (PG8_LAS unsigned*)(lds + (bufoff) + ldsw + _i * 8192), 16, 0, 0); } while (0)
#define PG8_LDA(dst, b, h) do { _Pragma("unroll") for (int m = 0; m < 4; ++m) _Pragma("unroll") for (int k = 0; k < 2; ++k) dst[m][k] = *(const PG8_LAS bf16x8*)(lds + PG8_SA(b, h) + aoff + m * 2048 + k * 1024); } while (0)
#define PG8_LDB(dst, b, h) do { _Pragma("unroll") for (int n = 0; n < 2; ++n) _Pragma("unroll") for (int k = 0; k < 2; ++k) dst[n][k] = *(const PG8_LAS bf16x8*)(lds + PG8_SB(b, h) + boff + n * 2048 + k * 1024); } while (0)
#define PG8_MMA(ai, bj, At, Bt) do { __builtin_amdgcn_s_setprio(1); _Pragma("unroll") for (int m = 0; m < 4; ++m) _Pragma("unroll") for (int n = 0; n < 2; ++n) _Pragma("unroll") for (int k = 0; k < 2; ++k) \
        acc[ai][bj][m][n] = __builtin_amdgcn_mfma_f32_16x16x32_bf16(Bt[n][k], At[m][k], acc[ai][bj][m][n], 0, 0, 0); __builtin_amdgcn_s_setprio(0); } while (0)
#define PG8_WAIT_V(n) asm volatile("s_waitcnt vmcnt(" #n ")" ::: "memory")
#define PG8_WAIT_L(n) asm volatile("s_waitcnt lgkmcnt(" #n ")" ::: "memory")
#define PG8_BAR __builtin_amdgcn_s_barrier()
#define PG8_SCHED __builtin_amdgcn_sched_barrier(0)
    Unit cur, nxt; int ui = 0;
    if (!S.next(0, cur)) return;
    f32x4 acc[2][2][4][2];
#pragma unroll
    for (int a = 0; a < 2; ++a)
#pragma unroll
        for (int b = 0; b < 2; ++b)
#pragma unroll
            for (int m = 0; m < 4; ++m)
#pragma unroll
                for (int n = 0; n < 2; ++n) acc[a][b][m][n] = (f32x4){0.f, 0.f, 0.f, 0.f};
    bf16x8 At[4][2], B0[2][2], B1[2][2];
    const char* cA = (const char*)g.A + (size_t)cur.am * tstep; const char* cB = (const char*)g.Bt + (size_t)cur.bt * tstep;
    S.a_ready(cur);
    if constexpr (SP2) {
        PG8_STAGE(PG8_SB(0, 0), cB, voffB); PG8_STAGE(PG8_SB(0, 1), cB + hstep, voffB); PG8_STAGE(PG8_SA(0, 0), cA, voffA); PG8_STAGE(PG8_SA(0, 1), cA + hstep, voffA);
        if (wr == 1) PG8_BAR;
        PG8_WAIT_V(2); PG8_BAR;
        PG8_STAGE(PG8_SB(1, 0), cB + kstep, voffB); PG8_STAGE(PG8_SA(1, 0), cA + kstep, voffA); PG8_STAGE(PG8_SB(1, 1), cB + hstep + kstep, voffB);
        PG8_WAIT_V(6); PG8_BAR;
    } else {
        PG8_STAGE(PG8_SB(0, 0), cB, voffB); PG8_STAGE(PG8_SA(0, 0), cA, voffA); PG8_STAGE(PG8_SB(0, 1), cB + hstep, voffB); PG8_STAGE(PG8_SA(0, 1), cA + hstep, voffA);
        if (wr == 1) PG8_BAR;
        PG8_WAIT_V(4); PG8_BAR;
        PG8_STAGE(PG8_SB(1, 0), cB + kstep, voffB); PG8_STAGE(PG8_SA(1, 0), cA + kstep, voffA); PG8_STAGE(PG8_SB(1, 1), cB + hstep + kstep, voffB);
        PG8_WAIT_V(6); PG8_BAR;
    }
    for (;;) {
        const bool has_next = S.next(ui + 1, nxt);
        const char* nA = has_next ? (const char*)g.A + (size_t)nxt.am * tstep : cA; const char* nB = has_next ? (const char*)g.Bt + (size_t)nxt.bt * tstep : cB;
        for (int t = 0; t < nt; t += 2) {
            const bool last = (t == nt - 2);
            const char* a1 = cA + (size_t)(t + 1) * kstep;
            const char* a2 = last ? nA : cA + (size_t)(t + 2) * kstep; const char* b2 = last ? nB : cB + (size_t)(t + 2) * kstep;
            const char* a3 = a2 + kstep; const char* b3 = b2 + kstep;
            if (last && has_next) S.a_ready(nxt);
            if constexpr (SP2) {
            PG8_LDB(B0, 0, 0); PG8_LDB(B1, 0, 1); PG8_SCHED; PG8_LDA(At, 0, 0); PG8_STAGE(PG8_SA(1, 1), a1 + hstep, voffA);
            PG8_WAIT_V(8); PG8_WAIT_L(0); PG8_BAR; PG8_MMA(0, 0, At, B0); PG8_MMA(0, 1, At, B1); PG8_BAR; PG8_SCHED;
            PG8_LDA(At, 0, 1); PG8_STAGE(PG8_SB(0, 0), b2, voffB); PG8_STAGE(PG8_SB(0, 1), b2 + hstep, voffB); PG8_STAGE(PG8_SA(0, 0), a2, voffA);
            PG8_WAIT_V(8); PG8_WAIT_L(0); PG8_BAR; PG8_MMA(1, 0, At, B0); PG8_MMA(1, 1, At, B1); PG8_BAR; PG8_SCHED;
            PG8_LDB(B0, 1, 0); PG8_LDB(B1, 1, 1); PG8_SCHED; PG8_LDA(At, 1, 0); PG8_STAGE(PG8_SA(0, 1), a2 + hstep, voffA);
            PG8_WAIT_V(8); PG8_WAIT_L(0); PG8_BAR; PG8_MMA(0, 0, At, B0); PG8_MMA(0, 1, At, B1); PG8_BAR; PG8_SCHED;
            PG8_LDA(At, 1, 1); PG8_STAGE(PG8_SB(1, 0), b3, voffB); PG8_STAGE(PG8_SB(1, 1), b3 + hstep, voffB); PG8_STAGE(PG8_SA(1, 0), a3, voffA);
            PG8_WAIT_V(8); PG8_WAIT_L(0); PG8_BAR; PG8_MMA(1, 0, At, B0); PG8_MMA(1, 1, At, B1); PG8_BAR; PG8_SCHED;
            } else {
            PG8_LDB(B0, 0, 0); PG8_SCHED; PG8_LDA(At, 0, 0); PG8_STAGE(PG8_SA(1, 1), a1 + hstep, voffA);
            PG8_WAIT_L(8); PG8_BAR; PG8_WAIT_L(0); PG8_MMA(0, 0, At, B0); PG8_BAR; PG8_SCHED;
            PG8_LDB(B1, 0, 1); PG8_STAGE(PG8_SB(0, 0), b2, voffB);
            PG8_BAR; PG8_WAIT_L(0); PG8_MMA(0, 1, At, B1); PG8_BAR;
            PG8_LDA(At, 0, 1); PG8_STAGE(PG8_SA(0, 0), a2, voffA);
            PG8_BAR; PG8_WAIT_L(0); PG8_MMA(1, 0, At, B0); PG8_BAR; PG8_SCHED;
            PG8_STAGE(PG8_SB(0, 1), b2 + hstep, voffB);
            PG8_WAIT_V(6); PG8_BAR; PG8_MMA(1, 1, At, B1); PG8_BAR;
            PG8_LDB(B0, 1, 0); PG8_SCHED; PG8_LDA(At, 1, 0); PG8_STAGE(PG8_SA(0, 1), a2 + hstep, voffA);
            PG8_WAIT_L(8); PG8_BAR; PG8_WAIT_L(0); PG8_MMA(0, 0, At, B0); PG8_BAR; PG8_SCHED;
            PG8_LDB(B1, 1, 1); PG8_STAGE(PG8_SB(1, 0), b3, voffB);
            PG8_BAR; PG8_WAIT_L(0); PG8_MMA(0, 1, At, B1); PG8_BAR;
            PG8_LDA(At, 1, 1); PG8_STAGE(PG8_SA(1, 0), a3, voffA);
            PG8_BAR; PG8_WAIT_L(0); PG8_MMA(1, 0, At, B0); PG8_BAR; PG8_SCHED;
            PG8_STAGE(PG8_SB(1, 1), b3 + hstep, voffB);
            PG8_WAIT_V(6); PG8_BAR; PG8_MMA(1, 1, At, B1); PG8_BAR;
            }
            if constexpr (Epi::MID_TILES > 0) { if (t + 2 == Epi::MID_TILES) E.mid(acc, cur, wr, wc, fr, fq); }
        }
        if constexpr (ALIGN_EPI) { if (wr == 0) PG8_BAR; }
        if constexpr (!Epi::AFTER_DRAIN) { E(acc, cur, wr, wc, fr, fq); S.done(cur); }
        if (!has_next) break;
#pragma unroll
        for (int a = 0; a < 2; ++a)
#pragma unroll
            for (int b = 0; b < 2; ++b)
#pragma unroll
                for (int m = 0; m < 4; ++m)
#pragma unroll
                    for (int n = 0; n < 2; ++n) acc[a][b][m][n] = (f32x4){0.f, 0.f, 0.f, 0.f};
        cur = nxt; cA = nA; cB = nB; ++ui;
        if constexpr (ALIGN_EPI) { if (wr == 1) PG8_BAR; }
    }
    PG8_WAIT_V(0);
    if constexpr (!ALIGN_EPI) { if (wr == 0) PG8_BAR; }
    PG8_BAR;
    if constexpr (Epi::AFTER_DRAIN) { E.fused(acc, cur, wr, wc, fr, fq, lds, wid, lane); S.done(cur); }
#undef PG8_SA
#undef PG8_SB
#undef PG8_STAGE
#undef PG8_LDA
#undef PG8_LDB
#undef PG8_MMA
#undef PG8_WAIT_V
#undef PG8_WAIT_L
#undef PG8_BAR
#undef PG8_SCHED
}
}
#include <hip/hip_bf16.h>
#include <cmath>
namespace attn_body {
using bf16=__hip_bfloat16;
using bf16x8=__attribute__((ext_vector_type(8)))short;
using s16x4=__attribute__((ext_vector_type(4)))short;
using f32x16=__attribute__((ext_vector_type(16)))float;
using u32x4=__attribute__((ext_vector_type(4)))unsigned;
constexpr int BATCH=16,NHEAD=8,SEQ=2048,D=64,PQ=3072,PO=768;
constexpr int NW=8,QBLK=32,QB=QBLK*NW,KVBLK=64,NQB=SEQ/QB;
constexpr int ATTN_UNIT_ROWS=QB;
__device__ __forceinline__ int crow(int r,int hi){return (r&3)+8*(r>>2)+4*hi;}
#define SBAR() __builtin_amdgcn_sched_barrier(0)
__device__ __forceinline__ void cmask(f32x16&p0,f32x16&p1,int jb,int qrel,int hi){
  const float NEG=-INFINITY; int kb=64*jb+4*hi;
  #pragma unroll
  for(int r=0;r<16;++r){int kv=kb+(r&3)+8*(r>>2); if(kv>qrel)p0[r]=NEG; if(kv+32>qrel)p1[r]=NEG;}
}

constexpr int NSLOT=3, SLOTB=8192;
constexpr int LDS_K=0, LDS_V=NSLOT*SLOTB, LDS_WS=2*NSLOT*SLOTB, LDS_OST=LDS_WS+NW*64*4, LDS_BYTES=LDS_OST+NW*4096;
constexpr float C2=0.125f*1.4426950408889634f;
__device__ __forceinline__ void glds16(const void*gsrc,unsigned lds_dst){unsigned keep;
  asm volatile("s_mov_b32 %0, m0\n\ts_mov_b32 m0, %2\n\ts_nop 0\n\tglobal_load_lds_dwordx4 %1, off\n\ts_mov_b32 m0, %0":"=&s"(keep):"v"(gsrc),"s"(lds_dst):"memory");}
__device__ __forceinline__ float max3f(float a,float b,float c){float r;asm("v_max3_f32 %0, %1, %2, %3":"=v"(r):"v"(a),"v"(b),"v"(c));return r;}
__device__ __forceinline__ float max2f(float a,float b){float r;asm("v_max_f32_e32 %0, %1, %2":"=v"(r):"v"(a),"v"(b));return r;}
__device__ __forceinline__ float fadd_s(float a,float b){float r;asm("v_add_f32_e32 %0, %1, %2":"=v"(r):"v"(a),"v"(b));return r;}
__device__ __forceinline__ float fsub_s(float a,float b){float r;asm("v_sub_f32_e32 %0, %1, %2":"=v"(r):"v"(a),"v"(b));return r;}
typedef float f32x2_t __attribute__((ext_vector_type(2))); typedef __bf16 bf16x2_t __attribute__((ext_vector_type(2)));
__device__ __forceinline__ unsigned cvtpk_s(float lo,float hi){f32x2_t v={lo,hi};bf16x2_t b=__builtin_convertvector(v,bf16x2_t);return __builtin_bit_cast(unsigned,b);}
#define WAIT_BAR(N) asm volatile("s_waitcnt vmcnt(" #N ") lgkmcnt(0)\n\ts_barrier":::"memory")

__device__ __forceinline__ void qkt(f32x16&p0,f32x16&p1,const char*Kslot,const bf16x8*qr,const f32x16&negm,int r32,int hi){
  const char*kb=Kslot+hi*1024+r32*16;
  #pragma unroll
  for(int d0=0;d0<4;++d0){
    const bf16x8 b0=*reinterpret_cast<const bf16x8*>(kb+d0*2048);
    const bf16x8 b1=*reinterpret_cast<const bf16x8*>(kb+d0*2048+512);
    if(d0==0){p0=__builtin_amdgcn_mfma_f32_32x32x16_bf16(b0,qr[0],negm,0,0,0);p1=__builtin_amdgcn_mfma_f32_32x32x16_bf16(b1,qr[0],negm,0,0,0);}
    else{p0=__builtin_amdgcn_mfma_f32_32x32x16_bf16(b0,qr[d0],p0,0,0,0);p1=__builtin_amdgcn_mfma_f32_32x32x16_bf16(b1,qr[d0],p1,0,0,0);}}
}
typedef __attribute__((address_space(3))) const char* lds_cptr;
typedef short v4i16_t __attribute__((ext_vector_type(4)));
__device__ __forceinline__ void kload8(bf16x8*kf,lds_cptr kp){
  kf[0]=*(const __attribute__((address_space(3))) bf16x8*)(kp);      kf[1]=*(const __attribute__((address_space(3))) bf16x8*)(kp+512);
  kf[2]=*(const __attribute__((address_space(3))) bf16x8*)(kp+2048); kf[3]=*(const __attribute__((address_space(3))) bf16x8*)(kp+2560);
  kf[4]=*(const __attribute__((address_space(3))) bf16x8*)(kp+4096); kf[5]=*(const __attribute__((address_space(3))) bf16x8*)(kp+4608);
  kf[6]=*(const __attribute__((address_space(3))) bf16x8*)(kp+6144); kf[7]=*(const __attribute__((address_space(3))) bf16x8*)(kp+6656);
}
__device__ __forceinline__ void kload2(bf16x8*kf,lds_cptr kp,int j){ kf[2*j]=*(const __attribute__((address_space(3))) bf16x8*)(kp+j*2048); kf[2*j+1]=*(const __attribute__((address_space(3))) bf16x8*)(kp+j*2048+512); }
__device__ __forceinline__ s16x4 vtr(lds_cptr p){ return __builtin_bit_cast(s16x4,__builtin_amdgcn_ds_read_tr16_b64_v4i16((__attribute__((address_space(3))) v4i16_t*)p)); }
__device__ __forceinline__ float rowmax(const f32x16&p0,const f32x16&p1){
  float a=max3f(p0[0],p0[1],p1[0]),b=max3f(p0[2],p0[3],p1[1]);a=max3f(a,p1[2],p1[3]);
  #pragma unroll
  for(int r=4;r<16;r+=4){a=max3f(a,p0[r],p0[r+1]);b=max3f(b,p0[r+2],p0[r+3]);a=max3f(a,p1[r],p1[r+1]);b=max3f(b,p1[r+2],p1[r+3]);}
  const float m=max2f(a,b);
  auto rr=__builtin_amdgcn_permlane32_swap(__float_as_uint(m),__float_as_uint(m),false,false);
  return max2f(__uint_as_float(rr[0]),__uint_as_float(rr[1]));
}
__device__ __forceinline__ void pv(f32x16*o,int vb,bf16x8 pa0,bf16x8 pa1,bf16x8 pa2,bf16x8 pa3){
  #pragma unroll
  for(int d0=0;d0<2;++d0){s16x4 lo[4],hi[4];
    #pragma unroll
    for(int ks=0;ks<4;++ks){
      asm volatile("ds_read_b64_tr_b16 %0,%1 offset:%c2":"=&v"(lo[ks]):"v"(vb),"i"(d0*4096+ks*1024):"memory");
      asm volatile("ds_read_b64_tr_b16 %0,%1 offset:%c2":"=&v"(hi[ks]):"v"(vb),"i"(d0*4096+ks*1024+512):"memory");}
    asm volatile("s_waitcnt lgkmcnt(0)":::"memory");SBAR();
    #define PK(k) (bf16x8){lo[k][0],lo[k][1],lo[k][2],lo[k][3],hi[k][0],hi[k][1],hi[k][2],hi[k][3]}
    o[d0]=__builtin_amdgcn_mfma_f32_32x32x16_bf16(pa0,PK(0),o[d0],0,0,0);
    o[d0]=__builtin_amdgcn_mfma_f32_32x32x16_bf16(pa1,PK(1),o[d0],0,0,0);
    o[d0]=__builtin_amdgcn_mfma_f32_32x32x16_bf16(pa2,PK(2),o[d0],0,0,0);
    o[d0]=__builtin_amdgcn_mfma_f32_32x32x16_bf16(pa3,PK(3),o[d0],0,0,0);
    #undef PK
  }
}

#ifndef ATTN_STORE16
#define ATTN_STORE16(p,v) (*(u32x4*)(p)=(v))
#endif
template<int THRL> __device__ __forceinline__ void attn_unit(int b,int h,int kvh,int qb,const bf16*Q,const bf16*__restrict__ K,const bf16*__restrict__ V,bf16*O,char*shm){
  int tid_=threadIdx.x; asm volatile("":"+v"(tid_)); const int tid=tid_,lane=tid&63,r32=lane&31,hi=lane>>5; const int wid=__builtin_amdgcn_readfirstlane(tid>>6);
  const long rowbase=(long)b*SEQ; const int q0=qb*QB;
  const bf16*Qw=Q+(rowbase+q0+wid*QBLK)*PQ+h*D;
  const bf16*Kh=K+rowbase*PQ+kvh*D,*Vh=V+rowbase*PQ+kvh*D;
  const unsigned lds0=(unsigned)(uintptr_t)shm;
  float*wsf=(float*)(shm+LDS_WS)+wid*64;
  const bf16*ksrc=Kh+(long)lane*PQ+wid*8;
  const bf16*vsrc=Vh+(long)(16*(wid&3)+(lane>>2))*PQ+(wid>>2)*32+(lane&3)*8;
  const unsigned kdst=lds0+LDS_K+wid*1024, vdst=lds0+LDS_V+wid*1024;
  #define DMA_K(t,slot) glds16(ksrc+(long)(t)*KVBLK*PQ,(unsigned)__builtin_amdgcn_readfirstlane(kdst+(slot)))
  #define DMA_V(t,slot) glds16(vsrc+(long)(t)*KVBLK*PQ,(unsigned)__builtin_amdgcn_readfirstlane(vdst+(slot)))
  const int vb0=(int)(lds0+LDS_V)+((lane>>4)&1)*32+(lane&3)*8+(4*hi+((lane&15)>>2))*64;
  const char*Kbase=shm+LDS_K; bf16x8 kf[8];
  const lds_cptr shm3=(lds_cptr)shm; const lds_cptr kp0=shm3+LDS_K+hi*1024+r32*16; const lds_cptr vp0=shm3+LDS_V+((lane>>4)&1)*32+(lane&3)*8+(4*hi+((lane&15)>>2))*64;
  constexpr int NT=SEQ/KVBLK;
  DMA_K(0,0);DMA_V(0,0);DMA_K(1,SLOTB);
  bf16x8 qr[4];
  #pragma unroll
  for(int d0=0;d0<4;++d0)qr[d0]=*reinterpret_cast<const bf16x8*>(&Qw[(long)r32*PQ+d0*16+hi*8]);
  float mhat=0.f,l_reg=0.f;f32x16 o[2];o[0]=f32x16{};o[1]=f32x16{};f32x16 negm=f32x16{};asm volatile("":"+v"(negm));

  #define CMASK(P0,P1,t) do{}while(0)
  bool resc=false;
  #define START(P0,P1) do{ const float rm=rowmax(P0,P1); resc=false; \
    { const float dl=rm; mhat=fadd_s(mhat,dl); \
      _Pragma("unroll") for(int r=0;r<16;++r){P0[r]=fsub_s(P0[r],dl);P1[r]=fsub_s(P1[r],dl);} \
      _Pragma("unroll") for(int r=0;r<16;++r)negm[r]=-mhat; asm volatile("":"+v"(negm)); } \
    _Pragma("unroll") for(int r=0;r<16;++r)P0[r]=__builtin_amdgcn_exp2f(P0[r]); }while(0)
  #define RESC() do{ if(resc){ asm volatile("s_waitcnt lgkmcnt(0)":::"memory"); \
      _Pragma("unroll") for(int d_=0;d_<2;++d_) _Pragma("unroll") for(int r=0;r<16;++r)o[d_][r]*=wsf[crow(r,hi)]; } }while(0)
  f32x16 pA0,pA1,pB0,pB1;
  int sl_prev=0,sl_cur=0,sl_next=SLOTB;
  #define ROT() do{sl_prev=sl_cur;sl_cur=sl_next;sl_next=(sl_next==(NSLOT-1)*SLOTB)?0:sl_next+SLOTB;}while(0)
  DMA_K(2,2*SLOTB);
  WAIT_BAR(3);
  qkt(pA0,pA1,Kbase,qr,negm,r32,hi);asm volatile("s_nop 15\n\ts_nop 7":"+v"(pA0),"+v"(pA1));CMASK(pA0,pA1,0);
  START(pA0,pA1);
  _Pragma("unroll") for(int r=0;r<16;++r)pA1[r]=__builtin_amdgcn_exp2f(pA1[r]);
  WAIT_BAR(0);
  DMA_K(3,0);DMA_V(1,SLOTB);
  ROT();
  kload8(kf,kp0+sl_cur);
  WAIT_BAR(2);
  s16x4 vlo[8],vhi[8]; u32x4 pw0,pw1,pw2,pw3;
  #define PKW(P,B) cvtpk_s(P[B],P[B+1])
  #define PAF(k) __builtin_bit_cast(bf16x8,pw##k)
  #define VFR(i) (bf16x8){vlo[i][0],vlo[i][1],vlo[i][2],vlo[i][3],vhi[i][0],vhi[i][1],vhi[i][2],vhi[i][3]}
  #define PIN(x) asm volatile("":"+v"(x))
  #define MX3(a,b,c) __builtin_fmaxf(__builtin_fmaxf((a),(b)),(c))
  #define GAPA(MF,A0,A1,A2,A3,W0,W1,PW) do{ MF; sacc+=A0; sacc+=A1; sacc+=A2; sacc+=A3; PIN(sacc); W0; W1; PIN(PW); SBAR(); }while(0)
  #define EX(v) __builtin_amdgcn_exp2f(v)
  #define GAPB(MF,X,B) do{ MF; X[B]=EX(X[B]); X[B+1]=EX(X[B+1]); X[B+2]=EX(X[B+2]); X[B+3]=EX(X[B+3]); PIN(X); SBAR(); }while(0)
  #define VRD(i) do{ vlo[i]=vtr(vp_+(((i)>>2)*4096+((i)&3)*1024)); vhi[i]=vtr(vp_+(((i)>>2)*4096+((i)&3)*1024+512)); }while(0)
  #define KRD(G,j) do{ if(G){ kload2(kf,kp0+sl_next,j); SBAR(); } }while(0)
  #define STEP(C0,C1,P0,P1,t,GK,GV,GL) do{ SBAR(); \
    const lds_cptr vp_=vp0+sl_prev; \
    VRD(0); SBAR(); float sacc=(P0[0]+P0[1]); \
    GAPA(C0=__builtin_amdgcn_mfma_f32_32x32x16_bf16(kf[0],qr[0],negm,0,0,0), P0[2],P0[3],P0[4],P0[5],     pw0[0]=PKW(P0,0), pw0[1]=PKW(P0,2), pw0); \
    VRD(4); SBAR(); GAPA(C1=__builtin_amdgcn_mfma_f32_32x32x16_bf16(kf[1],qr[0],negm,0,0,0), P0[6],P0[7],P0[8],P0[9],     pw0[2]=PKW(P0,4), pw0[3]=PKW(P0,6), pw0); \
    VRD(1); SBAR(); GAPA(C0=__builtin_amdgcn_mfma_f32_32x32x16_bf16(kf[2],qr[1],C0,0,0,0),   P0[10],P0[11],P0[12],P0[13], pw1[0]=PKW(P0,8), pw1[1]=PKW(P0,10), pw1); \
    VRD(5); SBAR(); GAPA(C1=__builtin_amdgcn_mfma_f32_32x32x16_bf16(kf[3],qr[1],C1,0,0,0),   P0[14],P0[15],P1[0],P1[1],   pw1[2]=PKW(P0,12),pw1[3]=PKW(P0,14), pw1); \
    VRD(2); SBAR(); GAPA(C0=__builtin_amdgcn_mfma_f32_32x32x16_bf16(kf[4],qr[2],C0,0,0,0),   P1[2],P1[3],P1[4],P1[5],     pw2[0]=PKW(P1,0), pw2[1]=PKW(P1,2), pw2); \
    VRD(6); SBAR(); GAPA(C1=__builtin_amdgcn_mfma_f32_32x32x16_bf16(kf[5],qr[2],C1,0,0,0),   P1[6],P1[7],P1[8],P1[9],     pw2[2]=PKW(P1,4), pw2[3]=PKW(P1,6), pw2); \
    VRD(3); SBAR(); GAPA(C0=__builtin_amdgcn_mfma_f32_32x32x16_bf16(kf[6],qr[3],C0,0,0,0),   P1[10],P1[11],P1[12],P1[13], pw3[0]=PKW(P1,8), pw3[1]=PKW(P1,10), pw3); \
    VRD(7); SBAR(); GAPA(C1=__builtin_amdgcn_mfma_f32_32x32x16_bf16(kf[7],qr[3],C1,0,0,0),   P1[14],P1[15],0.f,0.f,       pw3[2]=PKW(P1,12),pw3[3]=PKW(P1,14), pw3); \
    l_reg+=sacc; \
    if(GK){DMA_K((t)+3,sl_cur);} if(GV){DMA_V((t)+1,sl_next);} \
    CMASK(C0,C1,t); \
    { float a=MX3(C0[0],C0[1],C1[0]),b=MX3(C0[2],C0[3],C1[1]); a=MX3(a,C1[2],C1[3]); \
      _Pragma("unroll") for(int r=4;r<16;r+=4){a=MX3(a,C0[r],C0[r+1]);b=MX3(b,C0[r+2],C0[r+3]);a=MX3(a,C1[r],C1[r+1]);b=MX3(b,C1[r+2],C1[r+3]);} \
      float rm=__builtin_fmaxf(a,b); { auto rr=__builtin_amdgcn_permlane32_swap(__float_as_uint(rm),__float_as_uint(rm),false,false); rm=__builtin_fmaxf(__uint_as_float(rr[0]),__uint_as_float(rr[1])); } \
      resc=false; \
      if(__builtin_expect(__any(rm>(float)THRL),0)){ const float dl=__builtin_fmaxf(rm,0.f); mhat+=dl; \
        _Pragma("unroll") for(int r=0;r<16;++r){C0[r]-=dl;C1[r]-=dl;} \
        _Pragma("unroll") for(int r=0;r<16;++r)negm[r]=-mhat; asm volatile("":"+v"(negm)); \
        const float f=__builtin_amdgcn_exp2f(-dl); l_reg*=f; if(hi==0)wsf[r32]=f; resc=true; } } \
    SBAR(); \
    GAPB(o[0]=__builtin_amdgcn_mfma_f32_32x32x16_bf16(PAF(0),VFR(0),o[0],0,0,0), C0,0); \
    GAPB(o[1]=__builtin_amdgcn_mfma_f32_32x32x16_bf16(PAF(0),VFR(4),o[1],0,0,0), C0,4); \
    KRD(GL,0); GAPB(o[0]=__builtin_amdgcn_mfma_f32_32x32x16_bf16(PAF(1),VFR(1),o[0],0,0,0), C0,8); \
    KRD(GL,1); GAPB(o[1]=__builtin_amdgcn_mfma_f32_32x32x16_bf16(PAF(1),VFR(5),o[1],0,0,0), C0,12); \
    KRD(GL,2); GAPB(o[0]=__builtin_amdgcn_mfma_f32_32x32x16_bf16(PAF(2),VFR(2),o[0],0,0,0), C1,0); \
    KRD(GL,3); GAPB(o[1]=__builtin_amdgcn_mfma_f32_32x32x16_bf16(PAF(2),VFR(6),o[1],0,0,0), C1,4); \
    GAPB(o[0]=__builtin_amdgcn_mfma_f32_32x32x16_bf16(PAF(3),VFR(3),o[0],0,0,0), C1,8); \
    GAPB(o[1]=__builtin_amdgcn_mfma_f32_32x32x16_bf16(PAF(3),VFR(7),o[1],0,0,0), C1,12); \
    }while(0)
  int t=1;
  #undef CMASK
  #define CMASK(P0,P1,t) do{}while(0)
  for(;t+5<NT;t+=2){
    STEP(pB0,pB1,pA0,pA1,t,true,true,true);     WAIT_BAR(2); RESC(); ROT();
    STEP(pA0,pA1,pB0,pB1,t+1,true,true,true);   WAIT_BAR(2); RESC(); ROT();
  }
  #undef CMASK
  #define CMASK(P0,P1,t) do{}while(0)
  #define ENDW(tt) do{ if((tt)+3<NT){WAIT_BAR(2);} else if((tt)+2<NT){WAIT_BAR(1);} else {WAIT_BAR(0);} }while(0)
  for(;t+1<NT;t+=2){
    STEP(pB0,pB1,pA0,pA1,t,(t+3<NT),(t+1<NT),(t+1<NT));       ENDW(t);   RESC(); ROT();
    STEP(pA0,pA1,pB0,pB1,t+1,(t+4<NT),(t+2<NT),(t+2<NT));     ENDW(t+1); RESC(); ROT();
  }
  STEP(pB0,pB1,pA0,pA1,NT-1,false,false,false); RESC();
  { float sacc=pB0[0]+pB0[1]; _Pragma("unroll") for(int r=2;r<16;++r)sacc+=pB0[r]; _Pragma("unroll") for(int r=0;r<16;++r)sacc+=pB1[r]; l_reg+=sacc;
    pw0=(u32x4){PKW(pB0,0),PKW(pB0,2),PKW(pB0,4),PKW(pB0,6)};pw1=(u32x4){PKW(pB0,8),PKW(pB0,10),PKW(pB0,12),PKW(pB0,14)};pw2=(u32x4){PKW(pB1,0),PKW(pB1,2),PKW(pB1,4),PKW(pB1,6)};pw3=(u32x4){PKW(pB1,8),PKW(pB1,10),PKW(pB1,12),PKW(pB1,14)};
    SBAR(); pv(o,vb0+sl_cur,PAF(0),PAF(1),PAF(2),PAF(3)); }
  #undef PKW
  #undef PAF
  #undef VFR
  #undef PIN
  #undef MX3
  #undef GAPA
  #undef GAPB
  #undef EX
  #undef VRD
  #undef KRD
  #undef STEP
  #undef ENDW
  {auto rr=__builtin_amdgcn_permlane32_swap(__float_as_uint(l_reg),__float_as_uint(l_reg),false,false);l_reg=__uint_as_float(rr[0])+__uint_as_float(rr[1]);}
  if(hi==0)wsf[32+r32]=l_reg;asm volatile("s_waitcnt lgkmcnt(0)":::"memory");
  float rli[16];
  #pragma unroll
  for(int r=0;r<16;++r)rli[r]=__builtin_amdgcn_rcpf(wsf[32+crow(r,hi)]);
  bf16*Ow=O+(rowbase+q0+wid*QBLK)*PO+h*D;
  { bf16*stg=(bf16*)(shm+LDS_OST)+wid*2048;
    #pragma unroll
    for(int r=0;r<16;++r){const int orow=crow(r,hi);
      #pragma unroll
      for(int d0=0;d0<2;++d0)stg[orow*64+d0*32+r32]=__float2bfloat16(o[d0][r]*rli[r]);}
    asm volatile("s_waitcnt lgkmcnt(0)":::"memory");
    #pragma unroll
    for(int i=0;i<4;++i){const int row=i*8+(lane>>3),ch=lane&7; const u32x4 v=*(const u32x4*)(stg+row*64+ch*8); ATTN_STORE16(Ow+(long)row*PO+ch*8,v);} }
  asm volatile("s_waitcnt lgkmcnt(0)\n\ts_barrier":::"memory");
  #undef DMA_K
  #undef DMA_V
  #undef CMASK
  #undef START
  #undef RESC
  #undef ROT
}
constexpr int ATTN_LDS_BYTES=LDS_BYTES;
struct AttnTensors { const bf16* Q; const bf16* K; const bf16* V; bf16* O; };
constexpr int BAND_HALF=65536, BAND_K=0, BAND_V=32768;
__device__ __forceinline__ void band_half_unit(int hu,const bf16*__restrict__ QKV,int offq,int offk,int offv,bf16*OBG,float*LSEG,char*shm,char*wsb){
  int tid_=threadIdx.x; asm volatile("":"+v"(tid_)); const int tid=tid_,lane=tid&63,r32=lane&31,hi=lane>>5; const int wid=__builtin_amdgcn_readfirstlane(tid>>6);
  const int half=wid>>2, wq=wid&3;
  const int uh=__builtin_amdgcn_readfirstlane(2*hu+half);
  const int b=uh/192, rem=uh-b*192, head=rem>>4, ck=rem&15, g=head>>2, j=head&3;
  const int dil=(g==0)?1:(g==1)?4:16, sh=(g==0)?4:(g==1)?2:0;
  const int rc=ck>>sh, c=ck&((1<<sh)-1), ntile=(SEQ/64)/dil;
  const long rowbase=(long)b*SEQ;
  bf16*const OG=OBG+(long)g*BATCH*SEQ*256; float*const LG=LSEG+(long)g*BATCH*SEQ*4;
  const unsigned lds0=(unsigned)(uintptr_t)shm+half*BAND_HALF;
  char*hb=shm+half*BAND_HALF;
  typedef __attribute__((address_space(3))) float* lds_fptr;
  const lds_fptr wsf=(lds_fptr)(wsb+wid*256);
  const int mq=128*c+32*wq+r32;
  const bf16*Qrow=QKV+(rowbase+(long)mq*dil+rc)*PQ+offq+head*D;
  bf16x8 qr[4];
  #pragma unroll
  for(int d0=0;d0<4;++d0)qr[d0]=*reinterpret_cast<const bf16x8*>(&Qrow[d0*16+hi*8]);
  const bf16*Kc=QKV+(rowbase+rc)*PQ+offk+head*D, *Vc=QKV+(rowbase+rc)*PQ+offv+head*D;
  const int T0=2*c-1;
  #pragma unroll
  for(int s=0;s<4;++s){ int T=T0+s; T=T<0?0:(T>=ntile?ntile-1:T); const long p0_=(long)T*64;
    #pragma unroll
    for(int q_=0;q_<2;++q_){ const int cc_=2*wq+q_;
      glds16(Kc+((p0_+lane)*dil)*PQ+cc_*8,(unsigned)__builtin_amdgcn_readfirstlane(lds0+BAND_K+s*8192+cc_*1024));
      glds16(Vc+((p0_+16*(cc_&3)+(lane>>2))*dil)*PQ+(cc_>>2)*32+(lane&3)*8,(unsigned)__builtin_amdgcn_readfirstlane(lds0+BAND_V+s*8192+cc_*1024)); } }
  float mrun=-1e30f,l_reg=0.f; f32x16 o[2]; o[0]=f32x16{}; o[1]=f32x16{};
  const int vb0=(int)(lds0+BAND_V)+((lane>>4)&1)*32+(lane&3)*8+(4*hi+((lane&15)>>2))*64;
  #define BAND_STEP(s,NW_) do{ \
    asm volatile("s_waitcnt vmcnt(" #NW_ ")\n\ts_barrier":::"memory");     \
    const int T=T0+(s); const bool act=(T>=0&&T<ntile)&&((s)>=(wq>>1))&&((s)<=(wq>>1)+2); \
    if(act){ \
      f32x16 p0,p1; const f32x16 zero=f32x16{}; \
      qkt(p0,p1,hb+BAND_K+(s)*8192,qr,zero,r32,hi); \
      const int kb=64*T+4*hi-mq; \
      float mx=-1e30f; \
      _Pragma("unroll") for(int r=0;r<16;++r){ const int d0_=kb+(r&3)+8*(r>>2), d1_=d0_+32; \
        p0[r]=(d0_>=-64&&d0_<=64)?p0[r]:-1e30f; p1[r]=(d1_>=-64&&d1_<=64)?p1[r]:-1e30f; mx=__builtin_fmaxf(mx,__builtin_fmaxf(p0[r],p1[r])); } \
      mx=__builtin_fmaxf(mx,__shfl_xor(mx,32)); \
      const float mnew=__builtin_fmaxf(mrun,mx); const float f=__builtin_amdgcn_exp2f(mrun-mnew); mrun=mnew; \
      float sacc=0.f; \
      _Pragma("unroll") for(int r=0;r<16;++r){ p0[r]=(p0[r]>-1e29f)?__builtin_amdgcn_exp2f(p0[r]-mnew):0.f; p1[r]=(p1[r]>-1e29f)?__builtin_amdgcn_exp2f(p1[r]-mnew):0.f; sacc+=p0[r]+p1[r]; } \
      l_reg=l_reg*f+sacc; \
      if(hi==0)wsf[r32]=f; \
      _Pragma("unroll") for(int r=0;r<16;++r){ const float fr=wsf[crow(r,hi)]; o[0][r]*=fr; o[1][r]*=fr; } \
      u32x4 pw0,pw1,pw2,pw3; \
      pw0=(u32x4){cvtpk_s(p0[0],p0[1]),cvtpk_s(p0[2],p0[3]),cvtpk_s(p0[4],p0[5]),cvtpk_s(p0[6],p0[7])}; pw1=(u32x4){cvtpk_s(p0[8],p0[9]),cvtpk_s(p0[10],p0[11]),cvtpk_s(p0[12],p0[13]),cvtpk_s(p0[14],p0[15])}; \
      pw2=(u32x4){cvtpk_s(p1[0],p1[1]),cvtpk_s(p1[2],p1[3]),cvtpk_s(p1[4],p1[5]),cvtpk_s(p1[6],p1[7])}; pw3=(u32x4){cvtpk_s(p1[8],p1[9]),cvtpk_s(p1[10],p1[11]),cvtpk_s(p1[12],p1[13]),cvtpk_s(p1[14],p1[15])}; \
      SBAR(); pv(o,vb0+(s)*8192,__builtin_bit_cast(bf16x8,pw0),__builtin_bit_cast(bf16x8,pw1),__builtin_bit_cast(bf16x8,pw2),__builtin_bit_cast(bf16x8,pw3)); \
    } }while(0)
  BAND_STEP(0,12); BAND_STEP(1,8); BAND_STEP(2,4); BAND_STEP(3,0);
  #undef BAND_STEP
  l_reg+=__shfl_xor(l_reg,32);
  if(hi==0)wsf[32+r32]=l_reg;
  float rli[16];
  #pragma unroll
  for(int r=0;r<16;++r)rli[r]=__builtin_amdgcn_rcpf(wsf[32+crow(r,hi)]);
  asm volatile("s_waitcnt lgkmcnt(0)\n\ts_barrier":::"memory");
  { bf16*stg=(bf16*)(hb+BAND_V)+wq*2048;
    #pragma unroll
    for(int r=0;r<16;++r){const int orow=crow(r,hi);
      #pragma unroll
      for(int d0=0;d0<2;++d0)stg[orow*64+d0*32+r32]=__float2bfloat16(o[d0][r]*rli[r]);}
    asm volatile("s_waitcnt lgkmcnt(0)":::"memory");
    #pragma unroll
    for(int i=0;i<4;++i){const int row=i*8+(lane>>3),ch=lane&7; const u32x4 v=*(const u32x4*)(stg+row*64+ch*8);
      const long grow=rowbase+(long)(128*c+32*wq+row)*dil+rc;
      *(u32x4*)(OG+grow*256+j*64+ch*8)=v;} }
  if(hi==0){ const long grow=rowbase+(long)mq*dil+rc; LG[grow*4+j]=mrun+__builtin_log2f(l_reg); }
  asm volatile("s_waitcnt lgkmcnt(0)\n\ts_barrier":::"memory");
}
#undef SBAR
#undef WAIT_BAR
}
#define GAS __attribute__((address_space(1)))
#define LAS __attribute__((address_space(3)))
typedef unsigned short bf16;
typedef unsigned v4u __attribute__((ext_vector_type(4)));
typedef float f32x4 __attribute__((ext_vector_type(4)));
typedef short bf16x8 __attribute__((ext_vector_type(8)));
typedef GAS unsigned gu32;
typedef GAS unsigned long long gu64;
#define RLX_AGENT __ATOMIC_RELAXED, __HIP_MEMORY_SCOPE_AGENT
#define LDS_WAIT() asm volatile("s_waitcnt lgkmcnt(0)" ::: "memory")
#define VM_WAIT() asm volatile("s_waitcnt vmcnt(0)" ::: "memory")
__device__ __forceinline__ unsigned long long rt() { return __builtin_amdgcn_s_memrealtime(); }
__device__ __forceinline__ unsigned f2bf(float f) { unsigned u = __builtin_bit_cast(unsigned, f); return (u + 0x7fffu + ((u >> 16) & 1u)) >> 16; }
__device__ __forceinline__ unsigned pk2(float lo, float hi) { return f2bf(lo) | (f2bf(hi) << 16); }

#define XB_TMO      128
#define XB_XCNT(j)  (256  + 64 * (j))
#define XB_XSUB(j)  (1280 + 64 * (j))
#define XB_XGEN(j)  (2304 + 64 * (j))
#define XB_TOP      3328
#define XB_TOPGEN   3392
#define XCD_BAR_WORDS 3456
#define XB_SPIN_CAP (1u << 24)

__device__ __forceinline__ unsigned xb_ld(unsigned* p)              { return __hip_atomic_load(p, __ATOMIC_RELAXED, __HIP_MEMORY_SCOPE_AGENT); }
__device__ __forceinline__ unsigned xb_add(unsigned* p, unsigned v) { return __hip_atomic_fetch_add(p, v, __ATOMIC_RELAXED, __HIP_MEMORY_SCOPE_AGENT); }
__device__ __forceinline__ unsigned xb_xcc_id() { return (unsigned)__builtin_amdgcn_s_getreg((3 << 11) | 20) & 0xFu; }
#define XB_SPIN(cond, bar) do { unsigned _sp = 0; while (cond) { __builtin_amdgcn_s_sleep(1); \
    if ((++_sp & 255u) == 0u) { if (xb_ld(&(bar)[XB_TMO])) break; if (_sp > XB_SPIN_CAP) { atomicAdd(&(bar)[XB_TMO], 1u); break; } } } } while (0)

struct XcdBarrier {
    unsigned* bar; unsigned x;
    volatile LAS unsigned* st;
};

__device__ __forceinline__ XcdBarrier xcd_barrier_post(unsigned* bar, volatile LAS unsigned* st) {
    XcdBarrier b; b.bar = bar; b.x = xb_xcc_id(); b.st = st;
    if (threadIdx.x == 0) (void)xb_add(&bar[XB_XCNT(b.x)], 1u);
    return b;
}
__device__ __forceinline__ void xcd_barrier_complete(unsigned* bar, unsigned x, unsigned& nloc, unsigned& nx) {
    const unsigned G = gridDim.x * gridDim.y * gridDim.z;
    unsigned sum, cnt, mine, sp = 0u;
    for (;;) {
        sum = 0u; cnt = 0u; mine = 0u;
#pragma unroll
        for (unsigned j = 0; j < 16; ++j) { const unsigned c = xb_ld(&bar[XB_XCNT(j)]); sum += c; cnt += (c > 0u) ? 1u : 0u; mine = (j == x) ? c : mine; }
        if (sum == G) break;
        __builtin_amdgcn_s_sleep(1);
        if ((++sp & 255u) == 0u) { if (xb_ld(&bar[XB_TMO])) break; if (sp > XB_SPIN_CAP) { atomicAdd(&bar[XB_TMO], 1u); break; } }
    }
    nloc = mine > 0u ? mine : 1u; nx = cnt > 0u ? cnt : 1u;
}

__device__ __forceinline__ void xcd_barrier(const XcdBarrier& b) {
    asm volatile("s_waitcnt vmcnt(0)" ::: "memory");
    __syncthreads();
    if (threadIdx.x == 0) {
        unsigned* bar = b.bar;
        __builtin_amdgcn_s_waitcnt(0);
        unsigned nloc = b.st[0], nx = b.st[1];
        if (nloc == 0u) { xcd_barrier_complete(bar, b.x, nloc, nx); b.st[0] = nloc; b.st[1] = nx; }
        const unsigned old = xb_add(&bar[XB_XSUB(b.x)], 1u);
        const unsigned gen = old / nloc;
        if (old + 1u == (gen + 1u) * nloc) {
            __builtin_amdgcn_fence(__ATOMIC_RELEASE, "agent");
            asm volatile("s_waitcnt vmcnt(0)" ::: "memory");
            const unsigned og = xb_add(&bar[XB_TOP], 1u);
            const unsigned tg = og / nx;
            if (og + 1u == (tg + 1u) * nx) xb_add(&bar[XB_TOPGEN], 1u);
            else XB_SPIN(xb_ld(&bar[XB_TOPGEN]) == tg, bar);
            __builtin_amdgcn_fence(__ATOMIC_ACQUIRE, "agent");
            xb_add(&bar[XB_XGEN(b.x)], 1u);
            asm volatile("s_waitcnt vmcnt(0)" ::: "memory");
        } else {
            XB_SPIN(xb_ld(&bar[XB_XGEN(b.x)]) == gen, bar);
            __builtin_amdgcn_fence(__ATOMIC_ACQUIRE, "agent");
            asm volatile("s_waitcnt vmcnt(0)" ::: "memory");
        }
    }
    __syncthreads();
}


constexpr size_t MiB = 1u << 20;
constexpr size_t WS_CTL = 0, CTL_ZERO_BYTES = 1 * MiB;
constexpr size_t WS_STAT0 = 1 * MiB;
constexpr size_t WS_AFF = 2 * MiB;
constexpr size_t WS_INV = 4 * MiB;
constexpr size_t WS_TOK = 5 * MiB;
constexpr size_t WS_LSE = 6 * MiB;
constexpr size_t WS_WIN = 8 * MiB;
constexpr size_t WS_WA = 18 * MiB;
constexpr size_t WS_WO = 20 * MiB;
constexpr size_t WS_ROPEA = 22 * MiB;
constexpr size_t WS_ROPEB = 23 * MiB;
constexpr size_t ARENA = 24 * MiB;
constexpr size_t A_H0B = ARENA + 0 * MiB;
constexpr size_t A_QKV = ARENA + 64 * MiB;
constexpr size_t A_GATES = ARENA + 256 * MiB;
constexpr size_t A_ATTNA = ARENA + 0 * MiB;
constexpr size_t A_OBG = ARENA + 384 * MiB;
constexpr size_t A_MERGED = ARENA + 64 * MiB;
constexpr size_t A_MIX = ARENA + 128 * MiB;
constexpr size_t A_H1B = ARENA + 384 * MiB;
constexpr size_t A_WD = ARENA + 448 * MiB;
constexpr size_t A_XE = ARENA + 256 * MiB;
constexpr size_t A_ACT = ARENA + 0 * MiB;
constexpr size_t A_YE = ARENA + 256 * MiB;
constexpr size_t WS_END = ARENA + 512 * MiB;
constexpr int CW_TMO = 0, CW_BAR = 4096;

constexpr int RING_OFF = 0, RING_BYTES = 131072;
constexpr int LDSCTL_OFF = RING_BYTES, MISC_OFF = LDSCTL_OFF + 320;
constexpr int BANDWS_OFF = LDSCTL_OFF + 1024;
constexpr int LDS_BYTES = 147456;

typedef short s16x4v __attribute__((ext_vector_type(4)));
typedef unsigned u32x2 __attribute__((ext_vector_type(2)));

struct Frame {
    LAS unsigned char* lds;
    volatile LAS unsigned* MISC;
    gu32* ctl;
    int tid, lane, wave;
    int vcu, G;
};

__device__ __forceinline__ float wave_sum(float v) {
#pragma unroll
    for (int o = 1; o < 64; o <<= 1) v += __shfl_xor(v, o);
    return v;
}
__device__ __forceinline__ float bf2f(bf16 h) { return __uint_as_float(((unsigned)h) << 16); }

struct TJob { const float* src; bf16* dst; size_t off; int ldw, ldt, k0, n0, win, kdo; };
__device__ __forceinline__ void tjob_load(const TJob& j, f32x4 (&r)[8], int lane) {
    const float* p = j.src + (size_t)(j.k0 + (lane >> 3)) * j.ldw + j.n0 + 4 * (lane & 7);
#pragma unroll
    for (int i = 0; i < 8; ++i) r[i] = *(const GAS f32x4*)(p + (size_t)(8 * i) * j.ldw);
}
struct WinRow {
    __device__ __forceinline__ size_t operator()(int ncol) const {
        if (ncol >= QKVW) return (size_t)ncol;
        int pn, wc, d, map;
        if (ncol < OFF_KA) { const int h = ncol >> 6; pn = h >> 2; wc = h & 3; map = 0; }
        else if (ncol < OFF_VA) { pn = 2; wc = (ncol - OFF_KA) >> 6; map = 0; }
        else if (ncol < OFF_QB) { pn = 2; wc = 2 + ((ncol - OFF_VA) >> 6); map = 2; }
        else if (ncol < OFF_KB) { const int h = (ncol - OFF_QB) >> 6; pn = 3 + (h >> 2); wc = h & 3; map = 1; }
        else if (ncol < OFF_VB) { const int h = (ncol - OFF_KB) >> 6; pn = 6 + (h >> 2); wc = h & 3; map = 1; }
        else { const int h = (ncol - OFF_VB) >> 6; pn = 9 + (h >> 2); wc = h & 3; map = 2; }
        d = ncol & 63;
        int bj, fq, n; const int i = d & 3;
        if (map == 0) { n = d >> 5; bj = (d >> 4) & 1; fq = (d >> 2) & 3; }
        else if (map == 1) { fq = d >> 4; bj = (d >> 3) & 1; n = (d >> 2) & 1; }
        else { bj = d >> 5; fq = (d >> 3) & 3; n = (d >> 2) & 1; }
        return (size_t)(pn * 256 + 128 * bj + 32 * wc + 8 * fq + 4 * n + i);
    }
};

__device__ __forceinline__ void tjob_store(const TJob& j, const f32x4 (&r)[8], LAS float* scr, int lane) {
    { LAS float* w = scr + (4 * (lane & 7)) * 65 + (lane >> 3);
#pragma unroll
      for (int i = 0; i < 8; ++i) { w[8 * i] = r[i].x; w[65 + 8 * i] = r[i].y; w[130 + 8 * i] = r[i].z; w[195 + 8 * i] = r[i].w; } }
    LDS_WAIT(); asm volatile("" ::: "memory");
    const int c = lane & 7;
#pragma unroll
    for (int jj = 0; jj < 4; ++jj) { const int n = (lane >> 3) + 8 * jj; const LAS float* sp = scr + n * 65 + 8 * c;
        v4u o; o.x = pk2(sp[0], sp[1]); o.y = pk2(sp[2], sp[3]); o.z = pk2(sp[4], sp[5]); o.w = pk2(sp[6], sp[7]);
        const size_t row = j.win ? WinRow{}(j.n0 + n) : j.off + (size_t)n;
        *(GAS v4u*)(j.dst + row * (size_t)j.ldt + j.kdo + j.k0 + 8 * c) = o; }
    LDS_WAIT(); asm volatile("" ::: "memory");
}
template <class Decode>
__device__ __forceinline__ void tjobs_run(int first, int stride, int count, const Decode& decode, LAS float* scr, int lane) {
    TJob cur, nxt; f32x4 ra[8], rb[8];
    int it = first; if (it >= count) return;
    decode(it, cur); tjob_load(cur, ra, lane);
    for (;;) {
        const int itn = it + stride; const bool hn = itn < count;
        if (hn) { decode(itn, nxt); tjob_load(nxt, rb, lane); }
        tjob_store(cur, ra, scr, lane);
        if (!hn) break;
        cur = nxt; it = itn;
        ra[0] = rb[0]; ra[1] = rb[1]; ra[2] = rb[2]; ra[3] = rb[3]; ra[4] = rb[4]; ra[5] = rb[5]; ra[6] = rb[6]; ra[7] = rb[7];
    }
}

struct Ptrs {
    const float *x, *ln0_g, *ln0_b, *w_in, *b_gate, *qn_g, *kn_g, *w_a, *w_b, *w_out, *ln1_g, *ln1_b, *w_router, *w_gate_e, *w_up_e, *w_down_e, *ln2_g, *ln2_b;
    float* out; unsigned char* ws;
};
struct Args { Ptrs p; int ph_lo, ph_hi, li, pad; };
typedef const __attribute__((address_space(4))) Args* KArgsP;
__device__ __forceinline__ KArgsP kargs() { KArgsP k = (KArgsP)__builtin_amdgcn_kernarg_segment_ptr(); asm volatile("" : "+s"(k)); return k; }

__device__ __forceinline__ void sincos_rev(float angle, float& sn, float& cs) {
    const double rev = (double)angle * 0.15915494309189533577; const double fr = rev - __builtin_rint(rev);
    sn = __builtin_amdgcn_sinf((float)fr); cs = __builtin_amdgcn_cosf((float)fr);
}
__device__ __forceinline__ void p0_prologue(Frame& F, KArgsP K) {
    LAS float* scr = (LAS float*)(F.lds + RING_OFF + F.wave * 16384);
    const int gw = F.vcu * NWAVES + F.wave, NGW = F.G * NWAVES;
    bf16* win_t = (bf16*)(K->p.ws + WS_WIN); bf16* wa_t = (bf16*)(K->p.ws + WS_WA); bf16* wo_t = (bf16*)(K->p.ws + WS_WO);
    constexpr int I_IN = (1024 / 64) * (5120 / 32), I_A = (512 / 64) * (1024 / 32), I_B = (256 / 64) * (1024 / 32), I_O = (1024 / 64) * (1024 / 32);
    { const float* w_in = K->p.w_in; const float* w_a = K->p.w_a; const float* w_b = K->p.w_b; const float* w_o = K->p.w_out;
      auto decode = [&](int it, TJob& j) {
          int r = it; j.off = 0; j.win = 0; j.kdo = 0;
          if (r < I_IN) { j.src = w_in; j.ldw = 5120; j.dst = win_t; j.ldt = 1024; j.k0 = (r / 160) * 64; j.n0 = (r % 160) * 32; j.win = 1; return; } r -= I_IN;
          if (r < I_A) { j.src = w_a; j.ldw = 1024; j.dst = wa_t; j.ldt = 768; j.k0 = (r / 32) * 64; j.n0 = (r % 32) * 32; j.off = (size_t)j.n0; return; } r -= I_A;
          if (r < I_B) { j.src = w_b; j.ldw = 1024; j.dst = wa_t; j.ldt = 768; j.kdo = 512; j.k0 = (r / 32) * 64; j.n0 = (r % 32) * 32; j.off = (size_t)j.n0; return; } r -= I_B;
          j.src = w_o; j.ldw = 1024; j.dst = wo_t; j.ldt = 1024; j.k0 = (r / 32) * 64; j.n0 = (r % 32) * 32; j.off = (size_t)j.n0; };
      tjobs_run(gw, NGW, I_IN + I_A + I_B + I_O, decode, scr, F.lane); }
    { float* ra = (float*)(K->p.ws + WS_ROPEA); float* rb = (float*)(K->p.ws + WS_ROPEB);
      for (int it = F.vcu * (NWAVES * 64) + F.tid; it < SEQ * 40; it += F.G * NWAVES * 64) {
          const int t = it / 40, r = it - t * 40; float sn, cs;
          if (r < 32) { const int n = r >> 4, f = r & 15; const float pos = n ? (float)(t & 63) : (float)(t >> 6);
              sincos_rev(pos * exp2f(-(float)f * (13.287712379549449f / 16.f)), sn, cs); ra[t * 64 + n * 32 + f] = cs; ra[t * 64 + n * 32 + 16 + f] = sn; }
          else { const int f = r - 32; sincos_rev((float)t * exp2f(-(float)f * (18.931568569324174f / 8.f)), sn, cs); rb[t * 16 + f] = cs; rb[t * 16 + 8 + f] = sn; }
      } }
    bf16* h0b = (bf16*)(K->p.ws + A_H0B); float* st0 = (float*)(K->p.ws + WS_STAT0);
    f32x4 g[4], bb[4];
#pragma unroll
    for (int j = 0; j < 4; ++j) { g[j] = ((const f32x4*)K->p.ln0_g)[F.lane + 64 * j]; bb[j] = ((const f32x4*)K->p.ln0_b)[F.lane + 64 * j]; }
    f32x4 xc[4], xn[4];
    { const GAS f32x4* xr = (const GAS f32x4*)(K->p.x + (size_t)gw * DM) + F.lane;
#pragma unroll
      for (int j = 0; j < 4; ++j) xc[j] = xr[64 * j]; }
    for (int m = gw; m < MTOK; m += NGW) {
        if (m + NGW < MTOK) { const GAS f32x4* xr = (const GAS f32x4*)(K->p.x + (size_t)(m + NGW) * DM) + F.lane;
#pragma unroll
            for (int j = 0; j < 4; ++j) xn[j] = xr[64 * j]; }
        f32x4 v[4]; float s = 0.f;
#pragma unroll
        for (int j = 0; j < 4; ++j) { v[j] = xc[j]; s += (v[j].x + v[j].y) + (v[j].z + v[j].w); }
        const float mean = wave_sum(s) * (1.f / DM); float s2 = 0.f;
#pragma unroll
        for (int j = 0; j < 4; ++j) { v[j] = v[j] - mean; s2 += (v[j].x * v[j].x + v[j].y * v[j].y) + (v[j].z * v[j].z + v[j].w * v[j].w); }
        const float rstd = 1.f / sqrtf(wave_sum(s2) * (1.f / DM) + LN_EPS);
        GAS unsigned long long* o8 = (GAS unsigned long long*)(h0b + (size_t)m * DM) + F.lane;
#pragma unroll
        for (int j = 0; j < 4; ++j) { const f32x4 y = v[j] * rstd * g[j] + bb[j]; o8[64 * j] = (unsigned long long)pk2(y.x, y.y) | ((unsigned long long)pk2(y.z, y.w) << 32); }
        if (F.lane == 0) { st0[2 * m] = mean; st0[2 * m + 1] = rstd; }
#pragma unroll
        for (int j = 0; j < 4; ++j) xc[j] = xn[j];
    }
}

__device__ __forceinline__ void p3b_combine(Frame& F, KArgsP K) {
    const bf16* obg = (const bf16*)(K->p.ws + A_OBG); const float* lse = (const float*)(K->p.ws + WS_LSE); bf16* ob = (bf16*)(K->p.ws + A_ATTNA) + 512;
    for (int it = F.vcu; it < MTOK / 16; it += F.G) {
        const int m = it * 16 + (F.tid >> 5), ch = F.tid & 31, j = ch >> 3;
        const float l0 = lse[((size_t)0 * MTOK + m) * 4 + j], l1 = lse[((size_t)1 * MTOK + m) * 4 + j], l2 = lse[((size_t)2 * MTOK + m) * 4 + j];
        const float mx = fmaxf(l0, fmaxf(l1, l2)); float w0 = exp2f(l0 - mx), w1 = exp2f(l1 - mx), w2 = exp2f(l2 - mx); const float rs = 1.0f / (w0 + w1 + w2); w0 *= rs; w1 *= rs; w2 *= rs;
        const v4u a = *(const v4u*)(obg + ((size_t)0 * MTOK + m) * 256 + ch * 8), b = *(const v4u*)(obg + ((size_t)1 * MTOK + m) * 256 + ch * 8), c = *(const v4u*)(obg + ((size_t)2 * MTOK + m) * 256 + ch * 8);
        v4u o;
        o.x = pk2(w0 * pg8::bf_lo(a.x) + w1 * pg8::bf_lo(b.x) + w2 * pg8::bf_lo(c.x), w0 * pg8::bf_hi(a.x) + w1 * pg8::bf_hi(b.x) + w2 * pg8::bf_hi(c.x));
        o.y = pk2(w0 * pg8::bf_lo(a.y) + w1 * pg8::bf_lo(b.y) + w2 * pg8::bf_lo(c.y), w0 * pg8::bf_hi(a.y) + w1 * pg8::bf_hi(b.y) + w2 * pg8::bf_hi(c.y));
        o.z = pk2(w0 * pg8::bf_lo(a.z) + w1 * pg8::bf_lo(b.z) + w2 * pg8::bf_lo(c.z), w0 * pg8::bf_hi(a.z) + w1 * pg8::bf_hi(b.z) + w2 * pg8::bf_hi(c.z));
        o.w = pk2(w0 * pg8::bf_lo(a.w) + w1 * pg8::bf_lo(b.w) + w2 * pg8::bf_lo(c.w), w0 * pg8::bf_hi(a.w) + w1 * pg8::bf_hi(b.w) + w2 * pg8::bf_hi(c.w));
        *(v4u*)(ob + (size_t)m * 768 + ch * 8) = o;
    }
}

__device__ __forceinline__ void convert_experts(Frame& F, KArgsP K) {
    const int gw = F.vcu * NWAVES + F.wave, NGW = F.G * NWAVES;
    { LAS float* scr = (LAS float*)(F.lds + RING_OFF + F.wave * 16384);
      bf16* wgu = (bf16*)K->p.out; bf16* wd = (bf16*)(K->p.ws + A_WD);
      constexpr int I_G = 16 * 64, I_D = 32 * 32, PER_E = 2 * I_G + I_D;
      const float* wg = K->p.w_gate_e; const float* wu = K->p.w_up_e; const float* wdn = K->p.w_down_e;
      auto decode = [&](int it, TJob& j) {
          const int e = it / PER_E; int r = it - e * PER_E; j.win = 0; j.kdo = 0;
          if (r < 2 * I_G) { const int up = r >= I_G; r -= up * I_G; j.src = (up ? wu : wg) + (size_t)e * DM * DFF; j.ldw = DFF; j.dst = wgu; j.ldt = 1024; j.k0 = (r / 64) * 64; j.n0 = (r % 64) * 32;
              j.off = (size_t)e * 4096 + (j.n0 >> 7) * 256 + up * 128 + (j.n0 & 127); return; }
          r -= 2 * I_G; j.src = wdn + (size_t)e * DFF * DM; j.ldw = DM; j.dst = wd; j.ldt = 2048; j.k0 = (r / 32) * 64; j.n0 = (r % 32) * 32; j.off = (size_t)e * 1024 + j.n0; };
      tjobs_run(gw, NGW, NEXP * PER_E, decode, scr, F.lane); }
}

__device__ __forceinline__ void p5_ln1_router_convert(Frame& F, KArgsP K) {
    const int gw = F.vcu * NWAVES + F.wave, NGW = F.G * NWAVES;
    __syncthreads();
    { LAS f32x4* wl = (LAS f32x4*)(F.lds + RING_OFF); const f32x4* wr4 = (const f32x4*)K->p.w_router;
      for (int q = F.tid; q < 1024 * 4; q += NWAVES * 64) { const int col = q >> 2, e4 = q & 3; const int l = (col & 255) >> 2, i = col & 3, j = col >> 8;
          wl[((j * 4 + i) * 4 + e4) * 64 + l] = wr4[q]; } }
    __syncthreads();
    const bf16* mix = (const bf16*)(K->p.ws + A_MIX); bf16* h1b = (bf16*)(K->p.ws + A_H1B); const float* st0 = (const float*)(K->p.ws + WS_STAT0); float* aff = (float*)(K->p.ws + WS_AFF);
    f32x4 xv[4], xn[4]; u32x2 mw[4], mn[4]; float mean0 = 0.f, rstd0 = 0.f, mean0n = 0.f, rstd0n = 0.f;
    int m = gw;
    if (m < MTOK) { const GAS f32x4* xr = (const GAS f32x4*)(K->p.x + (size_t)m * DM) + F.lane; const GAS u32x2* mr = (const GAS u32x2*)(mix + (size_t)m * DM) + F.lane;
#pragma unroll
        for (int j = 0; j < 4; ++j) { xv[j] = xr[64 * j]; mw[j] = mr[64 * j]; }
        mean0 = st0[2 * m]; rstd0 = st0[2 * m + 1]; }
    for (; m < MTOK; m += NGW) {
        const int mnx = m + NGW;
        if (mnx < MTOK) { const GAS f32x4* xr = (const GAS f32x4*)(K->p.x + (size_t)mnx * DM) + F.lane; const GAS u32x2* mr = (const GAS u32x2*)(mix + (size_t)mnx * DM) + F.lane;
#pragma unroll
            for (int j = 0; j < 4; ++j) { xn[j] = xr[64 * j]; mn[j] = mr[64 * j]; }
            mean0n = st0[2 * mnx]; rstd0n = st0[2 * mnx + 1]; }
        f32x4 v[4]; float s = 0.f;
#pragma unroll
        for (int j = 0; j < 4; ++j) {
            const f32x4 g0 = ((const f32x4*)K->p.ln0_g)[F.lane + 64 * j], b0 = ((const f32x4*)K->p.ln0_b)[F.lane + 64 * j];
            const f32x4 h0 = (xv[j] - mean0) * rstd0 * g0 + b0;
            v[j] = h0 * ALPHA + (f32x4){pg8::bf_lo(mw[j].x), pg8::bf_hi(mw[j].x), pg8::bf_lo(mw[j].y), pg8::bf_hi(mw[j].y)};
            s += (v[j].x + v[j].y) + (v[j].z + v[j].w); }
        const float mean = wave_sum(s) * (1.f / DM); float s2 = 0.f;
#pragma unroll
        for (int j = 0; j < 4; ++j) { v[j] = v[j] - mean; s2 += (v[j].x * v[j].x + v[j].y * v[j].y) + (v[j].z * v[j].z + v[j].w * v[j].w); }
        const float rstd = 1.f / sqrtf(wave_sum(s2) * (1.f / DM) + LN_EPS);
        GAS unsigned long long* o8 = (GAS unsigned long long*)(h1b + (size_t)m * DM) + F.lane;
        float lg[16];
#pragma unroll
        for (int e = 0; e < 16; ++e) lg[e] = 0.f;
#pragma unroll
        for (int j = 0; j < 4; ++j) { const f32x4 g1 = ((const f32x4*)K->p.ln1_g)[F.lane + 64 * j], b1 = ((const f32x4*)K->p.ln1_b)[F.lane + 64 * j];
            const f32x4 y = v[j] * rstd * g1 + b1;
            o8[64 * j] = (unsigned long long)pk2(y.x, y.y) | ((unsigned long long)pk2(y.z, y.w) << 32);
            const LAS f32x4* wl = (const LAS f32x4*)(F.lds + RING_OFF) + F.lane;
            asm volatile("" ::: "memory");
#pragma unroll
            for (int i = 0; i < 4; ++i) { const float yv = y[i];
#pragma unroll
                for (int c = 0; c < 4; ++c) { const f32x4 w = wl[((j * 4 + i) * 4 + c) * 64]; lg[4 * c] += yv * w.x; lg[4 * c + 1] += yv * w.y; lg[4 * c + 2] += yv * w.z; lg[4 * c + 3] += yv * w.w; } } }
#pragma unroll
        for (int e = 0; e < 16; ++e) lg[e] = wave_sum(lg[e]);
        float mx = lg[0];
#pragma unroll
        for (int e = 1; e < 16; ++e) mx = fmaxf(mx, lg[e]);
        float se = 0.f;
#pragma unroll
        for (int e = 0; e < 16; ++e) { lg[e] = expf(lg[e] - mx); se += lg[e]; }
        float mine = 0.f;
#pragma unroll
        for (int e = 0; e < 16; ++e) if (F.lane == e) mine = lg[e] / se;
        if (F.lane < 16) aff[(size_t)m * 16 + F.lane] = mine;
#pragma unroll
        for (int j = 0; j < 4; ++j) { xv[j] = xn[j]; mw[j] = mn[j]; }
        mean0 = mean0n; rstd0 = rstd0n;
    }
}

__device__ __forceinline__ void p6_topk_unit(Frame& F, KArgsP K, int unit) {
    const int e = unit >> 4, b = unit & 15;
    const float* aff = (const float*)(K->p.ws + WS_AFF); short* inv = (short*)(K->p.ws + WS_INV); int* tok = (int*)(K->p.ws + WS_TOK);
    const bf16* h1b = (const bf16*)(K->p.ws + A_H1B); bf16* xe = (bf16*)(K->p.ws + A_XE);
    LAS unsigned* cnt = (LAS unsigned*)(F.lds + RING_OFF);
    LAS int* ltok = (LAS int*)(F.lds + RING_OFF + 256);
    unsigned key[4];
#pragma unroll
    for (int i = 0; i < 4; ++i) key[i] = __float_as_uint(aff[((size_t)b * SEQ + 4 * F.tid + i) * 16 + e]);
    __syncthreads();
    unsigned thr = 0u;
    for (int bit = 31; bit >= 0; --bit) {
        const unsigned cand = thr | (1u << bit);
        unsigned c = 0;
#pragma unroll
        for (int i = 0; i < 4; ++i) c += (unsigned)__popcll(__ballot(key[i] >= cand));
        LAS unsigned* cb = cnt + ((bit & 1) ? 8 : 0);
        if (F.lane == 0) cb[F.wave] = c;
        __syncthreads();
        unsigned tot = 0;
#pragma unroll
        for (int w = 0; w < 8; ++w) tot += cb[w];
        if (tot >= (unsigned)CAP) thr = cand;
    }
    __syncthreads();
    unsigned cg = 0, ce = 0;
#pragma unroll
    for (int i = 0; i < 4; ++i) { cg += key[i] > thr; ce += key[i] == thr; }
    unsigned pk = cg | (ce << 16), inc = pk;
#pragma unroll
    for (int o = 1; o < 64; o <<= 1) { const unsigned up = __shfl_up(inc, o); if (F.lane >= o) inc += up; }
    if (F.lane == 63) cnt[16 + F.wave] = inc;
    __syncthreads();
    unsigned base = 0, total = 0;
#pragma unroll
    for (int w = 0; w < 8; ++w) { const unsigned tw = cnt[16 + w]; if (w < F.wave) base += tw; total += tw; }
    const unsigned excl = base + inc - pk;
    unsigned pg = excl & 0xffffu, pe = excl >> 16; const unsigned ngt = total & 0xffffu; const unsigned need = (unsigned)CAP - ngt;
#pragma unroll
    for (int i = 0; i < 4; ++i) {
        const int t = 4 * F.tid + i; int slot = -1;
        if (key[i] > thr) { slot = (int)(pg + (pe < need ? pe : need)); ++pg; }
        else if (key[i] == thr) { if (pe < need) slot = (int)(pg + pe); ++pe; }
        inv[((size_t)b * SEQ + t) * 16 + e] = (short)slot;
        if (slot >= 0) { ltok[slot] = t; tok[unit * CAP + slot] = t; }
    }
    __syncthreads();
    for (int c0 = F.wave * 4; c0 < CAP; c0 += NWAVES * 4) {
        v4u a[4][2];
#pragma unroll
        for (int q = 0; q < 4; ++q) { const v4u* src = (const v4u*)(h1b + ((size_t)b * SEQ + ltok[c0 + q]) * DM); a[q][0] = src[F.lane]; a[q][1] = src[F.lane + 64]; }
#pragma unroll
        for (int q = 0; q < 4; ++q) { v4u* dst = (v4u*)(xe + ((size_t)unit * CAP + c0 + q) * DM); dst[F.lane] = a[q][0]; dst[F.lane + 64] = a[q][1]; }
    }
    __syncthreads();
}

__device__ __forceinline__ void p9_final(Frame& F, KArgsP K) {
    const int gw = F.vcu * NWAVES + F.wave, NGW = F.G * NWAVES;
    const float* aff = (const float*)(K->p.ws + WS_AFF); const short* inv = (const short*)(K->p.ws + WS_INV); const bf16* ye = (const bf16*)(K->p.ws + A_YE); const bf16* h1b = (const bf16*)(K->p.ws + A_H1B);
    f32x4 g2[2][2], b2[2][2];
#pragma unroll
    for (int jj = 0; jj < 2; ++jj)
#pragma unroll
        for (int q = 0; q < 2; ++q) { g2[jj][q] = *(const f32x4*)(K->p.ln2_g + 512 * jj + 8 * F.lane + 4 * q); b2[jj][q] = *(const f32x4*)(K->p.ln2_b + 512 * jj + 8 * F.lane + 4 * q); }
#define UNPK8(D_, W_, S_) do { D_[0] = pg8::bf_lo(W_.x) * (S_); D_[1] = pg8::bf_hi(W_.x) * (S_); D_[2] = pg8::bf_lo(W_.y) * (S_); D_[3] = pg8::bf_hi(W_.y) * (S_); \
                               D_[4] = pg8::bf_lo(W_.z) * (S_); D_[5] = pg8::bf_hi(W_.z) * (S_); D_[6] = pg8::bf_lo(W_[3]) * (S_); D_[7] = pg8::bf_hi(W_[3]) * (S_); } while (0)
#define FMA8(D_, W_, S_) do { D_[0] += pg8::bf_lo(W_.x) * (S_); D_[1] += pg8::bf_hi(W_.x) * (S_); D_[2] += pg8::bf_lo(W_.y) * (S_); D_[3] += pg8::bf_hi(W_.y) * (S_); \
                              D_[4] += pg8::bf_lo(W_.z) * (S_); D_[5] += pg8::bf_hi(W_.z) * (S_); D_[6] += pg8::bf_lo(W_[3]) * (S_); D_[7] += pg8::bf_hi(W_[3]) * (S_); } while (0)
    for (int m0 = gw; m0 < MTOK; m0 += 2 * NGW) {
        const int mA = m0, mB = m0 + NGW; const int bA = mA >> 11, bB = mB >> 11;
        const int ivA = (F.lane < 16) ? (int)inv[(size_t)mA * 16 + F.lane] : -1, ivB = (F.lane < 16) ? (int)inv[(size_t)mB * 16 + F.lane] : -1;
        const float afA = (F.lane < 16) ? aff[(size_t)mA * 16 + F.lane] : 0.f, afB = (F.lane < 16) ? aff[(size_t)mB * 16 + F.lane] : 0.f;
        const v4u* hA = (const v4u*)(h1b + (size_t)mA * DM) + F.lane; const v4u* hB = (const v4u*)(h1b + (size_t)mB * DM) + F.lane;
        const v4u hA0 = hA[0], hA1 = hA[64], hB0 = hB[0], hB1 = hB[64];
        unsigned long long mkA = __ballot(ivA >= 0), mkB = __ballot(ivB >= 0);
        float vA[2][8], vB[2][8];
        UNPK8(vA[0], hA0, ALPHA); UNPK8(vA[1], hA1, ALPHA); UNPK8(vB[0], hB0, ALPHA); UNPK8(vB[1], hB1, ALPHA);
        while (mkA | mkB) {
            int eA0 = 0, eA1 = 0, eB0 = 0, eB1 = 0; float gA0 = 0.f, gA1 = 0.f, gB0 = 0.f, gB1 = 0.f;
            const v4u *yA0 = hA, *yA1 = hA, *yB0 = hB, *yB1 = hB;
            if (mkA) { eA0 = __builtin_ctzll(mkA); mkA &= mkA - 1; gA0 = __builtin_bit_cast(float, __builtin_amdgcn_readlane(__builtin_bit_cast(int, afA), eA0));
                       yA0 = (const v4u*)(ye + ((size_t)(eA0 * 16 + bA) * CAP + __builtin_amdgcn_readlane(ivA, eA0)) * DM) + F.lane; }
            if (mkA) { eA1 = __builtin_ctzll(mkA); mkA &= mkA - 1; gA1 = __builtin_bit_cast(float, __builtin_amdgcn_readlane(__builtin_bit_cast(int, afA), eA1));
                       yA1 = (const v4u*)(ye + ((size_t)(eA1 * 16 + bA) * CAP + __builtin_amdgcn_readlane(ivA, eA1)) * DM) + F.lane; }
            if (mkB) { eB0 = __builtin_ctzll(mkB); mkB &= mkB - 1; gB0 = __builtin_bit_cast(float, __builtin_amdgcn_readlane(__builtin_bit_cast(int, afB), eB0));
                       yB0 = (const v4u*)(ye + ((size_t)(eB0 * 16 + bB) * CAP + __builtin_amdgcn_readlane(ivB, eB0)) * DM) + F.lane; }
            if (mkB) { eB1 = __builtin_ctzll(mkB); mkB &= mkB - 1; gB1 = __builtin_bit_cast(float, __builtin_amdgcn_readlane(__builtin_bit_cast(int, afB), eB1));
                       yB1 = (const v4u*)(ye + ((size_t)(eB1 * 16 + bB) * CAP + __builtin_amdgcn_readlane(ivB, eB1)) * DM) + F.lane; }
            const v4u a0 = yA0[0], a1 = yA0[64], a2 = yA1[0], a3 = yA1[64], c0 = yB0[0], c1 = yB0[64], c2 = yB1[0], c3 = yB1[64];
            FMA8(vA[0], a0, gA0); FMA8(vA[1], a1, gA0); FMA8(vA[0], a2, gA1); FMA8(vA[1], a3, gA1);
            FMA8(vB[0], c0, gB0); FMA8(vB[1], c1, gB0); FMA8(vB[0], c2, gB1); FMA8(vB[1], c3, gB1);
        }
        float sA = 0.f, sB = 0.f;
#pragma unroll
        for (int jj = 0; jj < 2; ++jj)
#pragma unroll
            for (int q = 0; q < 8; ++q) { sA += vA[jj][q]; sB += vB[jj][q]; }
        const float meanA = wave_sum(sA) * (1.f / DM), meanB = wave_sum(sB) * (1.f / DM); float qA = 0.f, qB = 0.f;
#pragma unroll
        for (int jj = 0; jj < 2; ++jj)
#pragma unroll
            for (int q = 0; q < 8; ++q) { vA[jj][q] -= meanA; qA += vA[jj][q] * vA[jj][q]; vB[jj][q] -= meanB; qB += vB[jj][q] * vB[jj][q]; }
        const float rsA = 1.f / sqrtf(wave_sum(qA) * (1.f / DM) + LN_EPS), rsB = 1.f / sqrtf(wave_sum(qB) * (1.f / DM) + LN_EPS);
        float* oA = K->p.out + (size_t)mA * DM + 8 * F.lane; float* oB = K->p.out + (size_t)mB * DM + 8 * F.lane;
#pragma unroll
        for (int jj = 0; jj < 2; ++jj)
#pragma unroll
            for (int q = 0; q < 2; ++q) {
                f32x4 o; o.x = vA[jj][4 * q] * rsA; o.y = vA[jj][4 * q + 1] * rsA; o.z = vA[jj][4 * q + 2] * rsA; o.w = vA[jj][4 * q + 3] * rsA;
                *(GAS f32x4*)(oA + 512 * jj + 4 * q) = o * g2[jj][q] + b2[jj][q];
                f32x4 p; p.x = vB[jj][4 * q] * rsB; p.y = vB[jj][4 * q + 1] * rsB; p.z = vB[jj][4 * q + 2] * rsB; p.w = vB[jj][4 * q + 3] * rsB;
                *(GAS f32x4*)(oB + 512 * jj + 4 * q) = p * g2[jj][q] + b2[jj][q]; }
    }
#undef UNPK8
#undef FMA8
}

struct OrderUp {
    int vcu;
    __device__ __forceinline__ bool next(int i, pg8::Unit& u) const {
        if (i >= NEXP) return false;
        const int e = i, x = vcu >> 5, l = vcu & 31, b = (x >> 1) * 4 + (l & 3), j = (x & 1) * 8 + (l >> 2);
        u.pm = e * 16 + b; u.pn = j; u.am = e * 16 + b; u.bt = e * 16 + j; return true;
    }
    __device__ __forceinline__ void a_ready(const pg8::Unit&) const {}
    __device__ __forceinline__ void done(const pg8::Unit&) const {}
};
struct OrderDown {
    int vcu;
    __device__ __forceinline__ bool next(int i, pg8::Unit& u) const {
        if (i >= 4) return false;
        const int x = vcu >> 5, l = vcu & 31, pm = i * 64 + x * 8 + (l & 7), pn = l >> 3;
        u.pm = pm; u.pn = pn; u.am = pm; u.bt = (pm >> 4) * 4 + pn; return true;
    }
    __device__ __forceinline__ void a_ready(const pg8::Unit&) const {}
    __device__ __forceinline__ void done(const pg8::Unit&) const {}
};

#ifndef MK_N_LAUNCHES
#define MK_N_LAUNCHES 1
#endif
constexpr int N_PHASES = 13;
#ifndef REP_P0
#define REP_P0 1
#endif
#ifndef REP_P1
#define REP_P1 1
#endif
#ifndef REP_DENSE
#define REP_DENSE 1
#endif
#ifndef REP_BAND
#define REP_BAND 1
#endif
#ifndef REP_WOUT
#define REP_WOUT 1
#endif
#ifndef REP_P6
#define REP_P6 1
#endif
#ifndef REP_TOPK
#define REP_TOPK 1
#endif
#ifndef REP_UP
#define REP_UP 1
#endif
#ifndef REP_DOWN
#define REP_DOWN 1
#endif
#define REPEAT(n) _Pragma("unroll 1") for (int rep_ = 0; rep_ < (n); ++rep_)
__global__ void __launch_bounds__(NWAVES * 64, 2) fwd_kernel(Args args) {
    extern __shared__ __attribute__((aligned(16))) unsigned char lds[];
#define MKFRAME(F) Frame F; { int t_ = threadIdx.x; asm volatile("" : "+v"(t_)); F.lds = (LAS unsigned char*)lds; F.MISC = (volatile LAS unsigned*)(F.lds + MISC_OFF); F.ctl = nullptr; \
        F.tid = t_; F.lane = t_ & 63; F.wave = __builtin_amdgcn_readfirstlane(t_ >> 6); F.G = 256; const int bx_ = blockIdx.x; F.vcu = (bx_ & 7) * 32 + (bx_ >> 3); }
#define BP(off) ((bf16*)(kargs()->p.ws + (off)))
#define SEAM() do { XcdBarrier b_; b_.bar = (unsigned*)(kargs()->p.ws + WS_CTL) + CW_BAR; b_.x = xb_xcc_id(); b_.st = (volatile LAS unsigned*)((LAS unsigned char*)lds + MISC_OFF) + 8; xcd_barrier(b_); } while (0)
    { const int t_ = threadIdx.x;
      for (int u = t_; u < (LDS_BYTES - LDSCTL_OFF) / 4; u += NWAVES * 64) ((LAS unsigned*)((LAS unsigned char*)lds + LDSCTL_OFF))[u] = 0u;
      __syncthreads();
      (void)xcd_barrier_post((unsigned*)(kargs()->p.ws + WS_CTL) + CW_BAR, (volatile LAS unsigned*)((LAS unsigned char*)lds + MISC_OFF) + 8); }

    REPEAT(REP_P0) { MKFRAME(F); p0_prologue(F, kargs()); } SEAM();
    REPEAT(REP_P1) { MKFRAME(F);
      pg8::Gemm g{BP(A_H0B), (const bf16*)(kargs()->p.ws + WS_WIN), MTOK, 5120, 1024}; pg8::StaticOrder S; S.init(MTOK, 5120, 256, (int)blockIdx.x);
      pg8::EpiProj2 E{BP(A_QKV), BP(A_GATES), kargs()->p.b_gate, kargs()->p.qn_g, kargs()->p.kn_g, (const float*)(kargs()->p.ws + WS_ROPEA), (const float*)(kargs()->p.ws + WS_ROPEB)};
      pg8::gemm_phase<pg8::EpiProj2, pg8::StaticOrder, true, true>(F.lds + RING_OFF, g, S, E); } SEAM();
    REPEAT(REP_DENSE) { MKFRAME(F);
      { const attn_body::bf16* q_ = (const attn_body::bf16*)BP(A_QKV); attn_body::bf16* o_ = (attn_body::bf16*)BP(A_ATTNA);
        const int g = F.vcu >> 3, s = F.vcu & 7, ab = g >> 1, akvh = g & 1;
        const int cpos = F.vcu % 5;
#pragma unroll 1
        for (int i = 0; i < 5; ++i) {
            if (i == cpos) { convert_experts(F, kargs()); asm volatile("s_waitcnt vmcnt(0) lgkmcnt(0)" ::: "memory"); __syncthreads(); }
            if (i < 4) attn_body::attn_unit<8>(ab, akvh * 4 + i, akvh, s, q_ + OFF_QA, q_ + OFF_KA, q_ + OFF_VA, o_, (char*)lds + RING_OFF);
        } }
      __syncthreads();
    }
    REPEAT(REP_BAND) { MKFRAME(F);
#pragma unroll 1
      for (int i = 0; i < 6; ++i) attn_body::band_half_unit(F.vcu + 256 * i, (const attn_body::bf16*)BP(A_QKV), OFF_QB, OFF_KB, OFF_VB, (attn_body::bf16*)BP(A_OBG), (float*)(kargs()->p.ws + WS_LSE), (char*)lds + RING_OFF, (char*)lds + BANDWS_OFF);
      __syncthreads(); } SEAM();
    { MKFRAME(F); p3b_combine(F, kargs()); } SEAM();
    { MKFRAME(F);
      pg8::Gemm g{BP(A_ATTNA), (const bf16*)(kargs()->p.ws + WS_WA), MTOK, 1024, 768}; pg8::StaticOrder S; S.init(MTOK, 1024, 256, (int)blockIdx.x);
      pg8::EpiGateMerge E{BP(A_MERGED), BP(A_GATES)};
      pg8::gemm_phase<pg8::EpiGateMerge, pg8::StaticOrder, true, true>(F.lds + RING_OFF, g, S, E); } SEAM();
    REPEAT(REP_WOUT) { MKFRAME(F);
      pg8::Gemm g{BP(A_MERGED), (const bf16*)(kargs()->p.ws + WS_WO), MTOK, 1024, 1024}; pg8::StaticOrder S; S.init(MTOK, 1024, 256, (int)blockIdx.x);
      pg8::EpiPlain E{BP(A_MIX), 1024};
      pg8::gemm_phase<pg8::EpiPlain, pg8::StaticOrder, true, true>(F.lds + RING_OFF, g, S, E); } SEAM();
    REPEAT(REP_P6) { MKFRAME(F); p5_ln1_router_convert(F, kargs()); } SEAM();
    REPEAT(REP_TOPK) { MKFRAME(F); p6_topk_unit(F, kargs(), F.vcu); } SEAM();
    REPEAT(REP_UP) { MKFRAME(F); pg8::Gemm g{BP(A_XE), (const bf16*)kargs()->p.out, 0, 0, 1024}; OrderUp S{F.vcu}; pg8::EpiSwiglu E{BP(A_ACT)};
      pg8::gemm_phase<pg8::EpiSwiglu, OrderUp, true, true>(F.lds + RING_OFF, g, S, E); } SEAM();
    REPEAT(REP_DOWN) { MKFRAME(F); pg8::Gemm g{BP(A_ACT), (const bf16*)(kargs()->p.ws + A_WD), 0, 0, 2048}; OrderDown S{F.vcu}; pg8::EpiPlain E{BP(A_YE), 1024};
      pg8::gemm_phase<pg8::EpiPlain, OrderDown, true, true>(F.lds + RING_OFF, g, S, E); } SEAM();
    { MKFRAME(F); p9_final(F, kargs()); }
#undef MKFRAME
#undef BP
#undef SEAM
}

extern "C" void kernel_launch(void* const* d_in, const int* in_sizes, int n_in, void* d_out, int out_size, void* d_ws, size_t ws_size, hipStream_t stream) {
    static int grid = 0;
    if (grid == 0) {
        if (n_in != 18 || in_sizes[0] != MTOK * DM || out_size != MTOK * DM || ws_size < WS_END) { fprintf(stderr, "kernel_launch: unexpected shapes / workspace (n_in %d, ws %zu, need %zu)\n", n_in, ws_size, (size_t)WS_END); grid = -1; return; }
        if (hipFuncSetAttribute((const void*)fwd_kernel, hipFuncAttributeMaxDynamicSharedMemorySize, LDS_BYTES) != hipSuccess) { fprintf(stderr, "kernel_launch: hipFuncSetAttribute failed\n"); grid = -1; return; }
        (void)hipGetLastError();
        grid = 256;
    }
    if (grid < 0) return;
    if (hipMemsetAsync((char*)d_ws + WS_CTL, 0, CTL_ZERO_BYTES, stream) != hipSuccess) return;
    Args a{};
    const float** pp = (const float**)&a.p;
    for (int i = 0; i < 18; ++i) pp[i] = (const float*)d_in[i];
    a.p.out = (float*)d_out; a.p.ws = (unsigned char*)d_ws;
    a.ph_lo = 0; a.ph_hi = N_PHASES; a.li = 0;
    hipLaunchKernelGGL(fwd_kernel, dim3(grid), dim3(NWAVES * 64), LDS_BYTES, stream, a);
}
```

```cpp
#include <hip/hip_runtime.h>
#include <cstdio>
#include <cstdint>
constexpr int NWAVES = 8;
constexpr int BATCH = 16, SEQ = 2048, DM = 1024, MTOK = BATCH * SEQ;
constexpr int NEXP = 16, CAP = 256, DFF = 2048, NSLOT = BATCH * NEXP * CAP;
constexpr int QKVW = 3072, GATEW = 2048;
constexpr int OFF_QA = 0, OFF_KA = 512, OFF_VA = 640, OFF_QB = 768, OFF_KB = 1536, OFF_VB = 2304;
constexpr float LN_EPS = 1e-5f, QK_EPS = 1e-6f;
constexpr float ALPHA = 1.189207115002721f;
constexpr float C2 = 0.125f * 1.4426950408889634f;

namespace pg8 {
#define PG8_LAS __attribute__((address_space(3)))
typedef unsigned short bf16_t;
typedef short bf16x8 __attribute__((ext_vector_type(8)));
typedef float f32x4 __attribute__((ext_vector_type(4)));
typedef unsigned u32x4 __attribute__((ext_vector_type(4)));
constexpr int BM = 256, BK = 64, HALF = 128, HTB = HALF * BK * 2  , STAGE_BYTES = 8 * HTB, NXCD = 8, WGM = 8;

__host__ __device__ __forceinline__ int lds_byte(int r, int c) { const int st = (r >> 4) * 2 + (c >> 5), rr = r & 15, cc = c & 31, ob = rr * 64 + cc * 2; return st * 1024 + (ob ^ (((ob >> 9) & 1) << 5)); }
__host__ __device__ __forceinline__ void stage_rc(int b, int& R, int& C) { const int st = b / 1024, sb = b % 1024, swz = sb ^ (((sb >> 9) & 1) << 5); R = (st >> 1) * 16 + swz / 64; C = (st & 1) * 32 + (swz % 64) / 2; }
__host__ __device__ __forceinline__ int perm32(int rho) { const int n = rho >> 4, i = rho & 15; return 8 * (i >> 2) + 4 * n + (i & 3); }

struct Unit { int pm, pn, am, bt; };
struct Gemm { const bf16_t* A; const bf16_t* Bt; int M, N, K; const PG8_LAS unsigned short* gidx; };

struct StaticOrder {
    int nM, nN, nwg, G, c;
    __host__ __device__ void init(int M, int N, int G_, int c_) { nM = M / BM; nN = N / BM; nwg = nM * nN; G = G_; c = c_; }
    __host__ __device__ bool next(int i, Unit& u) const {
        const long L = (long)i * G + c; if (L >= nwg) return false;
        int wgid = (int)L; { const int q = nwg / NXCD, r = nwg % NXCD, xcd = wgid % NXCD, off = wgid / NXCD; wgid = (xcd < r ? xcd * (q + 1) : r * (q + 1) + (xcd - r) * q) + off; }
        const int nig = WGM * nN, gid = wgid / nig, fm = gid * WGM, gsz = (nM - fm) < WGM ? (nM - fm) : WGM;
        u.pm = fm + ((wgid % nig) % gsz); u.pn = (wgid % nig) / gsz; u.am = u.pm; u.bt = u.pn; return true;
    }
    __device__ __forceinline__ void a_ready(const Unit&) const {}
    __device__ __forceinline__ void done(const Unit&) const {}
};

typedef float f32x2_cv __attribute__((ext_vector_type(2))); typedef __bf16 bf16x2_cv __attribute__((ext_vector_type(2)));
__device__ __forceinline__ unsigned cvt_pk_bf16(float lo, float hi) { f32x2_cv v = {lo, hi}; bf16x2_cv b = __builtin_convertvector(v, bf16x2_cv); return __builtin_bit_cast(unsigned, b); }
__device__ __forceinline__ float bf_lo(unsigned w) { return __uint_as_float(w << 16); }
__device__ __forceinline__ float bf_hi(unsigned w) { return __uint_as_float(w & 0xffff0000u); }
__device__ __forceinline__ float sigmoidf_(float x) { return __builtin_amdgcn_rcpf(1.0f + __builtin_amdgcn_exp2f(-1.4426950408889634f * x)); }
__device__ __forceinline__ u32x4 pack8(const f32x4 v0, const f32x4 v1) { u32x4 w; w.x = cvt_pk_bf16(v0[0], v0[1]); w.y = cvt_pk_bf16(v0[2], v0[3]); w.z = cvt_pk_bf16(v1[0], v1[1]); w.w = cvt_pk_bf16(v1[2], v1[3]); return w; }

struct EpiProj {
    static constexpr bool PERM = true, AFTER_DRAIN = false; static constexpr int MID_TILES = 0;
    bf16_t* qkv; bf16_t* gates; const float* b_gate;
    __device__ __forceinline__ void operator()(const f32x4 (&acc)[2][2][4][2], const Unit& u, int wr, int wc, int fr, int fq) const {
        const int row0 = u.pm * BM + wr * 64 + fr;
        const bool isg = u.pn >= 12;
        bf16_t* base = isg ? gates : qkv; const int ldc = isg ? 2048 : 3072; const int colt = isg ? (u.pn - 12) * BM : u.pn * BM;
        const int col0 = colt + wc * 32 + 8 * fq;
        f32x4 bv[2][2];
#pragma unroll
        for (int bj = 0; bj < 2; ++bj)
#pragma unroll
            for (int n = 0; n < 2; ++n) bv[bj][n] = isg ? *(const f32x4*)(b_gate + col0 + bj * HALF + 4 * n) : (f32x4){0.f, 0.f, 0.f, 0.f};
#pragma unroll
        for (int ai = 0; ai < 2; ++ai)
#pragma unroll
            for (int m = 0; m < 4; ++m) { bf16_t* rowp = base + (size_t)(row0 + ai * HALF + m * 16) * ldc + col0;
#pragma unroll
                for (int bj = 0; bj < 2; ++bj) { f32x4 v0 = acc[ai][bj][m][0] + bv[bj][0], v1 = acc[ai][bj][m][1] + bv[bj][1];
                    if (isg) {
#pragma unroll
                        for (int i = 0; i < 4; ++i) { v0[i] = sigmoidf_(v0[i]); v1[i] = sigmoidf_(v1[i]); } }
                    *(u32x4*)(rowp + bj * HALF) = pack8(v0, v1); } }
    }
};
struct EpiPlain {
    static constexpr bool PERM = true, AFTER_DRAIN = false; static constexpr int MID_TILES = 0;
    bf16_t* O; int ldc;
    __device__ __forceinline__ void operator()(const f32x4 (&acc)[2][2][4][2], const Unit& u, int wr, int wc, int fr, int fq) const {
        const int row0 = u.pm * BM + wr * 64 + fr; const int col0 = u.pn * BM + wc * 32 + 8 * fq;
#pragma unroll
        for (int ai = 0; ai < 2; ++ai)
#pragma unroll
            for (int m = 0; m < 4; ++m) { bf16_t* rowp = O + (size_t)(row0 + ai * HALF + m * 16) * ldc + col0;
#pragma unroll
                for (int bj = 0; bj < 2; ++bj) *(u32x4*)(rowp + bj * HALF) = pack8(acc[ai][bj][m][0], acc[ai][bj][m][1]); }
    }
};
template <bool ACCUM> struct EpiGate {
    static constexpr bool PERM = true, AFTER_DRAIN = false; static constexpr int MID_TILES = 0;
    bf16_t* merged; const bf16_t* gates; int goff;
    __device__ __forceinline__ void operator()(const f32x4 (&acc)[2][2][4][2], const Unit& u, int wr, int wc, int fr, int fq) const {
        const int row0 = u.pm * BM + wr * 64 + fr; const int col0 = u.pn * BM + wc * 32 + 8 * fq;
#pragma unroll
        for (int ai = 0; ai < 2; ++ai)
#pragma unroll
            for (int m = 0; m < 4; ++m) { const size_t r = (size_t)(row0 + ai * HALF + m * 16);
#pragma unroll
                for (int bj = 0; bj < 2; ++bj) {
                    const u32x4 g = *(const u32x4*)(gates + r * 2048 + goff + col0 + bj * HALF);
                    f32x4 v0 = acc[ai][bj][m][0], v1 = acc[ai][bj][m][1];
                    v0[0] *= bf_lo(g.x); v0[1] *= bf_hi(g.x); v0[2] *= bf_lo(g.y); v0[3] *= bf_hi(g.y);
                    v1[0] *= bf_lo(g.z); v1[1] *= bf_hi(g.z); v1[2] *= bf_lo(g.w); v1[3] *= bf_hi(g.w);
                    bf16_t* p = merged + r * 1024 + col0 + bj * HALF;
                    if (ACCUM) { const u32x4 o = *(const u32x4*)p;
                        v0[0] += bf_lo(o.x); v0[1] += bf_hi(o.x); v0[2] += bf_lo(o.y); v0[3] += bf_hi(o.y);
                        v1[0] += bf_lo(o.z); v1[1] += bf_hi(o.z); v1[2] += bf_lo(o.w); v1[3] += bf_hi(o.w); }
                    *(u32x4*)p = pack8(v0, v1); } }
    }
};
struct EpiSwiglu {
    static constexpr bool PERM = true, AFTER_DRAIN = false; static constexpr int MID_TILES = 0;
    bf16_t* act;
    __device__ __forceinline__ void operator()(const f32x4 (&acc)[2][2][4][2], const Unit& u, int wr, int wc, int fr, int fq) const {
        const int row0 = u.pm * BM + wr * 64 + fr; const int col0 = u.pn * HALF + wc * 32 + 8 * fq;
#pragma unroll
        for (int ai = 0; ai < 2; ++ai)
#pragma unroll
            for (int m = 0; m < 4; ++m) {
                f32x4 v0, v1;
#pragma unroll
                for (int i = 0; i < 4; ++i) { const float g0 = acc[ai][0][m][0][i], g1 = acc[ai][0][m][1][i];
                    v0[i] = g0 * sigmoidf_(g0) * acc[ai][1][m][0][i]; v1[i] = g1 * sigmoidf_(g1) * acc[ai][1][m][1][i]; }
                *(u32x4*)(act + (size_t)(row0 + ai * HALF + m * 16) * 2048 + col0) = pack8(v0, v1); }
    }
};

struct EpiProj2 {
    static constexpr bool PERM = true, AFTER_DRAIN = false; static constexpr int MID_TILES = 0;
    bf16_t* qkv; bf16_t* gates; const float* b_gate; const float* qn_g; const float* kn_g; const float* ropeA; const float* ropeB;
    typedef unsigned u32x2_t __attribute__((ext_vector_type(2)));
    __device__ __forceinline__ void operator()(const f32x4 (&acc)[2][2][4][2], const Unit& u, int wr, int wc, int fr, int fq) const {
        const int row0 = u.pm * BM + wr * 64 + fr;
        if (u.pn >= 12) {
            const int col0 = (u.pn - 12) * BM + wc * 32 + 8 * fq;
            f32x4 bv[2][2];
#pragma unroll
            for (int bj = 0; bj < 2; ++bj)
#pragma unroll
                for (int n = 0; n < 2; ++n) bv[bj][n] = *(const f32x4*)(b_gate + col0 + bj * HALF + 4 * n);
#pragma unroll
            for (int ai = 0; ai < 2; ++ai)
#pragma unroll
                for (int m = 0; m < 4; ++m) { bf16_t* rowp = gates + (size_t)(row0 + ai * HALF + m * 16) * 2048 + col0;
#pragma unroll
                    for (int bj = 0; bj < 2; ++bj) { f32x4 v0 = acc[ai][bj][m][0] + bv[bj][0], v1 = acc[ai][bj][m][1] + bv[bj][1];
#pragma unroll
                        for (int i = 0; i < 4; ++i) { v0[i] = sigmoidf_(v0[i]); v1[i] = sigmoidf_(v1[i]); }
                        *(u32x4*)(rowp + bj * HALF) = pack8(v0, v1); } }
            return;
        }
        int kind, colbase;
        if (u.pn < 2) { kind = 0; colbase = OFF_QA + (4 * u.pn + wc) * 64; }
        else if (u.pn == 2) { if (wc < 2) { kind = 1; colbase = OFF_KA + wc * 64; } else { kind = 2; colbase = OFF_VA + (wc - 2) * 64; } }
        else if (u.pn < 6) { kind = 3; colbase = OFF_QB + (4 * (u.pn - 3) + wc) * 64; }
        else if (u.pn < 9) { kind = 4; colbase = OFF_KB + (4 * (u.pn - 6) + wc) * 64; }
        else { kind = 2; colbase = OFF_VB + (4 * (u.pn - 9) + wc) * 64; }
        if (kind <= 1) {
            const float* gn = kind == 0 ? qn_g : kn_g; const float sc = kind == 0 ? C2 : 1.0f;
            f32x4 g[2][2];
#pragma unroll
            for (int bj = 0; bj < 2; ++bj)
#pragma unroll
                for (int n = 0; n < 2; ++n) g[bj][n] = *(const f32x4*)(gn + 32 * n + 16 * bj + 4 * fq) * sc;
#pragma unroll
            for (int ai = 0; ai < 2; ++ai)
#pragma unroll
                for (int m = 0; m < 4; ++m) { const int row = row0 + ai * HALF + m * 16; const float* ta = ropeA + (size_t)(row & (SEQ - 1)) * 64 + 4 * fq;
                    float ss = 0.f;
#pragma unroll
                    for (int bj = 0; bj < 2; ++bj)
#pragma unroll
                        for (int n = 0; n < 2; ++n) { const f32x4 x = acc[ai][bj][m][n]; ss += (x[0] * x[0] + x[1] * x[1]) + (x[2] * x[2] + x[3] * x[3]); }
                    ss += __shfl_xor(ss, 16); ss += __shfl_xor(ss, 32);
                    const float rs = 1.0f / sqrtf(ss * (1.0f / 64.0f) + QK_EPS);
                    bf16_t* rowp = qkv + (size_t)row * QKVW + colbase + 4 * fq;
#pragma unroll
                    for (int n = 0; n < 2; ++n) { const f32x4 cs = *(const f32x4*)(ta + n * 32), sn = *(const f32x4*)(ta + n * 32 + 16);
                        const f32x4 x1 = acc[ai][0][m][n] * rs * g[0][n], x2 = acc[ai][1][m][n] * rs * g[1][n];
                        const f32x4 o1 = x1 * cs - x2 * sn, o2 = x2 * cs + x1 * sn;
                        u32x2_t w1, w2; w1.x = cvt_pk_bf16(o1[0], o1[1]); w1.y = cvt_pk_bf16(o1[2], o1[3]); w2.x = cvt_pk_bf16(o2[0], o2[1]); w2.y = cvt_pk_bf16(o2[2], o2[3]);
                        *(u32x2_t*)(rowp + 32 * n) = w1; *(u32x2_t*)(rowp + 32 * n + 16) = w2; } }
        } else if (kind == 2) {
#pragma unroll
            for (int ai = 0; ai < 2; ++ai)
#pragma unroll
                for (int m = 0; m < 4; ++m) { bf16_t* rowp = qkv + (size_t)(row0 + ai * HALF + m * 16) * QKVW + colbase + 8 * fq;
#pragma unroll
                    for (int bj = 0; bj < 2; ++bj) *(u32x4*)(rowp + 32 * bj) = pack8(acc[ai][bj][m][0], acc[ai][bj][m][1]); }
        } else {
            const float sc = kind == 3 ? C2 : 1.0f;
#pragma unroll
            for (int ai = 0; ai < 2; ++ai)
#pragma unroll
                for (int m = 0; m < 4; ++m) { const int row = row0 + ai * HALF + m * 16; const float* tb = ropeB + (size_t)(row & (SEQ - 1)) * 16;
                    f32x4 a0 = acc[ai][0][m][0], a1 = acc[ai][0][m][1], b0 = acc[ai][1][m][0], b1 = acc[ai][1][m][1];
                    if (fq == 0) { const f32x4 c0 = *(const f32x4*)(tb), c1 = *(const f32x4*)(tb + 4), s0 = *(const f32x4*)(tb + 8), s1 = *(const f32x4*)(tb + 12);
                        const f32x4 o0 = a0 * c0 - b0 * s0, p0 = b0 * c0 + a0 * s0, o1 = a1 * c1 - b1 * s1, p1 = b1 * c1 + a1 * s1; a0 = o0; b0 = p0; a1 = o1; b1 = p1; }
                    a0 = a0 * sc; a1 = a1 * sc; b0 = b0 * sc; b1 = b1 * sc;
                    bf16_t* rowp = qkv + (size_t)row * QKVW + colbase + 16 * fq;
                    *(u32x4*)(rowp) = pack8(a0, a1); *(u32x4*)(rowp + 8) = pack8(b0, b1); }
        }
    }
};

struct EpiGateMerge {
    static constexpr bool PERM = true, AFTER_DRAIN = false; static constexpr int MID_TILES = 8;
    bf16_t* merged; const bf16_t* gates;
    __device__ __forceinline__ void mid(f32x4 (&acc)[2][2][4][2], const Unit& u, int wr, int wc, int fr, int fq) const {
        asm volatile("" : "+v"(fr), "+v"(fq));
        const int row0 = u.pm * BM + wr * 64 + fr; const int col0 = u.pn * BM + wc * 32 + 8 * fq;
#pragma unroll
        for (int ai = 0; ai < 2; ++ai)
#pragma unroll
            for (int m = 0; m < 4; ++m) { const bf16_t* gp = gates + (size_t)(row0 + ai * HALF + m * 16) * 2048 + col0;
#pragma unroll
                for (int bj = 0; bj < 2; ++bj) {
                    const u32x4 a = *(const u32x4*)(gp + bj * HALF), b = *(const u32x4*)(gp + 1024 + bj * HALF);
                    f32x4 r0, r1;
                    r0[0] = bf_lo(a.x) * __builtin_amdgcn_rcpf(bf_lo(b.x)); r0[1] = bf_hi(a.x) * __builtin_amdgcn_rcpf(bf_hi(b.x)); r0[2] = bf_lo(a.y) * __builtin_amdgcn_rcpf(bf_lo(b.y)); r0[3] = bf_hi(a.y) * __builtin_amdgcn_rcpf(bf_hi(b.y));
                    r1[0] = bf_lo(a.z) * __builtin_amdgcn_rcpf(bf_lo(b.z)); r1[1] = bf_hi(a.z) * __builtin_amdgcn_rcpf(bf_hi(b.z)); r1[2] = bf_lo(a.w) * __builtin_amdgcn_rcpf(bf_lo(b.w)); r1[3] = bf_hi(a.w) * __builtin_amdgcn_rcpf(bf_hi(b.w));
                    acc[ai][bj][m][0] = acc[ai][bj][m][0] * r0; acc[ai][bj][m][1] = acc[ai][bj][m][1] * r1; } }
    }
    __device__ __forceinline__ void operator()(const f32x4 (&acc)[2][2][4][2], const Unit& u, int wr, int wc, int fr, int fq) const {
        asm volatile("" : "+v"(fr), "+v"(fq));
        const int row0 = u.pm * BM + wr * 64 + fr; const int col0 = u.pn * BM + wc * 32 + 8 * fq;
#pragma unroll
        for (int ai = 0; ai < 2; ++ai)
#pragma unroll
            for (int m = 0; m < 4; ++m) { const size_t r = (size_t)(row0 + ai * HALF + m * 16);
#pragma unroll
                for (int bj = 0; bj < 2; ++bj) {
                    const u32x4 g = *(const u32x4*)(gates + r * 2048 + 1024 + col0 + bj * HALF);
                    f32x4 v0 = acc[ai][bj][m][0], v1 = acc[ai][bj][m][1];
                    v0[0] *= bf_lo(g.x); v0[1] *= bf_hi(g.x); v0[2] *= bf_lo(g.y); v0[3] *= bf_hi(g.y);
                    v1[0] *= bf_lo(g.z); v1[1] *= bf_hi(g.z); v1[2] *= bf_lo(g.w); v1[3] *= bf_hi(g.w);
                    *(u32x4*)(merged + r * 1024 + col0 + bj * HALF) = pack8(v0, v1); } }
    }
};
template <class Epi, class Sched, bool ALIGN_EPI = false, bool SP2 = false, bool GATHER = false>
__device__ __forceinline__ void gemm_phase(PG8_LAS unsigned char* lds, const Gemm g, const Sched& S, const Epi& E) {
    int tid_ = threadIdx.x; asm volatile("" : "+v"(tid_));
    const int tid = tid_, wid = __builtin_amdgcn_readfirstlane(tid >> 6), lane = tid & 63, wr = wid >> 2, wc = wid & 3, fr = lane & 15, fq = lane >> 4;
    const int K = g.K, nt = K / BK;
    unsigned voffA[2], voffB[2];
#pragma unroll
    for (int i = 0; i < 2; ++i) { int R, C; stage_rc(tid * 16 + i * 8192, R, C); const int Rb = Epi::PERM ? ((R & ~31) + perm32(R & 31)) : R;
        voffA[i] = (unsigned)(R * K + C) * 2u; voffB[i] = (unsigned)(Rb * K + C) * 2u; }
    unsigned vg[2][2], ng[2][2]; int gR[2], gC[2];
    if constexpr (GATHER) {
#pragma unroll
        for (int i = 0; i < 2; ++i) { stage_rc(tid * 16 + i * 8192, gR[i], gC[i]); }
    }
    int nraw[2][2];
#define PG8_GLOAD(raw, UI) do { _Pragma("unroll") for (int h_ = 0; h_ < 2; ++h_) _Pragma("unroll") for (int i_ = 0; i_ < 2; ++i_) raw[h_][i_] = (int)g.gidx[(UI) * 256 + h_ * 128 + gR[i_]]; } while (0)
#define PG8_GCALC(dst, raw, U) do { _Pragma("unroll") for (int h_ = 0; h_ < 2; ++h_) _Pragma("unroll") for (int i_ = 0; i_ < 2; ++i_) \
        dst[h_][i_] = (unsigned)((((U).am & 15) * 2048 + raw[h_][i_]) * K + gC[i_]) * 2u; } while (0)
    const size_t kstep = (size_t)(BK * 2);
    const size_t hstep = (size_t)HALF * K * 2;
    const size_t tstep = 2 * hstep;
    const unsigned ldsw = (unsigned)wid * 1024u;
    const int aoff = lds_byte(wr * 64 + fr, fq * 8), boff = lds_byte(wc * 32 + fr, fq * 8);
#define PG8_SA(b, h) (((b) * 2 + (h)) * HTB)
#define PG8_SB(b, h) ((4 + (b) * 2 + (h)) * HTB)
#define PG8_STAGE(bufoff, gbase, voff) do { _Pragma("unroll") for (int _i = 0; _i < 2; ++_i) \
        __builtin_amdgcn_global_load_lds((const unsigned*)((const char*)(gbase) + (voff)[_i]), (PG8_LAS unsigned*)(lds + (bufoff) + ldsw + _i * 8192), 16, 0, 0); } while (0)
#define PG8_LDA(dst, b, h) do { _Pragma("unroll") for (int m = 0; m < 4; ++m) _Pragma("unroll") for (int k = 0; k < 2; ++k) dst[m][k] = *(const PG8_LAS bf16x8*)(lds + PG8_SA(b, h) + aoff + m * 2048 + k * 1024); } while (0)
#define PG8_LDB(dst, b, h) do { _Pragma("unroll") for (int n = 0; n < 2; ++n) _Pragma("unroll") for (int k = 0; k < 2; ++k) dst[n][k] = *(const PG8_LAS bf16x8*)(lds + PG8_SB(b, h) + boff + n * 2048 + k * 1024); } while (0)
#define PG8_MMA(ai, bj, At, Bt) do { __builtin_amdgcn_s_setprio(1); _Pragma("unroll") for (int m = 0; m < 4; ++m) _Pragma("unroll") for (int n = 0; n < 2; ++n) _Pragma("unroll") for (int k = 0; k < 2; ++k) \
        acc[ai][bj][m][n] = __builtin_amdgcn_mfma_f32_16x16x32_bf16(Bt[n][k], At[m][k], acc[ai][bj][m][n], 0, 0, 0); __builtin_amdgcn_s_setprio(0); } while (0)
#define PG8_WAIT_V(n) asm volatile("s_waitcnt vmcnt(" #n ")" ::: "memory")
#define PG8_WAIT_L(n) asm volatile("s_waitcnt lgkmcnt(" #n ")" ::: "memory")
#define PG8_BAR __builtin_amdgcn_s_barrier()
#define PG8_SCHED __builtin_amdgcn_sched_barrier(0)
    Unit cur, nxt; int ui = 0;
    if (!S.next(0, cur)) return;
    f32x4 acc[2][2][4][2];
#pragma unroll
    for (int a = 0; a < 2; ++a)
#pragma unroll
        for (int b = 0; b < 2; ++b)
#pragma unroll
            for (int m = 0; m < 4; ++m)
#pragma unroll
                for (int n = 0; n < 2; ++n) acc[a][b][m][n] = (f32x4){0.f, 0.f, 0.f, 0.f};
    bf16x8 At[4][2], B0[2][2], B1[2][2];
    const char* cA = GATHER ? (const char*)g.A : (const char*)g.A + (size_t)cur.am * tstep; const char* cB = (const char*)g.Bt + (size_t)cur.bt * tstep;
    const size_t hstepA = GATHER ? 0 : hstep;
    if constexpr (GATHER) { PG8_GLOAD(nraw, 0); PG8_GCALC(vg, nraw, cur); }
    S.a_ready(cur);
    if constexpr (SP2) {
        PG8_STAGE(PG8_SB(0, 0), cB, voffB); PG8_STAGE(PG8_SB(0, 1), cB + hstep, voffB); PG8_STAGE(PG8_SA(0, 0), cA, (GATHER ? vg[0] : voffA)); PG8_STAGE(PG8_SA(0, 1), cA + hstepA, (GATHER ? vg[1] : voffA));
        if (wr == 1) PG8_BAR;
        PG8_WAIT_V(2); PG8_BAR;
        PG8_STAGE(PG8_SB(1, 0), cB + kstep, voffB); PG8_STAGE(PG8_SA(1, 0), cA + kstep, (GATHER ? vg[0] : voffA)); PG8_STAGE(PG8_SB(1, 1), cB + hstep + kstep, voffB);
        PG8_WAIT_V(6); PG8_BAR;
    } else {
        PG8_STAGE(PG8_SB(0, 0), cB, voffB); PG8_STAGE(PG8_SA(0, 0), cA, voffA); PG8_STAGE(PG8_SB(0, 1), cB + hstep, voffB); PG8_STAGE(PG8_SA(0, 1), cA + hstep, voffA);
        if (wr == 1) PG8_BAR;
        PG8_WAIT_V(4); PG8_BAR;
        PG8_STAGE(PG8_SB(1, 0), cB + kstep, voffB); PG8_STAGE(PG8_SA(1, 0), cA + kstep, voffA); PG8_STAGE(PG8_SB(1, 1), cB + hstep + kstep, voffB);
        PG8_WAIT_V(6); PG8_BAR;
    }
    for (;;) {
        const bool has_next = S.next(ui + 1, nxt);
        const char* nA = GATHER ? cA : (has_next ? (const char*)g.A + (size_t)nxt.am * tstep : cA); const char* nB = has_next ? (const char*)g.Bt + (size_t)nxt.bt * tstep : cB;
        if constexpr (GATHER) { if (has_next) { PG8_GLOAD(nraw, ui + 1); } }
        for (int t = 0; t < nt; t += 2) {
            const bool last = (t == nt - 2);
            const char* a1 = cA + (size_t)(t + 1) * kstep;
            const char* a2 = last ? nA : cA + (size_t)(t + 2) * kstep; const char* b2 = last ? nB : cB + (size_t)(t + 2) * kstep;
            const char* a3 = a2 + kstep; const char* b3 = b2 + kstep;
            if (last && has_next) S.a_ready(nxt);
            if constexpr (GATHER) { if (last) { if (has_next) { PG8_GCALC(ng, nraw, nxt); } else { ng[0][0] = vg[0][0]; ng[0][1] = vg[0][1]; ng[1][0] = vg[1][0]; ng[1][1] = vg[1][1]; } } }
            if constexpr (SP2) {
            PG8_LDB(B0, 0, 0); PG8_LDB(B1, 0, 1); PG8_SCHED; PG8_LDA(At, 0, 0); PG8_STAGE(PG8_SA(1, 1), a1 + hstepA, (GATHER ? vg[1] : voffA));
            PG8_WAIT_V(8); PG8_WAIT_L(0); PG8_BAR; PG8_MMA(0, 0, At, B0); PG8_MMA(0, 1, At, B1); PG8_BAR; PG8_SCHED;
            PG8_LDA(At, 0, 1); PG8_STAGE(PG8_SB(0, 0), b2, voffB); PG8_STAGE(PG8_SB(0, 1), b2 + hstep, voffB); PG8_STAGE(PG8_SA(0, 0), a2, (GATHER ? (last ? ng[0] : vg[0]) : voffA));
            PG8_WAIT_V(8); PG8_WAIT_L(0); PG8_BAR; PG8_MMA(1, 0, At, B0); PG8_MMA(1, 1, At, B1); PG8_BAR; PG8_SCHED;
            PG8_LDB(B0, 1, 0); PG8_LDB(B1, 1, 1); PG8_SCHED; PG8_LDA(At, 1, 0); PG8_STAGE(PG8_SA(0, 1), a2 + hstepA, (GATHER ? (last ? ng[1] : vg[1]) : voffA));
            PG8_WAIT_V(8); PG8_WAIT_L(0); PG8_BAR; PG8_MMA(0, 0, At, B0); PG8_MMA(0, 1, At, B1); PG8_BAR; PG8_SCHED;
            PG8_LDA(At, 1, 1); PG8_STAGE(PG8_SB(1, 0), b3, voffB); PG8_STAGE(PG8_SB(1, 1), b3 + hstep, voffB); PG8_STAGE(PG8_SA(1, 0), a3, (GATHER ? (last ? ng[0] : vg[0]) : voffA));
            PG8_WAIT_V(8); PG8_WAIT_L(0); PG8_BAR; PG8_MMA(1, 0, At, B0); PG8_MMA(1, 1, At, B1); PG8_BAR; PG8_SCHED;
            } else {
            PG8_LDB(B0, 0, 0); PG8_SCHED; PG8_LDA(At, 0, 0); PG8_STAGE(PG8_SA(1, 1), a1 + hstep, voffA);
            PG8_WAIT_L(8); PG8_BAR; PG8_WAIT_L(0); PG8_MMA(0, 0, At, B0); PG8_BAR; PG8_SCHED;
            PG8_LDB(B1, 0, 1); PG8_STAGE(PG8_SB(0, 0), b2, voffB);
            PG8_BAR; PG8_WAIT_L(0); PG8_MMA(0, 1, At, B1); PG8_BAR;
            PG8_LDA(At, 0, 1); PG8_STAGE(PG8_SA(0, 0), a2, voffA);
            PG8_BAR; PG8_WAIT_L(0); PG8_MMA(1, 0, At, B0); PG8_BAR; PG8_SCHED;
            PG8_STAGE(PG8_SB(0, 1), b2 + hstep, voffB);
            PG8_WAIT_V(6); PG8_BAR; PG8_MMA(1, 1, At, B1); PG8_BAR;
            PG8_LDB(B0, 1, 0); PG8_SCHED; PG8_LDA(At, 1, 0); PG8_STAGE(PG8_SA(0, 1), a2 + hstep, voffA);
            PG8_WAIT_L(8); PG8_BAR; PG8_WAIT_L(0); PG8_MMA(0, 0, At, B0); PG8_BAR; PG8_SCHED;
            PG8_LDB(B1, 1, 1); PG8_STAGE(PG8_SB(1, 0), b3, voffB);
            PG8_BAR; PG8_WAIT_L(0); PG8_MMA(0, 1, At, B1); PG8_BAR;
            PG8_LDA(At, 1, 1); PG8_STAGE(PG8_SA(1, 0), a3, voffA);
            PG8_BAR; PG8_WAIT_L(0); PG8_MMA(1, 0, At, B0); PG8_BAR; PG8_SCHED;
            PG8_STAGE(PG8_SB(1, 1), b3 + hstep, voffB);
            PG8_WAIT_V(6); PG8_BAR; PG8_MMA(1, 1, At, B1); PG8_BAR;
            }
            if constexpr (Epi::MID_TILES > 0) { if (t + 2 == Epi::MID_TILES) E.mid(acc, cur, wr, wc, fr, fq); }
        }
        if constexpr (ALIGN_EPI) { if (wr == 0) PG8_BAR; }
        if constexpr (!Epi::AFTER_DRAIN) { E(acc, cur, wr, wc, fr, fq); S.done(cur); }
        if (!has_next) break;
#pragma unroll
        for (int a = 0; a < 2; ++a)
#pragma unroll
            for (int b = 0; b < 2; ++b)
#pragma unroll
                for (int m = 0; m < 4; ++m)
#pragma unroll
                    for (int n = 0; n < 2; ++n) acc[a][b][m][n] = (f32x4){0.f, 0.f, 0.f, 0.f};
        cur = nxt; cA = nA; cB = nB; ++ui;
        if constexpr (GATHER) { vg[0][0] = ng[0][0]; vg[0][1] = ng[0][1]; vg[1][0] = ng[1][0]; vg[1][1] = ng[1][1]; }
        if constexpr (ALIGN_EPI) { if (wr == 1) PG8_BAR; }
    }
    PG8_WAIT_V(0);
    if constexpr (!ALIGN_EPI) { if (wr == 0) PG8_BAR; }
    PG8_BAR;
    if constexpr (Epi::AFTER_DRAIN) { E.fused(acc, cur, wr, wc, fr, fq, lds, wid, lane); S.done(cur); }
#undef PG8_GLOAD
#undef PG8_GCALC
#undef PG8_SA
#undef PG8_SB
#undef PG8_STAGE
#undef PG8_LDA
#undef PG8_LDB
#undef PG8_MMA
#undef PG8_WAIT_V
#undef PG8_WAIT_L
#undef PG8_BAR
#undef PG8_SCHED
}
}
#include <hip/hip_bf16.h>
#include <cmath>
namespace attn_body {
using bf16=__hip_bfloat16;
using bf16x8=__attribute__((ext_vector_type(8)))short;
using s16x4=__attribute__((ext_vector_type(4)))short;
using f32x16=__attribute__((ext_vector_type(16)))float;
using u32x4=__attribute__((ext_vector_type(4)))unsigned;
constexpr int BATCH=16,NHEAD=8,SEQ=2048,D=64,PQ=3072,PO=768;
constexpr int NW=8,QBLK=32,QB=QBLK*NW,KVBLK=64,NQB=SEQ/QB;
constexpr int ATTN_UNIT_ROWS=QB;
__device__ __forceinline__ int crow(int r,int hi){return (r&3)+8*(r>>2)+4*hi;}
#define SBAR() __builtin_amdgcn_sched_barrier(0)
__device__ __forceinline__ void cmask(f32x16&p0,f32x16&p1,int jb,int qrel,int hi){
  const float NEG=-INFINITY; int kb=64*jb+4*hi;
  #pragma unroll
  for(int r=0;r<16;++r){int kv=kb+(r&3)+8*(r>>2); if(kv>qrel)p0[r]=NEG; if(kv+32>qrel)p1[r]=NEG;}
}

constexpr int NSLOT=3, SLOTB=8192;
constexpr int LDS_K=0, LDS_V=NSLOT*SLOTB, LDS_WS=2*NSLOT*SLOTB, LDS_OST=LDS_WS+NW*64*4, LDS_BYTES=LDS_OST+NW*4096;
constexpr float C2=0.125f*1.4426950408889634f;
__device__ __forceinline__ void glds16(const void*gsrc,unsigned lds_dst){unsigned keep;
  asm volatile("s_mov_b32 %0, m0\n\ts_mov_b32 m0, %2\n\ts_nop 0\n\tglobal_load_lds_dwordx4 %1, off\n\ts_mov_b32 m0, %0":"=&s"(keep):"v"(gsrc),"s"(lds_dst):"memory");}
__device__ __forceinline__ float max3f(float a,float b,float c){float r;asm("v_max3_f32 %0, %1, %2, %3":"=v"(r):"v"(a),"v"(b),"v"(c));return r;}
__device__ __forceinline__ float max2f(float a,float b){float r;asm("v_max_f32_e32 %0, %1, %2":"=v"(r):"v"(a),"v"(b));return r;}
__device__ __forceinline__ float fadd_s(float a,float b){float r;asm("v_add_f32_e32 %0, %1, %2":"=v"(r):"v"(a),"v"(b));return r;}
__device__ __forceinline__ float fsub_s(float a,float b){float r;asm("v_sub_f32_e32 %0, %1, %2":"=v"(r):"v"(a),"v"(b));return r;}
typedef float f32x2_t __attribute__((ext_vector_type(2))); typedef __bf16 bf16x2_t __attribute__((ext_vector_type(2)));
__device__ __forceinline__ unsigned cvtpk_s(float lo,float hi){f32x2_t v={lo,hi};bf16x2_t b=__builtin_convertvector(v,bf16x2_t);return __builtin_bit_cast(unsigned,b);}
#define WAIT_BAR(N) asm volatile("s_waitcnt vmcnt(" #N ") lgkmcnt(0)\n\ts_barrier":::"memory")

__device__ __forceinline__ void qkt(f32x16&p0,f32x16&p1,const char*Kslot,const bf16x8*qr,const f32x16&negm,int r32,int hi){
  const char*kb=Kslot+hi*1024+r32*16;
  #pragma unroll
  for(int d0=0;d0<4;++d0){
    const bf16x8 b0=*reinterpret_cast<const bf16x8*>(kb+d0*2048);
    const bf16x8 b1=*reinterpret_cast<const bf16x8*>(kb+d0*2048+512);
    if(d0==0){p0=__builtin_amdgcn_mfma_f32_32x32x16_bf16(b0,qr[0],negm,0,0,0);p1=__builtin_amdgcn_mfma_f32_32x32x16_bf16(b1,qr[0],negm,0,0,0);}
    else{p0=__builtin_amdgcn_mfma_f32_32x32x16_bf16(b0,qr[d0],p0,0,0,0);p1=__builtin_amdgcn_mfma_f32_32x32x16_bf16(b1,qr[d0],p1,0,0,0);}}
}
typedef __attribute__((address_space(3))) const char* lds_cptr;
typedef short v4i16_t __attribute__((ext_vector_type(4)));
__device__ __forceinline__ void kload8(bf16x8*kf,lds_cptr kp){
  kf[0]=*(const __attribute__((address_space(3))) bf16x8*)(kp);      kf[1]=*(const __attribute__((address_space(3))) bf16x8*)(kp+512);
  kf[2]=*(const __attribute__((address_space(3))) bf16x8*)(kp+2048); kf[3]=*(const __attribute__((address_space(3))) bf16x8*)(kp+2560);
  kf[4]=*(const __attribute__((address_space(3))) bf16x8*)(kp+4096); kf[5]=*(const __attribute__((address_space(3))) bf16x8*)(kp+4608);
  kf[6]=*(const __attribute__((address_space(3))) bf16x8*)(kp+6144); kf[7]=*(const __attribute__((address_space(3))) bf16x8*)(kp+6656);
}
__device__ __forceinline__ void kload2(bf16x8*kf,lds_cptr kp,int j){ kf[2*j]=*(const __attribute__((address_space(3))) bf16x8*)(kp+j*2048); kf[2*j+1]=*(const __attribute__((address_space(3))) bf16x8*)(kp+j*2048+512); }
__device__ __forceinline__ s16x4 vtr(lds_cptr p){ return __builtin_bit_cast(s16x4,__builtin_amdgcn_ds_read_tr16_b64_v4i16((__attribute__((address_space(3))) v4i16_t*)p)); }
__device__ __forceinline__ float rowmax(const f32x16&p0,const f32x16&p1){
  float a=max3f(p0[0],p0[1],p1[0]),b=max3f(p0[2],p0[3],p1[1]);a=max3f(a,p1[2],p1[3]);
  #pragma unroll
  for(int r=4;r<16;r+=4){a=max3f(a,p0[r],p0[r+1]);b=max3f(b,p0[r+2],p0[r+3]);a=max3f(a,p1[r],p1[r+1]);b=max3f(b,p1[r+2],p1[r+3]);}
  const float m=max2f(a,b);
  auto rr=__builtin_amdgcn_permlane32_swap(__float_as_uint(m),__float_as_uint(m),false,false);
  return max2f(__uint_as_float(rr[0]),__uint_as_float(rr[1]));
}
__device__ __forceinline__ void pv(f32x16*o,int vb,bf16x8 pa0,bf16x8 pa1,bf16x8 pa2,bf16x8 pa3){
  #pragma unroll
  for(int d0=0;d0<2;++d0){s16x4 lo[4],hi[4];
    #pragma unroll
    for(int ks=0;ks<4;++ks){
      asm volatile("ds_read_b64_tr_b16 %0,%1 offset:%c2":"=&v"(lo[ks]):"v"(vb),"i"(d0*4096+ks*1024):"memory");
      asm volatile("ds_read_b64_tr_b16 %0,%1 offset:%c2":"=&v"(hi[ks]):"v"(vb),"i"(d0*4096+ks*1024+512):"memory");}
    asm volatile("s_waitcnt lgkmcnt(0)":::"memory");SBAR();
    #define PK(k) (bf16x8){lo[k][0],lo[k][1],lo[k][2],lo[k][3],hi[k][0],hi[k][1],hi[k][2],hi[k][3]}
    o[d0]=__builtin_amdgcn_mfma_f32_32x32x16_bf16(pa0,PK(0),o[d0],0,0,0);
    o[d0]=__builtin_amdgcn_mfma_f32_32x32x16_bf16(pa1,PK(1),o[d0],0,0,0);
    o[d0]=__builtin_amdgcn_mfma_f32_32x32x16_bf16(pa2,PK(2),o[d0],0,0,0);
    o[d0]=__builtin_amdgcn_mfma_f32_32x32x16_bf16(pa3,PK(3),o[d0],0,0,0);
    #undef PK
  }
}

#ifndef ATTN_STORE16
#define ATTN_STORE16(p,v) (*(u32x4*)(p)=(v))
#endif
template<int THRL> __device__ __forceinline__ void attn_unit(int b,int h,int kvh,int qb,const bf16*Q,const bf16*__restrict__ K,const bf16*__restrict__ V,bf16*O,char*shm){
  int tid_=threadIdx.x; asm volatile("":"+v"(tid_)); const int tid=tid_,lane=tid&63,r32=lane&31,hi=lane>>5; const int wid=__builtin_amdgcn_readfirstlane(tid>>6);
  const long rowbase=(long)b*SEQ; const int q0=qb*QB;
  const bf16*Qw=Q+(rowbase+q0+wid*QBLK)*PQ+h*D;
  const bf16*Kh=K+rowbase*PQ+kvh*D,*Vh=V+rowbase*PQ+kvh*D;
  const unsigned lds0=(unsigned)(uintptr_t)shm;
  float*wsf=(float*)(shm+LDS_WS)+wid*64;
  const bf16*ksrc=Kh+(long)lane*PQ+wid*8;
  const bf16*vsrc=Vh+(long)(16*(wid&3)+(lane>>2))*PQ+(wid>>2)*32+(lane&3)*8;
  const unsigned kdst=lds0+LDS_K+wid*1024, vdst=lds0+LDS_V+wid*1024;
  #define DMA_K(t,slot) glds16(ksrc+(long)(t)*KVBLK*PQ,(unsigned)__builtin_amdgcn_readfirstlane(kdst+(slot)))
  #define DMA_V(t,slot) glds16(vsrc+(long)(t)*KVBLK*PQ,(unsigned)__builtin_amdgcn_readfirstlane(vdst+(slot)))
  const int vb0=(int)(lds0+LDS_V)+((lane>>4)&1)*32+(lane&3)*8+(4*hi+((lane&15)>>2))*64;
  const char*Kbase=shm+LDS_K; bf16x8 kf[8];
  const lds_cptr shm3=(lds_cptr)shm; const lds_cptr kp0=shm3+LDS_K+hi*1024+r32*16; const lds_cptr vp0=shm3+LDS_V+((lane>>4)&1)*32+(lane&3)*8+(4*hi+((lane&15)>>2))*64;
  constexpr int NT=SEQ/KVBLK;
  DMA_K(0,0);DMA_V(0,0);DMA_K(1,SLOTB);
  bf16x8 qr[4];
  #pragma unroll
  for(int d0=0;d0<4;++d0)qr[d0]=*reinterpret_cast<const bf16x8*>(&Qw[(long)r32*PQ+d0*16+hi*8]);
  float mhat=0.f,l_reg=0.f;f32x16 o[2];o[0]=f32x16{};o[1]=f32x16{};f32x16 negm=f32x16{};asm volatile("":"+v"(negm));

  #define CMASK(P0,P1,t) do{}while(0)
  bool resc=false;
  #define START(P0,P1) do{ const float rm=rowmax(P0,P1); resc=false; \
    { const float dl=rm; mhat=fadd_s(mhat,dl); \
      _Pragma("unroll") for(int r=0;r<16;++r){P0[r]=fsub_s(P0[r],dl);P1[r]=fsub_s(P1[r],dl);} \
      _Pragma("unroll") for(int r=0;r<16;++r)negm[r]=-mhat; asm volatile("":"+v"(negm)); } \
    _Pragma("unroll") for(int r=0;r<16;++r)P0[r]=__builtin_amdgcn_exp2f(P0[r]); }while(0)
  #define RESC() do{ if(resc){ asm volatile("s_waitcnt lgkmcnt(0)":::"memory"); \
      _Pragma("unroll") for(int d_=0;d_<2;++d_) _Pragma("unroll") for(int r=0;r<16;++r)o[d_][r]*=wsf[crow(r,hi)]; } }while(0)
  f32x16 pA0,pA1,pB0,pB1;
  int sl_prev=0,sl_cur=0,sl_next=SLOTB;
  #define ROT() do{sl_prev=sl_cur;sl_cur=sl_next;sl_next=(sl_next==(NSLOT-1)*SLOTB)?0:sl_next+SLOTB;}while(0)
  DMA_K(2,2*SLOTB);
  WAIT_BAR(3);
  qkt(pA0,pA1,Kbase,qr,negm,r32,hi);asm volatile("s_nop 15\n\ts_nop 7":"+v"(pA0),"+v"(pA1));CMASK(pA0,pA1,0);
  START(pA0,pA1);
  _Pragma("unroll") for(int r=0;r<16;++r)pA1[r]=__builtin_amdgcn_exp2f(pA1[r]);
  WAIT_BAR(0);
  DMA_K(3,0);DMA_V(1,SLOTB);
  ROT();
  kload8(kf,kp0+sl_cur);
  WAIT_BAR(2);
  s16x4 vlo[8],vhi[8]; u32x4 pw0,pw1,pw2,pw3;
  #define PKW(P,B) cvtpk_s(P[B],P[B+1])
  #define PAF(k) __builtin_bit_cast(bf16x8,pw##k)
  #define VFR(i) (bf16x8){vlo[i][0],vlo[i][1],vlo[i][2],vlo[i][3],vhi[i][0],vhi[i][1],vhi[i][2],vhi[i][3]}
  #define PIN(x) asm volatile("":"+v"(x))
  #define MX3(a,b,c) __builtin_fmaxf(__builtin_fmaxf((a),(b)),(c))
  #define GAPA(MF,A0,A1,A2,A3,W0,W1,PW) do{ MF; sacc+=A0; sacc+=A1; sacc+=A2; sacc+=A3; PIN(sacc); W0; W1; PIN(PW); SBAR(); }while(0)
  #define EX(v) __builtin_amdgcn_exp2f(v)
  #define GAPB(MF,X,B) do{ MF; X[B]=EX(X[B]); X[B+1]=EX(X[B+1]); X[B+2]=EX(X[B+2]); X[B+3]=EX(X[B+3]); PIN(X); SBAR(); }while(0)
  #define VRD(i) do{ vlo[i]=vtr(vp_+(((i)>>2)*4096+((i)&3)*1024)); vhi[i]=vtr(vp_+(((i)>>2)*4096+((i)&3)*1024+512)); }while(0)
  #define KRD(G,j) do{ if(G){ kload2(kf,kp0+sl_next,j); SBAR(); } }while(0)
  #define STEP(C0,C1,P0,P1,t,GK,GV,GL) do{ SBAR(); \
    const lds_cptr vp_=vp0+sl_prev; \
    VRD(0); SBAR(); float sacc=(P0[0]+P0[1]); \
    GAPA(C0=__builtin_amdgcn_mfma_f32_32x32x16_bf16(kf[0],qr[0],negm,0,0,0), P0[2],P0[3],P0[4],P0[5],     pw0[0]=PKW(P0,0), pw0[1]=PKW(P0,2), pw0); \
    VRD(4); SBAR(); GAPA(C1=__builtin_amdgcn_mfma_f32_32x32x16_bf16(kf[1],qr[0],negm,0,0,0), P0[6],P0[7],P0[8],P0[9],     pw0[2]=PKW(P0,4), pw0[3]=PKW(P0,6), pw0); \
    VRD(1); SBAR(); GAPA(C0=__builtin_amdgcn_mfma_f32_32x32x16_bf16(kf[2],qr[1],C0,0,0,0),   P0[10],P0[11],P0[12],P0[13], pw1[0]=PKW(P0,8), pw1[1]=PKW(P0,10), pw1); \
    VRD(5); SBAR(); GAPA(C1=__builtin_amdgcn_mfma_f32_32x32x16_bf16(kf[3],qr[1],C1,0,0,0),   P0[14],P0[15],P1[0],P1[1],   pw1[2]=PKW(P0,12),pw1[3]=PKW(P0,14), pw1); \
    VRD(2); SBAR(); GAPA(C0=__builtin_amdgcn_mfma_f32_32x32x16_bf16(kf[4],qr[2],C0,0,0,0),   P1[2],P1[3],P1[4],P1[5],     pw2[0]=PKW(P1,0), pw2[1]=PKW(P1,2), pw2); \
    VRD(6); SBAR(); GAPA(C1=__builtin_amdgcn_mfma_f32_32x32x16_bf16(kf[5],qr[2],C1,0,0,0),   P1[6],P1[7],P1[8],P1[9],     pw2[2]=PKW(P1,4), pw2[3]=PKW(P1,6), pw2); \
    VRD(3); SBAR(); GAPA(C0=__builtin_amdgcn_mfma_f32_32x32x16_bf16(kf[6],qr[3],C0,0,0,0),   P1[10],P1[11],P1[12],P1[13], pw3[0]=PKW(P1,8), pw3[1]=PKW(P1,10), pw3); \
    VRD(7); SBAR(); GAPA(C1=__builtin_amdgcn_mfma_f32_32x32x16_bf16(kf[7],qr[3],C1,0,0,0),   P1[14],P1[15],0.f,0.f,       pw3[2]=PKW(P1,12),pw3[3]=PKW(P1,14), pw3); \
    l_reg+=sacc; \
    if(GK){DMA_K((t)+3,sl_cur);} if(GV){DMA_V((t)+1,sl_next);} \
    CMASK(C0,C1,t); \
    { float a=MX3(C0[0],C0[1],C1[0]),b=MX3(C0[2],C0[3],C1[1]); a=MX3(a,C1[2],C1[3]); \
      _Pragma("unroll") for(int r=4;r<16;r+=4){a=MX3(a,C0[r],C0[r+1]);b=MX3(b,C0[r+2],C0[r+3]);a=MX3(a,C1[r],C1[r+1]);b=MX3(b,C1[r+2],C1[r+3]);} \
      float rm=__builtin_fmaxf(a,b); { auto rr=__builtin_amdgcn_permlane32_swap(__float_as_uint(rm),__float_as_uint(rm),false,false); rm=__builtin_fmaxf(__uint_as_float(rr[0]),__uint_as_float(rr[1])); } \
      resc=false; \
      if(__builtin_expect(__any(rm>(float)THRL),0)){ const float dl=__builtin_fmaxf(rm,0.f); mhat+=dl; \
        _Pragma("unroll") for(int r=0;r<16;++r){C0[r]-=dl;C1[r]-=dl;} \
        _Pragma("unroll") for(int r=0;r<16;++r)negm[r]=-mhat; asm volatile("":"+v"(negm)); \
        const float f=__builtin_amdgcn_exp2f(-dl); l_reg*=f; if(hi==0)wsf[r32]=f; resc=true; } } \
    SBAR(); \
    GAPB(o[0]=__builtin_amdgcn_mfma_f32_32x32x16_bf16(PAF(0),VFR(0),o[0],0,0,0), C0,0); \
    GAPB(o[1]=__builtin_amdgcn_mfma_f32_32x32x16_bf16(PAF(0),VFR(4),o[1],0,0,0), C0,4); \
    KRD(GL,0); GAPB(o[0]=__builtin_amdgcn_mfma_f32_32x32x16_bf16(PAF(1),VFR(1),o[0],0,0,0), C0,8); \
    KRD(GL,1); GAPB(o[1]=__builtin_amdgcn_mfma_f32_32x32x16_bf16(PAF(1),VFR(5),o[1],0,0,0), C0,12); \
    KRD(GL,2); GAPB(o[0]=__builtin_amdgcn_mfma_f32_32x32x16_bf16(PAF(2),VFR(2),o[0],0,0,0), C1,0); \
    KRD(GL,3); GAPB(o[1]=__builtin_amdgcn_mfma_f32_32x32x16_bf16(PAF(2),VFR(6),o[1],0,0,0), C1,4); \
    GAPB(o[0]=__builtin_amdgcn_mfma_f32_32x32x16_bf16(PAF(3),VFR(3),o[0],0,0,0), C1,8); \
    GAPB(o[1]=__builtin_amdgcn_mfma_f32_32x32x16_bf16(PAF(3),VFR(7),o[1],0,0,0), C1,12); \
    }while(0)
  int t=1;
  #undef CMASK
  #define CMASK(P0,P1,t) do{}while(0)
  for(;t+5<NT;t+=2){
    STEP(pB0,pB1,pA0,pA1,t,true,true,true);     WAIT_BAR(2); RESC(); ROT();
    STEP(pA0,pA1,pB0,pB1,t+1,true,true,true);   WAIT_BAR(2); RESC(); ROT();
  }
  #undef CMASK
  #define CMASK(P0,P1,t) do{}while(0)
  #define ENDW(tt) do{ if((tt)+3<NT){WAIT_BAR(2);} else if((tt)+2<NT){WAIT_BAR(1);} else {WAIT_BAR(0);} }while(0)
  for(;t+1<NT;t+=2){
    STEP(pB0,pB1,pA0,pA1,t,(t+3<NT),(t+1<NT),(t+1<NT));       ENDW(t);   RESC(); ROT();
    STEP(pA0,pA1,pB0,pB1,t+1,(t+4<NT),(t+2<NT),(t+2<NT));     ENDW(t+1); RESC(); ROT();
  }
  STEP(pB0,pB1,pA0,pA1,NT-1,false,false,false); RESC();
  { float sacc=pB0[0]+pB0[1]; _Pragma("unroll") for(int r=2;r<16;++r)sacc+=pB0[r]; _Pragma("unroll") for(int r=0;r<16;++r)sacc+=pB1[r]; l_reg+=sacc;
    pw0=(u32x4){PKW(pB0,0),PKW(pB0,2),PKW(pB0,4),PKW(pB0,6)};pw1=(u32x4){PKW(pB0,8),PKW(pB0,10),PKW(pB0,12),PKW(pB0,14)};pw2=(u32x4){PKW(pB1,0),PKW(pB1,2),PKW(pB1,4),PKW(pB1,6)};pw3=(u32x4){PKW(pB1,8),PKW(pB1,10),PKW(pB1,12),PKW(pB1,14)};
    SBAR(); pv(o,vb0+sl_cur,PAF(0),PAF(1),PAF(2),PAF(3)); }
  #undef PKW
  #undef PAF
  #undef VFR
  #undef PIN
  #undef MX3
  #undef GAPA
  #undef GAPB
  #undef EX
  #undef VRD
  #undef KRD
  #undef STEP
  #undef ENDW
  {auto rr=__builtin_amdgcn_permlane32_swap(__float_as_uint(l_reg),__float_as_uint(l_reg),false,false);l_reg=__uint_as_float(rr[0])+__uint_as_float(rr[1]);}
  if(hi==0)wsf[32+r32]=l_reg;asm volatile("s_waitcnt lgkmcnt(0)":::"memory");
  float rli[16];
  #pragma unroll
  for(int r=0;r<16;++r)rli[r]=__builtin_amdgcn_rcpf(wsf[32+crow(r,hi)]);
  bf16*Ow=O+(rowbase+q0+wid*QBLK)*PO+h*D;
  { bf16*stg=(bf16*)(shm+LDS_OST)+wid*2048;
    #pragma unroll
    for(int r=0;r<16;++r){const int orow=crow(r,hi);
      #pragma unroll
      for(int d0=0;d0<2;++d0)stg[orow*64+d0*32+r32]=__float2bfloat16(o[d0][r]*rli[r]);}
    asm volatile("s_waitcnt lgkmcnt(0)":::"memory");
    #pragma unroll
    for(int i=0;i<4;++i){const int row=i*8+(lane>>3),ch=lane&7; const u32x4 v=*(const u32x4*)(stg+row*64+ch*8); ATTN_STORE16(Ow+(long)row*PO+ch*8,v);} }
  asm volatile("s_waitcnt lgkmcnt(0)\n\ts_barrier":::"memory");
  #undef DMA_K
  #undef DMA_V
  #undef CMASK
  #undef START
  #undef RESC
  #undef ROT
}
constexpr int ATTN_LDS_BYTES=LDS_BYTES;
struct AttnTensors { const bf16* Q; const bf16* K; const bf16* V; bf16* O; };
constexpr int BAND_HALF=65536, BAND_K=0, BAND_V=32768;
__device__ __forceinline__ void band_half_unit(int hu,const bf16*__restrict__ QKV,int offq,int offk,int offv,bf16*OBG,float*LSEG,char*shm,char*wsb){
  int tid_=threadIdx.x; asm volatile("":"+v"(tid_)); const int tid=tid_,lane=tid&63,r32=lane&31,hi=lane>>5; const int wid=__builtin_amdgcn_readfirstlane(tid>>6);
  const int half=wid>>2, wq=wid&3;
  const int uh=__builtin_amdgcn_readfirstlane(2*hu+half);
  const int b=uh/192, rem=uh-b*192, head=rem>>4, ck=rem&15, g=head>>2, j=head&3;
  const int dil=(g==0)?1:(g==1)?4:16, sh=(g==0)?4:(g==1)?2:0;
  const int rc=ck>>sh, c=ck&((1<<sh)-1), ntile=(SEQ/64)/dil;
  const long rowbase=(long)b*SEQ;
  bf16*const OG=OBG+(long)g*BATCH*SEQ*256; float*const LG=LSEG+(long)g*BATCH*SEQ*4;
  const unsigned lds0=(unsigned)(uintptr_t)shm+half*BAND_HALF;
  char*hb=shm+half*BAND_HALF;
  typedef __attribute__((address_space(3))) float* lds_fptr;
  const lds_fptr wsf=(lds_fptr)(wsb+wid*256);
  const int mq=128*c+32*wq+r32;
  const bf16*Qrow=QKV+(rowbase+(long)mq*dil+rc)*PQ+offq+head*D;
  bf16x8 qr[4];
  #pragma unroll
  for(int d0=0;d0<4;++d0)qr[d0]=*reinterpret_cast<const bf16x8*>(&Qrow[d0*16+hi*8]);
  const bf16*Kc=QKV+(rowbase+rc)*PQ+offk+head*D, *Vc=QKV+(rowbase+rc)*PQ+offv+head*D;
  const int T0=2*c-1;
  #pragma unroll
  for(int s=0;s<4;++s){ int T=T0+s; T=T<0?0:(T>=ntile?ntile-1:T); const long p0_=(long)T*64;
    #pragma unroll
    for(int q_=0;q_<2;++q_){ const int cc_=2*wq+q_;
      glds16(Kc+((p0_+lane)*dil)*PQ+cc_*8,(unsigned)__builtin_amdgcn_readfirstlane(lds0+BAND_K+s*8192+cc_*1024));
      glds16(Vc+((p0_+16*(cc_&3)+(lane>>2))*dil)*PQ+(cc_>>2)*32+(lane&3)*8,(unsigned)__builtin_amdgcn_readfirstlane(lds0+BAND_V+s*8192+cc_*1024)); } }
  float mrun=-1e30f,l_reg=0.f; f32x16 o[2]; o[0]=f32x16{}; o[1]=f32x16{};
  const int vb0=(int)(lds0+BAND_V)+((lane>>4)&1)*32+(lane&3)*8+(4*hi+((lane&15)>>2))*64;
  #define BAND_STEP(s,NW_) do{ \
    asm volatile("s_waitcnt vmcnt(" #NW_ ")\n\ts_barrier":::"memory");     \
    const int T=T0+(s); const bool act=(T>=0&&T<ntile)&&((s)>=(wq>>1))&&((s)<=(wq>>1)+2); \
    if(act){ \
      f32x16 p0,p1; const f32x16 zero=f32x16{}; \
      qkt(p0,p1,hb+BAND_K+(s)*8192,qr,zero,r32,hi); \
      const int kb=64*T+4*hi-mq; \
      float mx=-1e30f; \
      _Pragma("unroll") for(int r=0;r<16;++r){ const int d0_=kb+(r&3)+8*(r>>2), d1_=d0_+32; \
        p0[r]=(d0_>=-64&&d0_<=64)?p0[r]:-1e30f; p1[r]=(d1_>=-64&&d1_<=64)?p1[r]:-1e30f; mx=__builtin_fmaxf(mx,__builtin_fmaxf(p0[r],p1[r])); } \
      mx=__builtin_fmaxf(mx,__shfl_xor(mx,32)); \
      const float mnew=__builtin_fmaxf(mrun,mx); const float f=__builtin_amdgcn_exp2f(mrun-mnew); mrun=mnew; \
      float sacc=0.f; \
      _Pragma("unroll") for(int r=0;r<16;++r){ p0[r]=(p0[r]>-1e29f)?__builtin_amdgcn_exp2f(p0[r]-mnew):0.f; p1[r]=(p1[r]>-1e29f)?__builtin_amdgcn_exp2f(p1[r]-mnew):0.f; sacc+=p0[r]+p1[r]; } \
      l_reg=l_reg*f+sacc; \
      if(hi==0)wsf[r32]=f; \
      _Pragma("unroll") for(int r=0;r<16;++r){ const float fr=wsf[crow(r,hi)]; o[0][r]*=fr; o[1][r]*=fr; } \
      u32x4 pw0,pw1,pw2,pw3; \
      pw0=(u32x4){cvtpk_s(p0[0],p0[1]),cvtpk_s(p0[2],p0[3]),cvtpk_s(p0[4],p0[5]),cvtpk_s(p0[6],p0[7])}; pw1=(u32x4){cvtpk_s(p0[8],p0[9]),cvtpk_s(p0[10],p0[11]),cvtpk_s(p0[12],p0[13]),cvtpk_s(p0[14],p0[15])}; \
      pw2=(u32x4){cvtpk_s(p1[0],p1[1]),cvtpk_s(p1[2],p1[3]),cvtpk_s(p1[4],p1[5]),cvtpk_s(p1[6],p1[7])}; pw3=(u32x4){cvtpk_s(p1[8],p1[9]),cvtpk_s(p1[10],p1[11]),cvtpk_s(p1[12],p1[13]),cvtpk_s(p1[14],p1[15])}; \
      SBAR(); pv(o,vb0+(s)*8192,__builtin_bit_cast(bf16x8,pw0),__builtin_bit_cast(bf16x8,pw1),__builtin_bit_cast(bf16x8,pw2),__builtin_bit_cast(bf16x8,pw3)); \
    } }while(0)
  BAND_STEP(0,12); BAND_STEP(1,8); BAND_STEP(2,4); BAND_STEP(3,0);
  #undef BAND_STEP
  l_reg+=__shfl_xor(l_reg,32);
  if(hi==0)wsf[32+r32]=l_reg;
  float rli[16];
  #pragma unroll
  for(int r=0;r<16;++r)rli[r]=__builtin_amdgcn_rcpf(wsf[32+crow(r,hi)]);
  asm volatile("s_waitcnt lgkmcnt(0)\n\ts_barrier":::"memory");
  { bf16*stg=(bf16*)(hb+BAND_V)+wq*2048;
    #pragma unroll
    for(int r=0;r<16;++r){const int orow=crow(r,hi);
      #pragma unroll
      for(int d0=0;d0<2;++d0)stg[orow*64+d0*32+r32]=__float2bfloat16(o[d0][r]*rli[r]);}
    asm volatile("s_waitcnt lgkmcnt(0)":::"memory");
    #pragma unroll
    for(int i=0;i<4;++i){const int row=i*8+(lane>>3),ch=lane&7; const u32x4 v=*(const u32x4*)(stg+row*64+ch*8);
      const long grow=rowbase+(long)(128*c+32*wq+row)*dil+rc;
      *(u32x4*)(OG+grow*256+j*64+ch*8)=v;} }
  if(hi==0){ const long grow=rowbase+(long)mq*dil+rc; LG[grow*4+j]=mrun+__builtin_log2f(l_reg); }
  asm volatile("s_waitcnt lgkmcnt(0)\n\ts_barrier":::"memory");
}
#undef SBAR
#undef WAIT_BAR
}
#define GAS __attribute__((address_space(1)))
#define LAS __attribute__((address_space(3)))
typedef unsigned short bf16;
typedef unsigned v4u __attribute__((ext_vector_type(4)));
typedef float f32x4 __attribute__((ext_vector_type(4)));
typedef short bf16x8 __attribute__((ext_vector_type(8)));
typedef GAS unsigned gu32;
typedef GAS unsigned long long gu64;
#define RLX_AGENT __ATOMIC_RELAXED, __HIP_MEMORY_SCOPE_AGENT
#define LDS_WAIT() asm volatile("s_waitcnt lgkmcnt(0)" ::: "memory")
#define VM_WAIT() asm volatile("s_waitcnt vmcnt(0)" ::: "memory")
__device__ __forceinline__ unsigned long long rt() { return __builtin_amdgcn_s_memrealtime(); }
__device__ __forceinline__ unsigned f2bf(float f) { unsigned u = __builtin_bit_cast(unsigned, f); return (u + 0x7fffu + ((u >> 16) & 1u)) >> 16; }
typedef float f32x2_pk __attribute__((ext_vector_type(2))); typedef __bf16 bf16x2_pk __attribute__((ext_vector_type(2)));
__device__ __forceinline__ unsigned pk2(float lo, float hi) { f32x2_pk v = {lo, hi}; return __builtin_bit_cast(unsigned, __builtin_convertvector(v, bf16x2_pk)); }

#define XB_TMO      128
#define XB_XCNT(j)  (256  + 64 * (j))
#define XB_XSUB(j)  (1280 + 64 * (j))
#define XB_XGEN(j)  (2304 + 64 * (j))
#define XB_TOP      3328
#define XB_TOPGEN   3392
#define XCD_BAR_WORDS 3456
#define XB_SPIN_CAP (1u << 24)

__device__ __forceinline__ unsigned xb_ld(unsigned* p)              { return __hip_atomic_load(p, __ATOMIC_RELAXED, __HIP_MEMORY_SCOPE_AGENT); }
__device__ __forceinline__ unsigned xb_add(unsigned* p, unsigned v) { return __hip_atomic_fetch_add(p, v, __ATOMIC_RELAXED, __HIP_MEMORY_SCOPE_AGENT); }
__device__ __forceinline__ unsigned xb_xcc_id() { return (unsigned)__builtin_amdgcn_s_getreg((3 << 11) | 20) & 0xFu; }
#define XB_SPIN(cond, bar) do { unsigned _sp = 0; while (cond) { __builtin_amdgcn_s_sleep(1); \
    if ((++_sp & 255u) == 0u) { if (xb_ld(&(bar)[XB_TMO])) break; if (_sp > XB_SPIN_CAP) { atomicAdd(&(bar)[XB_TMO], 1u); break; } } } } while (0)

struct XcdBarrier {
    unsigned* bar; unsigned x;
    volatile LAS unsigned* st;
};

__device__ __forceinline__ XcdBarrier xcd_barrier_post(unsigned* bar, volatile LAS unsigned* st) {
    XcdBarrier b; b.bar = bar; b.x = xb_xcc_id(); b.st = st;
    if (threadIdx.x == 0) (void)xb_add(&bar[XB_XCNT(b.x)], 1u);
    return b;
}
__device__ __forceinline__ void xcd_barrier_complete(unsigned* bar, unsigned x, unsigned& nloc, unsigned& nx) {
    const unsigned G = gridDim.x * gridDim.y * gridDim.z;
    unsigned sum, cnt, mine, sp = 0u;
    for (;;) {
        sum = 0u; cnt = 0u; mine = 0u;
#pragma unroll
        for (unsigned j = 0; j < 16; ++j) { const unsigned c = xb_ld(&bar[XB_XCNT(j)]); sum += c; cnt += (c > 0u) ? 1u : 0u; mine = (j == x) ? c : mine; }
        if (sum == G) break;
        __builtin_amdgcn_s_sleep(1);
        if ((++sp & 255u) == 0u) { if (xb_ld(&bar[XB_TMO])) break; if (sp > XB_SPIN_CAP) { atomicAdd(&bar[XB_TMO], 1u); break; } }
    }
    nloc = mine > 0u ? mine : 1u; nx = cnt > 0u ? cnt : 1u;
}

__device__ __forceinline__ void xcd_barrier(const XcdBarrier& b) {
    asm volatile("s_waitcnt vmcnt(0)" ::: "memory");
    __syncthreads();
    if (threadIdx.x == 0) {
        unsigned* bar = b.bar;
        __builtin_amdgcn_s_waitcnt(0);
        unsigned nloc = b.st[0], nx = b.st[1];
        if (nloc == 0u) { xcd_barrier_complete(bar, b.x, nloc, nx); b.st[0] = nloc; b.st[1] = nx; }
        const unsigned old = xb_add(&bar[XB_XSUB(b.x)], 1u);
        const unsigned gen = old / nloc;
        if (old + 1u == (gen + 1u) * nloc) {
            __builtin_amdgcn_fence(__ATOMIC_RELEASE, "agent");
            asm volatile("s_waitcnt vmcnt(0)" ::: "memory");
            const unsigned og = xb_add(&bar[XB_TOP], 1u);
            const unsigned tg = og / nx;
            if (og + 1u == (tg + 1u) * nx) xb_add(&bar[XB_TOPGEN], 1u);
            else XB_SPIN(xb_ld(&bar[XB_TOPGEN]) == tg, bar);
            __builtin_amdgcn_fence(__ATOMIC_ACQUIRE, "agent");
            xb_add(&bar[XB_XGEN(b.x)], 1u);
            asm volatile("s_waitcnt vmcnt(0)" ::: "memory");
        } else {
            XB_SPIN(xb_ld(&bar[XB_XGEN(b.x)]) == gen, bar);
            __builtin_amdgcn_fence(__ATOMIC_ACQUIRE, "agent");
            asm volatile("s_waitcnt vmcnt(0)" ::: "memory");
        }
    }
    __syncthreads();
}


constexpr size_t MiB = 1u << 20;
constexpr size_t WS_CTL = 0, CTL_ZERO_BYTES = 1 * MiB;
constexpr size_t WS_STAT0 = 1 * MiB;
constexpr size_t WS_AFF = 2 * MiB;
constexpr size_t WS_INV = 4 * MiB;
constexpr size_t WS_TOK = 5 * MiB;
constexpr size_t WS_LSE = 6 * MiB;
constexpr size_t WS_WIN = 8 * MiB;
constexpr size_t WS_WA = 18 * MiB;
constexpr size_t WS_WO = 20 * MiB;
constexpr size_t WS_ROPEA = 22 * MiB;
constexpr size_t WS_ROPEB = 23 * MiB;
constexpr size_t ARENA = 24 * MiB;
constexpr size_t A_H0B = ARENA + 0 * MiB;
constexpr size_t A_QKV = ARENA + 64 * MiB;
constexpr size_t A_GATES = ARENA + 256 * MiB;
constexpr size_t A_ATTNA = ARENA + 0 * MiB;
constexpr size_t A_OBG = ARENA + 384 * MiB;
constexpr size_t A_MERGED = ARENA + 64 * MiB;
constexpr size_t A_MIX = ARENA + 128 * MiB;
constexpr size_t A_H1B = ARENA + 384 * MiB;
constexpr size_t A_WD = ARENA + 448 * MiB;
constexpr size_t A_XE = ARENA + 256 * MiB;
constexpr size_t A_ACT = ARENA + 0 * MiB;
constexpr size_t A_YE = ARENA + 256 * MiB;
constexpr size_t WS_END = ARENA + 512 * MiB;
constexpr int CW_TMO = 0, CW_BAR = 4096;

constexpr int RING_OFF = 0, RING_BYTES = 131072;
constexpr int LDSCTL_OFF = RING_BYTES, MISC_OFF = LDSCTL_OFF + 320;
constexpr int BANDWS_OFF = LDSCTL_OFF + 1024;
constexpr int GIDX_OFF = LDSCTL_OFF + 4096;
constexpr int LDS_BYTES = 147456;

typedef short s16x4v __attribute__((ext_vector_type(4)));
typedef unsigned u32x2 __attribute__((ext_vector_type(2)));

struct Frame {
    LAS unsigned char* lds;
    volatile LAS unsigned* MISC;
    gu32* ctl;
    int tid, lane, wave;
    int vcu, G;
};

__device__ __forceinline__ float wave_sum(float v) {
#pragma unroll
    for (int o = 1; o < 64; o <<= 1) v += __shfl_xor(v, o);
    return v;
}
__device__ __forceinline__ float bf2f(bf16 h) { return __uint_as_float(((unsigned)h) << 16); }

struct TJob { const float* src; bf16* dst; size_t off; int ldw, ldt, k0, n0, win, kdo; };
__device__ __forceinline__ void tjob_load(const TJob& j, f32x4 (&r)[8], int lane) {
    const float* p = j.src + (size_t)(j.k0 + (lane >> 3)) * j.ldw + j.n0 + 4 * (lane & 7);
#pragma unroll
    for (int i = 0; i < 8; ++i) r[i] = *(const GAS f32x4*)(p + (size_t)(8 * i) * j.ldw);
}
struct WinRow {
    __device__ __forceinline__ size_t operator()(int ncol) const {
        if (ncol >= QKVW) return (size_t)ncol;
        int pn, wc, d, map;
        if (ncol < OFF_KA) { const int h = ncol >> 6; pn = h >> 2; wc = h & 3; map = 0; }
        else if (ncol < OFF_VA) { pn = 2; wc = (ncol - OFF_KA) >> 6; map = 0; }
        else if (ncol < OFF_QB) { pn = 2; wc = 2 + ((ncol - OFF_VA) >> 6); map = 2; }
        else if (ncol < OFF_KB) { const int h = (ncol - OFF_QB) >> 6; pn = 3 + (h >> 2); wc = h & 3; map = 1; }
        else if (ncol < OFF_VB) { const int h = (ncol - OFF_KB) >> 6; pn = 6 + (h >> 2); wc = h & 3; map = 1; }
        else { const int h = (ncol - OFF_VB) >> 6; pn = 9 + (h >> 2); wc = h & 3; map = 2; }
        d = ncol & 63;
        int bj, fq, n; const int i = d & 3;
        if (map == 0) { n = d >> 5; bj = (d >> 4) & 1; fq = (d >> 2) & 3; }
        else if (map == 1) { fq = d >> 4; bj = (d >> 3) & 1; n = (d >> 2) & 1; }
        else { bj = d >> 5; fq = (d >> 3) & 3; n = (d >> 2) & 1; }
        return (size_t)(pn * 256 + 128 * bj + 32 * wc + 8 * fq + 4 * n + i);
    }
};

__device__ __forceinline__ void tjob_store(const TJob& j, const f32x4 (&r)[8], LAS float* scr, int lane) {
    { LAS float* w = scr + (4 * (lane & 7)) * 65 + (lane >> 3);
#pragma unroll
      for (int i = 0; i < 8; ++i) { w[8 * i] = r[i].x; w[65 + 8 * i] = r[i].y; w[130 + 8 * i] = r[i].z; w[195 + 8 * i] = r[i].w; } }
    LDS_WAIT(); asm volatile("" ::: "memory");
    const int c = lane & 7;
#pragma unroll
    for (int jj = 0; jj < 4; ++jj) { const int n = (lane >> 3) + 8 * jj; const LAS float* sp = scr + n * 65 + 8 * c;
        v4u o; o.x = pk2(sp[0], sp[1]); o.y = pk2(sp[2], sp[3]); o.z = pk2(sp[4], sp[5]); o.w = pk2(sp[6], sp[7]);
        const size_t row = j.win ? WinRow{}(j.n0 + n) : j.off + (size_t)n;
        *(GAS v4u*)(j.dst + row * (size_t)j.ldt + j.kdo + j.k0 + 8 * c) = o; }
    LDS_WAIT(); asm volatile("" ::: "memory");
}
template <class Decode>
__device__ __forceinline__ void tjobs_run(int first, int stride, int count, const Decode& decode, LAS float* scr, int lane) {
    TJob cur, nxt; f32x4 ra[8], rb[8];
    int it = first; if (it >= count) return;
    decode(it, cur); tjob_load(cur, ra, lane);
    for (;;) {
        const int itn = it + stride; const bool hn = itn < count;
        if (hn) { decode(itn, nxt); tjob_load(nxt, rb, lane); }
        tjob_store(cur, ra, scr, lane);
        if (!hn) break;
        cur = nxt; it = itn;
        ra[0] = rb[0]; ra[1] = rb[1]; ra[2] = rb[2]; ra[3] = rb[3]; ra[4] = rb[4]; ra[5] = rb[5]; ra[6] = rb[6]; ra[7] = rb[7];
    }
}

struct Ptrs {
    const float *x, *ln0_g, *ln0_b, *w_in, *b_gate, *qn_g, *kn_g, *w_a, *w_b, *w_out, *ln1_g, *ln1_b, *w_router, *w_gate_e, *w_up_e, *w_down_e, *ln2_g, *ln2_b;
    float* out; unsigned char* ws;
};
struct Args { Ptrs p; int ph_lo, ph_hi, li, pad; };
typedef const __attribute__((address_space(4))) Args* KArgsP;
__device__ __forceinline__ KArgsP kargs() { KArgsP k = (KArgsP)__builtin_amdgcn_kernarg_segment_ptr(); asm volatile("" : "+s"(k)); return k; }

__device__ __forceinline__ void sincos_rev(float angle, float& sn, float& cs) {
    const double rev = (double)angle * 0.15915494309189533577; const double fr = rev - __builtin_rint(rev);
    sn = __builtin_amdgcn_sinf((float)fr); cs = __builtin_amdgcn_cosf((float)fr);
}
__device__ __forceinline__ void p0_prologue(Frame& F, KArgsP K) {
    LAS float* scr = (LAS float*)(F.lds + RING_OFF + F.wave * 16384);
    const int gw = F.vcu * NWAVES + F.wave, NGW = F.G * NWAVES;
    bf16* win_t = (bf16*)(K->p.ws + WS_WIN); bf16* wa_t = (bf16*)(K->p.ws + WS_WA); bf16* wo_t = (bf16*)(K->p.ws + WS_WO);
    constexpr int I_IN = (1024 / 64) * (5120 / 32), I_A = (512 / 64) * (1024 / 32), I_B = (256 / 64) * (1024 / 32), I_O = (1024 / 64) * (1024 / 32);
    { const float* w_in = K->p.w_in; const float* w_a = K->p.w_a; const float* w_b = K->p.w_b; const float* w_o = K->p.w_out;
      auto decode = [&](int it, TJob& j) {
          int r = it; j.off = 0; j.win = 0; j.kdo = 0;
          if (r < I_IN) { j.src = w_in; j.ldw = 5120; j.dst = win_t; j.ldt = 1024; j.k0 = (r / 160) * 64; j.n0 = (r % 160) * 32; j.win = 1; return; } r -= I_IN;
          if (r < I_A) { j.src = w_a; j.ldw = 1024; j.dst = wa_t; j.ldt = 768; j.k0 = (r / 32) * 64; j.n0 = (r % 32) * 32; j.off = (size_t)j.n0; return; } r -= I_A;
          if (r < I_B) { j.src = w_b; j.ldw = 1024; j.dst = wa_t; j.ldt = 768; j.kdo = 512; j.k0 = (r / 32) * 64; j.n0 = (r % 32) * 32; j.off = (size_t)j.n0; return; } r -= I_B;
          j.src = w_o; j.ldw = 1024; j.dst = wo_t; j.ldt = 1024; j.k0 = (r / 32) * 64; j.n0 = (r % 32) * 32; j.off = (size_t)j.n0; };
      tjobs_run(gw, NGW, I_IN + I_A + I_B + I_O, decode, scr, F.lane); }
    { float* ra = (float*)(K->p.ws + WS_ROPEA); float* rb = (float*)(K->p.ws + WS_ROPEB);
      for (int it = F.vcu * (NWAVES * 64) + F.tid; it < SEQ * 40; it += F.G * NWAVES * 64) {
          const int t = it / 40, r = it - t * 40; float sn, cs;
          if (r < 32) { const int n = r >> 4, f = r & 15; const float pos = n ? (float)(t & 63) : (float)(t >> 6);
              sincos_rev(pos * exp2f(-(float)f * (13.287712379549449f / 16.f)), sn, cs); ra[t * 64 + n * 32 + f] = cs; ra[t * 64 + n * 32 + 16 + f] = sn; }
          else { const int f = r - 32; sincos_rev((float)t * exp2f(-(float)f * (18.931568569324174f / 8.f)), sn, cs); rb[t * 16 + f] = cs; rb[t * 16 + 8 + f] = sn; }
      } }
    bf16* h0b = (bf16*)(K->p.ws + A_H0B); float* st0 = (float*)(K->p.ws + WS_STAT0);
    f32x4 g[4], bb[4];
#pragma unroll
    for (int j = 0; j < 4; ++j) { g[j] = ((const f32x4*)K->p.ln0_g)[F.lane + 64 * j]; bb[j] = ((const f32x4*)K->p.ln0_b)[F.lane + 64 * j]; }
    f32x4 xc[4], xn[4];
    { const GAS f32x4* xr = (const GAS f32x4*)(K->p.x + (size_t)gw * DM) + F.lane;
#pragma unroll
      for (int j = 0; j < 4; ++j) xc[j] = xr[64 * j]; }
    for (int m = gw; m < MTOK; m += NGW) {
        if (m + NGW < MTOK) { const GAS f32x4* xr = (const GAS f32x4*)(K->p.x + (size_t)(m + NGW) * DM) + F.lane;
#pragma unroll
            for (int j = 0; j < 4; ++j) xn[j] = xr[64 * j]; }
        f32x4 v[4]; float s = 0.f;
#pragma unroll
        for (int j = 0; j < 4; ++j) { v[j] = xc[j]; s += (v[j].x + v[j].y) + (v[j].z + v[j].w); }
        const float mean = wave_sum(s) * (1.f / DM); float s2 = 0.f;
#pragma unroll
        for (int j = 0; j < 4; ++j) { v[j] = v[j] - mean; s2 += (v[j].x * v[j].x + v[j].y * v[j].y) + (v[j].z * v[j].z + v[j].w * v[j].w); }
        const float rstd = 1.f / sqrtf(wave_sum(s2) * (1.f / DM) + LN_EPS);
        GAS unsigned long long* o8 = (GAS unsigned long long*)(h0b + (size_t)m * DM) + F.lane;
#pragma unroll
        for (int j = 0; j < 4; ++j) { const f32x4 y = v[j] * rstd * g[j] + bb[j]; o8[64 * j] = (unsigned long long)pk2(y.x, y.y) | ((unsigned long long)pk2(y.z, y.w) << 32); }
        if (F.lane == 0) { st0[2 * m] = mean; st0[2 * m + 1] = rstd; }
#pragma unroll
        for (int j = 0; j < 4; ++j) xc[j] = xn[j];
    }
}

__device__ __forceinline__ void p3b_combine(Frame& F, KArgsP K) {
    const bf16* obg = (const bf16*)(K->p.ws + A_OBG); const float* lse = (const float*)(K->p.ws + WS_LSE); bf16* ob = (bf16*)(K->p.ws + A_ATTNA) + 512;
    for (int it = F.vcu; it < MTOK / 16; it += F.G) {
        const int m = it * 16 + (F.tid >> 5), ch = F.tid & 31, j = ch >> 3;
        const float l0 = lse[((size_t)0 * MTOK + m) * 4 + j], l1 = lse[((size_t)1 * MTOK + m) * 4 + j], l2 = lse[((size_t)2 * MTOK + m) * 4 + j];
        const float mx = fmaxf(l0, fmaxf(l1, l2)); float w0 = exp2f(l0 - mx), w1 = exp2f(l1 - mx), w2 = exp2f(l2 - mx); const float rs = 1.0f / (w0 + w1 + w2); w0 *= rs; w1 *= rs; w2 *= rs;
        const v4u a = *(const v4u*)(obg + ((size_t)0 * MTOK + m) * 256 + ch * 8), b = *(const v4u*)(obg + ((size_t)1 * MTOK + m) * 256 + ch * 8), c = *(const v4u*)(obg + ((size_t)2 * MTOK + m) * 256 + ch * 8);
        v4u o;
        o.x = pk2(w0 * pg8::bf_lo(a.x) + w1 * pg8::bf_lo(b.x) + w2 * pg8::bf_lo(c.x), w0 * pg8::bf_hi(a.x) + w1 * pg8::bf_hi(b.x) + w2 * pg8::bf_hi(c.x));
        o.y = pk2(w0 * pg8::bf_lo(a.y) + w1 * pg8::bf_lo(b.y) + w2 * pg8::bf_lo(c.y), w0 * pg8::bf_hi(a.y) + w1 * pg8::bf_hi(b.y) + w2 * pg8::bf_hi(c.y));
        o.z = pk2(w0 * pg8::bf_lo(a.z) + w1 * pg8::bf_lo(b.z) + w2 * pg8::bf_lo(c.z), w0 * pg8::bf_hi(a.z) + w1 * pg8::bf_hi(b.z) + w2 * pg8::bf_hi(c.z));
        o.w = pk2(w0 * pg8::bf_lo(a.w) + w1 * pg8::bf_lo(b.w) + w2 * pg8::bf_lo(c.w), w0 * pg8::bf_hi(a.w) + w1 * pg8::bf_hi(b.w) + w2 * pg8::bf_hi(c.w));
        *(v4u*)(ob + (size_t)m * 768 + ch * 8) = o;
    }
}

__device__ __forceinline__ void convert_experts(Frame& F, KArgsP K) {
    const int gw = F.vcu * NWAVES + F.wave, NGW = F.G * NWAVES;
    { LAS float* scr = (LAS float*)(F.lds + RING_OFF + F.wave * 16384);
      bf16* wgu = (bf16*)K->p.out; bf16* wd = (bf16*)(K->p.ws + A_WD);
      constexpr int I_G = 16 * 64, I_D = 32 * 32, PER_E = 2 * I_G + I_D;
      const float* wg = K->p.w_gate_e; const float* wu = K->p.w_up_e; const float* wdn = K->p.w_down_e;
      auto decode = [&](int it, TJob& j) {
          const int e = it / PER_E; int r = it - e * PER_E; j.win = 0; j.kdo = 0;
          if (r < 2 * I_G) { const int up = r >= I_G; r -= up * I_G; j.src = (up ? wu : wg) + (size_t)e * DM * DFF; j.ldw = DFF; j.dst = wgu; j.ldt = 1024; j.k0 = (r / 64) * 64; j.n0 = (r % 64) * 32;
              j.off = (size_t)e * 4096 + (j.n0 >> 7) * 256 + up * 128 + (j.n0 & 127); return; }
          r -= 2 * I_G; j.src = wdn + (size_t)e * DFF * DM; j.ldw = DM; j.dst = wd; j.ldt = 2048; j.k0 = (r / 32) * 64; j.n0 = (r % 32) * 32; j.off = (size_t)e * 1024 + j.n0; };
      tjobs_run(gw, NGW, NEXP * PER_E, decode, scr, F.lane); }
}

__device__ __forceinline__ void p5_ln1_router_convert(Frame& F, KArgsP K) {
    const int gw = F.vcu * NWAVES + F.wave, NGW = F.G * NWAVES;
    __syncthreads();
    { LAS f32x4* wl = (LAS f32x4*)(F.lds + RING_OFF); const f32x4* wr4 = (const f32x4*)K->p.w_router;
      for (int q = F.tid; q < 1024 * 4; q += NWAVES * 64) { const int col = q >> 2, e4 = q & 3; const int l = (col & 255) >> 2, i = col & 3, j = col >> 8;
          wl[((j * 4 + i) * 4 + e4) * 64 + l] = wr4[q]; } }
    __syncthreads();
    const bf16* mix = (const bf16*)(K->p.ws + A_MIX); bf16* h1b = (bf16*)(K->p.ws + A_H1B); const float* st0 = (const float*)(K->p.ws + WS_STAT0); float* aff = (float*)(K->p.ws + WS_AFF);
    f32x4 xv[4], xn[4]; u32x2 mw[4], mn[4]; float mean0 = 0.f, rstd0 = 0.f, mean0n = 0.f, rstd0n = 0.f;
    int m = gw;
    if (m < MTOK) { const GAS f32x4* xr = (const GAS f32x4*)(K->p.x + (size_t)m * DM) + F.lane; const GAS u32x2* mr = (const GAS u32x2*)(mix + (size_t)m * DM) + F.lane;
#pragma unroll
        for (int j = 0; j < 4; ++j) { xv[j] = xr[64 * j]; mw[j] = mr[64 * j]; }
        mean0 = st0[2 * m]; rstd0 = st0[2 * m + 1]; }
    for (; m < MTOK; m += NGW) {
        const int mnx = m + NGW;
        if (mnx < MTOK) { const GAS f32x4* xr = (const GAS f32x4*)(K->p.x + (size_t)mnx * DM) + F.lane; const GAS u32x2* mr = (const GAS u32x2*)(mix + (size_t)mnx * DM) + F.lane;
#pragma unroll
            for (int j = 0; j < 4; ++j) { xn[j] = xr[64 * j]; mn[j] = mr[64 * j]; }
            mean0n = st0[2 * mnx]; rstd0n = st0[2 * mnx + 1]; }
        f32x4 v[4]; float s = 0.f;
#pragma unroll
        for (int j = 0; j < 4; ++j) {
            const f32x4 g0 = ((const f32x4*)K->p.ln0_g)[F.lane + 64 * j], b0 = ((const f32x4*)K->p.ln0_b)[F.lane + 64 * j];
            const f32x4 h0 = (xv[j] - mean0) * rstd0 * g0 + b0;
            v[j] = h0 * ALPHA + (f32x4){pg8::bf_lo(mw[j].x), pg8::bf_hi(mw[j].x), pg8::bf_lo(mw[j].y), pg8::bf_hi(mw[j].y)};
            s += (v[j].x + v[j].y) + (v[j].z + v[j].w); }
        const float mean = wave_sum(s) * (1.f / DM); float s2 = 0.f;
#pragma unroll
        for (int j = 0; j < 4; ++j) { v[j] = v[j] - mean; s2 += (v[j].x * v[j].x + v[j].y * v[j].y) + (v[j].z * v[j].z + v[j].w * v[j].w); }
        const float rstd = 1.f / sqrtf(wave_sum(s2) * (1.f / DM) + LN_EPS);
        GAS unsigned long long* o8 = (GAS unsigned long long*)(h1b + (size_t)m * DM) + F.lane;
        float lg[16];
#pragma unroll
        for (int e = 0; e < 16; ++e) lg[e] = 0.f;
#pragma unroll
        for (int j = 0; j < 4; ++j) { const f32x4 g1 = ((const f32x4*)K->p.ln1_g)[F.lane + 64 * j], b1 = ((const f32x4*)K->p.ln1_b)[F.lane + 64 * j];
            const f32x4 y = v[j] * rstd * g1 + b1;
            o8[64 * j] = (unsigned long long)pk2(y.x, y.y) | ((unsigned long long)pk2(y.z, y.w) << 32);
            const LAS f32x4* wl = (const LAS f32x4*)(F.lds + RING_OFF) + F.lane;
            asm volatile("" ::: "memory");
#pragma unroll
            for (int i = 0; i < 4; ++i) { const float yv = y[i];
#pragma unroll
                for (int c = 0; c < 4; ++c) { const f32x4 w = wl[((j * 4 + i) * 4 + c) * 64]; lg[4 * c] += yv * w.x; lg[4 * c + 1] += yv * w.y; lg[4 * c + 2] += yv * w.z; lg[4 * c + 3] += yv * w.w; } } }
#pragma unroll
        for (int e = 0; e < 16; ++e) lg[e] = wave_sum(lg[e]);
        float mx = lg[0];
#pragma unroll
        for (int e = 1; e < 16; ++e) mx = fmaxf(mx, lg[e]);
        float se = 0.f;
#pragma unroll
        for (int e = 0; e < 16; ++e) { lg[e] = expf(lg[e] - mx); se += lg[e]; }
        float mine = 0.f;
#pragma unroll
        for (int e = 0; e < 16; ++e) if (F.lane == e) mine = lg[e] / se;
        if (F.lane < 16) aff[(size_t)m * 16 + F.lane] = mine;
#pragma unroll
        for (int j = 0; j < 4; ++j) { xv[j] = xn[j]; mw[j] = mn[j]; }
        mean0 = mean0n; rstd0 = rstd0n;
    }
}

__device__ __forceinline__ void p6_topk_unit(Frame& F, KArgsP K, int unit) {
    const int e = unit >> 4, b = unit & 15;
    const float* aff = (const float*)(K->p.ws + WS_AFF); short* inv = (short*)(K->p.ws + WS_INV); int* tok = (int*)(K->p.ws + WS_TOK);
    LAS unsigned* cnt = (LAS unsigned*)(F.lds + RING_OFF);
    unsigned key[4];
#pragma unroll
    for (int i = 0; i < 4; ++i) key[i] = __float_as_uint(aff[((size_t)b * SEQ + 4 * F.tid + i) * 16 + e]);
    __syncthreads();
    unsigned thr = 0u;
    for (int bit = 31; bit >= 0; --bit) {
        const unsigned cand = thr | (1u << bit);
        unsigned c = 0;
#pragma unroll
        for (int i = 0; i < 4; ++i) c += (unsigned)__popcll(__ballot(key[i] >= cand));
        LAS unsigned* cb = cnt + ((bit & 1) ? 8 : 0);
        if (F.lane == 0) cb[F.wave] = c;
        __syncthreads();
        unsigned tot = 0;
#pragma unroll
        for (int w = 0; w < 8; ++w) tot += cb[w];
        if (tot >= (unsigned)CAP) thr = cand;
    }
    __syncthreads();
    unsigned cg = 0, ce = 0;
#pragma unroll
    for (int i = 0; i < 4; ++i) { cg += key[i] > thr; ce += key[i] == thr; }
    unsigned pk = cg | (ce << 16), inc = pk;
#pragma unroll
    for (int o = 1; o < 64; o <<= 1) { const unsigned up = __shfl_up(inc, o); if (F.lane >= o) inc += up; }
    if (F.lane == 63) cnt[16 + F.wave] = inc;
    __syncthreads();
    unsigned base = 0, total = 0;
#pragma unroll
    for (int w = 0; w < 8; ++w) { const unsigned tw = cnt[16 + w]; if (w < F.wave) base += tw; total += tw; }
    const unsigned excl = base + inc - pk;
    unsigned pg = excl & 0xffffu, pe = excl >> 16; const unsigned ngt = total & 0xffffu; const unsigned need = (unsigned)CAP - ngt;
#pragma unroll
    for (int i = 0; i < 4; ++i) {
        const int t = 4 * F.tid + i; int slot = -1;
        if (key[i] > thr) { slot = (int)(pg + (pe < need ? pe : need)); ++pg; }
        else if (key[i] == thr) { if (pe < need) slot = (int)(pg + pe); ++pe; }
        inv[((size_t)b * SEQ + t) * 16 + e] = (short)slot;
        if (slot >= 0) tok[unit * CAP + slot] = t;
    }
    __syncthreads();
}

__device__ __forceinline__ void p9_final(Frame& F, KArgsP K) {
    const int gw = F.vcu * NWAVES + F.wave, NGW = F.G * NWAVES;
    const float* aff = (const float*)(K->p.ws + WS_AFF); const short* inv = (const short*)(K->p.ws + WS_INV); const bf16* ye = (const bf16*)(K->p.ws + A_YE); const bf16* h1b = (const bf16*)(K->p.ws + A_H1B);
    f32x4 g2[2][2], b2[2][2];
#pragma unroll
    for (int jj = 0; jj < 2; ++jj)
#pragma unroll
        for (int q = 0; q < 2; ++q) { g2[jj][q] = *(const f32x4*)(K->p.ln2_g + 512 * jj + 8 * F.lane + 4 * q); b2[jj][q] = *(const f32x4*)(K->p.ln2_b + 512 * jj + 8 * F.lane + 4 * q); }
#define UNPK8(D_, W_, S_) do { D_[0] = pg8::bf_lo(W_.x) * (S_); D_[1] = pg8::bf_hi(W_.x) * (S_); D_[2] = pg8::bf_lo(W_.y) * (S_); D_[3] = pg8::bf_hi(W_.y) * (S_); \
                               D_[4] = pg8::bf_lo(W_.z) * (S_); D_[5] = pg8::bf_hi(W_.z) * (S_); D_[6] = pg8::bf_lo(W_[3]) * (S_); D_[7] = pg8::bf_hi(W_[3]) * (S_); } while (0)
#define FMA8(D_, W_, S_) do { D_[0] += pg8::bf_lo(W_.x) * (S_); D_[1] += pg8::bf_hi(W_.x) * (S_); D_[2] += pg8::bf_lo(W_.y) * (S_); D_[3] += pg8::bf_hi(W_.y) * (S_); \
                              D_[4] += pg8::bf_lo(W_.z) * (S_); D_[5] += pg8::bf_hi(W_.z) * (S_); D_[6] += pg8::bf_lo(W_[3]) * (S_); D_[7] += pg8::bf_hi(W_[3]) * (S_); } while (0)
    for (int m0 = gw; m0 < MTOK; m0 += 2 * NGW) {
        const int mA = m0, mB = m0 + NGW; const int bA = mA >> 11, bB = mB >> 11;
        const int ivA = (F.lane < 16) ? (int)inv[(size_t)mA * 16 + F.lane] : -1, ivB = (F.lane < 16) ? (int)inv[(size_t)mB * 16 + F.lane] : -1;
        const float afA = (F.lane < 16) ? aff[(size_t)mA * 16 + F.lane] : 0.f, afB = (F.lane < 16) ? aff[(size_t)mB * 16 + F.lane] : 0.f;
        const v4u* hA = (const v4u*)(h1b + (size_t)mA * DM) + F.lane; const v4u* hB = (const v4u*)(h1b + (size_t)mB * DM) + F.lane;
        const v4u hA0 = hA[0], hA1 = hA[64], hB0 = hB[0], hB1 = hB[64];
        unsigned long long mkA = __ballot(ivA >= 0), mkB = __ballot(ivB >= 0);
        float vA[2][8], vB[2][8];
        UNPK8(vA[0], hA0, ALPHA); UNPK8(vA[1], hA1, ALPHA); UNPK8(vB[0], hB0, ALPHA); UNPK8(vB[1], hB1, ALPHA);
        while (mkA | mkB) {
            int eA0 = 0, eA1 = 0, eB0 = 0, eB1 = 0; float gA0 = 0.f, gA1 = 0.f, gB0 = 0.f, gB1 = 0.f;
            const v4u *yA0 = hA, *yA1 = hA, *yB0 = hB, *yB1 = hB;
            if (mkA) { eA0 = __builtin_ctzll(mkA); mkA &= mkA - 1; gA0 = __builtin_bit_cast(float, __builtin_amdgcn_readlane(__builtin_bit_cast(int, afA), eA0));
                       yA0 = (const v4u*)(ye + ((size_t)(eA0 * 16 + bA) * CAP + __builtin_amdgcn_readlane(ivA, eA0)) * DM) + F.lane; }
            if (mkA) { eA1 = __builtin_ctzll(mkA); mkA &= mkA - 1; gA1 = __builtin_bit_cast(float, __builtin_amdgcn_readlane(__builtin_bit_cast(int, afA), eA1));
                       yA1 = (const v4u*)(ye + ((size_t)(eA1 * 16 + bA) * CAP + __builtin_amdgcn_readlane(ivA, eA1)) * DM) + F.lane; }
            if (mkB) { eB0 = __builtin_ctzll(mkB); mkB &= mkB - 1; gB0 = __builtin_bit_cast(float, __builtin_amdgcn_readlane(__builtin_bit_cast(int, afB), eB0));
                       yB0 = (const v4u*)(ye + ((size_t)(eB0 * 16 + bB) * CAP + __builtin_amdgcn_readlane(ivB, eB0)) * DM) + F.lane; }
            if (mkB) { eB1 = __builtin_ctzll(mkB); mkB &= mkB - 1; gB1 = __builtin_bit_cast(float, __builtin_amdgcn_readlane(__builtin_bit_cast(int, afB), eB1));
                       yB1 = (const v4u*)(ye + ((size_t)(eB1 * 16 + bB) * CAP + __builtin_amdgcn_readlane(ivB, eB1)) * DM) + F.lane; }
            const v4u a0 = yA0[0], a1 = yA0[64], a2 = yA1[0], a3 = yA1[64], c0 = yB0[0], c1 = yB0[64], c2 = yB1[0], c3 = yB1[64];
            FMA8(vA[0], a0, gA0); FMA8(vA[1], a1, gA0); FMA8(vA[0], a2, gA1); FMA8(vA[1], a3, gA1);
            FMA8(vB[0], c0, gB0); FMA8(vB[1], c1, gB0); FMA8(vB[0], c2, gB1); FMA8(vB[1], c3, gB1);
        }
        float sA = 0.f, sB = 0.f;
#pragma unroll
        for (int jj = 0; jj < 2; ++jj)
#pragma unroll
            for (int q = 0; q < 8; ++q) { sA += vA[jj][q]; sB += vB[jj][q]; }
        const float meanA = wave_sum(sA) * (1.f / DM), meanB = wave_sum(sB) * (1.f / DM); float qA = 0.f, qB = 0.f;
#pragma unroll
        for (int jj = 0; jj < 2; ++jj)
#pragma unroll
            for (int q = 0; q < 8; ++q) { vA[jj][q] -= meanA; qA += vA[jj][q] * vA[jj][q]; vB[jj][q] -= meanB; qB += vB[jj][q] * vB[jj][q]; }
        const float rsA = 1.f / sqrtf(wave_sum(qA) * (1.f / DM) + LN_EPS), rsB = 1.f / sqrtf(wave_sum(qB) * (1.f / DM) + LN_EPS);
        float* oA = K->p.out + (size_t)mA * DM + 8 * F.lane; float* oB = K->p.out + (size_t)mB * DM + 8 * F.lane;
#pragma unroll
        for (int jj = 0; jj < 2; ++jj)
#pragma unroll
            for (int q = 0; q < 2; ++q) {
                f32x4 o; o.x = vA[jj][4 * q] * rsA; o.y = vA[jj][4 * q + 1] * rsA; o.z = vA[jj][4 * q + 2] * rsA; o.w = vA[jj][4 * q + 3] * rsA;
                *(GAS f32x4*)(oA + 512 * jj + 4 * q) = o * g2[jj][q] + b2[jj][q];
                f32x4 p; p.x = vB[jj][4 * q] * rsB; p.y = vB[jj][4 * q + 1] * rsB; p.z = vB[jj][4 * q + 2] * rsB; p.w = vB[jj][4 * q + 3] * rsB;
                *(GAS f32x4*)(oB + 512 * jj + 4 * q) = p * g2[jj][q] + b2[jj][q]; }
    }
#undef UNPK8
#undef FMA8
}

struct OrderUp {
    int vcu;
    __device__ __forceinline__ bool next(int i, pg8::Unit& u) const {
        if (i >= NEXP) return false;
        const int e = i, x = vcu >> 5, l = vcu & 31, b = (x >> 1) * 4 + (l & 3), j = (x & 1) * 8 + (l >> 2);
        u.pm = e * 16 + b; u.pn = j; u.am = e * 16 + b; u.bt = e * 16 + j; return true;
    }
    __device__ __forceinline__ void a_ready(const pg8::Unit&) const {}
    __device__ __forceinline__ void done(const pg8::Unit&) const {}
};
struct OrderDown {
    int vcu;
    __device__ __forceinline__ bool next(int i, pg8::Unit& u) const {
        if (i >= 4) return false;
        const int x = vcu >> 5, l = vcu & 31, pm = i * 64 + x * 8 + (l & 7), pn = l >> 3;
        u.pm = pm; u.pn = pn; u.am = pm; u.bt = (pm >> 4) * 4 + pn; return true;
    }
    __device__ __forceinline__ void a_ready(const pg8::Unit&) const {}
    __device__ __forceinline__ void done(const pg8::Unit&) const {}
};

#ifndef MK_N_LAUNCHES
#define MK_N_LAUNCHES 1
#endif
constexpr int N_PHASES = 13;
#ifndef REP_P0
#define REP_P0 1
#endif
#ifndef REP_P1
#define REP_P1 1
#endif
#ifndef REP_DENSE
#define REP_DENSE 1
#endif
#ifndef REP_BAND
#define REP_BAND 1
#endif
#ifndef REP_WOUT
#define REP_WOUT 1
#endif
#ifndef REP_P6
#define REP_P6 1
#endif
#ifndef REP_TOPK
#define REP_TOPK 1
#endif
#ifndef REP_UP
#define REP_UP 1
#endif
#ifndef REP_DOWN
#define REP_DOWN 1
#endif
#define REPEAT(n) _Pragma("unroll 1") for (int rep_ = 0; rep_ < (n); ++rep_)
__global__ void __launch_bounds__(NWAVES * 64, 2) fwd_kernel(Args args) {
    extern __shared__ __attribute__((aligned(16))) unsigned char lds[];
#define MKFRAME(F) Frame F; { int t_ = threadIdx.x; asm volatile("" : "+v"(t_)); F.lds = (LAS unsigned char*)lds; F.MISC = (volatile LAS unsigned*)(F.lds + MISC_OFF); F.ctl = nullptr; \
        F.tid = t_; F.lane = t_ & 63; F.wave = __builtin_amdgcn_readfirstlane(t_ >> 6); F.G = 256; const int bx_ = blockIdx.x; F.vcu = (bx_ & 7) * 32 + (bx_ >> 3); }
#define BP(off) ((bf16*)(kargs()->p.ws + (off)))
#define SEAM() do { XcdBarrier b_; b_.bar = (unsigned*)(kargs()->p.ws + WS_CTL) + CW_BAR; b_.x = xb_xcc_id(); b_.st = (volatile LAS unsigned*)((LAS unsigned char*)lds + MISC_OFF) + 8; xcd_barrier(b_); } while (0)
    { const int t_ = threadIdx.x;
      for (int u = t_; u < (LDS_BYTES - LDSCTL_OFF) / 4; u += NWAVES * 64) ((LAS unsigned*)((LAS unsigned char*)lds + LDSCTL_OFF))[u] = 0u;
      __syncthreads();
      (void)xcd_barrier_post((unsigned*)(kargs()->p.ws + WS_CTL) + CW_BAR, (volatile LAS unsigned*)((LAS unsigned char*)lds + MISC_OFF) + 8); }

    REPEAT(REP_P0) { MKFRAME(F); p0_prologue(F, kargs()); } SEAM();
    REPEAT(REP_P1) { MKFRAME(F);
      pg8::Gemm g{BP(A_H0B), (const bf16*)(kargs()->p.ws + WS_WIN), MTOK, 5120, 1024}; pg8::StaticOrder S; S.init(MTOK, 5120, 256, (int)blockIdx.x);
      pg8::EpiProj2 E{BP(A_QKV), BP(A_GATES), kargs()->p.b_gate, kargs()->p.qn_g, kargs()->p.kn_g, (const float*)(kargs()->p.ws + WS_ROPEA), (const float*)(kargs()->p.ws + WS_ROPEB)};
      pg8::gemm_phase<pg8::EpiProj2, pg8::StaticOrder, true, true>(F.lds + RING_OFF, g, S, E); } SEAM();
    REPEAT(REP_DENSE) { MKFRAME(F);
      { const attn_body::bf16* q_ = (const attn_body::bf16*)BP(A_QKV); attn_body::bf16* o_ = (attn_body::bf16*)BP(A_ATTNA);
        const int g = F.vcu >> 3, s = F.vcu & 7, ab = g >> 1, akvh = g & 1;
        const int cpos = F.vcu % 5;
#pragma unroll 1
        for (int i = 0; i < 5; ++i) {
            if (i == cpos) { convert_experts(F, kargs()); asm volatile("s_waitcnt vmcnt(0) lgkmcnt(0)" ::: "memory"); __syncthreads(); }
            if (i < 4) attn_body::attn_unit<8>(ab, akvh * 4 + i, akvh, s, q_ + OFF_QA, q_ + OFF_KA, q_ + OFF_VA, o_, (char*)lds + RING_OFF);
        } }
      __syncthreads();
    }
    REPEAT(REP_BAND) { MKFRAME(F);
#pragma unroll 1
      for (int i = 0; i < 6; ++i) attn_body::band_half_unit(F.vcu + 256 * i, (const attn_body::bf16*)BP(A_QKV), OFF_QB, OFF_KB, OFF_VB, (attn_body::bf16*)BP(A_OBG), (float*)(kargs()->p.ws + WS_LSE), (char*)lds + RING_OFF, (char*)lds + BANDWS_OFF);
      __syncthreads(); } SEAM();
    { MKFRAME(F); p3b_combine(F, kargs()); } SEAM();
    { MKFRAME(F);
      pg8::Gemm g{BP(A_ATTNA), (const bf16*)(kargs()->p.ws + WS_WA), MTOK, 1024, 768}; pg8::StaticOrder S; S.init(MTOK, 1024, 256, (int)blockIdx.x);
      pg8::EpiGateMerge E{BP(A_MERGED), BP(A_GATES)};
      pg8::gemm_phase<pg8::EpiGateMerge, pg8::StaticOrder, true, true>(F.lds + RING_OFF, g, S, E); } SEAM();
    REPEAT(REP_WOUT) { MKFRAME(F);
      pg8::Gemm g{BP(A_MERGED), (const bf16*)(kargs()->p.ws + WS_WO), MTOK, 1024, 1024}; pg8::StaticOrder S; S.init(MTOK, 1024, 256, (int)blockIdx.x);
      pg8::EpiPlain E{BP(A_MIX), 1024};
      pg8::gemm_phase<pg8::EpiPlain, pg8::StaticOrder, true, true>(F.lds + RING_OFF, g, S, E); } SEAM();
    REPEAT(REP_P6) { MKFRAME(F); p5_ln1_router_convert(F, kargs()); } SEAM();
    REPEAT(REP_TOPK) { MKFRAME(F); p6_topk_unit(F, kargs(), F.vcu); } SEAM();
    REPEAT(REP_UP) { MKFRAME(F); OrderUp S{F.vcu};
      { LAS unsigned short* gi = (LAS unsigned short*)(F.lds + GIDX_OFF); const int* tok = (const int*)(kargs()->p.ws + WS_TOK);
        for (int q = F.tid; q < NEXP * CAP; q += NWAVES * 64) { pg8::Unit u; S.next(q >> 8, u); gi[q] = (unsigned short)tok[u.am * CAP + (q & 255)]; }
        __syncthreads(); }
      pg8::Gemm g{BP(A_H1B), (const bf16*)kargs()->p.out, 0, 0, 1024, (const LAS unsigned short*)(F.lds + GIDX_OFF)}; pg8::EpiSwiglu E{BP(A_ACT)};
      pg8::gemm_phase<pg8::EpiSwiglu, OrderUp, true, true, true>(F.lds + RING_OFF, g, S, E); } SEAM();
    REPEAT(REP_DOWN) { MKFRAME(F); pg8::Gemm g{BP(A_ACT), (const bf16*)(kargs()->p.ws + A_WD), 0, 0, 2048}; OrderDown S{F.vcu}; pg8::EpiPlain E{BP(A_YE), 1024};
      pg8::gemm_phase<pg8::EpiPlain, OrderDown, true, true>(F.lds + RING_OFF, g, S, E); } SEAM();
    { MKFRAME(F); p9_final(F, kargs()); }
#undef MKFRAME
#undef BP
#undef SEAM
}

extern "C" void kernel_launch(void* const* d_in, const int* in_sizes, int n_in, void* d_out, int out_size, void* d_ws, size_t ws_size, hipStream_t stream) {
    static int grid = 0;
    if (grid == 0) {
        if (n_in != 18 || in_sizes[0] != MTOK * DM || out_size != MTOK * DM || ws_size < WS_END) { fprintf(stderr, "kernel_launch: unexpected shapes / workspace (n_in %d, ws %zu, need %zu)\n", n_in, ws_size, (size_t)WS_END); grid = -1; return; }
        if (hipFuncSetAttribute((const void*)fwd_kernel, hipFuncAttributeMaxDynamicSharedMemorySize, LDS_BYTES) != hipSuccess) { fprintf(stderr, "kernel_launch: hipFuncSetAttribute failed\n"); grid = -1; return; }
        (void)hipGetLastError();
        grid = 256;
    }
    if (grid < 0) return;
    if (hipMemsetAsync((char*)d_ws + WS_CTL, 0, CTL_ZERO_BYTES, stream) != hipSuccess) return;
    Args a{};
    const float** pp = (const float**)&a.p;
    for (int i = 0; i < 18; ++i) pp[i] = (const float*)d_in[i];
    a.p.out = (float*)d_out; a.p.ws = (unsigned char*)d_ws;
    a.ph_lo = 0; a.ph_hi = N_PHASES; a.li = 0;
    hipLaunchKernelGGL(fwd_kernel, dim3(grid), dim3(NWAVES * 64), LDS_BYTES, stream, a);
}
```
